# Optimizing an MI355X kernel written in HIP

```python
import math
import jax, jax.numpy as jnp
from jax import lax
import numpy as np

D_MODEL = 1024
BATCH = 8
SEQ = 4096
DEPTH = 4
DEC_BATCH = 16
DEC_SEQ = 64
PAST_LEN = 2048

CHUNK = 64
N_META = 16
D_RNN = D_MODEL
N_RNN_BLOCKS = 8
RNN_BLOCK = D_RNN // N_RNN_BLOCKS
CONV_W = 4
LRU_C = 8.0
N_HEADS = 8
HEAD_DIM = D_MODEL // (2 * N_HEADS)
V_DIM = 2 * HEAD_DIM
QK_W = N_HEADS * 2 * HEAD_DIM
D_ATT = N_HEADS * V_DIM
IN_COLS = 2 * D_RNN + 2 * QK_W + 2 * D_ATT + 2 * D_MODEL
Q_BLOCK = 128
ROPE_THETA = 10000.0
EPS = 1e-6

kernel_name = "hawk_diffattn_gated_stream_step"

F32 = jnp.float32


def rms_norm(x, w):
    xf = x.astype(F32)
    y = xf * lax.rsqrt(jnp.mean(xf * xf, axis=-1, keepdims=True) + EPS)
    return (y * w.astype(F32)).astype(x.dtype)


def rope(x, pos):
    half = HEAD_DIM // 2
    inv = 1.0 / (ROPE_THETA ** (jnp.arange(half, dtype=F32) / half))
    ang = pos.astype(F32)[:, None] * inv[None, :]
    cos = jnp.cos(ang)[None, :, None, None, :]
    sin = jnp.sin(ang)[None, :, None, None, :]
    xf = x.astype(F32)
    x1, x2 = xf[..., :half], xf[..., half:]
    return jnp.concatenate([x1 * cos - x2 * sin, x2 * cos + x1 * sin], axis=-1).astype(x.dtype)


def in_projection(h, norm_w, w_in):
    z = rms_norm(h, norm_w) @ w_in
    parts = []
    off = 0
    for width in (D_RNN, D_RNN, QK_W, QK_W, D_ATT, D_ATT, D_MODEL, D_MODEL):
        parts.append(z[..., off:off + width])
        off += width
    return parts


def causal_conv(x, prefix, conv_w, conv_b):
    T = x.shape[1]
    xp = jnp.concatenate([prefix.astype(x.dtype), x], axis=1)
    y = conv_b + xp[:, 0:T] * conv_w[0]
    for k in range(1, CONV_W):
        y = y + xp[:, k:k + T] * conv_w[k]
    return y, xp[:, -(CONV_W - 1):]


def block_diag(x, w, b):
    B, T, _ = x.shape
    xb = x.reshape(B, T, N_RNN_BLOCKS, RNN_BLOCK)
    return jnp.einsum('btni,nij->btnj', xb, w).reshape(B, T, D_RNN) + b


def rglru_branch(xr, zr, prefix, h0, conv_w, conv_b, w_rg, b_rg, w_ig, b_ig, lru_lambda):
    xc, new_prefix = causal_conv(xr, prefix, conv_w, conv_b)
    r = jax.nn.sigmoid(block_diag(xc, w_rg, b_rg).astype(F32))
    i = jax.nn.sigmoid(block_diag(xc, w_ig, b_ig).astype(F32))
    log_a = -LRU_C * r * jax.nn.softplus(-lru_lambda.astype(F32))
    a = jnp.exp(log_a)
    mult = jnp.sqrt(-jnp.expm1(2.0 * log_a))
    b = mult * i * xc.astype(F32)
    b = b.at[:, 0].add(a[:, 0] * h0.astype(F32))

    def combine(lhs, rhs):
        a1, b1 = lhs
        a2, b2 = rhs
        return a1 * a2, a2 * b1 + b2

    _, hs = lax.associative_scan(combine, (a, b), axis=1)
    out = hs.astype(xr.dtype) * jax.nn.silu(zr)
    return out, new_prefix, hs[:, -1].astype(xr.dtype)


def diff_core(q, k, v, lam, mask):
    s = jnp.einsum('bqhcd,bkhcd->bhcqk', q, k).astype(F32) * (HEAD_DIM ** -0.5)
    if mask is not None:
        s = jnp.where(mask, s, -jnp.inf)
    p = jax.nn.softmax(s, axis=-1)
    attn = p[:, :, 0] - lam * p[:, :, 1]
    return jnp.einsum('bhqk,bkhe->bqhe', attn.astype(v.dtype), v)


def prompt_attention(q, k, v, lam):
    B, T = q.shape[:2]
    S = T - N_META
    pos = jnp.arange(T)
    chunk_id = jnp.where(pos < N_META, 0, (pos - N_META) // CHUNK + 1)
    o_meta = diff_core(q[:, :N_META], k[:, :N_META], v[:, :N_META], lam, None)
    nb = S // Q_BLOCK
    qf = q[:, N_META:].reshape(B, nb, Q_BLOCK, N_HEADS, 2, HEAD_DIM).swapaxes(0, 1)
    qc = chunk_id[N_META:].reshape(nb, Q_BLOCK)

    def one_block(args):
        qb, cb = args
        mask = chunk_id[None, :] <= cb[:, None]
        return diff_core(qb, k, v, lam, mask)

    o_f = lax.map(one_block, (qf, qc))
    o_f = o_f.swapaxes(0, 1).reshape(B, S, N_HEADS, V_DIM)
    return jnp.concatenate([o_meta, o_f], axis=1)


def diff_attn_finish(o, za, subln_w, lam_init):
    o = rms_norm(o, subln_w) * (1.0 - lam_init)
    B, T = o.shape[:2]
    return o.reshape(B, T, D_ATT) * jax.nn.silu(za)


def merge_out(o_rnn, o_att, g_rnn, g_att, w_proj_rnn, w_proj_att, w_out):
    m = jax.nn.sigmoid(g_rnn) * (o_rnn @ w_proj_rnn) + jax.nn.sigmoid(g_att) * (o_att @ w_proj_att)
    return m @ w_out


def setup_inputs(seed: int = 0) -> dict:
    key = jax.random.key(seed)
    ks = jax.random.split(key, 32)

    def nrm(k, shape, scale):
        return jax.random.normal(k, shape, F32) * scale

    u = jax.random.uniform(ks[12], (DEPTH, D_RNN), F32, 0.9, 0.999)
    return {
        "x_prompt": nrm(ks[0], (BATCH, SEQ, D_MODEL), 1.0),
        "x_sample": nrm(ks[1], (DEC_BATCH, DEC_SEQ, D_MODEL), 1.0),
        "cache_k": nrm(ks[2], (DEPTH, DEC_BATCH, PAST_LEN, N_HEADS, 2, HEAD_DIM), 1.0),
        "cache_v": nrm(ks[3], (DEPTH, DEC_BATCH, PAST_LEN, N_HEADS, V_DIM), 1.0),
        "state_conv": nrm(ks[4], (DEPTH, DEC_BATCH, CONV_W - 1, D_RNN), 1.0),
        "state_rnn": nrm(ks[5], (DEPTH, DEC_BATCH, D_RNN), 0.5),
        "meta_tokens": nrm(ks[6], (N_META, D_MODEL), 1.0),
        "norm_w": 1.0 + nrm(ks[7], (DEPTH, D_MODEL), 0.01),
        "w_in": nrm(ks[8], (DEPTH, D_MODEL, IN_COLS), D_MODEL ** -0.5),
        "conv_w": nrm(ks[9], (DEPTH, CONV_W, D_RNN), CONV_W ** -0.5),
        "conv_b": nrm(ks[10], (DEPTH, D_RNN), 0.01),
        "w_rg": nrm(ks[11], (DEPTH, N_RNN_BLOCKS, RNN_BLOCK, RNN_BLOCK), RNN_BLOCK ** -0.5),
        "b_rg": nrm(ks[13], (DEPTH, D_RNN), 0.01),
        "w_ig": nrm(ks[14], (DEPTH, N_RNN_BLOCKS, RNN_BLOCK, RNN_BLOCK), RNN_BLOCK ** -0.5),
        "b_ig": nrm(ks[15], (DEPTH, D_RNN), 0.01),
        "lru_lambda": jnp.log(u) - jnp.log1p(-u),
        "lambda_q1": nrm(ks[16], (DEPTH, HEAD_DIM), 0.1),
        "lambda_k1": nrm(ks[17], (DEPTH, HEAD_DIM), 0.1),
        "lambda_q2": nrm(ks[18], (DEPTH, HEAD_DIM), 0.1),
        "lambda_k2": nrm(ks[19], (DEPTH, HEAD_DIM), 0.1),
        "subln_w": 1.0 + nrm(ks[20], (DEPTH, V_DIM), 0.01),
        "w_proj_rnn": nrm(ks[21], (DEPTH, D_RNN, D_MODEL), D_RNN ** -0.5),
        "w_proj_att": nrm(ks[22], (DEPTH, D_ATT, D_MODEL), D_ATT ** -0.5),
        "w_out": nrm(ks[23], (DEPTH, D_MODEL, D_MODEL), D_MODEL ** -0.5),
        "final_norm_w": 1.0 + nrm(ks[24], (D_MODEL,), 0.01),
    }


def reference(x_prompt, x_sample, cache_k, cache_v, state_conv, state_rnn, meta_tokens,
              norm_w, w_in, conv_w, conv_b, w_rg, b_rg, w_ig, b_ig, lru_lambda,
              lambda_q1, lambda_k1, lambda_q2, lambda_k2, subln_w,
              w_proj_rnn, w_proj_att, w_out, final_norm_w):
    B = x_prompt.shape[0]
    DB, S = x_sample.shape[0], x_sample.shape[1]
    dt = x_prompt.dtype
    hp = jnp.concatenate(
        [jnp.broadcast_to(meta_tokens[None].astype(dt), (B, N_META, D_MODEL)), x_prompt], axis=1)
    hs = x_sample
    Tp = hp.shape[1]
    past = cache_k.shape[2]
    pos_p = jnp.arange(Tp)
    pos_s = N_META + past + jnp.arange(S)

    kp_l, vp_l, cp_l, rp_l = [], [], [], []
    ks_l, vs_l, cs_l, rs_l = [], [], [], []
    for l in range(DEPTH):
        lam_init = 0.8 - 0.6 * math.exp(-0.3 * l)
        lam = (jnp.exp(jnp.sum(lambda_q1[l].astype(F32) * lambda_k1[l].astype(F32)))
               - jnp.exp(jnp.sum(lambda_q2[l].astype(F32) * lambda_k2[l].astype(F32))) + lam_init)
        rnn_args = (conv_w[l], conv_b[l], w_rg[l], b_rg[l], w_ig[l], b_ig[l], lru_lambda[l])

        xr, zr, q, k, v, za, g_r, g_a = in_projection(hp, norm_w[l], w_in[l])
        q = rope(q.reshape(B, Tp, N_HEADS, 2, HEAD_DIM), pos_p)
        k = rope(k.reshape(B, Tp, N_HEADS, 2, HEAD_DIM), pos_p)
        v = v.reshape(B, Tp, N_HEADS, V_DIM)
        o_r, cp, rp = rglru_branch(xr, zr, jnp.zeros((B, CONV_W - 1, D_RNN), dt),
                                   jnp.zeros((B, D_RNN), dt), *rnn_args)
        o_a = diff_attn_finish(prompt_attention(q, k, v, lam), za, subln_w[l], lam_init)
        hp = hp + merge_out(o_r, o_a, g_r, g_a, w_proj_rnn[l], w_proj_att[l], w_out[l])
        kp_l.append(k)
        vp_l.append(v)
        cp_l.append(cp)
        rp_l.append(rp)

        xr, zr, q, k, v, za, g_r, g_a = in_projection(hs, norm_w[l], w_in[l])
        q = rope(q.reshape(DB, S, N_HEADS, 2, HEAD_DIM), pos_s)
        k = rope(k.reshape(DB, S, N_HEADS, 2, HEAD_DIM), pos_s)
        v = v.reshape(DB, S, N_HEADS, V_DIM)
        o_r, cs, rs = rglru_branch(xr, zr, state_conv[l], state_rnn[l], *rnn_args)
        k_all = jnp.concatenate([cache_k[l].astype(k.dtype), k], axis=1)
        v_all = jnp.concatenate([cache_v[l].astype(v.dtype), v], axis=1)
        o_a = diff_attn_finish(diff_core(q, k_all, v_all, lam, None), za, subln_w[l], lam_init)
        hs = hs + merge_out(o_r, o_a, g_r, g_a, w_proj_rnn[l], w_proj_att[l], w_out[l])
        ks_l.append(k)
        vs_l.append(v)
        cs_l.append(cs)
        rs_l.append(rs)

    y_prompt = rms_norm(hp[:, N_META:], final_norm_w)
    y_sample = rms_norm(hs, final_norm_w)
    return (y_prompt, y_sample,
            jnp.stack(kp_l), jnp.stack(vp_l), jnp.stack(cp_l), jnp.stack(rp_l),
            jnp.stack(ks_l), jnp.stack(vs_l), jnp.stack(cs_l), jnp.stack(rs_l))
```

```cpp
#include <hip/hip_runtime.h>
#include <hip/hip_bf16.h>
#include <cstdio>
#include <cstdint>
#include <cmath>

#ifndef MK_PER_PHASE
#define MK_PER_PHASE 1
#endif

constexpr int D = 1024, NB = 8, SEQ = 4096, DEPTH = 4, NDB = 16, DSQ = 64, PAST = 2048, NMETA = 16, NH = 8, INC = 8192;
constexpr int MP = NB * SEQ;
constexpr int MSM = NDB * DSQ;
constexpr int ROW_S = MP, ROW_M = MP + MSM;
constexpr int M = ROW_M + 256;
constexpr int TP = NMETA + SEQ;
constexpr int KPROWS = 64 + SEQ;
constexpr int KSROWS = PAST + DSQ;
constexpr float EPS = 1e-6f;
constexpr float QSCALE = 0.125f * 1.4426950408889634f;

constexpr size_t O_YP = 0, O_YS = 33554432, O_KP = 34603008, O_VP = 169345024, O_CP = 304087040, O_RP = 304185344,
                 O_KS = 304218112, O_VS = 308412416, O_CS = 312606720, O_RS = 312803328, O_END = 312868864;

constexpr size_t MiB = 1u << 20;
constexpr size_t WS_CTL = 0, CTL_ZERO_BYTES = 1 * MiB;
constexpr size_t WS_TCOS = 1 * MiB, WS_TSIN = 2 * MiB;
constexpr size_t WS_MISC = 3 * MiB;
constexpr size_t WS_W = 4 * MiB, W_LAYER = 24 * MiB, W_IN = 0, W_PROJ = 16 * MiB, W_OUT = 20 * MiB, W_G = 22 * MiB;
constexpr size_t WS_HRES = 100 * MiB;
constexpr size_t WS_HB = 233 * MiB;
constexpr size_t WS_SSQ = 300 * MiB;
constexpr size_t WS_XR = 303 * MiB, WS_ZR = 370 * MiB, WS_Q = 437 * MiB, WS_ZA = 504 * MiB, WS_RHO = 571 * MiB, WS_SGA = 638 * MiB;
constexpr size_t WS_OX = 705 * MiB;
constexpr size_t WS_MB = 838 * MiB;
constexpr size_t WS_OP = 905 * MiB;
constexpr size_t WS_KP = 1038 * MiB, WS_VP = 1103 * MiB;
constexpr size_t WS_KS = 1168 * MiB, WS_VS = 1432 * MiB;
constexpr size_t WS_END = 1696 * MiB;
static_assert(WS_HRES + (size_t)M * D * 4 <= WS_HB && WS_HB + (size_t)M * D * 2 <= WS_SSQ && WS_SSQ + (size_t)M * 64 <= WS_XR, "ws map 1");
static_assert(WS_XR + (size_t)M * D * 2 <= WS_ZR && WS_SGA + (size_t)M * D * 2 <= WS_OX && WS_OX + (size_t)M * 4096 <= WS_MB && WS_MB + (size_t)M * 2048 <= WS_OP, "ws map 2");
static_assert(WS_OP + (size_t)M * 4096 <= WS_KP && WS_KP + (size_t)NB * KPROWS * 2048 <= WS_VP && WS_VP + (size_t)NB * KPROWS * 2048 <= WS_KS, "ws map 3");
static_assert(WS_KS + (size_t)DEPTH * NDB * KSROWS * 2048 <= WS_VS && WS_VS + (size_t)DEPTH * NDB * KSROWS * 2048 <= WS_END, "ws map 4");
constexpr int CW_TMO = 0, CW_CODE = 1;
constexpr int CW_QUEUE = 64;
constexpr int CW_BAR = 4096;

namespace pg8 {
#define PG8_LAS __attribute__((address_space(3)))
typedef unsigned short bf16_t;
typedef short bf16x8 __attribute__((ext_vector_type(8)));
typedef float f32x4 __attribute__((ext_vector_type(4)));
typedef unsigned u32x4 __attribute__((ext_vector_type(4)));
typedef unsigned u32x2 __attribute__((ext_vector_type(2)));
constexpr int BM = 256, BK = 64, HALF = 128, HTB = HALF * BK * 2  , STAGE_BYTES = 8 * HTB, NXCD = 8, WGM = 8;

__host__ __device__ __forceinline__ int lds_byte(int r, int c) { const int st = (r >> 4) * 2 + (c >> 5), rr = r & 15, cc = c & 31, ob = rr * 64 + cc * 2; return st * 1024 + (ob ^ (((ob >> 9) & 1) << 5)); }
__host__ __device__ __forceinline__ void stage_rc(int b, int& R, int& C) { const int st = b / 1024, sb = b % 1024, swz = sb ^ (((sb >> 9) & 1) << 5); R = (st >> 1) * 16 + swz / 64; C = (st & 1) * 32 + (swz % 64) / 2; }
__host__ __device__ __forceinline__ int perm32(int rho) { const int n = rho >> 4, i = rho & 15; return 8 * (i >> 2) + 4 * n + (i & 3); }

struct Unit { int pm, pn, kh; };
struct Gemm { const bf16_t* A; const bf16_t* Bt; int ld, kt; };

struct StaticOrder {
    int nM, nN, nwg, G, c;
    __host__ __device__ void init(int M_, int N_, int G_, int c_) { nM = M_ / BM; nN = N_ / BM; nwg = nM * nN; G = G_; c = c_; }
    __host__ __device__ bool next(int i, Unit& u) const {
        const long L = (long)i * G + c; if (L >= nwg) return false;
        int wgid = (int)L; { const int q = nwg / NXCD, r = nwg % NXCD, xcd = wgid % NXCD, off = wgid / NXCD; wgid = (xcd < r ? xcd * (q + 1) : r * (q + 1) + (xcd - r) * q) + off; }
        const int nig = WGM * nN, gid = wgid / nig, fm = gid * WGM, gsz = (nM - fm) < WGM ? (nM - fm) : WGM;
        u.pm = fm + ((wgid % nig) % gsz); u.pn = (wgid % nig) / gsz; u.kh = 0; return true;
    }
    __device__ __forceinline__ void a_ready(const Unit&) const {}
    __device__ __forceinline__ void done(const Unit&) const {}
};
struct TwoPartOrder {
    StaticOrder S;
    __host__ __device__ void init(int M_, int N_, int G_, int c_) { S.init(M_, N_, G_, c_); }
    __host__ __device__ bool next(int i, Unit& u) const { if (!S.next(i >> 1, u)) return false; u.kh = i & 1; return true; }
    __device__ __forceinline__ void a_ready(const Unit&) const {}
    __device__ __forceinline__ void done(const Unit&) const {}
};
__device__ __forceinline__ unsigned cvt_pk_bf16(float lo, float hi) { unsigned r; asm volatile("v_cvt_pk_bf16_f32 %0, %1, %2" : "=v"(r) : "v"(lo), "v"(hi)); return r; }
__device__ __forceinline__ float bf_lo(unsigned w) { return __uint_as_float(w << 16); }
__device__ __forceinline__ float bf_hi(unsigned w) { return __uint_as_float(w & 0xffff0000u); }
__device__ __forceinline__ float sigm(float x) { return __builtin_amdgcn_rcpf(1.0f + __expf(-x)); }
__device__ __forceinline__ u32x4 pack8(const f32x4 a, const f32x4 b) { u32x4 w; w.x = cvt_pk_bf16(a[0], a[1]); w.y = cvt_pk_bf16(a[2], a[3]); w.z = cvt_pk_bf16(b[0], b[1]); w.w = cvt_pk_bf16(b[2], b[3]); return w; }

struct EpiIn {
    static constexpr bool PERM = true, AFTER_DRAIN = false, TWO_PART = false;
    int l; unsigned char* ws; float* out;
    __device__ __forceinline__ void mid(f32x4 (&)[2][2][4][2], const Unit&, int, int, int, int) const {}
    __device__ __forceinline__ void operator()(const f32x4 (&acc)[2][2][4][2], const Unit& u, int wr, int wc, int fr_in, int fq_in) const {
        int fr = fr_in, fq = fq_in; asm volatile("" : "+v"(fr), "+v"(fq));
        const float* ssq = (const float*)(ws + WS_SSQ); const float* tcos = (const float*)(ws + WS_TCOS); const float* tsin = (const float*)(ws + WS_TSIN);
        bf16_t* XR = (bf16_t*)(ws + WS_XR); bf16_t* ZR = (bf16_t*)(ws + WS_ZR); bf16_t* Q = (bf16_t*)(ws + WS_Q); bf16_t* ZA = (bf16_t*)(ws + WS_ZA); bf16_t* RHO = (bf16_t*)(ws + WS_RHO); bf16_t* SGA = (bf16_t*)(ws + WS_SGA);
        bf16_t* KP = (bf16_t*)(ws + WS_KP); bf16_t* VP = (bf16_t*)(ws + WS_VP); bf16_t* KS = (bf16_t*)(ws + WS_KS) + (size_t)l * NDB * KSROWS * D; bf16_t* VS = (bf16_t*)(ws + WS_VS) + (size_t)l * NDB * KSROWS * D;
        const int part = u.pn >> 2, pm = u.pm;
        const int ct = (u.pn & 3) * 256 + wc * 32 + 8 * fq;
        const int a = wc & 1;
#pragma unroll
        for (int ai = 0; ai < 2; ++ai)
#pragma unroll
            for (int m = 0; m < 4; ++m) {
                const int r = ai * HALF + wr * 64 + m * 16 + fr; const size_t grow = (size_t)pm * BM + r;
                const f32x4* sp = (const f32x4*)(ssq + grow * 16); const f32x4 s0 = sp[0], s1 = sp[1], s2 = sp[2], s3 = sp[3];
                const float tot = (((s0[0] + s0[1]) + (s0[2] + s0[3])) + ((s1[0] + s1[1]) + (s1[2] + s1[3]))) + (((s2[0] + s2[1]) + (s2[2] + s2[3])) + ((s3[0] + s3[1]) + (s3[2] + s3[3])));
                const float rs = rsqrtf(tot * (1.0f / 1024.0f) + EPS);
                int pos, nrep = 1; size_t krow, frow; bool valid = true;
                if (pm < 128) { const int b = pm >> 4, t = (pm & 15) * 256 + r; pos = NMETA + t; krow = (size_t)b * KPROWS + 64 + t; frow = (size_t)(l * NB + b) * TP + NMETA + t; }
                else if (pm < 132) { const int idx = (pm - 128) * 256 + r, db = idx >> 6, s = idx & 63; pos = NMETA + PAST + s; krow = (size_t)db * KSROWS + PAST + s; frow = (size_t)(l * NDB + db) * DSQ + s; }
                else { pos = r & 15; krow = (size_t)(r & 15); frow = (size_t)(l * NB) * TP + (r & 15); nrep = NB; valid = r < NMETA; }
                const bool smp = (pm >= 128 && pm < 132);
                if (part == 0) {
                    bf16_t* rowp = XR + grow * D + ct;
#pragma unroll
                    for (int bj = 0; bj < 2; ++bj) { const f32x4 v0 = acc[ai][bj][m][0] * rs, v1 = acc[ai][bj][m][1] * rs; *(u32x4*)(rowp + bj * HALF) = pack8(v0, v1); }
                    if (m == 3 && fr >= 13) {
                        float* dst = nullptr;
                        if (pm < 128) { if ((pm & 15) == 15 && ai == 1 && wr == 1) dst = out + O_CP + ((size_t)(l * NB + (pm >> 4)) * 3 + (fr - 13)) * D; }
                        else if (pm < 132) { const int db = ((pm - 128) * 256 + r) >> 6; dst = out + O_CS + ((size_t)(l * NDB + db) * 3 + (fr - 13)) * D; }
                        if (dst) {
#pragma unroll
                            for (int bj = 0; bj < 2; ++bj) { *(f32x4*)(dst + ct + bj * HALF) = acc[ai][bj][m][0] * rs; *(f32x4*)(dst + ct + bj * HALF + 4) = acc[ai][bj][m][1] * rs; }
                        }
                    }
                } else if (part == 1 || part == 5) {
                    bf16_t* rowp = (part == 1 ? ZR : ZA) + grow * D + ct;
#pragma unroll
                    for (int bj = 0; bj < 2; ++bj) { f32x4 v0 = acc[ai][bj][m][0] * rs, v1 = acc[ai][bj][m][1] * rs;
#pragma unroll
                        for (int e = 0; e < 4; ++e) { v0[e] = v0[e] * sigm(v0[e]); v1[e] = v1[e] * sigm(v1[e]); }
                        *(u32x4*)(rowp + bj * HALF) = pack8(v0, v1); }
                } else if (part == 2 || part == 3) {
                    const size_t ci = (size_t)pos * 32 + 16 * a + 4 * fq; const f32x4 c4 = *(const f32x4*)(tcos + ci), s4 = *(const f32x4*)(tsin + ci);
#pragma unroll
                    for (int bj = 0; bj < 2; ++bj) { const f32x4 x1 = acc[ai][bj][m][0] * rs, x2 = acc[ai][bj][m][1] * rs; const f32x4 o1 = x1 * c4 - x2 * s4, o2 = x2 * c4 + x1 * s4;
                        if (part == 2) { *(u32x4*)(Q + grow * D + ct + bj * HALF) = pack8(o1 * QSCALE, o2 * QSCALE); }
                        else if (valid) {
                            const int oc = 64 * (4 * (u.pn & 3) + 2 * bj + (wc >> 1)) + 16 * a + 4 * fq;
                            const u32x4 w = pack8(o1, o2);
                            bf16_t* kd = (smp ? KS : KP) + krow * D + ct + bj * HALF; float* fd = out + (smp ? O_KS : O_KP) + frow * D + oc;
                            for (int rep = 0; rep < nrep; ++rep) { *(u32x4*)(kd + (size_t)rep * KPROWS * D) = w; *(f32x4*)(fd + (size_t)rep * TP * D) = o1; *(f32x4*)(fd + (size_t)rep * TP * D + 32) = o2; }
                        } }
                } else if (part == 4) {
                    if (valid) {
#pragma unroll
                        for (int bj = 0; bj < 2; ++bj) { const f32x4 v0 = acc[ai][bj][m][0] * rs, v1 = acc[ai][bj][m][1] * rs; const u32x4 w = pack8(v0, v1);
                            bf16_t* vd = (smp ? VS : VP) + krow * D + ct + bj * HALF; float* fd = out + (smp ? O_VS : O_VP) + frow * D + ct + bj * HALF;
                            for (int rep = 0; rep < nrep; ++rep) { *(u32x4*)(vd + (size_t)rep * KPROWS * D) = w; *(f32x4*)(fd + (size_t)rep * TP * D) = v0; *(f32x4*)(fd + (size_t)rep * TP * D + 4) = v1; } }
                    }
                } else {
                    const int gc = 128 * (u.pn - 24) + wc * 32 + 8 * fq;
                    f32x4 rho[2], sga[2];
#pragma unroll
                    for (int n = 0; n < 2; ++n) { const f32x4 gr = acc[ai][0][m][n] * rs, ga = acc[ai][1][m][n] * rs;
#pragma unroll
                        for (int e = 0; e < 4; ++e) { const float er = __expf(-fminf(fmaxf(gr[e], -30.f), 30.f)), ea = __expf(-fminf(fmaxf(ga[e], -30.f), 30.f));
                            rho[n][e] = (1.0f + ea) * __builtin_amdgcn_rcpf(1.0f + er); sga[n][e] = __builtin_amdgcn_rcpf(1.0f + ea); } }
                    *(u32x4*)(RHO + grow * D + gc) = pack8(rho[0], rho[1]); *(u32x4*)(SGA + grow * D + gc) = pack8(sga[0], sga[1]);
                }
                asm volatile("" ::: "memory");
            }
    }
};

struct EpiProj {
    static constexpr bool PERM = true, AFTER_DRAIN = false, TWO_PART = true;
    unsigned char* ws;
    __device__ __forceinline__ void mid(f32x4 (&acc)[2][2][4][2], const Unit& u, int wr, int wc, int fr_in, int fq_in) const {
        int fr = fr_in, fq = fq_in; asm volatile("" : "+v"(fr), "+v"(fq));
        const bf16_t* RHO = (const bf16_t*)(ws + WS_RHO);
        const int c0 = u.pn * BM + wc * 32 + 8 * fq;
#pragma unroll
        for (int ai = 0; ai < 2; ++ai)
#pragma unroll
            for (int m = 0; m < 4; ++m) { const size_t grow = (size_t)u.pm * BM + ai * HALF + wr * 64 + m * 16 + fr;
#pragma unroll
                for (int bj = 0; bj < 2; ++bj) { const u32x4 w = *(const u32x4*)(RHO + grow * D + c0 + bj * HALF);
                    acc[ai][bj][m][0] *= (f32x4){bf_lo(w.x), bf_hi(w.x), bf_lo(w.y), bf_hi(w.y)}; acc[ai][bj][m][1] *= (f32x4){bf_lo(w.z), bf_hi(w.z), bf_lo(w.w), bf_hi(w.w)}; }
                if (m & 1) asm volatile("" ::: "memory"); }
    }
    __device__ __forceinline__ void operator()(const f32x4 (&acc)[2][2][4][2], const Unit& u, int wr, int wc, int fr_in, int fq_in) const {
        int fr = fr_in, fq = fq_in; asm volatile("" : "+v"(fr), "+v"(fq));
        const bf16_t* SGA = (const bf16_t*)(ws + WS_SGA); bf16_t* MB = (bf16_t*)(ws + WS_MB);
        const int c0 = u.pn * BM + wc * 32 + 8 * fq;
#pragma unroll
        for (int ai = 0; ai < 2; ++ai)
#pragma unroll
            for (int m = 0; m < 4; ++m) { const size_t grow = (size_t)u.pm * BM + ai * HALF + wr * 64 + m * 16 + fr;
#pragma unroll
                for (int bj = 0; bj < 2; ++bj) { const u32x4 w = *(const u32x4*)(SGA + grow * D + c0 + bj * HALF);
                    const f32x4 v0 = acc[ai][bj][m][0] * (f32x4){bf_lo(w.x), bf_hi(w.x), bf_lo(w.y), bf_hi(w.y)}, v1 = acc[ai][bj][m][1] * (f32x4){bf_lo(w.z), bf_hi(w.z), bf_lo(w.w), bf_hi(w.w)};
                    *(u32x4*)(MB + grow * D + c0 + bj * HALF) = pack8(v0, v1); }
                if (m & 1) asm volatile("" ::: "memory"); }
    }
};

struct EpiOut {
    static constexpr bool PERM = false, AFTER_DRAIN = false, TWO_PART = false;
    unsigned char* ws;
    __device__ __forceinline__ void mid(f32x4 (&)[2][2][4][2], const Unit&, int, int, int, int) const {}
    __device__ __forceinline__ void operator()(const f32x4 (&acc)[2][2][4][2], const Unit& u, int wr, int wc, int fr_in, int fq_in) const {
        int fr = fr_in, fq = fq_in; asm volatile("" : "+v"(fr), "+v"(fq));
        float* HRES = (float*)(ws + WS_HRES); bf16_t* HB = (bf16_t*)(ws + WS_HB); float* ssq = (float*)(ws + WS_SSQ);
        const int c0 = u.pn * BM + wc * 32 + 4 * fq;
#pragma unroll
        for (int ai = 0; ai < 2; ++ai)
#pragma unroll
            for (int m = 0; m < 4; ++m) { const size_t grow = (size_t)u.pm * BM + ai * HALF + wr * 64 + m * 16 + fr; float ss = 0.f;
#pragma unroll
                for (int bj = 0; bj < 2; ++bj)
#pragma unroll
                    for (int n = 0; n < 2; ++n) { const size_t off = grow * D + c0 + bj * HALF + n * 16; const f32x4 hv = *(const f32x4*)(HRES + off) + acc[ai][bj][m][n];
                        *(f32x4*)(HRES + off) = hv; u32x2 w; w.x = cvt_pk_bf16(hv[0], hv[1]); w.y = cvt_pk_bf16(hv[2], hv[3]); *(u32x2*)(HB + off) = w;
                        ss += (hv[0] * hv[0] + hv[1] * hv[1]) + (hv[2] * hv[2] + hv[3] * hv[3]); }
                ss += __shfl_xor(ss, 16); ss += __shfl_xor(ss, 32);
                if (fq == 0) ssq[grow * 16 + u.pn * 4 + wc] = ss;
                asm volatile("" ::: "memory"); }
    }
};
template <class Epi, class Sched, bool ALIGN_EPI = false, bool SP2 = false>
__device__ __forceinline__ void gemm_phase(PG8_LAS unsigned char* lds, const Gemm g, const Sched& S, const Epi& E) {
    int tid_o = threadIdx.x; asm volatile("" : "+v"(tid_o));
    const int tid = tid_o, wid = __builtin_amdgcn_readfirstlane(tid >> 6), lane = tid & 63, wr = wid >> 2, wc = wid & 3, fr = lane & 15, fq = lane >> 4;
    const int K = g.ld, nt = g.kt / BK; const size_t khb = (size_t)g.kt * 2;
    unsigned voffA[2], voffB[2];
#pragma unroll
    for (int i = 0; i < 2; ++i) { int R, C; stage_rc(tid * 16 + i * 8192, R, C); const int Rb = Epi::PERM ? ((R & ~31) + perm32(R & 31)) : R;
        voffA[i] = (unsigned)(R * K + C) * 2u; voffB[i] = (unsigned)(Rb * K + C) * 2u; }
    const size_t kstep = (size_t)(BK * 2);
    const size_t hstep = (size_t)HALF * K * 2;
    const size_t tstep = 2 * hstep;
    const unsigned ldsw = (unsigned)wid * 1024u;
    const int aoff = lds_byte(wr * 64 + fr, fq * 8), boff = lds_byte(wc * 32 + fr, fq * 8);
#define PG8_SA(b, h) (((b) * 2 + (h)) * HTB)
#define PG8_SB(b, h) ((4 + (b) * 2 + (h)) * HTB)
#define PG8_STAGE(bufoff, gbase, voff) do { _Pragma("unroll") for (int _i = 0; _i < 2; ++_i) \
        __builtin_amdgcn_global_load_lds((const unsigned*)((const char*)(gbase) + (voff)[_i]), (PG8_LAS unsigned*)(lds + (bufoff) + ldsw + _i * 8192), 16, 0, 0); } while (0)
#define PG8_LDA(dst, b, h) do { _Pragma("unroll") for (int m = 0; m < 4; ++m) _Pragma("unroll") for (int k = 0; k < 2; ++k) dst[m][k] = *(const PG8_LAS bf16x8*)(lds + PG8_SA(b, h) + aoff + m * 2048 + k * 1024); } while (0)
#define PG8_LDB(dst, b, h) do { _Pragma("unroll") for (int n = 0; n < 2; ++n) _Pragma("unroll") for (int k = 0; k < 2; ++k) dst[n][k] = *(const PG8_LAS bf16x8*)(lds + PG8_SB(b, h) + boff + n * 2048 + k * 1024); } while (0)
#define PG8_MMA(ai, bj, At, Bt) do { __builtin_amdgcn_s_setprio(1); _Pragma("unroll") for (int m = 0; m < 4; ++m) _Pragma("unroll") for (int n = 0; n < 2; ++n) _Pragma("unroll") for (int k = 0; k < 2; ++k) \
        acc[ai][bj][m][n] = __builtin_amdgcn_mfma_f32_16x16x32_bf16(Bt[n][k], At[m][k], acc[ai][bj][m][n], 0, 0, 0); __builtin_amdgcn_s_setprio(0); } while (0)
#define PG8_WAIT_V(n) asm volatile("s_waitcnt vmcnt(" #n ")" ::: "memory")
#define PG8_WAIT_L(n) asm volatile("s_waitcnt lgkmcnt(" #n ")" ::: "memory")
#define PG8_BAR __builtin_amdgcn_s_barrier()
#define PG8_SCHED __builtin_amdgcn_sched_barrier(0)
    Unit cur, nxt; int ui = 0;
    if (!S.next(0, cur)) return;
    f32x4 acc[2][2][4][2];
#pragma unroll
    for (int a = 0; a < 2; ++a)
#pragma unroll
        for (int b = 0; b < 2; ++b)
#pragma unroll
            for (int m = 0; m < 4; ++m)
#pragma unroll
                for (int n = 0; n < 2; ++n) acc[a][b][m][n] = (f32x4){0.f, 0.f, 0.f, 0.f};
    bf16x8 At[4][2], B0[2][2], B1[2][2];
    const char* cA = (const char*)g.A + (size_t)cur.pm * tstep + (size_t)cur.kh * khb; const char* cB = (const char*)g.Bt + (size_t)cur.pn * tstep + (size_t)cur.kh * khb;
    S.a_ready(cur);
    if constexpr (SP2) {
        PG8_STAGE(PG8_SB(0, 0), cB, voffB); PG8_STAGE(PG8_SB(0, 1), cB + hstep, voffB); PG8_STAGE(PG8_SA(0, 0), cA, voffA); PG8_STAGE(PG8_SA(0, 1), cA + hstep, voffA);
        if (wr == 1) PG8_BAR;
        PG8_WAIT_V(2); PG8_BAR;
        PG8_STAGE(PG8_SB(1, 0), cB + kstep, voffB); PG8_STAGE(PG8_SA(1, 0), cA + kstep, voffA); PG8_STAGE(PG8_SB(1, 1), cB + hstep + kstep, voffB);
        PG8_WAIT_V(6); PG8_BAR;
    } else {
        PG8_STAGE(PG8_SB(0, 0), cB, voffB); PG8_STAGE(PG8_SA(0, 0), cA, voffA); PG8_STAGE(PG8_SB(0, 1), cB + hstep, voffB); PG8_STAGE(PG8_SA(0, 1), cA + hstep, voffA);
        if (wr == 1) PG8_BAR;
        PG8_WAIT_V(4); PG8_BAR;
        PG8_STAGE(PG8_SB(1, 0), cB + kstep, voffB); PG8_STAGE(PG8_SA(1, 0), cA + kstep, voffA); PG8_STAGE(PG8_SB(1, 1), cB + hstep + kstep, voffB);
        PG8_WAIT_V(6); PG8_BAR;
    }
    for (;;) {
        const bool has_next = S.next(ui + 1, nxt);
        const char* nA = has_next ? (const char*)g.A + (size_t)nxt.pm * tstep + (size_t)nxt.kh * khb : cA; const char* nB = has_next ? (const char*)g.Bt + (size_t)nxt.pn * tstep + (size_t)nxt.kh * khb : cB;
        for (int t = 0; t < nt; t += 2) {
            const bool last = (t == nt - 2);
            const char* a1 = cA + (size_t)(t + 1) * kstep;
            const char* a2 = last ? nA : cA + (size_t)(t + 2) * kstep; const char* b2 = last ? nB : cB + (size_t)(t + 2) * kstep;
            const char* a3 = a2 + kstep; const char* b3 = b2 + kstep;
            if (last && has_next) S.a_ready(nxt);
            if constexpr (SP2) {
            PG8_LDB(B0, 0, 0); PG8_LDB(B1, 0, 1); PG8_SCHED; PG8_LDA(At, 0, 0); PG8_STAGE(PG8_SA(1, 1), a1 + hstep, voffA);
            PG8_WAIT_V(8); PG8_WAIT_L(0); PG8_BAR; PG8_MMA(0, 0, At, B0); PG8_MMA(0, 1, At, B1); PG8_BAR; PG8_SCHED;
            PG8_LDA(At, 0, 1); PG8_STAGE(PG8_SB(0, 0), b2, voffB); PG8_STAGE(PG8_SB(0, 1), b2 + hstep, voffB); PG8_STAGE(PG8_SA(0, 0), a2, voffA);
            PG8_WAIT_V(8); PG8_WAIT_L(0); PG8_BAR; PG8_MMA(1, 0, At, B0); PG8_MMA(1, 1, At, B1); PG8_BAR; PG8_SCHED;
            PG8_LDB(B0, 1, 0); PG8_LDB(B1, 1, 1); PG8_SCHED; PG8_LDA(At, 1, 0); PG8_STAGE(PG8_SA(0, 1), a2 + hstep, voffA);
            PG8_WAIT_V(8); PG8_WAIT_L(0); PG8_BAR; PG8_MMA(0, 0, At, B0); PG8_MMA(0, 1, At, B1); PG8_BAR; PG8_SCHED;
            PG8_LDA(At, 1, 1); PG8_STAGE(PG8_SB(1, 0), b3, voffB); PG8_STAGE(PG8_SB(1, 1), b3 + hstep, voffB); PG8_STAGE(PG8_SA(1, 0), a3, voffA);
            PG8_WAIT_V(8); PG8_WAIT_L(0); PG8_BAR; PG8_MMA(1, 0, At, B0); PG8_MMA(1, 1, At, B1); PG8_BAR; PG8_SCHED;
            } else {
            PG8_LDB(B0, 0, 0); PG8_SCHED; PG8_LDA(At, 0, 0); PG8_STAGE(PG8_SA(1, 1), a1 + hstep, voffA);
            PG8_WAIT_L(8); PG8_BAR; PG8_WAIT_L(0); PG8_MMA(0, 0, At, B0); PG8_BAR; PG8_SCHED;
            PG8_LDB(B1, 0, 1); PG8_STAGE(PG8_SB(0, 0), b2, voffB);
            PG8_BAR; PG8_WAIT_L(0); PG8_MMA(0, 1, At, B1); PG8_BAR;
            PG8_LDA(At, 0, 1); PG8_STAGE(PG8_SA(0, 0), a2, voffA);
            PG8_BAR; PG8_WAIT_L(0); PG8_MMA(1, 0, At, B0); PG8_BAR; PG8_SCHED;
            PG8_STAGE(PG8_SB(0, 1), b2 + hstep, voffB);
            PG8_WAIT_V(6); PG8_BAR; PG8_MMA(1, 1, At, B1); PG8_BAR;
            PG8_LDB(B0, 1, 0); PG8_SCHED; PG8_LDA(At, 1, 0); PG8_STAGE(PG8_SA(0, 1), a2 + hstep, voffA);
            PG8_WAIT_L(8); PG8_BAR; PG8_WAIT_L(0); PG8_MMA(0, 0, At, B0); PG8_BAR; PG8_SCHED;
            PG8_LDB(B1, 1, 1); PG8_STAGE(PG8_SB(1, 0), b3, voffB);
            PG8_BAR; PG8_WAIT_L(0); PG8_MMA(0, 1, At, B1); PG8_BAR;
            PG8_LDA(At, 1, 1); PG8_STAGE(PG8_SA(1, 0), a3, voffA);
            PG8_BAR; PG8_WAIT_L(0); PG8_MMA(1, 0, At, B0); PG8_BAR; PG8_SCHED;
            PG8_STAGE(PG8_SB(1, 1), b3 + hstep, voffB);
            PG8_WAIT_V(6); PG8_BAR; PG8_MMA(1, 1, At, B1); PG8_BAR;
            }
        }
        if constexpr (ALIGN_EPI) { if (wr == 0) PG8_BAR; }
        bool keep = false;
        if constexpr (Epi::TWO_PART) { if (cur.kh == 0) { E.mid(acc, cur, wr, wc, fr, fq); keep = true; } else { E(acc, cur, wr, wc, fr, fq); } } else { E(acc, cur, wr, wc, fr, fq); }
        S.done(cur);
        if (!has_next) break;
        if (!keep) {
#pragma unroll
        for (int a = 0; a < 2; ++a)
#pragma unroll
            for (int b = 0; b < 2; ++b)
#pragma unroll
                for (int m = 0; m < 4; ++m)
#pragma unroll
                    for (int n = 0; n < 2; ++n) acc[a][b][m][n] = (f32x4){0.f, 0.f, 0.f, 0.f};
        }
        cur = nxt; cA = nA; cB = nB; ++ui;
        if constexpr (ALIGN_EPI) { if (wr == 1) PG8_BAR; }
    }
    PG8_WAIT_V(0);
    if constexpr (!ALIGN_EPI) { if (wr == 0) PG8_BAR; }
    PG8_BAR;
#undef PG8_SA
#undef PG8_SB
#undef PG8_STAGE
#undef PG8_LDA
#undef PG8_LDB
#undef PG8_MMA
#undef PG8_WAIT_V
#undef PG8_WAIT_L
#undef PG8_BAR
#undef PG8_SCHED
}
}

#include <hip/hip_bf16.h>
#include <cmath>
namespace attn_body {
using bf16=__hip_bfloat16;
using bf16x8=__attribute__((ext_vector_type(8)))short;
using s16x4=__attribute__((ext_vector_type(4)))short;
using f32x16=__attribute__((ext_vector_type(16)))float;
using u32x4=__attribute__((ext_vector_type(4)))unsigned;
constexpr int D=64,DM=1024,OPITCH=2048;
constexpr int NW=8,QBLK=32,QB=QBLK*NW,KVBLK=64;
constexpr int ATTN_PITCH=DM, ATTN_UNIT_ROWS=QB;
__device__ __forceinline__ int crow(int r,int hi){return (r&3)+8*(r>>2)+4*hi;}
#define SBAR() __builtin_amdgcn_sched_barrier(0)
__device__ __forceinline__ void cmask(f32x16&p0,f32x16&p1,int jb,int qrel,int hi){
  const float NEG=-INFINITY; int kb=64*jb+4*hi;
  #pragma unroll
  for(int r=0;r<16;++r){int kv=kb+(r&3)+8*(r>>2); if(kv>qrel)p0[r]=NEG; if(kv+32>qrel)p1[r]=NEG;}
}

constexpr int NSLOT=3, SLOTB=8192;
constexpr int LDS_K=0, LDS_V=NSLOT*SLOTB, LDS_WS=2*NSLOT*SLOTB, LDS_OST=LDS_WS+NW*64*4, LDS_BYTES=LDS_OST+NW*4096;
constexpr float C2=0.125f*1.4426950408889634f;
__device__ __forceinline__ void glds16(const void*gsrc,unsigned lds_dst){unsigned keep;
  asm volatile("s_mov_b32 %0, m0\n\ts_mov_b32 m0, %2\n\ts_nop 0\n\tglobal_load_lds_dwordx4 %1, off\n\ts_mov_b32 m0, %0":"=&s"(keep):"v"(gsrc),"s"(lds_dst):"memory");}
__device__ __forceinline__ float max3f(float a,float b,float c){float r;asm("v_max3_f32 %0, %1, %2, %3":"=v"(r):"v"(a),"v"(b),"v"(c));return r;}
__device__ __forceinline__ float max2f(float a,float b){float r;asm("v_max_f32_e32 %0, %1, %2":"=v"(r):"v"(a),"v"(b));return r;}
__device__ __forceinline__ float fadd_s(float a,float b){float r;asm("v_add_f32_e32 %0, %1, %2":"=v"(r):"v"(a),"v"(b));return r;}
__device__ __forceinline__ float fsub_s(float a,float b){float r;asm("v_sub_f32_e32 %0, %1, %2":"=v"(r):"v"(a),"v"(b));return r;}
typedef float f32x2_t __attribute__((ext_vector_type(2))); typedef __bf16 bf16x2_t __attribute__((ext_vector_type(2)));
__device__ __forceinline__ unsigned cvtpk_s(float lo,float hi){f32x2_t v={lo,hi};bf16x2_t b=__builtin_convertvector(v,bf16x2_t);return __builtin_bit_cast(unsigned,b);}
#define WAIT_BAR(N) asm volatile("s_waitcnt vmcnt(" #N ") lgkmcnt(0)\n\ts_barrier":::"memory")

__device__ __forceinline__ void qkt(f32x16&p0,f32x16&p1,const char*Kslot,const bf16x8*qr,const f32x16&negm,int r32,int hi){
  const char*kb=Kslot+hi*1024+r32*16;
  #pragma unroll
  for(int d0=0;d0<4;++d0){
    const bf16x8 b0=*reinterpret_cast<const bf16x8*>(kb+d0*2048);
    const bf16x8 b1=*reinterpret_cast<const bf16x8*>(kb+d0*2048+512);
    if(d0==0){p0=__builtin_amdgcn_mfma_f32_32x32x16_bf16(b0,qr[0],negm,0,0,0);p1=__builtin_amdgcn_mfma_f32_32x32x16_bf16(b1,qr[0],negm,0,0,0);}
    else{p0=__builtin_amdgcn_mfma_f32_32x32x16_bf16(b0,qr[d0],p0,0,0,0);p1=__builtin_amdgcn_mfma_f32_32x32x16_bf16(b1,qr[d0],p1,0,0,0);}}
}
typedef __attribute__((address_space(3))) const char* lds_cptr;
typedef short v4i16_t __attribute__((ext_vector_type(4)));
__device__ __forceinline__ void kload8(bf16x8*kf,lds_cptr kp){
  kf[0]=*(const __attribute__((address_space(3))) bf16x8*)(kp);      kf[1]=*(const __attribute__((address_space(3))) bf16x8*)(kp+512);
  kf[2]=*(const __attribute__((address_space(3))) bf16x8*)(kp+2048); kf[3]=*(const __attribute__((address_space(3))) bf16x8*)(kp+2560);
  kf[4]=*(const __attribute__((address_space(3))) bf16x8*)(kp+4096); kf[5]=*(const __attribute__((address_space(3))) bf16x8*)(kp+4608);
  kf[6]=*(const __attribute__((address_space(3))) bf16x8*)(kp+6144); kf[7]=*(const __attribute__((address_space(3))) bf16x8*)(kp+6656);
}
__device__ __forceinline__ void kload2(bf16x8*kf,lds_cptr kp,int j){ kf[2*j]=*(const __attribute__((address_space(3))) bf16x8*)(kp+j*2048); kf[2*j+1]=*(const __attribute__((address_space(3))) bf16x8*)(kp+j*2048+512); }
__device__ __forceinline__ s16x4 vtr(lds_cptr p){ return __builtin_bit_cast(s16x4,__builtin_amdgcn_ds_read_tr16_b64_v4i16((__attribute__((address_space(3))) v4i16_t*)p)); }
__device__ __forceinline__ float rowmax(const f32x16&p0,const f32x16&p1){
  float a=max3f(p0[0],p0[1],p1[0]),b=max3f(p0[2],p0[3],p1[1]);a=max3f(a,p1[2],p1[3]);
  #pragma unroll
  for(int r=4;r<16;r+=4){a=max3f(a,p0[r],p0[r+1]);b=max3f(b,p0[r+2],p0[r+3]);a=max3f(a,p1[r],p1[r+1]);b=max3f(b,p1[r+2],p1[r+3]);}
  const float m=max2f(a,b);
  auto rr=__builtin_amdgcn_permlane32_swap(__float_as_uint(m),__float_as_uint(m),false,false);
  return max2f(__uint_as_float(rr[0]),__uint_as_float(rr[1]));
}
__device__ __forceinline__ void pv(f32x16*o,int vb,bf16x8 pa0,bf16x8 pa1,bf16x8 pa2,bf16x8 pa3){
  #pragma unroll
  for(int d0=0;d0<2;++d0){s16x4 lo[4],hi[4];
    #pragma unroll
    for(int ks=0;ks<4;++ks){
      asm volatile("ds_read_b64_tr_b16 %0,%1 offset:%c2":"=&v"(lo[ks]):"v"(vb),"i"(d0*4096+ks*1024):"memory");
      asm volatile("ds_read_b64_tr_b16 %0,%1 offset:%c2":"=&v"(hi[ks]):"v"(vb),"i"(d0*4096+ks*1024+512):"memory");}
    asm volatile("s_waitcnt lgkmcnt(0)":::"memory");SBAR();
    #define PK(k) (bf16x8){lo[k][0],lo[k][1],lo[k][2],lo[k][3],hi[k][0],hi[k][1],hi[k][2],hi[k][3]}
    o[d0]=__builtin_amdgcn_mfma_f32_32x32x16_bf16(pa0,PK(0),o[d0],0,0,0);
    o[d0]=__builtin_amdgcn_mfma_f32_32x32x16_bf16(pa1,PK(1),o[d0],0,0,0);
    o[d0]=__builtin_amdgcn_mfma_f32_32x32x16_bf16(pa2,PK(2),o[d0],0,0,0);
    o[d0]=__builtin_amdgcn_mfma_f32_32x32x16_bf16(pa3,PK(3),o[d0],0,0,0);
    #undef PK
  }
}

#ifndef ATTN_STORE16
#define ATTN_STORE16(p,v) (*(u32x4*)(p)=(v))
#endif
template<int THRL,bool MASKED> __device__ __forceinline__ void attn_unit(const bf16*Qin,const bf16*__restrict__ Kh,const bf16*__restrict__ Vh,bf16*Oin,const int NT,const int vis,const int qwaves,char*shm){
  int tid_o=threadIdx.x; asm volatile("":"+v"(tid_o));
  const int tid=tid_o,lane=tid&63,r32=lane&31,hi=lane>>5; const int wid=__builtin_amdgcn_readfirstlane(tid>>6);
  const bf16*Qw=Qin+(long)((wid&(qwaves-1))*QBLK)*DM;
  const unsigned lds0=(unsigned)(uintptr_t)shm;
  float*wsf=(float*)(shm+LDS_WS)+wid*64;
  const bf16*ksrc=Kh+(long)lane*DM+wid*8;
  const bf16*vsrc=Vh+(long)(16*(wid&3)+(lane>>2))*DM+(wid>>2)*32+(lane&3)*8;
  const unsigned kdst=lds0+LDS_K+wid*1024, vdst=lds0+LDS_V+wid*1024;
  #define DMA_K(t,slot) glds16(ksrc+(long)(t)*KVBLK*DM,(unsigned)__builtin_amdgcn_readfirstlane(kdst+(slot)))
  #define DMA_V(t,slot) glds16(vsrc+(long)(t)*KVBLK*DM,(unsigned)__builtin_amdgcn_readfirstlane(vdst+(slot)))
  const int vb0=(int)(lds0+LDS_V)+((lane>>4)&1)*32+(lane&3)*8+(4*hi+((lane&15)>>2))*64;
  const char*Kbase=shm+LDS_K; bf16x8 kf[8];
  const lds_cptr shm3=(lds_cptr)shm; const lds_cptr kp0=shm3+LDS_K+hi*1024+r32*16; const lds_cptr vp0=shm3+LDS_V+((lane>>4)&1)*32+(lane&3)*8+(4*hi+((lane&15)>>2))*64;
  DMA_K(0,0);DMA_V(0,0);DMA_K(1,SLOTB);
  bf16x8 qr[4];
  #pragma unroll
  for(int d0=0;d0<4;++d0)qr[d0]=*reinterpret_cast<const bf16x8*>(&Qw[(long)r32*DM+d0*16+hi*8]);
  float mhat=0.f,l_reg=0.f;f32x16 o[2];o[0]=f32x16{};o[1]=f32x16{};f32x16 negm=f32x16{};asm volatile("":"+v"(negm));
  #define CMASK(P0,P1,t) do{ if(MASKED){ const int jb_=(t)-(NT-4); if(jb_>=vis){ _Pragma("unroll") for(int r_=0;r_<16;++r_){P0[r_]=-INFINITY;P1[r_]=-INFINITY;} } } }while(0)
  bool resc=false;
  #define START(P0,P1) do{ const float rm=rowmax(P0,P1); resc=false; \
    { const float dl=rm; mhat=fadd_s(mhat,dl); \
      _Pragma("unroll") for(int r=0;r<16;++r){P0[r]=fsub_s(P0[r],dl);P1[r]=fsub_s(P1[r],dl);} \
      _Pragma("unroll") for(int r=0;r<16;++r)negm[r]=-mhat; asm volatile("":"+v"(negm)); } \
    _Pragma("unroll") for(int r=0;r<16;++r)P0[r]=__builtin_amdgcn_exp2f(P0[r]); }while(0)
  #define RESC() do{ if(resc){ asm volatile("s_waitcnt lgkmcnt(0)":::"memory"); \
      _Pragma("unroll") for(int d_=0;d_<2;++d_) _Pragma("unroll") for(int r=0;r<16;++r)o[d_][r]*=wsf[crow(r,hi)]; } }while(0)
  f32x16 pA0,pA1,pB0,pB1;
  int sl_prev=0,sl_cur=0,sl_next=SLOTB;
  #define ROT() do{sl_prev=sl_cur;sl_cur=sl_next;sl_next=(sl_next==(NSLOT-1)*SLOTB)?0:sl_next+SLOTB;}while(0)
  DMA_K(2,2*SLOTB);
  WAIT_BAR(3);
  qkt(pA0,pA1,Kbase,qr,negm,r32,hi);asm volatile("s_nop 15\n\ts_nop 7":"+v"(pA0),"+v"(pA1));
  if(MASKED){ _Pragma("unroll") for(int r_=8;r_<16;++r_)pA0[r_]=-INFINITY; _Pragma("unroll") for(int r_=0;r_<16;++r_)pA1[r_]=-INFINITY; }
  START(pA0,pA1);
  _Pragma("unroll") for(int r=0;r<16;++r)pA1[r]=__builtin_amdgcn_exp2f(pA1[r]);
  WAIT_BAR(0);
  DMA_K(3,0);DMA_V(1,SLOTB);
  ROT();
  kload8(kf,kp0+sl_cur);
  WAIT_BAR(2);
  s16x4 vlo[8],vhi[8]; u32x4 pw0,pw1,pw2,pw3;
  #define PKW(P,B) cvtpk_s(P[B],P[B+1])
  #define PAF(k) __builtin_bit_cast(bf16x8,pw##k)
  #define VFR(i) (bf16x8){vlo[i][0],vlo[i][1],vlo[i][2],vlo[i][3],vhi[i][0],vhi[i][1],vhi[i][2],vhi[i][3]}
  #define PIN(x) asm volatile("":"+v"(x))
  #define MX3(a,b,c) __builtin_fmaxf(__builtin_fmaxf((a),(b)),(c))
  #define GAPA(MF,A0,A1,A2,A3,W0,W1,PW) do{ MF; sacc+=A0; sacc+=A1; sacc+=A2; sacc+=A3; PIN(sacc); W0; W1; PIN(PW); SBAR(); }while(0)
  #define EX(v) __builtin_amdgcn_exp2f(v)
  #define GAPB(MF,X,B) do{ MF; X[B]=EX(X[B]); X[B+1]=EX(X[B+1]); X[B+2]=EX(X[B+2]); X[B+3]=EX(X[B+3]); PIN(X); SBAR(); }while(0)
  #define VRD(i) do{ vlo[i]=vtr(vp_+(((i)>>2)*4096+((i)&3)*1024)); vhi[i]=vtr(vp_+(((i)>>2)*4096+((i)&3)*1024+512)); }while(0)
  #define KRD(G,j) do{ if(G){ kload2(kf,kp0+sl_next,j); SBAR(); } }while(0)
  #define STEP(C0,C1,P0,P1,t,GK,GV,GL) do{ SBAR(); \
    const lds_cptr vp_=vp0+sl_prev; \
    VRD(0); SBAR(); float sacc=(P0[0]+P0[1]); \
    GAPA(C0=__builtin_amdgcn_mfma_f32_32x32x16_bf16(kf[0],qr[0],negm,0,0,0), P0[2],P0[3],P0[4],P0[5],     pw0[0]=PKW(P0,0), pw0[1]=PKW(P0,2), pw0); \
    VRD(4); SBAR(); GAPA(C1=__builtin_amdgcn_mfma_f32_32x32x16_bf16(kf[1],qr[0],negm,0,0,0), P0[6],P0[7],P0[8],P0[9],     pw0[2]=PKW(P0,4), pw0[3]=PKW(P0,6), pw0); \
    VRD(1); SBAR(); GAPA(C0=__builtin_amdgcn_mfma_f32_32x32x16_bf16(kf[2],qr[1],C0,0,0,0),   P0[10],P0[11],P0[12],P0[13], pw1[0]=PKW(P0,8), pw1[1]=PKW(P0,10), pw1); \
    VRD(5); SBAR(); GAPA(C1=__builtin_amdgcn_mfma_f32_32x32x16_bf16(kf[3],qr[1],C1,0,0,0),   P0[14],P0[15],P1[0],P1[1],   pw1[2]=PKW(P0,12),pw1[3]=PKW(P0,14), pw1); \
    VRD(2); SBAR(); GAPA(C0=__builtin_amdgcn_mfma_f32_32x32x16_bf16(kf[4],qr[2],C0,0,0,0),   P1[2],P1[3],P1[4],P1[5],     pw2[0]=PKW(P1,0), pw2[1]=PKW(P1,2), pw2); \
    VRD(6); SBAR(); GAPA(C1=__builtin_amdgcn_mfma_f32_32x32x16_bf16(kf[5],qr[2],C1,0,0,0),   P1[6],P1[7],P1[8],P1[9],     pw2[2]=PKW(P1,4), pw2[3]=PKW(P1,6), pw2); \
    VRD(3); SBAR(); GAPA(C0=__builtin_amdgcn_mfma_f32_32x32x16_bf16(kf[6],qr[3],C0,0,0,0),   P1[10],P1[11],P1[12],P1[13], pw3[0]=PKW(P1,8), pw3[1]=PKW(P1,10), pw3); \
    VRD(7); SBAR(); GAPA(C1=__builtin_amdgcn_mfma_f32_32x32x16_bf16(kf[7],qr[3],C1,0,0,0),   P1[14],P1[15],0.f,0.f,       pw3[2]=PKW(P1,12),pw3[3]=PKW(P1,14), pw3); \
    l_reg+=sacc; \
    if(GK){DMA_K((t)+3,sl_cur);} if(GV){DMA_V((t)+1,sl_next);} \
    CMASK(C0,C1,t); \
    { float a=MX3(C0[0],C0[1],C1[0]),b=MX3(C0[2],C0[3],C1[1]); a=MX3(a,C1[2],C1[3]); \
      _Pragma("unroll") for(int r=4;r<16;r+=4){a=MX3(a,C0[r],C0[r+1]);b=MX3(b,C0[r+2],C0[r+3]);a=MX3(a,C1[r],C1[r+1]);b=MX3(b,C1[r+2],C1[r+3]);} \
      float rm=__builtin_fmaxf(a,b); { auto rr=__builtin_amdgcn_permlane32_swap(__float_as_uint(rm),__float_as_uint(rm),false,false); rm=__builtin_fmaxf(__uint_as_float(rr[0]),__uint_as_float(rr[1])); } \
      resc=false; \
      if(__builtin_expect(__any(rm>(float)THRL),0)){ const float dl=__builtin_fmaxf(rm,0.f); mhat+=dl; \
        _Pragma("unroll") for(int r=0;r<16;++r){C0[r]-=dl;C1[r]-=dl;} \
        _Pragma("unroll") for(int r=0;r<16;++r)negm[r]=-mhat; asm volatile("":"+v"(negm)); \
        const float f=__builtin_amdgcn_exp2f(-dl); l_reg*=f; if(hi==0)wsf[r32]=f; resc=true; } } \
    SBAR(); \
    GAPB(o[0]=__builtin_amdgcn_mfma_f32_32x32x16_bf16(PAF(0),VFR(0),o[0],0,0,0), C0,0); \
    GAPB(o[1]=__builtin_amdgcn_mfma_f32_32x32x16_bf16(PAF(0),VFR(4),o[1],0,0,0), C0,4); \
    KRD(GL,0); GAPB(o[0]=__builtin_amdgcn_mfma_f32_32x32x16_bf16(PAF(1),VFR(1),o[0],0,0,0), C0,8); \
    KRD(GL,1); GAPB(o[1]=__builtin_amdgcn_mfma_f32_32x32x16_bf16(PAF(1),VFR(5),o[1],0,0,0), C0,12); \
    KRD(GL,2); GAPB(o[0]=__builtin_amdgcn_mfma_f32_32x32x16_bf16(PAF(2),VFR(2),o[0],0,0,0), C1,0); \
    KRD(GL,3); GAPB(o[1]=__builtin_amdgcn_mfma_f32_32x32x16_bf16(PAF(2),VFR(6),o[1],0,0,0), C1,4); \
    GAPB(o[0]=__builtin_amdgcn_mfma_f32_32x32x16_bf16(PAF(3),VFR(3),o[0],0,0,0), C1,8); \
    GAPB(o[1]=__builtin_amdgcn_mfma_f32_32x32x16_bf16(PAF(3),VFR(7),o[1],0,0,0), C1,12); \
    }while(0)
  int t=1;
  #undef CMASK
  #define CMASK(P0,P1,t) do{}while(0)
  for(;t+5<NT;t+=2){
    STEP(pB0,pB1,pA0,pA1,t,true,true,true);     WAIT_BAR(2); RESC(); ROT();
    STEP(pA0,pA1,pB0,pB1,t+1,true,true,true);   WAIT_BAR(2); RESC(); ROT();
  }
  #undef CMASK
  #define CMASK(P0,P1,t) do{ if(MASKED){ const int jb_=(t)-(NT-4); if(jb_>=vis){ _Pragma("unroll") for(int r_=0;r_<16;++r_){P0[r_]=-INFINITY;P1[r_]=-INFINITY;} } } }while(0)
  #define ENDW(tt) do{ if((tt)+3<NT){WAIT_BAR(2);} else if((tt)+2<NT){WAIT_BAR(1);} else {WAIT_BAR(0);} }while(0)
  for(;t+1<NT;t+=2){
    STEP(pB0,pB1,pA0,pA1,t,(t+3<NT),(t+1<NT),(t+1<NT));       ENDW(t);   RESC(); ROT();
    STEP(pA0,pA1,pB0,pB1,t+1,(t+4<NT),(t+2<NT),(t+2<NT));     ENDW(t+1); RESC(); ROT();
  }
  { float sacc=pA0[0]+pA0[1]; _Pragma("unroll") for(int r=2;r<16;++r)sacc+=pA0[r]; _Pragma("unroll") for(int r=0;r<16;++r)sacc+=pA1[r]; l_reg+=sacc;
    pw0=(u32x4){PKW(pA0,0),PKW(pA0,2),PKW(pA0,4),PKW(pA0,6)};pw1=(u32x4){PKW(pA0,8),PKW(pA0,10),PKW(pA0,12),PKW(pA0,14)};pw2=(u32x4){PKW(pA1,0),PKW(pA1,2),PKW(pA1,4),PKW(pA1,6)};pw3=(u32x4){PKW(pA1,8),PKW(pA1,10),PKW(pA1,12),PKW(pA1,14)};
    SBAR(); pv(o,vb0+sl_prev,PAF(0),PAF(1),PAF(2),PAF(3)); }
  #undef PKW
  #undef PAF
  #undef VFR
  #undef PIN
  #undef MX3
  #undef GAPA
  #undef GAPB
  #undef EX
  #undef VRD
  #undef KRD
  #undef STEP
  #undef ENDW
  {auto rr=__builtin_amdgcn_permlane32_swap(__float_as_uint(l_reg),__float_as_uint(l_reg),false,false);l_reg=__uint_as_float(rr[0])+__uint_as_float(rr[1]);}
  if(hi==0)wsf[32+r32]=l_reg;asm volatile("s_waitcnt lgkmcnt(0)":::"memory");
  float rli[16];
  #pragma unroll
  for(int r=0;r<16;++r)rli[r]=__builtin_amdgcn_rcpf(wsf[32+crow(r,hi)]);
  bf16*Ow=Oin+(long)(wid*QBLK)*OPITCH;
  { bf16*stg=(bf16*)(shm+LDS_OST)+wid*2048;
    #pragma unroll
    for(int r=0;r<16;++r){const int orow=crow(r,hi);
      #pragma unroll
      for(int d0=0;d0<2;++d0)stg[orow*64+d0*32+r32]=__float2bfloat16(o[d0][r]*rli[r]);}
    asm volatile("s_waitcnt lgkmcnt(0)":::"memory");
    #pragma unroll
    for(int i=0;i<4;++i){const int row=i*8+(lane>>3),ch=lane&7; const u32x4 v=*(const u32x4*)(stg+row*64+ch*8); if(wid<qwaves)ATTN_STORE16(Ow+(long)row*OPITCH+ch*8,v);} }
  asm volatile("s_waitcnt lgkmcnt(0)\n\ts_barrier":::"memory");
  #undef DMA_K
  #undef DMA_V
  #undef CMASK
  #undef START
  #undef RESC
  #undef ROT
}
constexpr int ATTN_LDS_BYTES=LDS_BYTES;
#undef SBAR
#undef WAIT_BAR
}

#define GAS __attribute__((address_space(1)))
#define LAS __attribute__((address_space(3)))
typedef unsigned short bf16;
typedef unsigned v4u __attribute__((ext_vector_type(4)));
typedef float f32x4 __attribute__((ext_vector_type(4)));
typedef short bf16x8 __attribute__((ext_vector_type(8)));
typedef GAS unsigned gu32;
typedef GAS unsigned long long gu64;
#define RLX_AGENT __ATOMIC_RELAXED, __HIP_MEMORY_SCOPE_AGENT
#define LDS_WAIT() asm volatile("s_waitcnt lgkmcnt(0)" ::: "memory")
#define VM_WAIT() asm volatile("s_waitcnt vmcnt(0)" ::: "memory")
__device__ __forceinline__ unsigned long long rt() { return __builtin_amdgcn_s_memrealtime(); }
__device__ __forceinline__ unsigned f2bf(float f) { unsigned u = __builtin_bit_cast(unsigned, f); return (u + 0x7fffu + ((u >> 16) & 1u)) >> 16; }
__device__ __forceinline__ unsigned pk2(float lo, float hi) { return f2bf(lo) | (f2bf(hi) << 16); }

#define XB_TMO      128
#define XB_XCNT(j)  (256  + 64 * (j))
#define XB_XSUB(j)  (1280 + 64 * (j))
#define XB_XGEN(j)  (2304 + 64 * (j))
#define XB_TOP      3328
#define XB_TOPGEN   3392
#define XCD_BAR_WORDS 3456
#define XB_SPIN_CAP (1u << 18)

__device__ __forceinline__ unsigned xb_ld(unsigned* p)              { return __hip_atomic_load(p, __ATOMIC_RELAXED, __HIP_MEMORY_SCOPE_AGENT); }
__device__ __forceinline__ unsigned xb_add(unsigned* p, unsigned v) { return __hip_atomic_fetch_add(p, v, __ATOMIC_RELAXED, __HIP_MEMORY_SCOPE_AGENT); }
__device__ __forceinline__ unsigned xb_xcc_id() { return (unsigned)__builtin_amdgcn_s_getreg((3 << 11) | 20) & 0xFu; }
#define XB_SPIN(cond, bar) do { unsigned _sp = 0; while (cond) { __builtin_amdgcn_s_sleep(1); \
    if ((++_sp & 255u) == 0u) { if (xb_ld(&(bar)[XB_TMO])) break; if (_sp > XB_SPIN_CAP) { atomicAdd(&(bar)[XB_TMO], 1u); break; } } } } while (0)

struct XcdBarrier {
    unsigned* bar; unsigned x;
    volatile LAS unsigned* st;
};

__device__ __forceinline__ XcdBarrier xcd_barrier_post(unsigned* bar, volatile LAS unsigned* st) {
    XcdBarrier b; b.bar = bar; b.x = xb_xcc_id(); b.st = st;
    if (threadIdx.x == 0) (void)xb_add(&bar[XB_XCNT(b.x)], 1u);
    return b;
}
__device__ __forceinline__ void xcd_barrier_complete(unsigned* bar, unsigned x, unsigned& nloc, unsigned& nx) {
    const unsigned G = gridDim.x * gridDim.y * gridDim.z;
    unsigned sum, cnt, mine, sp = 0u;
    for (;;) {
        sum = 0u; cnt = 0u; mine = 0u;
#pragma unroll
        for (unsigned j = 0; j < 16; ++j) { const unsigned c = xb_ld(&bar[XB_XCNT(j)]); sum += c; cnt += (c > 0u) ? 1u : 0u; mine = (j == x) ? c : mine; }
        if (sum == G) break;
        __builtin_amdgcn_s_sleep(1);
        if ((++sp & 255u) == 0u) { if (xb_ld(&bar[XB_TMO])) break; if (sp > XB_SPIN_CAP) { atomicAdd(&bar[XB_TMO], 1u); break; } }
    }
    nloc = mine > 0u ? mine : 1u; nx = cnt > 0u ? cnt : 1u;
}

__device__ __forceinline__ void xcd_barrier(const XcdBarrier& b) {
    asm volatile("s_waitcnt vmcnt(0)" ::: "memory");
    __syncthreads();
    if (threadIdx.x == 0) {
        unsigned* bar = b.bar;
        __builtin_amdgcn_s_waitcnt(0);
        unsigned nloc = b.st[0], nx = b.st[1];
        if (nloc == 0u) { xcd_barrier_complete(bar, b.x, nloc, nx); b.st[0] = nloc; b.st[1] = nx; }
        const unsigned old = xb_add(&bar[XB_XSUB(b.x)], 1u);
        const unsigned gen = old / nloc;
        if (old + 1u == (gen + 1u) * nloc) {
            __builtin_amdgcn_fence(__ATOMIC_RELEASE, "agent");
            asm volatile("s_waitcnt vmcnt(0)" ::: "memory");
            const unsigned og = xb_add(&bar[XB_TOP], 1u);
            const unsigned tg = og / nx;
            if (og + 1u == (tg + 1u) * nx) xb_add(&bar[XB_TOPGEN], 1u);
            else XB_SPIN(xb_ld(&bar[XB_TOPGEN]) == tg, bar);
            __builtin_amdgcn_fence(__ATOMIC_ACQUIRE, "agent");
            xb_add(&bar[XB_XGEN(b.x)], 1u);
            asm volatile("s_waitcnt vmcnt(0)" ::: "memory");
        } else {
            XB_SPIN(xb_ld(&bar[XB_XGEN(b.x)]) == gen, bar);
            __builtin_amdgcn_fence(__ATOMIC_ACQUIRE, "agent");
            asm volatile("s_waitcnt vmcnt(0)" ::: "memory");
        }
    }
    __syncthreads();
}

constexpr int NWAVES = 8;
constexpr int RING_OFF = 0, RING_BYTES = 131072;
constexpr int LDSCTL_OFF = RING_BYTES, MISC_OFF = LDSCTL_OFF + 320;
constexpr int LDS_BYTES = 147456;
static_assert(MISC_OFF + 128 <= LDS_BYTES, "LDS map");
constexpr int N_PHASES = 2 + 5 * DEPTH;

struct Args { const float* in[25]; float* out; unsigned char* ws; int ph_lo, ph_hi, li, pad; };
#define CAS __attribute__((address_space(4)))
typedef const CAS struct Args* ArgsP;
#define KARG() ({ ArgsP p_ = (ArgsP)__builtin_amdgcn_kernarg_segment_ptr(); asm volatile("" : "+s"(p_)); p_; })
enum { I_XP = 0, I_XS, I_CK, I_CV, I_SC, I_SR, I_META, I_NW, I_WIN, I_CW, I_CB, I_WRG, I_BRG, I_WIG, I_BIG, I_LAM, I_LQ1, I_LK1, I_LQ2, I_LK2, I_SUBLN, I_WPR, I_WPA, I_WOUT, I_FNW };

__device__ __forceinline__ float wave_sum(float v) {
#pragma unroll
    for (int o = 1; o < 64; o <<= 1) v += __shfl_xor(v, o);
    return v;
}
__device__ __forceinline__ v4u pack8f(const f32x4 a, const f32x4 b) { v4u w; w.x = pk2(a[0], a[1]); w.y = pk2(a[2], a[3]); w.z = pk2(b[0], b[1]); w.w = pk2(b[2], b[3]); return w; }
__device__ __forceinline__ float bflo(unsigned w) { return __uint_as_float(w << 16); }
__device__ __forceinline__ float bfhi(unsigned w) { return __uint_as_float(w & 0xffff0000u); }

__host__ __device__ __forceinline__ int colmap_in(int np) {
    if (np >= 2048 && np < 4096) { const int g = np >> 6, j = np & 63, a = j >> 5, fq = (j >> 3) & 3, n = (j >> 2) & 1, e = j & 3; return (g << 6) + 32 * n + 16 * a + 4 * fq + e; }
    if (np >= 6144) { const int w = np - 6144, j8 = w >> 8, half = (w >> 7) & 1, cc = w & 127; return 6144 + half * 1024 + 128 * j8 + cc; }
    return np;
}
template <bool MAPPED>
__device__ __forceinline__ void p0_item(const float* W, int N, const float* kscale, bf16* WT, int ldk, int koff, LAS float* scr, int kb, int nb, int lane) {
    const int k0 = 64 * kb, n0 = 32 * nb; const int np = n0 + (lane & 31); const int src = MAPPED ? colmap_in(np) : np;
#pragma unroll 8
    for (int i = 0; i < 32; ++i) { const int kk = 2 * i + (lane >> 5); float v = W[(size_t)(k0 + kk) * N + src]; if (kscale) v *= kscale[k0 + kk]; scr[kk * 33 + (lane & 31)] = v; }
    LDS_WAIT(); asm volatile("" ::: "memory");
    const int c = lane & 7;
#pragma unroll
    for (int j = 0; j < 4; ++j) { const int n = (lane >> 3) + 8 * j; const LAS float* s = scr + (8 * c) * 33 + n;
        v4u o; o.x = pk2(s[0 * 33], s[1 * 33]); o.y = pk2(s[2 * 33], s[3 * 33]); o.z = pk2(s[4 * 33], s[5 * 33]); o.w = pk2(s[6 * 33], s[7 * 33]);
        *(GAS v4u*)(WT + (size_t)(n0 + n) * ldk + koff + k0 + 8 * c) = o; }
    LDS_WAIT(); asm volatile("" ::: "memory");
}

__device__ __forceinline__ void p0_prologue(ArgsP args, LAS unsigned char* lds, int lane, int wave, int vcu, int G) {
    unsigned char* ws = args->ws;
    LAS float* scr = (LAS float*)(lds + RING_OFF + wave * 16384);
    const int gw = vcu * NWAVES + wave, NGW = G * NWAVES;
    constexpr int IT_L = 4096 + 512 + 512 + 512 + 128;
    for (int it = gw; it < DEPTH * IT_L; it += NGW) {
        const int l = it / IT_L; int r = it % IT_L; unsigned char* wl = ws + WS_W + (size_t)l * W_LAYER;
        if (r < 4096) { p0_item<true>(args->in[I_WIN] + (size_t)l * D * INC, INC, args->in[I_NW] + l * D, (bf16*)(wl + W_IN), D, 0, scr, r >> 8, r & 255, lane); continue; } r -= 4096;
        if (r < 512) { p0_item<false>(args->in[I_WPR] + (size_t)l * D * D, D, nullptr, (bf16*)(wl + W_PROJ), 2 * D, 0, scr, r >> 5, r & 31, lane); continue; } r -= 512;
        if (r < 512) { p0_item<false>(args->in[I_WPA] + (size_t)l * D * D, D, nullptr, (bf16*)(wl + W_PROJ), 2 * D, D, scr, r >> 5, r & 31, lane); continue; } r -= 512;
        if (r < 512) { p0_item<false>(args->in[I_WOUT] + (size_t)l * D * D, D, nullptr, (bf16*)(wl + W_OUT), D, 0, scr, r >> 5, r & 31, lane); continue; } r -= 512;
        { const int gate = r >> 6, blk = (r >> 3) & 7, kb = (r >> 2) & 1, nb = r & 3;
          p0_item<false>(args->in[gate ? I_WIG : I_WRG] + (size_t)(l * 8 + blk) * 16384, 128, nullptr, (bf16*)(wl + W_G) + (size_t)(blk * 2 + gate) * 16384, 128, 0, scr, kb, nb, lane); }
    }
    { float* HRES = (float*)(ws + WS_HRES); bf16* HB = (bf16*)(ws + WS_HB); float* SSQ = (float*)(ws + WS_SSQ);
      for (int row = gw; row < M; row += NGW) {
        const float* src = row < ROW_S ? args->in[I_XP] + (size_t)row * D : row < ROW_M ? args->in[I_XS] + (size_t)(row - ROW_S) * D : (row - ROW_M) < NMETA ? args->in[I_META] + (size_t)(row - ROW_M) * D : nullptr;
        f32x4 v[4]; float s = 0.f;
#pragma unroll
        for (int j = 0; j < 4; ++j) { v[j] = src ? ((const GAS f32x4*)src)[lane + 64 * j] : (f32x4){0.f, 0.f, 0.f, 0.f}; s += (v[j].x * v[j].x + v[j].y * v[j].y) + (v[j].z * v[j].z + v[j].w * v[j].w); }
        s = wave_sum(s);
#pragma unroll
        for (int j = 0; j < 4; ++j) { ((GAS f32x4*)(HRES + (size_t)row * D))[lane + 64 * j] = v[j];
            ((GAS unsigned long long*)(HB + (size_t)row * D))[lane + 64 * j] = (unsigned long long)pk2(v[j].x, v[j].y) | ((unsigned long long)pk2(v[j].z, v[j].w) << 32); }
        if (lane < 16) SSQ[(size_t)row * 16 + lane] = lane == 0 ? s : 0.f;
      } }
    const int gtid = gw * 64 + lane, NTH = NGW * 64;
    { float* TC = (float*)(ws + WS_TCOS); float* TS = (float*)(ws + WS_TSIN);
      for (int idx = gtid; idx < TP * 32; idx += NTH) {
        const int pos = idx >> 5, i = idx & 31;
        double th = 1.0; for (int k = 0; k < i; ++k) th *= 0.74989420933245582730;
        const double t2 = th * th; double cb = 1.0, sb = th, tc = 1.0, tsn = th;
#pragma unroll 1
        for (int k = 1; k <= 11; ++k) { tc *= -t2 / (double)((2 * k - 1) * (2 * k)); tsn *= -t2 / (double)((2 * k) * (2 * k + 1)); cb += tc; sb += tsn; }
        double cr = 1.0, sr = 0.0;
#pragma unroll 1
        for (int bit = 0; bit < 13; ++bit) { if ((pos >> bit) & 1) { const double c2 = cr * cb - sr * sb, s2 = sr * cb + cr * sb; cr = c2; sr = s2; } const double c3 = cb * cb - sb * sb, s3 = 2.0 * cb * sb; cb = c3; sb = s3; }
        TC[idx] = (float)cr; TS[idx] = (float)sr;
      } }
    if (gw < DEPTH) { const int l = gw; const float s1 = wave_sum(args->in[I_LQ1][l * 64 + lane] * args->in[I_LK1][l * 64 + lane]), s2 = wave_sum(args->in[I_LQ2][l * 64 + lane] * args->in[I_LK2][l * 64 + lane]);
        if (lane == 0) { const float li = 0.8f - 0.6f * expf(-0.3f * (float)l); ((float*)(ws + WS_MISC))[l] = expf(s1) - expf(s2) + li; ((float*)(ws + WS_MISC))[8 + l] = 1.0f - li; } }
    { bf16* KS = (bf16*)(ws + WS_KS); bf16* VS = (bf16*)(ws + WS_VS); const float* ck = args->in[I_CK]; const float* cv = args->in[I_CV];
      constexpr int NCH = DEPTH * NDB * PAST * 128;
      for (int c = gtid; c < NCH; c += NTH) {
        const int row = c >> 7, chn = c & 127, ldb = row >> 11, j = row & 2047; const size_t drow = ((size_t)ldb * KSROWS + j) * D;
        { const int g = chn >> 3, q8 = chn & 7, d0 = 16 * (q8 >> 2) + 4 * (q8 & 3); const float* s = ck + (size_t)row * D + 64 * g + d0;
          const f32x4 lo = *(const GAS f32x4*)s, hi = *(const GAS f32x4*)(s + 32); *(GAS v4u*)(KS + drow + 8 * chn) = pack8f(lo, hi); }
        { const float* s = cv + (size_t)row * D + 8 * chn; const f32x4 lo = *(const GAS f32x4*)s, hi = *(const GAS f32x4*)(s + 4); *(GAS v4u*)(VS + drow + 8 * chn) = pack8f(lo, hi); }
      } }
    { bf16* KP = (bf16*)(ws + WS_KP); bf16* VP = (bf16*)(ws + WS_VP);
      for (int c = gtid; c < NB * 48 * 128; c += NTH) { const int b = c / (48 * 128), rr = (c / 128) % 48, chn = c & 127; const size_t off = ((size_t)b * KPROWS + 16 + rr) * D + 8 * chn;
        *(GAS v4u*)(KP + off) = (v4u){0u, 0u, 0u, 0u}; *(GAS v4u*)(VP + off) = (v4u){0u, 0u, 0u, 0u}; } }
}

constexpr int RNN_XS = 0, RNN_XC = 36864, RNN_XA = 71680;
template <bool FINAL>
__device__ __forceinline__ void rnn_unit(ArgsP args, int l, int kind, int seq, int n, int g, LAS unsigned char* lds, int tid, int lane, int wid) {
    unsigned char* ws = args->ws;
    LAS float* XS = (LAS float*)(lds + RNN_XS); LAS float* XC = (LAS float*)(lds + RNN_XC); LAS bf16* XA = (LAS bf16*)(lds + RNN_XA);
    const bf16* XR = (const bf16*)(ws + WS_XR);
    float* HMETA = (float*)(ws + WS_MISC + 4096); float* SUM = (float*)(ws + WS_MISC + 65536);
    const int q = lane >> 4, cl = lane & 15, cc = 16 * wid + cl, ch = 128 * n + cc;
    const float brg = args->in[I_BRG][l * D + ch], big = args->in[I_BIG][l * D + ch];
    float sp; { const float x = -args->in[I_LAM][l * D + ch]; sp = fmaxf(x, 0.f) + log1pf(__expf(-fabsf(x))); }
    const int c2 = tid & 127, rg = tid >> 7, chc = 128 * n + c2;
    const float cw0 = args->in[I_CW][(l * 4 + 0) * D + chc], cw1 = args->in[I_CW][(l * 4 + 1) * D + chc], cw2 = args->in[I_CW][(l * 4 + 2) * D + chc], cw3 = args->in[I_CW][(l * 4 + 3) * D + chc], cb = args->in[I_CB][l * D + chc];
    const bf16* wg = (const bf16*)(ws + WS_W + (size_t)l * W_LAYER + W_G) + (size_t)(n * 2) * 16384;
    bf16x8 Br[4], Bi[4];
#pragma unroll
    for (int ks = 0; ks < 4; ++ks) { Br[ks] = *(const bf16x8*)(wg + (size_t)cc * 128 + 32 * ks + 8 * q); Bi[ks] = *(const bf16x8*)(wg + 16384 + (size_t)cc * 128 + 32 * ks + 8 * q); }
    const int ntiles = kind == 0 ? 16 : 1, nvalid = kind == 2 ? NMETA : 64;
    const size_t rowbase = kind == 0 ? (size_t)seq * SEQ + (size_t)g * 1024 : kind == 1 ? (size_t)ROW_S + (size_t)seq * DSQ : (size_t)ROW_M;
    float hrun = 0.f, Arun = 1.f, Brun = 0.f;
    if (FINAL) {
        if (kind == 0) { hrun = HMETA[ch]; for (int gg = 0; gg < g; ++gg) { const float sa = SUM[((size_t)(seq * 4 + gg) * D + ch) * 2], sb = SUM[((size_t)(seq * 4 + gg) * D + ch) * 2 + 1]; hrun = sa * hrun + sb; } }
        else if (kind == 1) hrun = args->in[I_SR][(size_t)(l * NDB + seq) * D + ch];
    }
    for (int j = 0; j < ntiles; ++j) {
        const size_t row0 = rowbase + 64 * j;
        const bool seqstart = (kind != 0) || (g == 0 && j == 0);
        for (int id = tid; id < 67 * 16; id += NWAVES * 64) {
            const int i = id >> 4, c8 = id & 15; f32x4 lo, hi;
            if (i >= 3 || !seqstart || kind == 0) {
                const size_t srow = (i >= 3 || !seqstart) ? row0 + i - 3 : (size_t)ROW_M + 13 + i;
                const v4u w = *(const GAS v4u*)(XR + srow * D + 128 * n + 8 * c8);
                lo = (f32x4){bflo(w.x), bfhi(w.x), bflo(w.y), bfhi(w.y)}; hi = (f32x4){bflo(w.z), bfhi(w.z), bflo(w.w), bfhi(w.w)};
            } else if (kind == 1) { const float* sc = args->in[I_SC] + ((size_t)(l * NDB + seq) * 3 + i) * D + 128 * n + 8 * c8; lo = *(const GAS f32x4*)sc; hi = *(const GAS f32x4*)(sc + 4); }
            else { lo = (f32x4){0.f, 0.f, 0.f, 0.f}; hi = lo; }
            *(LAS f32x4*)(XS + i * 132 + 8 * c8) = lo; *(LAS f32x4*)(XS + i * 132 + 8 * c8 + 4) = hi;
        }
        __syncthreads();
        { const int rb = 16 * rg; float x0 = XS[(rb + 0) * 132 + c2], x1 = XS[(rb + 1) * 132 + c2], x2 = XS[(rb + 2) * 132 + c2];
#pragma unroll
          for (int r = 0; r < 16; ++r) { const float x3 = XS[(rb + r + 3) * 132 + c2]; const float xc = (((cb + x0 * cw0) + x1 * cw1) + x2 * cw2) + x3 * cw3;
              XC[(rb + r) * 132 + c2] = xc; XA[(rb + r) * 136 + c2] = (bf16)f2bf(xc); x0 = x1; x1 = x2; x2 = x3; } }
        __syncthreads();
#pragma unroll
        for (int mt = 0; mt < 4; ++mt) {
            f32x4 ar = {0.f, 0.f, 0.f, 0.f}, ai = {0.f, 0.f, 0.f, 0.f};
#pragma unroll
            for (int ks = 0; ks < 4; ++ks) { const bf16x8 A = *(const LAS bf16x8*)(XA + (16 * mt + cl) * 136 + 32 * ks + 8 * q);
                ar = __builtin_amdgcn_mfma_f32_16x16x32_bf16(A, Br[ks], ar, 0, 0, 0); ai = __builtin_amdgcn_mfma_f32_16x16x32_bf16(A, Bi[ks], ai, 0, 0, 0); }
            float a[4], b[4];
#pragma unroll
            for (int i = 0; i < 4; ++i) { const int r = 16 * mt + 4 * q + i; const float xc = XC[r * 132 + cc];
                const float rr = 1.0f / (1.0f + __expf(-(ar[i] + brg))), ii = 1.0f / (1.0f + __expf(-(ai[i] + big)));
                const float la = -8.0f * rr * sp; a[i] = __expf(la); b[i] = sqrtf(fmaxf(-expm1f(2.0f * la), 0.f)) * ii * xc;
                if (r >= nvalid) { a[i] = 1.f; b[i] = 0.f; } }
            const float A4 = (a[0] * a[1]) * (a[2] * a[3]), B4 = ((b[0] * a[1] + b[1]) * a[2] + b[2]) * a[3] + b[3];
            float Ai = A4, Bi2 = B4;
            { const float ua = __shfl_up(Ai, 16), ub = __shfl_up(Bi2, 16); if (q >= 1) { Bi2 = Ai * ub + Bi2; Ai = ua * Ai; } }
            { const float ua = __shfl_up(Ai, 32), ub = __shfl_up(Bi2, 32); if (q >= 2) { Bi2 = Ai * ub + Bi2; Ai = ua * Ai; } }
            float Ae = __shfl_up(Ai, 16), Be = __shfl_up(Bi2, 16); if (q == 0) { Ae = 1.f; Be = 0.f; }
            const float At = __shfl(Ai, 48 + cl), Bt = __shfl(Bi2, 48 + cl);
            if (FINAL) {
                float h = Ae * hrun + Be;
#pragma unroll
                for (int i = 0; i < 4; ++i) { h = a[i] * h + b[i]; XC[(16 * mt + 4 * q + i) * 132 + cc] = h; }
                hrun = At * hrun + Bt;
            } else { Brun = At * Brun + Bt; Arun = Arun * At; }
        }
        if (FINAL) {
            __syncthreads();
            const bf16* ZR = (const bf16*)(ws + WS_ZR); bf16* OX = (bf16*)(ws + WS_OX);
#pragma unroll
            for (int k = 0; k < 2; ++k) { const int id = tid + k * NWAVES * 64, r = id >> 4, c8 = id & 15;
                const f32x4 h0 = *(const LAS f32x4*)(XC + r * 132 + 8 * c8), h1 = *(const LAS f32x4*)(XC + r * 132 + 8 * c8 + 4);
                const v4u z = *(const GAS v4u*)(ZR + (row0 + r) * D + 128 * n + 8 * c8);
                const f32x4 o0 = h0 * (f32x4){bflo(z.x), bfhi(z.x), bflo(z.y), bfhi(z.y)}, o1 = h1 * (f32x4){bflo(z.z), bfhi(z.z), bflo(z.w), bfhi(z.w)};
                *(GAS v4u*)(OX + (row0 + r) * 2 * D + 128 * n + 8 * c8) = pack8f(o0, o1); }
        }
    }
    if (q == 0) {
        if (FINAL) { if (kind == 0 && g == 3) args->out[O_RP + (size_t)(l * NB + seq) * D + ch] = hrun; if (kind == 1) args->out[O_RS + (size_t)(l * NDB + seq) * D + ch] = hrun; }
        else { if (kind == 0) { SUM[((size_t)(seq * 4 + g) * D + ch) * 2] = Arun; SUM[((size_t)(seq * 4 + g) * D + ch) * 2 + 1] = Brun; } else if (kind == 2) HMETA[ch] = Brun; }
    }
    __syncthreads();
}

__device__ __forceinline__ void attn_finish(ArgsP args, int l, size_t row0, int h, int nw, int lane, int wid) {
    if (wid >= nw) return;
    unsigned char* ws = args->ws;
    asm volatile("s_waitcnt vmcnt(0)" ::: "memory");
    const float lam = ((const float*)(ws + WS_MISC))[l], oml = ((const float*)(ws + WS_MISC))[8 + l];
    int ln = lane; asm volatile("" : "+v"(ln));
    const int r = ln >> 1, half = ln & 1; const size_t row = row0 + 32 * wid + r;
    const bf16* p1 = (const bf16*)(ws + WS_OP) + row * 2048 + (size_t)(h * 2) * 128 + half * 64; const bf16* p2 = p1 + 128;
    float d[64]; float ss = 0.f;
#pragma unroll
    for (int k = 0; k < 8; ++k) { const v4u a = *(const GAS v4u*)(p1 + 8 * k), b = *(const GAS v4u*)(p2 + 8 * k);
        d[8 * k + 0] = bflo(a.x) - lam * bflo(b.x); d[8 * k + 1] = bfhi(a.x) - lam * bfhi(b.x); d[8 * k + 2] = bflo(a.y) - lam * bflo(b.y); d[8 * k + 3] = bfhi(a.y) - lam * bfhi(b.y);
        d[8 * k + 4] = bflo(a.z) - lam * bflo(b.z); d[8 * k + 5] = bfhi(a.z) - lam * bfhi(b.z); d[8 * k + 6] = bflo(a.w) - lam * bflo(b.w); d[8 * k + 7] = bfhi(a.w) - lam * bfhi(b.w);
#pragma unroll
        for (int e = 0; e < 8; ++e) ss += d[8 * k + e] * d[8 * k + e]; }
    ss += __shfl_xor(ss, 1);
    const float scale = rsqrtf(ss * (1.0f / 128.0f) + EPS) * oml;
    const bf16* za = (const bf16*)(ws + WS_ZA) + row * D + h * 128 + half * 64; const float* sw = args->in[I_SUBLN] + l * 128 + half * 64;
    bf16* od = (bf16*)(ws + WS_OX) + row * 2 * D + D + h * 128 + half * 64;
#pragma unroll
    for (int k = 0; k < 8; ++k) { const v4u z = *(const GAS v4u*)(za + 8 * k); const f32x4 w0 = *(const GAS f32x4*)(sw + 8 * k), w1 = *(const GAS f32x4*)(sw + 8 * k + 4);
        f32x4 o0, o1;
        o0[0] = d[8 * k + 0] * scale * w0[0] * bflo(z.x); o0[1] = d[8 * k + 1] * scale * w0[1] * bfhi(z.x); o0[2] = d[8 * k + 2] * scale * w0[2] * bflo(z.y); o0[3] = d[8 * k + 3] * scale * w0[3] * bfhi(z.y);
        o1[0] = d[8 * k + 4] * scale * w1[0] * bflo(z.z); o1[1] = d[8 * k + 5] * scale * w1[1] * bfhi(z.z); o1[2] = d[8 * k + 6] * scale * w1[2] * bflo(z.w); o1[3] = d[8 * k + 7] * scale * w1[3] * bfhi(z.w);
        *(GAS v4u*)(od + 8 * k) = pack8f(o0, o1); }
}
__device__ __forceinline__ void attn_super(ArgsP args, int l, int kind, int a, int h, int qb, char* shm, int lane, int wid) {
    typedef attn_body::bf16 abf;
    unsigned char* ws = args->ws;
    const abf* Q = (const abf*)(ws + WS_Q); abf* OP = (abf*)(ws + WS_OP);
    size_t qrow; const abf* Kb; const abf* Vb; int NT, vis, qwaves;
    if (kind == 0)      { qrow = (size_t)a * SEQ + (size_t)qb * 256; Kb = (const abf*)(ws + WS_KP) + (size_t)a * KPROWS * D; Vb = (const abf*)(ws + WS_VP) + (size_t)a * KPROWS * D; NT = 4 * qb + 5; vis = (wid >> 1) + 1; qwaves = 8; }
    else if (kind == 1) { qrow = (size_t)ROW_S + (size_t)a * DSQ; Kb = (const abf*)(ws + WS_KS) + (size_t)(l * NDB + a) * KSROWS * D; Vb = (const abf*)(ws + WS_VS) + (size_t)(l * NDB + a) * KSROWS * D; NT = 33; vis = 4; qwaves = 2; }
    else                { qrow = (size_t)ROW_M; Kb = (const abf*)(ws + WS_KP); Vb = (const abf*)(ws + WS_VP); NT = 5; vis = 0; qwaves = 8; }
#pragma unroll 1
    for (int cv = 0; cv < 4; ++cv) { const int c = cv >> 1, vh = cv & 1;
        const abf* Qi = Q + qrow * D + (h * 2 + c) * 64; const abf* Ki = Kb + (h * 2 + c) * 64; const abf* Vi = Vb + h * 128 + vh * 64; abf* Oi = OP + qrow * 2048 + (h * 2 + c) * 128 + vh * 64;
        if (kind == 1) attn_body::attn_unit<8, false>(Qi, Ki, Vi, Oi, NT, vis, qwaves, shm);
        else           attn_body::attn_unit<8, true>(Qi, Ki, Vi, Oi, NT, vis, qwaves, shm);
    }
    attn_finish(args, l, qrow, h, qwaves, lane, wid);
}

__global__ void __launch_bounds__(NWAVES * 64, 2) hawk_fwd(Args args) {
    extern __shared__ __attribute__((aligned(16))) unsigned char lds_raw[];
    LAS unsigned char* lds = (LAS unsigned char*)lds_raw;
    volatile LAS unsigned* MISC = (volatile LAS unsigned*)(lds + MISC_OFF);
    const int tid = threadIdx.x;
    const int G = gridDim.x; const int bx = blockIdx.x; const int vcu = (G % 8 == 0) ? (bx % 8) * (G / 8) + bx / 8 : bx;
    for (int u = tid; u < (LDS_BYTES - LDSCTL_OFF) / 4; u += NWAVES * 64) ((LAS unsigned*)(lds + LDSCTL_OFF))[u] = 0u;
    __syncthreads();
#if MK_PER_PHASE
#define GRID_BAR() do { if (tid == 0) __hip_atomic_store((gu32*)(KARG()->ws + WS_CTL) + CW_TMO, 0xBADBA0u, RLX_AGENT); } while (0)
#else
    (void)xcd_barrier_post((unsigned*)((gu32*)(KARG()->ws + WS_CTL) + CW_BAR), MISC + 8);
#define GRID_BAR() do { XcdBarrier bar_; bar_.bar = (unsigned*)((gu32*)(KARG()->ws + WS_CTL) + CW_BAR); bar_.x = xb_xcc_id(); bar_.st = MISC + 8; xcd_barrier(bar_); } while (0)
#endif
    const int lo = KARG()->ph_lo, hi = KARG()->ph_hi;
#define IN(k) (lo <= (k) && (k) < hi)
#ifndef PHMASK
#define PHMASK 0xff
#endif
#define PH(b) ((PHMASK >> (b)) & 1)
#define BOTH(k) (IN(k) && IN((k) + 1))
    typedef pg8::bf16_t pb;
    if (PH(0) && IN(0)) { int tid_l = tid; asm volatile("" : "+v"(tid_l)); p0_prologue(KARG(), lds, tid_l & 63, __builtin_amdgcn_readfirstlane(tid_l >> 6), vcu, G); if (BOTH(0)) GRID_BAR(); }

    for (int l = 0; l < DEPTH; ++l) {
        const int pbase = 1 + 5 * l;
        if (PH(1) && IN(pbase)) {
            ArgsP args = KARG(); unsigned char* ws = args->ws; unsigned char* wl = ws + WS_W + (size_t)l * W_LAYER;
            pg8::Gemm g{(const pb*)(ws + WS_HB), (const pb*)(wl + W_IN), D, D}; pg8::StaticOrder S; S.init(M, INC, G, bx);
            pg8::EpiIn E{l, ws, args->out};
            pg8::gemm_phase<pg8::EpiIn, pg8::StaticOrder, true, true>(lds + RING_OFF, g, S, E);
            if (BOTH(pbase)) GRID_BAR();
        }
        if (PH(2) && IN(pbase + 1)) {
            for (int u = bx; u < 200; u += G) {
                ArgsP args = KARG();
                int tid_l = tid; asm volatile("" : "+v"(tid_l)); const int lane_l = tid_l & 63, wave_l = __builtin_amdgcn_readfirstlane(tid_l >> 6);
                if (u < 192) rnn_unit<false>(args, l, 0, u / 24, (u % 24) / 3, u % 3, lds + RING_OFF, tid_l, lane_l, wave_l);
                else rnn_unit<false>(args, l, 2, 0, u - 192, 0, lds + RING_OFF, tid_l, lane_l, wave_l);
            }
            if (BOTH(pbase + 1)) GRID_BAR();
        }
        if ((PH(3) || PH(4)) && IN(pbase + 2)) {
            for (;;) {
                ArgsP args = KARG();
                int tid_l = tid; asm volatile("" : "+v"(tid_l)); const int lane_l = tid_l & 63, wave_l = __builtin_amdgcn_readfirstlane(tid_l >> 6);
                if (tid_l == 0) MISC[0] = __hip_atomic_fetch_add((gu32*)(args->ws + WS_CTL) + CW_QUEUE + 64 * l, 1u, RLX_AGENT);
                __syncthreads();
                const int idx = (int)MISC[0];
                __syncthreads();
                if (idx >= 1552) break;
                if (!PH(3) && idx < 392) continue;
                if (!PH(4) && idx >= 392) continue;
                if (idx < 256) rnn_unit<true>(args, l, 0, idx >> 5, (idx >> 2) & 7, idx & 3, lds + RING_OFF, tid_l, lane_l, wave_l);
                else if (idx < 384) rnn_unit<true>(args, l, 1, (idx - 256) >> 3, (idx - 256) & 7, 0, lds + RING_OFF, tid_l, lane_l, wave_l);
                else if (idx < 392) rnn_unit<true>(args, l, 2, 0, idx - 384, 0, lds + RING_OFF, tid_l, lane_l, wave_l);
                else { const int i = idx - 392;
                    if (i < 576) attn_super(args, l, 0, (i & 63) >> 3, i & 7, 15 - (i >> 6), (char*)lds_raw + RING_OFF, lane_l, wave_l);
                    else if (i < 704) attn_super(args, l, 1, (i - 576) >> 3, (i - 576) & 7, 0, (char*)lds_raw + RING_OFF, lane_l, wave_l);
                    else if (i < 1152) attn_super(args, l, 0, ((i - 704) & 63) >> 3, (i - 704) & 7, 6 - ((i - 704) >> 6), (char*)lds_raw + RING_OFF, lane_l, wave_l);
                    else attn_super(args, l, 2, 0, i - 1152, 0, (char*)lds_raw + RING_OFF, lane_l, wave_l); }
            }
            if (BOTH(pbase + 2)) GRID_BAR();
        }
        if (PH(5) && IN(pbase + 3)) {
            ArgsP args = KARG(); unsigned char* ws = args->ws; unsigned char* wl = ws + WS_W + (size_t)l * W_LAYER;
            pg8::Gemm g{(const pb*)(ws + WS_OX), (const pb*)(wl + W_PROJ), 2 * D, D}; pg8::TwoPartOrder S; S.init(M, D, G, bx);
            pg8::EpiProj E{ws};
            pg8::gemm_phase<pg8::EpiProj, pg8::TwoPartOrder, true, true>(lds + RING_OFF, g, S, E);
            if (BOTH(pbase + 3)) GRID_BAR();
        }
        if (PH(6) && IN(pbase + 4)) {
            ArgsP args = KARG(); unsigned char* ws = args->ws; unsigned char* wl = ws + WS_W + (size_t)l * W_LAYER;
            pg8::Gemm g{(const pb*)(ws + WS_MB), (const pb*)(wl + W_OUT), D, D}; pg8::StaticOrder S; S.init(M, D, G, bx);
            pg8::EpiOut E{ws};
            pg8::gemm_phase<pg8::EpiOut, pg8::StaticOrder, true, true>(lds + RING_OFF, g, S, E);
            if (BOTH(pbase + 4)) GRID_BAR();
        }
    }
    if (PH(7) && IN(N_PHASES - 1)) {
        ArgsP args = KARG(); unsigned char* ws = args->ws;
        int tid_l = tid; asm volatile("" : "+v"(tid_l)); const int lane = tid_l & 63, wave = __builtin_amdgcn_readfirstlane(tid_l >> 6);
        const float* HRES = (const float*)(ws + WS_HRES); const float* fw = args->in[I_FNW];
        const int gw = vcu * NWAVES + wave, NGW = G * NWAVES;
        f32x4 w4[4];
#pragma unroll
        for (int j = 0; j < 4; ++j) w4[j] = ((const GAS f32x4*)fw)[lane + 64 * j];
        for (int row = gw; row < ROW_M; row += NGW) {
            f32x4 v[4]; float s = 0.f;
#pragma unroll
            for (int j = 0; j < 4; ++j) { v[j] = ((const GAS f32x4*)(HRES + (size_t)row * D))[lane + 64 * j]; s += (v[j].x * v[j].x + v[j].y * v[j].y) + (v[j].z * v[j].z + v[j].w * v[j].w); }
            const float rs = rsqrtf(wave_sum(s) * (1.0f / 1024.0f) + EPS);
            float* o = args->out + (row < ROW_S ? O_YP + (size_t)row * D : O_YS + (size_t)(row - ROW_S) * D);
#pragma unroll
            for (int j = 0; j < 4; ++j) ((GAS f32x4*)o)[lane + 64 * j] = v[j] * rs * w4[j];
        }
    }
#undef IN
#undef BOTH
}

extern "C" void kernel_launch(void* const* d_in, const int* in_sizes, int n_in, void* d_out, int out_size, void* d_ws, size_t ws_size, hipStream_t stream) {
    static int grid = 0;
    if (grid == 0) {
        if (n_in != 25 || (size_t)out_size != O_END || ws_size < WS_END) { fprintf(stderr, "kernel_launch: unexpected shapes (n_in %d, out %d, ws %zu); nothing launched\n", n_in, out_size, ws_size); grid = -1; return; }
        int dev = 0, cus = 0, per_cu = 0;
        if (hipGetDevice(&dev) != hipSuccess || hipDeviceGetAttribute(&cus, hipDeviceAttributeMultiprocessorCount, dev) != hipSuccess) { grid = -1; return; }
        if (hipFuncSetAttribute((const void*)hawk_fwd, hipFuncAttributeMaxDynamicSharedMemorySize, LDS_BYTES) != hipSuccess) { fprintf(stderr, "kernel_launch: hipFuncSetAttribute failed\n"); grid = -1; return; }
        if (hipOccupancyMaxActiveBlocksPerMultiprocessor(&per_cu, (const void*)hawk_fwd, NWAVES * 64, LDS_BYTES) != hipSuccess || per_cu < 1) { fprintf(stderr, "kernel_launch: occupancy query reports %d workgroups per CU\n", per_cu); }
        (void)hipGetLastError();
        grid = cus;
    }
    if (grid < 0) return;
    if (hipMemsetAsync((char*)d_ws + WS_CTL, 0, CTL_ZERO_BYTES, stream) != hipSuccess) return;
    Args a{};
    for (int i = 0; i < 25; ++i) a.in[i] = (const float*)d_in[i];
    a.out = (float*)d_out; a.ws = (unsigned char*)d_ws;
#if MK_PER_PHASE
    for (int p = 0; p < N_PHASES; ++p) { a.ph_lo = p; a.ph_hi = p + 1; a.li = p; hipLaunchKernelGGL(hawk_fwd, dim3(grid), dim3(NWAVES * 64), LDS_BYTES, stream, a); }
#else
    a.ph_lo = 0; a.ph_hi = N_PHASES; a.li = 0;
    hipLaunchKernelGGL(hawk_fwd, dim3(grid), dim3(NWAVES * 64), LDS_BYTES, stream, a);
#endif
    const hipError_t le = hipPeekAtLastError();
    if (le != hipSuccess) fprintf(stderr, "kernel_launch: launch failed: %s\n", hipGetErrorName(le));
}
```

```cpp
#include <hip/hip_runtime.h>
#include <hip/hip_bf16.h>
#include <cstdio>
#include <cstdint>
#include <cmath>

#ifndef MK_PROBE
#define MK_PROBE 0
#endif
#ifndef MK_REP_P0
#define MK_REP_P0 1
#endif
#ifndef MK_REP_P1
#define MK_REP_P1 1
#endif
#ifndef MK_REP_P2
#define MK_REP_P2 1
#endif
#ifndef MK_REP_P3
#define MK_REP_P3 1
#endif
#ifndef MK_REP_P4
#define MK_REP_P4 1
#endif
#ifndef MK_REP_P5
#define MK_REP_P5 1
#endif
#ifndef MK_ALIGN_P1
#define MK_ALIGN_P1 true
#endif
#ifndef MK_EPI2
#define MK_EPI2 0
#endif
#ifndef MK_KPROBE
#define MK_KPROBE 0
#endif
#ifndef MK_STAGGER
#define MK_STAGGER 0
#endif
#ifndef MK_PER_PHASE
#define MK_PER_PHASE 0
#endif

constexpr int D = 1024, NB = 8, SEQ = 4096, DEPTH = 4, NDB = 16, DSQ = 64, PAST = 2048, NMETA = 16, NH = 8, INC = 8192;
constexpr int MP = NB * SEQ;
constexpr int MSM = NDB * DSQ;
constexpr int ROW_S = MP, ROW_M = MP + MSM;
constexpr int M = ROW_M + 256;
constexpr int TP = NMETA + SEQ;
constexpr int KPROWS = 64 + SEQ;
constexpr int KSROWS = PAST + DSQ;
constexpr float EPS = 1e-6f;
constexpr float QSCALE = 0.125f * 1.4426950408889634f;

constexpr size_t O_YP = 0, O_YS = 33554432, O_KP = 34603008, O_VP = 169345024, O_CP = 304087040, O_RP = 304185344,
                 O_KS = 304218112, O_VS = 308412416, O_CS = 312606720, O_RS = 312803328, O_END = 312868864;

constexpr size_t MiB = 1u << 20;
constexpr size_t WS_CTL = 0, CTL_ZERO_BYTES = 1 * MiB;
constexpr size_t WS_TCOS = 1 * MiB, WS_TSIN = 2 * MiB;
constexpr size_t WS_MISC = 3 * MiB;
constexpr size_t WS_W = 4 * MiB, W_LAYER = 24 * MiB, W_IN = 0, W_PROJ = 16 * MiB, W_OUT = 20 * MiB, W_G = 22 * MiB;
constexpr size_t WS_HRES = 100 * MiB;
constexpr size_t WS_HB = 233 * MiB;
constexpr size_t WS_SSQ = 300 * MiB;
constexpr size_t WS_XR = 303 * MiB, WS_ZR = 370 * MiB, WS_Q = 437 * MiB, WS_ZA = 504 * MiB, WS_RHO = 571 * MiB, WS_SGA = 638 * MiB;
constexpr size_t WS_OX = 705 * MiB;
constexpr size_t WS_MB = 838 * MiB;
constexpr size_t WS_OP = 905 * MiB;
constexpr size_t WS_KP = 1038 * MiB, WS_VP = 1103 * MiB;
constexpr size_t WS_KS = 1168 * MiB, WS_VS = 1432 * MiB;
constexpr size_t WS_HRES2 = 1696 * MiB;
constexpr size_t WS_END = 1830 * MiB;
static_assert(WS_HRES + (size_t)M * D * 4 <= WS_HB && WS_HB + (size_t)M * D * 2 <= WS_SSQ && WS_SSQ + (size_t)M * 64 <= WS_XR, "ws map 1");
static_assert(WS_XR + (size_t)M * D * 2 <= WS_ZR && WS_SGA + (size_t)M * D * 2 <= WS_OX && WS_OX + (size_t)M * 4096 <= WS_MB && WS_MB + (size_t)M * 2048 <= WS_OP, "ws map 2");
static_assert(WS_OP + (size_t)M * 4096 <= WS_KP && WS_KP + (size_t)NB * KPROWS * 2048 <= WS_VP && WS_VP + (size_t)NB * KPROWS * 2048 <= WS_KS, "ws map 3");
static_assert(WS_KS + (size_t)DEPTH * NDB * KSROWS * 2048 <= WS_VS && WS_VS + (size_t)DEPTH * NDB * KSROWS * 2048 <= WS_END, "ws map 4");
constexpr int CW_TMO = 0, CW_CODE = 1;
constexpr int CW_QUEUE = 64;
constexpr int CW_BAR = 8192;

struct Args { const float* in[25]; float* out; unsigned char* ws; int ph_lo, ph_hi, li, pad; };
#define CAS __attribute__((address_space(4)))
typedef const CAS struct Args* ArgsP;
#define KARG() ({ ArgsP p_ = (ArgsP)__builtin_amdgcn_kernarg_segment_ptr(); asm volatile("" : "+s"(p_)); p_; })
enum { I_XP = 0, I_XS, I_CK, I_CV, I_SC, I_SR, I_META, I_NW, I_WIN, I_CW, I_CB, I_WRG, I_BRG, I_WIG, I_BIG, I_LAM, I_LQ1, I_LK1, I_LQ2, I_LK2, I_SUBLN, I_WPR, I_WPA, I_WOUT, I_FNW };


namespace pg8 {
#define PG8_LAS __attribute__((address_space(3)))
typedef unsigned short bf16_t;
typedef short bf16x8 __attribute__((ext_vector_type(8)));
typedef float f32x4 __attribute__((ext_vector_type(4)));
typedef unsigned u32x4 __attribute__((ext_vector_type(4)));
typedef unsigned u32x2 __attribute__((ext_vector_type(2)));
constexpr int BM = 256, BK = 64, HALF = 128, HTB = HALF * BK * 2  , STAGE_BYTES = 8 * HTB, NXCD = 8, WGM = 4;

__host__ __device__ __forceinline__ int lds_byte(int r, int c) { const int st = (r >> 4) * 2 + (c >> 5), rr = r & 15, cc = c & 31, ob = rr * 64 + cc * 2; return st * 1024 + (ob ^ (((ob >> 9) & 1) << 5)); }
__host__ __device__ __forceinline__ void stage_rc(int b, int& R, int& C) { const int st = b / 1024, sb = b % 1024, swz = sb ^ (((sb >> 9) & 1) << 5); R = (st >> 1) * 16 + swz / 64; C = (st & 1) * 32 + (swz % 64) / 2; }
__host__ __device__ __forceinline__ int perm32(int rho) { const int n = rho >> 4, i = rho & 15; return 8 * (i >> 2) + 4 * n + (i & 3); }

struct Unit { int pm, pn, kh; };
struct Gemm { const bf16_t* A; const bf16_t* Bt; int ld, kt, ks; };

struct StaticOrder {
    int nM, nN, nwg, G, c;
    __host__ __device__ void init(int M_, int N_, int G_, int c_) { nM = M_ / BM; nN = N_ / BM; nwg = nM * nN; G = G_; c = c_; }
    __host__ __device__ bool next(int i, Unit& u) const {
        const long L = (long)i * G + c; if (L >= nwg) return false;
        int wgid = (int)L; { const int q = nwg / NXCD, r = nwg % NXCD, xcd = wgid % NXCD, off = wgid / NXCD; wgid = (xcd < r ? xcd * (q + 1) : r * (q + 1) + (xcd - r) * q) + off; }
        const int nig = WGM * nN, gid = wgid / nig, fm = gid * WGM, gsz = (nM - fm) < WGM ? (nM - fm) : WGM;
        u.pm = fm + ((wgid % nig) % gsz); u.pn = (wgid % nig) / gsz;
        u.kh = 0; return true;
    }
    __device__ __forceinline__ void a_ready(const Unit&) const {}
    __device__ __forceinline__ void done(const Unit&) const {}
};
struct OneUnit {
    int pm, pn, nk;
    __host__ __device__ bool next(int i, Unit& u) const { if (i >= nk) return false; u.pm = pm; u.pn = pn; u.kh = i; return true; }
    __device__ __forceinline__ void a_ready(const Unit&) const {}
    __device__ __forceinline__ void done(const Unit&) const {}
};
struct TwoPartOrder {
    StaticOrder S;
    __host__ __device__ void init(int M_, int N_, int G_, int c_) { S.init(M_, N_, G_, c_); }
    __host__ __device__ bool next(int i, Unit& u) const { if (!S.next(i >> 1, u)) return false; u.kh = i & 1; return true; }
    __device__ __forceinline__ void a_ready(const Unit&) const {}
    __device__ __forceinline__ void done(const Unit&) const {}
};
__device__ __forceinline__ unsigned cvt_pk_bf16(float lo, float hi) { unsigned r; asm volatile("v_cvt_pk_bf16_f32 %0, %1, %2" : "=v"(r) : "v"(lo), "v"(hi)); return r; }
__device__ __forceinline__ float bf_lo(unsigned w) { return __uint_as_float(w << 16); }
__device__ __forceinline__ float bf_hi(unsigned w) { return __uint_as_float(w & 0xffff0000u); }
__device__ __forceinline__ float sigm(float x) { return __builtin_amdgcn_rcpf(1.0f + __expf(-x)); }
__device__ __forceinline__ u32x4 pack8(const f32x4 a, const f32x4 b) { u32x4 w; w.x = cvt_pk_bf16(a[0], a[1]); w.y = cvt_pk_bf16(a[2], a[3]); w.z = cvt_pk_bf16(b[0], b[1]); w.w = cvt_pk_bf16(b[2], b[3]); return w; }

struct EpiIn {
    static constexpr bool PERM = true, AFTER_DRAIN = false, TWO_PART = (MK_KPROBE != 0);
    int l; unsigned char* ws; float* out;
    __device__ __forceinline__ void mid(f32x4 (&)[2][2][4][2], const Unit&, int, int, int, int) const {}
    __device__ __forceinline__ void operator()(const f32x4 (&acc)[2][2][4][2], const Unit& u, int wr, int wc, int fr_in, int fq_in) const {
        int fr = fr_in, fq = fq_in; asm volatile("" : "+v"(fr), "+v"(fq));
        const float* ssq = (const float*)(ws + WS_SSQ); const float* tcos = (const float*)(ws + WS_TCOS); const float* tsin = (const float*)(ws + WS_TSIN);
        bf16_t* XR = (bf16_t*)(ws + WS_XR); bf16_t* ZR = (bf16_t*)(ws + WS_ZR); bf16_t* Q = (bf16_t*)(ws + WS_Q); bf16_t* ZA = (bf16_t*)(ws + WS_ZA); bf16_t* RHO = (bf16_t*)(ws + WS_RHO); bf16_t* SGA = (bf16_t*)(ws + WS_SGA);
        bf16_t* KP = (bf16_t*)(ws + WS_KP); bf16_t* VP = (bf16_t*)(ws + WS_VP); bf16_t* KS = (bf16_t*)(ws + WS_KS) + (size_t)l * NDB * KSROWS * D; bf16_t* VS = (bf16_t*)(ws + WS_VS) + (size_t)l * NDB * KSROWS * D;
        const int part = u.pn >> 2, pm = u.pm;
        const int ct = (u.pn & 3) * 256 + wc * 32 + 8 * fq;
        const int a = wc & 1;
        float rsv[2][4];
        { f32x4 sq[2][4];
#pragma unroll
          for (int ai = 0; ai < 2; ++ai)
#pragma unroll
            for (int m = 0; m < 4; ++m) sq[ai][m] = *(const f32x4*)(ssq + ((size_t)pm * BM + ai * HALF + wr * 64 + m * 16 + fr) * 16 + 4 * fq);
#pragma unroll
          for (int ai = 0; ai < 2; ++ai)
#pragma unroll
            for (int m = 0; m < 4; ++m) { float t = (sq[ai][m][0] + sq[ai][m][1]) + (sq[ai][m][2] + sq[ai][m][3]); t += __shfl_xor(t, 16); t += __shfl_xor(t, 32); rsv[ai][m] = rsqrtf(t * (1.0f / 1024.0f) + EPS) * (MK_KPROBE ? 0.5f : 1.0f); } }
        asm volatile("" ::: "memory");
#pragma unroll
        for (int ai = 0; ai < 2; ++ai) {
#pragma unroll
            for (int m = 0; m < 4; ++m) {
                const int r = ai * HALF + wr * 64 + m * 16 + fr; const size_t grow = (size_t)pm * BM + r;
                const float rs = rsv[ai][m];
                int pos, nrep = 1; size_t krow, frow; bool valid = true;
                if (pm < 128) { const int b = pm >> 4, t = (pm & 15) * 256 + r; pos = NMETA + t; krow = (size_t)b * KPROWS + 64 + t; frow = (size_t)(l * NB + b) * TP + NMETA + t; }
                else if (pm < 132) { const int idx = (pm - 128) * 256 + r, db = idx >> 6, s = idx & 63; pos = NMETA + PAST + s; krow = (size_t)db * KSROWS + PAST + s; frow = (size_t)(l * NDB + db) * DSQ + s; }
                else { pos = r & 15; krow = (size_t)(r & 15); frow = (size_t)(l * NB) * TP + (r & 15); nrep = NB; valid = r < NMETA; }
                const bool smp = (pm >= 128 && pm < 132);
                if (part == 0) {
                    bf16_t* rowp = XR + grow * D + ct;
#pragma unroll
                    for (int bj = 0; bj < 2; ++bj) { const f32x4 v0 = acc[ai][bj][m][0] * rs, v1 = acc[ai][bj][m][1] * rs; *(u32x4*)(rowp + bj * HALF) = pack8(v0, v1); }
                    if (m == 3 && fr >= 13) {
                        float* dst = nullptr;
                        if (pm < 128) { if ((pm & 15) == 15 && ai == 1 && wr == 1) dst = out + O_CP + ((size_t)(l * NB + (pm >> 4)) * 3 + (fr - 13)) * D; }
                        else if (pm < 132) { const int db = ((pm - 128) * 256 + r) >> 6; dst = out + O_CS + ((size_t)(l * NDB + db) * 3 + (fr - 13)) * D; }
                        if (dst) {
#pragma unroll
                            for (int bj = 0; bj < 2; ++bj) { *(f32x4*)(dst + ct + bj * HALF) = acc[ai][bj][m][0] * rs; *(f32x4*)(dst + ct + bj * HALF + 4) = acc[ai][bj][m][1] * rs; }
                        }
                    }
                } else if (part == 1 || part == 5) {
                    bf16_t* rowp = (part == 1 ? ZR : ZA) + grow * D + ct;
#pragma unroll
                    for (int bj = 0; bj < 2; ++bj) { f32x4 v0 = acc[ai][bj][m][0] * rs, v1 = acc[ai][bj][m][1] * rs;
#pragma unroll
                        for (int e = 0; e < 4; ++e) { v0[e] = v0[e] * sigm(v0[e]); v1[e] = v1[e] * sigm(v1[e]); }
                        *(u32x4*)(rowp + bj * HALF) = pack8(v0, v1); }
                } else if (part == 2 || part == 3) {
                    const size_t ci = (size_t)pos * 32 + 16 * a + 4 * fq; const f32x4 c4 = *(const f32x4*)(tcos + ci), s4 = *(const f32x4*)(tsin + ci);
#pragma unroll
                    for (int bj = 0; bj < 2; ++bj) { const f32x4 x1 = acc[ai][bj][m][0] * rs, x2 = acc[ai][bj][m][1] * rs; const f32x4 o1 = x1 * c4 - x2 * s4, o2 = x2 * c4 + x1 * s4;
                        if (part == 2) { *(u32x4*)(Q + grow * D + ct + bj * HALF) = pack8(o1 * QSCALE, o2 * QSCALE); }
                        else if (valid) {
                            const int oc = 64 * (4 * (u.pn & 3) + 2 * bj + (wc >> 1)) + 16 * a + 4 * fq;
                            const u32x4 w = pack8(o1, o2);
                            bf16_t* kd = (smp ? KS : KP) + krow * D + ct + bj * HALF; float* fd = out + (smp ? O_KS : O_KP) + frow * D + oc;
                            for (int rep = 0; rep < nrep; ++rep) { *(u32x4*)(kd + (size_t)rep * KPROWS * D) = w; *(f32x4*)(fd + (size_t)rep * TP * D) = o1; *(f32x4*)(fd + (size_t)rep * TP * D + 32) = o2; }
                        } }
                } else if (part == 4) {
                    if (valid) {
#pragma unroll
                        for (int bj = 0; bj < 2; ++bj) { const f32x4 v0 = acc[ai][bj][m][0] * rs, v1 = acc[ai][bj][m][1] * rs; const u32x4 w = pack8(v0, v1);
                            bf16_t* vd = (smp ? VS : VP) + krow * D + ct + bj * HALF; float* fd = out + (smp ? O_VS : O_VP) + frow * D + ct + bj * HALF;
                            for (int rep = 0; rep < nrep; ++rep) { *(u32x4*)(vd + (size_t)rep * KPROWS * D) = w; *(f32x4*)(fd + (size_t)rep * TP * D) = v0; *(f32x4*)(fd + (size_t)rep * TP * D + 4) = v1; } }
                    }
                } else {
                    const int gc = 128 * (u.pn - 24) + wc * 32 + 8 * fq;
                    f32x4 rho[2], sga[2];
#pragma unroll
                    for (int n = 0; n < 2; ++n) { const f32x4 gr = acc[ai][0][m][n] * rs, ga = acc[ai][1][m][n] * rs;
#pragma unroll
                        for (int e = 0; e < 4; ++e) { const float er = __expf(-fminf(fmaxf(gr[e], -30.f), 30.f)), ea = __expf(-fminf(fmaxf(ga[e], -30.f), 30.f));
                            rho[n][e] = (1.0f + ea) * __builtin_amdgcn_rcpf(1.0f + er); sga[n][e] = __builtin_amdgcn_rcpf(1.0f + ea); } }
                    *(u32x4*)(RHO + grow * D + gc) = pack8(rho[0], rho[1]); *(u32x4*)(SGA + grow * D + gc) = pack8(sga[0], sga[1]);
                }
                asm volatile("" ::: "memory");
            }
        }
    }
};

struct EpiProj {
    static constexpr bool PERM = true, AFTER_DRAIN = false, TWO_PART = true;
    unsigned char* ws;
    __device__ __forceinline__ void mid(f32x4 (&acc)[2][2][4][2], const Unit& u, int wr, int wc, int fr_in, int fq_in) const {
        int fr = fr_in, fq = fq_in; asm volatile("" : "+v"(fr), "+v"(fq));
        const bf16_t* RHO = (const bf16_t*)(ws + WS_RHO);
        const int c0 = u.pn * BM + wc * 32 + 8 * fq;
        u32x4 wv[2][4][2];
#pragma unroll
        for (int ai = 0; ai < 2; ++ai)
#pragma unroll
            for (int m = 0; m < 4; ++m)
#pragma unroll
                for (int bj = 0; bj < 2; ++bj) wv[ai][m][bj] = *(const u32x4*)(RHO + ((size_t)u.pm * BM + ai * HALF + wr * 64 + m * 16 + fr) * D + c0 + bj * HALF);
#pragma unroll
        for (int ai = 0; ai < 2; ++ai)
#pragma unroll
            for (int m = 0; m < 4; ++m)
#pragma unroll
                for (int bj = 0; bj < 2; ++bj) { const u32x4 w = wv[ai][m][bj];
                    acc[ai][bj][m][0] *= (f32x4){bf_lo(w.x), bf_hi(w.x), bf_lo(w.y), bf_hi(w.y)}; acc[ai][bj][m][1] *= (f32x4){bf_lo(w.z), bf_hi(w.z), bf_lo(w.w), bf_hi(w.w)}; }
    }
    __device__ __forceinline__ void operator()(const f32x4 (&acc)[2][2][4][2], const Unit& u, int wr, int wc, int fr_in, int fq_in) const {
        int fr = fr_in, fq = fq_in; asm volatile("" : "+v"(fr), "+v"(fq));
        const bf16_t* SGA = (const bf16_t*)(ws + WS_SGA); bf16_t* MB = (bf16_t*)(ws + WS_MB);
        const int c0 = u.pn * BM + wc * 32 + 8 * fq;
        u32x4 wv[2][4][2];
#pragma unroll
        for (int ai = 0; ai < 2; ++ai)
#pragma unroll
            for (int m = 0; m < 4; ++m)
#pragma unroll
                for (int bj = 0; bj < 2; ++bj) wv[ai][m][bj] = *(const u32x4*)(SGA + ((size_t)u.pm * BM + ai * HALF + wr * 64 + m * 16 + fr) * D + c0 + bj * HALF);
        asm volatile("" ::: "memory");
#pragma unroll
        for (int ai = 0; ai < 2; ++ai)
#pragma unroll
            for (int m = 0; m < 4; ++m) { const size_t grow = (size_t)u.pm * BM + ai * HALF + wr * 64 + m * 16 + fr;
#pragma unroll
                for (int bj = 0; bj < 2; ++bj) { const u32x4 w = wv[ai][m][bj];
                    const f32x4 v0 = acc[ai][bj][m][0] * (f32x4){bf_lo(w.x), bf_hi(w.x), bf_lo(w.y), bf_hi(w.y)}, v1 = acc[ai][bj][m][1] * (f32x4){bf_lo(w.z), bf_hi(w.z), bf_lo(w.w), bf_hi(w.w)};
                    *(u32x4*)(MB + grow * D + c0 + bj * HALF) = pack8(v0, v1); }
                if (m & 1) asm volatile("" ::: "memory"); }
    }
};

struct EpiOut {
    static constexpr bool PERM = true, AFTER_DRAIN = false, TWO_PART = false;
    unsigned char* ws;
    __device__ __forceinline__ void mid(f32x4 (&)[2][2][4][2], const Unit&, int, int, int, int) const {}
    __device__ __forceinline__ void operator()(const f32x4 (&acc)[2][2][4][2], const Unit& u, int wr, int wc, int fr_in, int fq_in) const {
        int fr = fr_in, fq = fq_in; asm volatile("" : "+v"(fr), "+v"(fq));
        bf16_t* HB = (bf16_t*)(ws + WS_HB); float* ssq = (float*)(ws + WS_SSQ);
        const int c0 = u.pn * BM + wc * 32 + 8 * fq;
        u32x4 hin[2][4][2];
#pragma unroll
        for (int ai = 0; ai < 2; ++ai)
#pragma unroll
            for (int m = 0; m < 4; ++m)
#pragma unroll
                for (int bj = 0; bj < 2; ++bj) hin[ai][m][bj] = *(const u32x4*)(HB + ((size_t)u.pm * BM + ai * HALF + wr * 64 + m * 16 + fr) * D + c0 + bj * HALF);
        asm volatile("" ::: "memory");
#pragma unroll
        for (int ai = 0; ai < 2; ++ai)
#pragma unroll
            for (int m = 0; m < 4; ++m) { const size_t grow = (size_t)u.pm * BM + ai * HALF + wr * 64 + m * 16 + fr; float ss = 0.f;
#pragma unroll
                for (int bj = 0; bj < 2; ++bj) { const u32x4 w = hin[ai][m][bj];
                    const f32x4 v0 = (f32x4){bf_lo(w.x), bf_hi(w.x), bf_lo(w.y), bf_hi(w.y)} + acc[ai][bj][m][0], v1 = (f32x4){bf_lo(w.z), bf_hi(w.z), bf_lo(w.w), bf_hi(w.w)} + acc[ai][bj][m][1];
                    *(u32x4*)(HB + grow * D + c0 + bj * HALF) = pack8(v0, v1);
                    ss += ((v0[0] * v0[0] + v0[1] * v0[1]) + (v0[2] * v0[2] + v0[3] * v0[3])) + ((v1[0] * v1[0] + v1[1] * v1[1]) + (v1[2] * v1[2] + v1[3] * v1[3])); }
                ss += __shfl_xor(ss, 16); ss += __shfl_xor(ss, 32);
                if (fq == 0) ssq[grow * 16 + u.pn * 4 + wc] = ss;
            }
    }
};
template <class Epi, class Sched, bool ALIGN_EPI = false, bool SP2 = false>
__device__ __forceinline__ void gemm_phase(PG8_LAS unsigned char* lds, const Gemm g, const Sched& S, const Epi& E) {
    int tid_o = threadIdx.x; asm volatile("" : "+v"(tid_o));
    const int tid = tid_o, wid = __builtin_amdgcn_readfirstlane(tid >> 6), lane = tid & 63, wr = wid >> 2, wc = wid & 3, fr = lane & 15, fq = lane >> 4;
    const int K = g.ld, nt = g.kt / BK; const size_t khb = (size_t)g.ks * 2;
    unsigned voffA[2], voffB[2];
#pragma unroll
    for (int i = 0; i < 2; ++i) { int R, C; stage_rc(tid * 16 + i * 8192, R, C); const int Rb = Epi::PERM ? ((R & ~31) + perm32(R & 31)) : R;
        voffA[i] = (unsigned)(R * K + C) * 2u; voffB[i] = (unsigned)(Rb * K + C) * 2u; }
    const size_t kstep = (size_t)(BK * 2);
    const size_t hstep = (size_t)HALF * K * 2;
    const size_t tstep = 2 * hstep;
    const unsigned ldsw = (unsigned)wid * 1024u;
    const int aoff = lds_byte(wr * 64 + fr, fq * 8), boff = lds_byte(wc * 32 + fr, fq * 8);
#define PG8_SA(b, h) (((b) * 2 + (h)) * HTB)
#define PG8_SB(b, h) ((4 + (b) * 2 + (h)) * HTB)
#define PG8_STAGE(bufoff, gbase, voff) do { _Pragma("unroll") for (int _i = 0; _i < 2; ++_i) \
        __builtin_amdgcn_global_load_lds((const unsigned*)((const char*)(gbase) + (voff)[_i]), (PG8_LAS unsigned*)(lds + (bufoff) + ldsw + _i * 8192), 16, 0, 0); } while (0)
#define PG8_LDA(dst, b, h) do { _Pragma("unroll") for (int m = 0; m < 4; ++m) _Pragma("unroll") for (int k = 0; k < 2; ++k) dst[m][k] = *(const PG8_LAS bf16x8*)(lds + PG8_SA(b, h) + aoff + m * 2048 + k * 1024); } while (0)
#define PG8_LDB(dst, b, h) do { _Pragma("unroll") for (int n = 0; n < 2; ++n) _Pragma("unroll") for (int k = 0; k < 2; ++k) dst[n][k] = *(const PG8_LAS bf16x8*)(lds + PG8_SB(b, h) + boff + n * 2048 + k * 1024); } while (0)
#define PG8_MMA(ai, bj, At, Bt) do { __builtin_amdgcn_s_setprio(1); _Pragma("unroll") for (int m = 0; m < 4; ++m) _Pragma("unroll") for (int n = 0; n < 2; ++n) _Pragma("unroll") for (int k = 0; k < 2; ++k) \
        acc[ai][bj][m][n] = __builtin_amdgcn_mfma_f32_16x16x32_bf16(Bt[n][k], At[m][k], acc[ai][bj][m][n], 0, 0, 0); __builtin_amdgcn_s_setprio(0); } while (0)
#define PG8_WAIT_V(n) asm volatile("s_waitcnt vmcnt(" #n ")" ::: "memory")
#define PG8_WAIT_L(n) asm volatile("s_waitcnt lgkmcnt(" #n ")" ::: "memory")
#define PG8_BAR __builtin_amdgcn_s_barrier()
#define PG8_SCHED __builtin_amdgcn_sched_barrier(0)
    Unit cur, nxt; int ui = 0;
    if (!S.next(0, cur)) return;
    f32x4 acc[2][2][4][2];
#pragma unroll
    for (int a = 0; a < 2; ++a)
#pragma unroll
        for (int b = 0; b < 2; ++b)
#pragma unroll
            for (int m = 0; m < 4; ++m)
#pragma unroll
                for (int n = 0; n < 2; ++n) acc[a][b][m][n] = (f32x4){0.f, 0.f, 0.f, 0.f};
    bf16x8 At[4][2], B0[2][2], B1[2][2];
    const char* cA = (const char*)g.A + (size_t)cur.pm * tstep + (size_t)cur.kh * khb; const char* cB = (const char*)g.Bt + (size_t)cur.pn * tstep + (size_t)cur.kh * khb;
    S.a_ready(cur);
    if constexpr (SP2) {
        PG8_STAGE(PG8_SB(0, 0), cB, voffB); PG8_STAGE(PG8_SB(0, 1), cB + hstep, voffB); PG8_STAGE(PG8_SA(0, 0), cA, voffA); PG8_STAGE(PG8_SA(0, 1), cA + hstep, voffA);
        if (wr == 1) PG8_BAR;
        PG8_WAIT_V(2); PG8_BAR;
        PG8_STAGE(PG8_SB(1, 0), cB + kstep, voffB); PG8_STAGE(PG8_SA(1, 0), cA + kstep, voffA); PG8_STAGE(PG8_SB(1, 1), cB + hstep + kstep, voffB);
        PG8_WAIT_V(6); PG8_BAR;
    } else {
        PG8_STAGE(PG8_SB(0, 0), cB, voffB); PG8_STAGE(PG8_SA(0, 0), cA, voffA); PG8_STAGE(PG8_SB(0, 1), cB + hstep, voffB); PG8_STAGE(PG8_SA(0, 1), cA + hstep, voffA);
        if (wr == 1) PG8_BAR;
        PG8_WAIT_V(4); PG8_BAR;
        PG8_STAGE(PG8_SB(1, 0), cB + kstep, voffB); PG8_STAGE(PG8_SA(1, 0), cA + kstep, voffA); PG8_STAGE(PG8_SB(1, 1), cB + hstep + kstep, voffB);
        PG8_WAIT_V(6); PG8_BAR;
    }
    for (;;) {
        const bool has_next = S.next(ui + 1, nxt);
        const char* nA = has_next ? (const char*)g.A + (size_t)nxt.pm * tstep + (size_t)nxt.kh * khb : cA; const char* nB = has_next ? (const char*)g.Bt + (size_t)nxt.pn * tstep + (size_t)nxt.kh * khb : cB;
        for (int t = 0; t < nt; t += 2) {
            const bool last = (t == nt - 2);
            const char* a1 = cA + (size_t)(t + 1) * kstep;
            const char* a2 = last ? nA : cA + (size_t)(t + 2) * kstep; const char* b2 = last ? nB : cB + (size_t)(t + 2) * kstep;
            const char* a3 = a2 + kstep; const char* b3 = b2 + kstep;
            if (last && has_next) S.a_ready(nxt);
            if constexpr (SP2) {
            PG8_LDB(B0, 0, 0); PG8_LDB(B1, 0, 1); PG8_SCHED; PG8_LDA(At, 0, 0); PG8_STAGE(PG8_SA(1, 1), a1 + hstep, voffA);
            PG8_WAIT_V(8); PG8_WAIT_L(0); PG8_BAR; PG8_MMA(0, 0, At, B0); PG8_MMA(0, 1, At, B1); PG8_BAR; PG8_SCHED;
            PG8_LDA(At, 0, 1); PG8_STAGE(PG8_SB(0, 0), b2, voffB); PG8_STAGE(PG8_SB(0, 1), b2 + hstep, voffB); PG8_STAGE(PG8_SA(0, 0), a2, voffA);
            PG8_WAIT_V(8); PG8_WAIT_L(0); PG8_BAR; PG8_MMA(1, 0, At, B0); PG8_MMA(1, 1, At, B1); PG8_BAR; PG8_SCHED;
            PG8_LDB(B0, 1, 0); PG8_LDB(B1, 1, 1); PG8_SCHED; PG8_LDA(At, 1, 0); PG8_STAGE(PG8_SA(0, 1), a2 + hstep, voffA);
            PG8_WAIT_V(8); PG8_WAIT_L(0); PG8_BAR; PG8_MMA(0, 0, At, B0); PG8_MMA(0, 1, At, B1); PG8_BAR; PG8_SCHED;
            PG8_LDA(At, 1, 1); PG8_STAGE(PG8_SB(1, 0), b3, voffB); PG8_STAGE(PG8_SB(1, 1), b3 + hstep, voffB); PG8_STAGE(PG8_SA(1, 0), a3, voffA);
            PG8_WAIT_V(8); PG8_WAIT_L(0); PG8_BAR; PG8_MMA(1, 0, At, B0); PG8_MMA(1, 1, At, B1); PG8_BAR; PG8_SCHED;
            } else {
            PG8_LDB(B0, 0, 0); PG8_SCHED; PG8_LDA(At, 0, 0); PG8_STAGE(PG8_SA(1, 1), a1 + hstep, voffA);
            PG8_WAIT_L(8); PG8_BAR; PG8_WAIT_L(0); PG8_MMA(0, 0, At, B0); PG8_BAR; PG8_SCHED;
            PG8_LDB(B1, 0, 1); PG8_STAGE(PG8_SB(0, 0), b2, voffB);
            PG8_BAR; PG8_WAIT_L(0); PG8_MMA(0, 1, At, B1); PG8_BAR;
            PG8_LDA(At, 0, 1); PG8_STAGE(PG8_SA(0, 0), a2, voffA);
            PG8_BAR; PG8_WAIT_L(0); PG8_MMA(1, 0, At, B0); PG8_BAR; PG8_SCHED;
            PG8_STAGE(PG8_SB(0, 1), b2 + hstep, voffB);
            PG8_WAIT_V(6); PG8_BAR; PG8_MMA(1, 1, At, B1); PG8_BAR;
            PG8_LDB(B0, 1, 0); PG8_SCHED; PG8_LDA(At, 1, 0); PG8_STAGE(PG8_SA(0, 1), a2 + hstep, voffA);
            PG8_WAIT_L(8); PG8_BAR; PG8_WAIT_L(0); PG8_MMA(0, 0, At, B0); PG8_BAR; PG8_SCHED;
            PG8_LDB(B1, 1, 1); PG8_STAGE(PG8_SB(1, 0), b3, voffB);
            PG8_BAR; PG8_WAIT_L(0); PG8_MMA(0, 1, At, B1); PG8_BAR;
            PG8_LDA(At, 1, 1); PG8_STAGE(PG8_SA(1, 0), a3, voffA);
            PG8_BAR; PG8_WAIT_L(0); PG8_MMA(1, 0, At, B0); PG8_BAR; PG8_SCHED;
            PG8_STAGE(PG8_SB(1, 1), b3 + hstep, voffB);
            PG8_WAIT_V(6); PG8_BAR; PG8_MMA(1, 1, At, B1); PG8_BAR;
            }
        }
        if constexpr (ALIGN_EPI) { if (wr == 0) PG8_BAR; }
        bool keep = false;
        if constexpr (Epi::TWO_PART) { if (cur.kh == 0) { E.mid(acc, cur, wr, wc, fr, fq); keep = true; } else { E(acc, cur, wr, wc, fr, fq); } } else { E(acc, cur, wr, wc, fr, fq); }
        S.done(cur);
        if (!has_next) break;
        if (!keep) {
#pragma unroll
        for (int a = 0; a < 2; ++a)
#pragma unroll
            for (int b = 0; b < 2; ++b)
#pragma unroll
                for (int m = 0; m < 4; ++m)
#pragma unroll
                    for (int n = 0; n < 2; ++n) acc[a][b][m][n] = (f32x4){0.f, 0.f, 0.f, 0.f};
        }
        cur = nxt; cA = nA; cB = nB; ++ui;
        if constexpr (ALIGN_EPI) { if (wr == 1) PG8_BAR; }
    }
    PG8_WAIT_V(0);
    if constexpr (!ALIGN_EPI) { if (wr == 0) PG8_BAR; }
    PG8_BAR;
#undef PG8_SA
#undef PG8_SB
#undef PG8_STAGE
#undef PG8_LDA
#undef PG8_LDB
#undef PG8_MMA
#undef PG8_WAIT_V
#undef PG8_WAIT_L
#undef PG8_BAR
#undef PG8_SCHED
}
}

#include <hip/hip_bf16.h>
#include <cmath>
namespace attn_body {
using bf16=__hip_bfloat16;
using bf16x8=__attribute__((ext_vector_type(8)))short;
using s16x4=__attribute__((ext_vector_type(4)))short;
using f32x16=__attribute__((ext_vector_type(16)))float;
using u32x4=__attribute__((ext_vector_type(4)))unsigned;
constexpr int D=64,DM=1024,OPITCH=2048;
constexpr int NW=8,QBLK=32,QB=QBLK*NW,KVBLK=64;
constexpr int ATTN_PITCH=DM, ATTN_UNIT_ROWS=QB;
__device__ __forceinline__ int crow(int r,int hi){return (r&3)+8*(r>>2)+4*hi;}
#define SBAR() __builtin_amdgcn_sched_barrier(0)
__device__ __forceinline__ void cmask(f32x16&p0,f32x16&p1,int jb,int qrel,int hi){
  const float NEG=-INFINITY; int kb=64*jb+4*hi;
  #pragma unroll
  for(int r=0;r<16;++r){int kv=kb+(r&3)+8*(r>>2); if(kv>qrel)p0[r]=NEG; if(kv+32>qrel)p1[r]=NEG;}
}

constexpr int NSLOT=3, SLOTB=8192;
constexpr int LDS_K=0, LDS_V=NSLOT*SLOTB, LDS_WS=2*NSLOT*SLOTB, LDS_OST=LDS_WS+NW*64*4, LDS_BYTES=LDS_OST+NW*4096;
constexpr float C2=0.125f*1.4426950408889634f;
__device__ __forceinline__ void glds16(const void*gsrc,unsigned lds_dst){unsigned keep;
  asm volatile("s_mov_b32 %0, m0\n\ts_mov_b32 m0, %2\n\ts_nop 0\n\tglobal_load_lds_dwordx4 %1, off\n\ts_mov_b32 m0, %0":"=&s"(keep):"v"(gsrc),"s"(lds_dst):"memory");}
__device__ __forceinline__ float max3f(float a,float b,float c){float r;asm("v_max3_f32 %0, %1, %2, %3":"=v"(r):"v"(a),"v"(b),"v"(c));return r;}
__device__ __forceinline__ float max2f(float a,float b){float r;asm("v_max_f32_e32 %0, %1, %2":"=v"(r):"v"(a),"v"(b));return r;}
__device__ __forceinline__ float fadd_s(float a,float b){float r;asm("v_add_f32_e32 %0, %1, %2":"=v"(r):"v"(a),"v"(b));return r;}
__device__ __forceinline__ float fsub_s(float a,float b){float r;asm("v_sub_f32_e32 %0, %1, %2":"=v"(r):"v"(a),"v"(b));return r;}
typedef float f32x2_t __attribute__((ext_vector_type(2))); typedef __bf16 bf16x2_t __attribute__((ext_vector_type(2)));
__device__ __forceinline__ unsigned cvtpk_s(float lo,float hi){f32x2_t v={lo,hi};bf16x2_t b=__builtin_convertvector(v,bf16x2_t);return __builtin_bit_cast(unsigned,b);}
#define WAIT_BAR(N) asm volatile("s_waitcnt vmcnt(" #N ") lgkmcnt(0)\n\ts_barrier":::"memory")

__device__ __forceinline__ void qkt(f32x16&p0,f32x16&p1,const char*Kslot,const bf16x8*qr,const f32x16&negm,int r32,int hi){
  const char*kb=Kslot+hi*1024+r32*16;
  #pragma unroll
  for(int d0=0;d0<4;++d0){
    const bf16x8 b0=*reinterpret_cast<const bf16x8*>(kb+d0*2048);
    const bf16x8 b1=*reinterpret_cast<const bf16x8*>(kb+d0*2048+512);
    if(d0==0){p0=__builtin_amdgcn_mfma_f32_32x32x16_bf16(b0,qr[0],negm,0,0,0);p1=__builtin_amdgcn_mfma_f32_32x32x16_bf16(b1,qr[0],negm,0,0,0);}
    else{p0=__builtin_amdgcn_mfma_f32_32x32x16_bf16(b0,qr[d0],p0,0,0,0);p1=__builtin_amdgcn_mfma_f32_32x32x16_bf16(b1,qr[d0],p1,0,0,0);}}
}
typedef __attribute__((address_space(3))) const char* lds_cptr;
typedef short v4i16_t __attribute__((ext_vector_type(4)));
__device__ __forceinline__ void kload8(bf16x8*kf,lds_cptr kp){
  kf[0]=*(const __attribute__((address_space(3))) bf16x8*)(kp);      kf[1]=*(const __attribute__((address_space(3))) bf16x8*)(kp+512);
  kf[2]=*(const __attribute__((address_space(3))) bf16x8*)(kp+2048); kf[3]=*(const __attribute__((address_space(3))) bf16x8*)(kp+2560);
  kf[4]=*(const __attribute__((address_space(3))) bf16x8*)(kp+4096); kf[5]=*(const __attribute__((address_space(3))) bf16x8*)(kp+4608);
  kf[6]=*(const __attribute__((address_space(3))) bf16x8*)(kp+6144); kf[7]=*(const __attribute__((address_space(3))) bf16x8*)(kp+6656);
}
__device__ __forceinline__ void kload2(bf16x8*kf,lds_cptr kp,int j){ kf[2*j]=*(const __attribute__((address_space(3))) bf16x8*)(kp+j*2048); kf[2*j+1]=*(const __attribute__((address_space(3))) bf16x8*)(kp+j*2048+512); }
__device__ __forceinline__ s16x4 vtr(lds_cptr p){ return __builtin_bit_cast(s16x4,__builtin_amdgcn_ds_read_tr16_b64_v4i16((__attribute__((address_space(3))) v4i16_t*)p)); }
__device__ __forceinline__ float rowmax(const f32x16&p0,const f32x16&p1){
  float a=max3f(p0[0],p0[1],p1[0]),b=max3f(p0[2],p0[3],p1[1]);a=max3f(a,p1[2],p1[3]);
  #pragma unroll
  for(int r=4;r<16;r+=4){a=max3f(a,p0[r],p0[r+1]);b=max3f(b,p0[r+2],p0[r+3]);a=max3f(a,p1[r],p1[r+1]);b=max3f(b,p1[r+2],p1[r+3]);}
  const float m=max2f(a,b);
  auto rr=__builtin_amdgcn_permlane32_swap(__float_as_uint(m),__float_as_uint(m),false,false);
  return max2f(__uint_as_float(rr[0]),__uint_as_float(rr[1]));
}
__device__ __forceinline__ void pv(f32x16*o,int vb,bf16x8 pa0,bf16x8 pa1,bf16x8 pa2,bf16x8 pa3){
  #pragma unroll
  for(int d0=0;d0<2;++d0){s16x4 lo[4],hi[4];
    #pragma unroll
    for(int ks=0;ks<4;++ks){
      asm volatile("ds_read_b64_tr_b16 %0,%1 offset:%c2":"=&v"(lo[ks]):"v"(vb),"i"(d0*4096+ks*1024):"memory");
      asm volatile("ds_read_b64_tr_b16 %0,%1 offset:%c2":"=&v"(hi[ks]):"v"(vb),"i"(d0*4096+ks*1024+512):"memory");}
    asm volatile("s_waitcnt lgkmcnt(0)":::"memory");SBAR();
    #define PK(k) (bf16x8){lo[k][0],lo[k][1],lo[k][2],lo[k][3],hi[k][0],hi[k][1],hi[k][2],hi[k][3]}
    o[d0]=__builtin_amdgcn_mfma_f32_32x32x16_bf16(pa0,PK(0),o[d0],0,0,0);
    o[d0]=__builtin_amdgcn_mfma_f32_32x32x16_bf16(pa1,PK(1),o[d0],0,0,0);
    o[d0]=__builtin_amdgcn_mfma_f32_32x32x16_bf16(pa2,PK(2),o[d0],0,0,0);
    o[d0]=__builtin_amdgcn_mfma_f32_32x32x16_bf16(pa3,PK(3),o[d0],0,0,0);
    #undef PK
  }
}

#ifndef ATTN_STORE16
#define ATTN_STORE16(p,v) (*(u32x4*)(p)=(v))
#endif
template<int THRL,bool MASKED> __device__ __forceinline__ void attn_unit(const bf16*Qin,const bf16*__restrict__ Kh,const bf16*__restrict__ Vh,bf16*Oin,const int NT,const int vis,const int qwaves,char*shm){
  int tid_o=threadIdx.x; asm volatile("":"+v"(tid_o));
  const int tid=tid_o,lane=tid&63,r32=lane&31,hi=lane>>5; const int wid=__builtin_amdgcn_readfirstlane(tid>>6);
  const bf16*Qw=Qin+(long)((wid&(qwaves-1))*QBLK)*DM;
  const unsigned lds0=(unsigned)(uintptr_t)shm;
  float*wsf=(float*)(shm+LDS_WS)+wid*64;
  const bf16*ksrc=Kh+(long)lane*DM+wid*8;
  const bf16*vsrc=Vh+(long)(16*(wid&3)+(lane>>2))*DM+(wid>>2)*32+(lane&3)*8;
  const unsigned kdst=lds0+LDS_K+wid*1024, vdst=lds0+LDS_V+wid*1024;
  #define DMA_K(t,slot) glds16(ksrc+(long)(t)*KVBLK*DM,(unsigned)__builtin_amdgcn_readfirstlane(kdst+(slot)))
  #define DMA_V(t,slot) glds16(vsrc+(long)(t)*KVBLK*DM,(unsigned)__builtin_amdgcn_readfirstlane(vdst+(slot)))
  const int vb0=(int)(lds0+LDS_V)+((lane>>4)&1)*32+(lane&3)*8+(4*hi+((lane&15)>>2))*64;
  const char*Kbase=shm+LDS_K; bf16x8 kf[8];
  const lds_cptr shm3=(lds_cptr)shm; const lds_cptr kp0=shm3+LDS_K+hi*1024+r32*16; const lds_cptr vp0=shm3+LDS_V+((lane>>4)&1)*32+(lane&3)*8+(4*hi+((lane&15)>>2))*64;
  DMA_K(0,0);DMA_V(0,0);DMA_K(1,SLOTB);
  bf16x8 qr[4];
  #pragma unroll
  for(int d0=0;d0<4;++d0)qr[d0]=*reinterpret_cast<const bf16x8*>(&Qw[(long)r32*DM+d0*16+hi*8]);
  float mhat=0.f,l_reg=0.f;f32x16 o[2];o[0]=f32x16{};o[1]=f32x16{};f32x16 negm=f32x16{};asm volatile("":"+v"(negm));
  #define CMASK(P0,P1,t) do{ if(MASKED){ const int jb_=(t)-(NT-4); if(jb_>=vis){ _Pragma("unroll") for(int r_=0;r_<16;++r_){P0[r_]=-INFINITY;P1[r_]=-INFINITY;} } } }while(0)
  bool resc=false;
  #define START(P0,P1) do{ const float rm=rowmax(P0,P1); resc=false; \
    { const float dl=rm; mhat=fadd_s(mhat,dl); \
      _Pragma("unroll") for(int r=0;r<16;++r){P0[r]=fsub_s(P0[r],dl);P1[r]=fsub_s(P1[r],dl);} \
      _Pragma("unroll") for(int r=0;r<16;++r)negm[r]=-mhat; asm volatile("":"+v"(negm)); } \
    _Pragma("unroll") for(int r=0;r<16;++r)P0[r]=__builtin_amdgcn_exp2f(P0[r]); }while(0)
  #define RESC() do{ if(resc){ asm volatile("s_waitcnt lgkmcnt(0)":::"memory"); \
      _Pragma("unroll") for(int d_=0;d_<2;++d_) _Pragma("unroll") for(int r=0;r<16;++r)o[d_][r]*=wsf[crow(r,hi)]; } }while(0)
  f32x16 pA0,pA1,pB0,pB1;
  int sl_prev=0,sl_cur=0,sl_next=SLOTB;
  #define ROT() do{sl_prev=sl_cur;sl_cur=sl_next;sl_next=(sl_next==(NSLOT-1)*SLOTB)?0:sl_next+SLOTB;}while(0)
  DMA_K(2,2*SLOTB);
  WAIT_BAR(3);
  qkt(pA0,pA1,Kbase,qr,negm,r32,hi);asm volatile("s_nop 15\n\ts_nop 7":"+v"(pA0),"+v"(pA1));
  if(MASKED){ _Pragma("unroll") for(int r_=8;r_<16;++r_)pA0[r_]=-INFINITY; _Pragma("unroll") for(int r_=0;r_<16;++r_)pA1[r_]=-INFINITY; }
  START(pA0,pA1);
  _Pragma("unroll") for(int r=0;r<16;++r)pA1[r]=__builtin_amdgcn_exp2f(pA1[r]);
  WAIT_BAR(0);
  DMA_K(3,0);DMA_V(1,SLOTB);
  ROT();
  kload8(kf,kp0+sl_cur);
  WAIT_BAR(2);
  s16x4 vlo[8],vhi[8]; u32x4 pw0,pw1,pw2,pw3;
  #define PKW(P,B) cvtpk_s(P[B],P[B+1])
  #define PAF(k) __builtin_bit_cast(bf16x8,pw##k)
  #define VFR(i) (bf16x8){vlo[i][0],vlo[i][1],vlo[i][2],vlo[i][3],vhi[i][0],vhi[i][1],vhi[i][2],vhi[i][3]}
  #define PIN(x) asm volatile("":"+v"(x))
  #define MX3(a,b,c) __builtin_fmaxf(__builtin_fmaxf((a),(b)),(c))
  #define GAPA(MF,A0,A1,A2,A3,W0,W1,PW) do{ MF; sacc+=A0; sacc+=A1; sacc+=A2; sacc+=A3; PIN(sacc); W0; W1; PIN(PW); SBAR(); }while(0)
  #define EX(v) __builtin_amdgcn_exp2f(v)
  #define GAPB(MF,X,B) do{ MF; X[B]=EX(X[B]); X[B+1]=EX(X[B+1]); X[B+2]=EX(X[B+2]); X[B+3]=EX(X[B+3]); PIN(X); SBAR(); }while(0)
  #define VRD(i) do{ vlo[i]=vtr(vp_+(((i)>>2)*4096+((i)&3)*1024)); vhi[i]=vtr(vp_+(((i)>>2)*4096+((i)&3)*1024+512)); }while(0)
  #define KRD(G,j) do{ if(G){ kload2(kf,kp0+sl_next,j); SBAR(); } }while(0)
  #define STEP(C0,C1,P0,P1,t,GK,GV,GL) do{ SBAR(); \
    const lds_cptr vp_=vp0+sl_prev; \
    VRD(0); SBAR(); float sacc=(P0[0]+P0[1]); \
    GAPA(C0=__builtin_amdgcn_mfma_f32_32x32x16_bf16(kf[0],qr[0],negm,0,0,0), P0[2],P0[3],P0[4],P0[5],     pw0[0]=PKW(P0,0), pw0[1]=PKW(P0,2), pw0); \
    VRD(4); SBAR(); GAPA(C1=__builtin_amdgcn_mfma_f32_32x32x16_bf16(kf[1],qr[0],negm,0,0,0), P0[6],P0[7],P0[8],P0[9],     pw0[2]=PKW(P0,4), pw0[3]=PKW(P0,6), pw0); \
    VRD(1); SBAR(); GAPA(C0=__builtin_amdgcn_mfma_f32_32x32x16_bf16(kf[2],qr[1],C0,0,0,0),   P0[10],P0[11],P0[12],P0[13], pw1[0]=PKW(P0,8), pw1[1]=PKW(P0,10), pw1); \
    VRD(5); SBAR(); GAPA(C1=__builtin_amdgcn_mfma_f32_32x32x16_bf16(kf[3],qr[1],C1,0,0,0),   P0[14],P0[15],P1[0],P1[1],   pw1[2]=PKW(P0,12),pw1[3]=PKW(P0,14), pw1); \
    VRD(2); SBAR(); GAPA(C0=__builtin_amdgcn_mfma_f32_32x32x16_bf16(kf[4],qr[2],C0,0,0,0),   P1[2],P1[3],P1[4],P1[5],     pw2[0]=PKW(P1,0), pw2[1]=PKW(P1,2), pw2); \
    VRD(6); SBAR(); GAPA(C1=__builtin_amdgcn_mfma_f32_32x32x16_bf16(kf[5],qr[2],C1,0,0,0),   P1[6],P1[7],P1[8],P1[9],     pw2[2]=PKW(P1,4), pw2[3]=PKW(P1,6), pw2); \
    VRD(3); SBAR(); GAPA(C0=__builtin_amdgcn_mfma_f32_32x32x16_bf16(kf[6],qr[3],C0,0,0,0),   P1[10],P1[11],P1[12],P1[13], pw3[0]=PKW(P1,8), pw3[1]=PKW(P1,10), pw3); \
    VRD(7); SBAR(); GAPA(C1=__builtin_amdgcn_mfma_f32_32x32x16_bf16(kf[7],qr[3],C1,0,0,0),   P1[14],P1[15],0.f,0.f,       pw3[2]=PKW(P1,12),pw3[3]=PKW(P1,14), pw3); \
    l_reg+=sacc; \
    if(GK){DMA_K((t)+3,sl_cur);} if(GV){DMA_V((t)+1,sl_next);} \
    CMASK(C0,C1,t); \
    { float a=MX3(C0[0],C0[1],C1[0]),b=MX3(C0[2],C0[3],C1[1]); a=MX3(a,C1[2],C1[3]); \
      _Pragma("unroll") for(int r=4;r<16;r+=4){a=MX3(a,C0[r],C0[r+1]);b=MX3(b,C0[r+2],C0[r+3]);a=MX3(a,C1[r],C1[r+1]);b=MX3(b,C1[r+2],C1[r+3]);} \
      float rm=__builtin_fmaxf(a,b); { auto rr=__builtin_amdgcn_permlane32_swap(__float_as_uint(rm),__float_as_uint(rm),false,false); rm=__builtin_fmaxf(__uint_as_float(rr[0]),__uint_as_float(rr[1])); } \
      resc=false; \
      if(__builtin_expect(__any(rm>(float)THRL),0)){ const float dl=__builtin_fmaxf(rm,0.f); mhat+=dl; \
        _Pragma("unroll") for(int r=0;r<16;++r){C0[r]-=dl;C1[r]-=dl;} \
        _Pragma("unroll") for(int r=0;r<16;++r)negm[r]=-mhat; asm volatile("":"+v"(negm)); \
        const float f=__builtin_amdgcn_exp2f(-dl); l_reg*=f; if(hi==0)wsf[r32]=f; resc=true; } } \
    SBAR(); \
    GAPB(o[0]=__builtin_amdgcn_mfma_f32_32x32x16_bf16(PAF(0),VFR(0),o[0],0,0,0), C0,0); \
    GAPB(o[1]=__builtin_amdgcn_mfma_f32_32x32x16_bf16(PAF(0),VFR(4),o[1],0,0,0), C0,4); \
    KRD(GL,0); GAPB(o[0]=__builtin_amdgcn_mfma_f32_32x32x16_bf16(PAF(1),VFR(1),o[0],0,0,0), C0,8); \
    KRD(GL,1); GAPB(o[1]=__builtin_amdgcn_mfma_f32_32x32x16_bf16(PAF(1),VFR(5),o[1],0,0,0), C0,12); \
    KRD(GL,2); GAPB(o[0]=__builtin_amdgcn_mfma_f32_32x32x16_bf16(PAF(2),VFR(2),o[0],0,0,0), C1,0); \
    KRD(GL,3); GAPB(o[1]=__builtin_amdgcn_mfma_f32_32x32x16_bf16(PAF(2),VFR(6),o[1],0,0,0), C1,4); \
    GAPB(o[0]=__builtin_amdgcn_mfma_f32_32x32x16_bf16(PAF(3),VFR(3),o[0],0,0,0), C1,8); \
    GAPB(o[1]=__builtin_amdgcn_mfma_f32_32x32x16_bf16(PAF(3),VFR(7),o[1],0,0,0), C1,12); \
    }while(0)
  int t=1;
  #undef CMASK
  #define CMASK(P0,P1,t) do{}while(0)
  for(;t+5<NT;t+=2){
    STEP(pB0,pB1,pA0,pA1,t,true,true,true);     WAIT_BAR(2); RESC(); ROT();
    STEP(pA0,pA1,pB0,pB1,t+1,true,true,true);   WAIT_BAR(2); RESC(); ROT();
  }
  #undef CMASK
  #define CMASK(P0,P1,t) do{ if(MASKED){ const int jb_=(t)-(NT-4); if(jb_>=vis){ _Pragma("unroll") for(int r_=0;r_<16;++r_){P0[r_]=-INFINITY;P1[r_]=-INFINITY;} } } }while(0)
  #define ENDW(tt) do{ if((tt)+3<NT){WAIT_BAR(2);} else if((tt)+2<NT){WAIT_BAR(1);} else {WAIT_BAR(0);} }while(0)
  for(;t+1<NT;t+=2){
    STEP(pB0,pB1,pA0,pA1,t,(t+3<NT),(t+1<NT),(t+1<NT));       ENDW(t);   RESC(); ROT();
    STEP(pA0,pA1,pB0,pB1,t+1,(t+4<NT),(t+2<NT),(t+2<NT));     ENDW(t+1); RESC(); ROT();
  }
  { float sacc=pA0[0]+pA0[1]; _Pragma("unroll") for(int r=2;r<16;++r)sacc+=pA0[r]; _Pragma("unroll") for(int r=0;r<16;++r)sacc+=pA1[r]; l_reg+=sacc;
    pw0=(u32x4){PKW(pA0,0),PKW(pA0,2),PKW(pA0,4),PKW(pA0,6)};pw1=(u32x4){PKW(pA0,8),PKW(pA0,10),PKW(pA0,12),PKW(pA0,14)};pw2=(u32x4){PKW(pA1,0),PKW(pA1,2),PKW(pA1,4),PKW(pA1,6)};pw3=(u32x4){PKW(pA1,8),PKW(pA1,10),PKW(pA1,12),PKW(pA1,14)};
    SBAR(); pv(o,vb0+sl_prev,PAF(0),PAF(1),PAF(2),PAF(3)); }
  #undef PKW
  #undef PAF
  #undef VFR
  #undef PIN
  #undef MX3
  #undef GAPA
  #undef GAPB
  #undef EX
  #undef VRD
  #undef KRD
  #undef STEP
  #undef ENDW
  {auto rr=__builtin_amdgcn_permlane32_swap(__float_as_uint(l_reg),__float_as_uint(l_reg),false,false);l_reg=__uint_as_float(rr[0])+__uint_as_float(rr[1]);}
  if(hi==0)wsf[32+r32]=l_reg;asm volatile("s_waitcnt lgkmcnt(0)":::"memory");
  float rli[16];
  #pragma unroll
  for(int r=0;r<16;++r)rli[r]=__builtin_amdgcn_rcpf(wsf[32+crow(r,hi)]);
  bf16*Ow=Oin+(long)(wid*QBLK)*OPITCH;
  { bf16*stg=(bf16*)(shm+LDS_OST)+wid*2048;
    #pragma unroll
    for(int r=0;r<16;++r){const int orow=crow(r,hi);
      #pragma unroll
      for(int d0=0;d0<2;++d0)stg[orow*64+d0*32+r32]=__float2bfloat16(o[d0][r]*rli[r]);}
    asm volatile("s_waitcnt lgkmcnt(0)":::"memory");
    #pragma unroll
    for(int i=0;i<4;++i){const int row=i*8+(lane>>3),ch=lane&7; const u32x4 v=*(const u32x4*)(stg+row*64+ch*8); if(wid<qwaves)ATTN_STORE16(Ow+(long)row*OPITCH+ch*8,v);} }
  asm volatile("s_waitcnt lgkmcnt(0)\n\ts_barrier":::"memory");
  #undef DMA_K
  #undef DMA_V
  #undef CMASK
  #undef START
  #undef RESC
  #undef ROT
}
constexpr int ATTN_LDS_BYTES=LDS_BYTES;
#undef SBAR
#undef WAIT_BAR
}

namespace attn128 {
using namespace attn_body;
#define SBAR() __builtin_amdgcn_sched_barrier(0)
#define WAIT_BAR(N) asm volatile("s_waitcnt vmcnt(" #N ") lgkmcnt(0)\n\ts_barrier":::"memory")
constexpr int VSLOTB=16384;
constexpr int L_K=0, L_V=NSLOT*SLOTB, L_WS=L_V+NSLOT*VSLOTB, L_OST=L_WS+NW*64*4, L_BYTES=L_OST+NW*4096;
__device__ __forceinline__ void pv4(f32x16*o,int vb,bf16x8 pa0,bf16x8 pa1,bf16x8 pa2,bf16x8 pa3){
  #pragma unroll
  for(int d0=0;d0<4;++d0){s16x4 lo[4],hi[4];
    #pragma unroll
    for(int ks=0;ks<4;++ks){
      asm volatile("ds_read_b64_tr_b16 %0,%1 offset:%c2":"=&v"(lo[ks]):"v"(vb),"i"(d0*4096+ks*1024):"memory");
      asm volatile("ds_read_b64_tr_b16 %0,%1 offset:%c2":"=&v"(hi[ks]):"v"(vb),"i"(d0*4096+ks*1024+512):"memory");}
    asm volatile("s_waitcnt lgkmcnt(0)":::"memory");SBAR();
    #define PK(k) (bf16x8){lo[k][0],lo[k][1],lo[k][2],lo[k][3],hi[k][0],hi[k][1],hi[k][2],hi[k][3]}
    o[d0]=__builtin_amdgcn_mfma_f32_32x32x16_bf16(pa0,PK(0),o[d0],0,0,0);
    o[d0]=__builtin_amdgcn_mfma_f32_32x32x16_bf16(pa1,PK(1),o[d0],0,0,0);
    o[d0]=__builtin_amdgcn_mfma_f32_32x32x16_bf16(pa2,PK(2),o[d0],0,0,0);
    o[d0]=__builtin_amdgcn_mfma_f32_32x32x16_bf16(pa3,PK(3),o[d0],0,0,0);
    #undef PK
  }
}
struct Fin { int l, h; unsigned qrow; };
template<int THRL,bool MASKED,bool DUAL,bool FIN> __device__ __forceinline__ void attn_unit128(const bf16*Qin,const bf16*__restrict__ Kh,const bf16*__restrict__ Vh,bf16*Oin,const int NT,const int vis,const int qwaves,char*shm,const Fin fin){
  int tid_o=threadIdx.x; asm volatile("":"+v"(tid_o));
  const int tid=tid_o,lane=tid&63,r32=lane&31,hi=lane>>5; const int wid=__builtin_amdgcn_readfirstlane(tid>>6);
  constexpr int KSL=DUAL?2:1;
  constexpr int LK=0, LV=NSLOT*SLOTB*KSL, LWS=LV+NSLOT*VSLOTB, LOST=LWS+NW*64*4;
  const int cmap=DUAL?((wid>>1)&1):0, qgrp=DUAL?(wid&1):(wid&(qwaves-1)); const bool do_store=DUAL?(wid<4):(wid<qwaves);
  const bf16*Qw=Qin+cmap*64+(long)(qgrp*QBLK)*DM;
  const unsigned lds0=(unsigned)(uintptr_t)shm;
  float*wsf=(float*)(shm+LWS)+wid*64;
  const bf16*ksrc=Kh+(long)lane*DM+wid*8;
  const bf16*vsrc=Vh+(long)(16*(wid&3)+(lane>>2))*DM+(wid>>2)*32+(lane&3)*8;
  const unsigned kdst=lds0+LK+wid*1024, vdst=lds0+LV+wid*1024;
  #define DMA_K(t,slot) do{ glds16(ksrc+(long)(t)*KVBLK*DM,(unsigned)__builtin_amdgcn_readfirstlane(kdst+KSL*(slot))); if(DUAL) glds16(ksrc+(long)(t)*KVBLK*DM+64,(unsigned)__builtin_amdgcn_readfirstlane(kdst+KSL*(slot)+8192)); }while(0)
  #define DMA_V(t,slot) do{ glds16(vsrc+(long)(t)*KVBLK*DM,(unsigned)__builtin_amdgcn_readfirstlane(vdst+2*(slot))); glds16(vsrc+(long)(t)*KVBLK*DM+64,(unsigned)__builtin_amdgcn_readfirstlane(vdst+2*(slot)+8192)); }while(0)
  const int vb0=(int)(lds0+LV)+((lane>>4)&1)*32+(lane&3)*8+(4*hi+((lane&15)>>2))*64;
  const char*Kbase=shm+LK+cmap*8192; bf16x8 kf[8];
  const lds_cptr shm3=(lds_cptr)shm; const lds_cptr kp0=shm3+LK+cmap*8192+hi*1024+r32*16; const lds_cptr vp0=shm3+LV+((lane>>4)&1)*32+(lane&3)*8+(4*hi+((lane&15)>>2))*64;
  DMA_K(0,0);DMA_V(0,0);DMA_K(1,SLOTB);
  bf16x8 qr[4];
  #pragma unroll
  for(int d0=0;d0<4;++d0)qr[d0]=*reinterpret_cast<const bf16x8*>(&Qw[(long)r32*DM+d0*16+hi*8]);
  float mhat=0.f,l_reg=0.f;f32x16 o[4];o[0]=f32x16{};o[1]=f32x16{};o[2]=f32x16{};o[3]=f32x16{};f32x16 negm=f32x16{};asm volatile("":"+v"(negm));
  #define CMASK(P0,P1,t) do{ if(MASKED){ const int jb_=(t)-(NT-4); if(jb_>=vis){ _Pragma("unroll") for(int r_=0;r_<16;++r_){P0[r_]=-INFINITY;P1[r_]=-INFINITY;} } } }while(0)
  bool resc=false;
  #define START(P0,P1) do{ const float rm=rowmax(P0,P1); resc=false; \
    { const float dl=rm; mhat=fadd_s(mhat,dl); \
      _Pragma("unroll") for(int r=0;r<16;++r){P0[r]=fsub_s(P0[r],dl);P1[r]=fsub_s(P1[r],dl);} \
      _Pragma("unroll") for(int r=0;r<16;++r)negm[r]=-mhat; asm volatile("":"+v"(negm)); } \
    _Pragma("unroll") for(int r=0;r<16;++r)P0[r]=__builtin_amdgcn_exp2f(P0[r]); }while(0)
  #define RESC() do{ if(resc){ asm volatile("s_waitcnt lgkmcnt(0)":::"memory"); \
      _Pragma("unroll") for(int d_=0;d_<4;++d_) _Pragma("unroll") for(int r=0;r<16;++r)o[d_][r]*=wsf[crow(r,hi)]; } }while(0)
  f32x16 pA0,pA1,pB0,pB1;
  int sl_prev=0,sl_cur=0,sl_next=SLOTB;
  #define ROT() do{sl_prev=sl_cur;sl_cur=sl_next;sl_next=(sl_next==(NSLOT-1)*SLOTB)?0:sl_next+SLOTB;}while(0)
  DMA_K(2,2*SLOTB);
  if constexpr(DUAL){WAIT_BAR(6);}else{WAIT_BAR(4);}
  { const f32x16 zc=f32x16{}; qkt(pA0,pA1,Kbase,qr,zc,r32,hi); } asm volatile("s_nop 15\n\ts_nop 7":"+v"(pA0),"+v"(pA1));
  if(MASKED){ _Pragma("unroll") for(int r_=8;r_<16;++r_)pA0[r_]=-INFINITY; _Pragma("unroll") for(int r_=0;r_<16;++r_)pA1[r_]=-INFINITY; }
  START(pA0,pA1);
  _Pragma("unroll") for(int r=0;r<16;++r)pA1[r]=__builtin_amdgcn_exp2f(pA1[r]);
  WAIT_BAR(0);
  DMA_K(3,0);DMA_V(1,SLOTB);
  ROT();
  kload8(kf,kp0+KSL*sl_cur);
  if constexpr(DUAL){WAIT_BAR(4);}else{WAIT_BAR(3);}
  s16x4 wlo[3],whi[3]; u32x4 pw0,pw1,pw2,pw3;
  #define PKW(P,B) cvtpk_s(P[B],P[B+1])
  #define PAF(k) __builtin_bit_cast(bf16x8,pw##k)
  #define VFW(s) (bf16x8){wlo[s][0],wlo[s][1],wlo[s][2],wlo[s][3],whi[s][0],whi[s][1],whi[s][2],whi[s][3]}
  #define PIN(x) asm volatile("":"+v"(x))
  #define MX3(a,b,c) __builtin_fmaxf(__builtin_fmaxf((a),(b)),(c))
  #define GAPA(MF,A0,A1,A2,A3,W0,W1,PW) do{ MF; sacc+=A0; sacc+=A1; sacc+=A2; sacc+=A3; PIN(sacc); W0; W1; PIN(PW); SBAR(); }while(0)
  #define EX(v) __builtin_amdgcn_exp2f(v)
  #define VRW(s,f) do{ wlo[s]=vtr(vp_+(((f)>>2)*4096+((f)&3)*1024)); whi[s]=vtr(vp_+(((f)>>2)*4096+((f)&3)*1024+512)); }while(0)
  #define KRD(G,j) do{ if(G){ kload2(kf,kp0+KSL*sl_next,j); SBAR(); } }while(0)
  #define FJ(j) ((((j)&3)<<2)|((j)>>2))
  #define VREQ(j) do{ VRW((j)%3,FJ(j)); SBAR(); }while(0)
  #define GAPB(RD,JN,KQ,QD,JU,X,B) do{ if(RD){ VREQ(JN); } o[QD]=__builtin_amdgcn_mfma_f32_32x32x16_bf16(PAF(KQ),VFW((JU)%3),o[QD],0,0,0); X[B]=EX(X[B]); X[B+1]=EX(X[B+1]); PIN(X); SBAR(); }while(0)
  #define STEP(C0,C1,P0,P1,t,GK,GV,GL) do{ SBAR(); \
    const lds_cptr vp_=vp0+2*sl_prev; \
    float sacc=(P0[0]+P0[1]); \
    GAPA(C0=__builtin_amdgcn_mfma_f32_32x32x16_bf16(kf[0],qr[0],negm,0,0,0), P0[2],P0[3],P0[4],P0[5],     pw0[0]=PKW(P0,0), pw0[1]=PKW(P0,2), pw0); \
    GAPA(C1=__builtin_amdgcn_mfma_f32_32x32x16_bf16(kf[1],qr[0],negm,0,0,0), P0[6],P0[7],P0[8],P0[9],     pw0[2]=PKW(P0,4), pw0[3]=PKW(P0,6), pw0); \
    GAPA(C0=__builtin_amdgcn_mfma_f32_32x32x16_bf16(kf[2],qr[1],C0,0,0,0),   P0[10],P0[11],P0[12],P0[13], pw1[0]=PKW(P0,8), pw1[1]=PKW(P0,10), pw1); \
    GAPA(C1=__builtin_amdgcn_mfma_f32_32x32x16_bf16(kf[3],qr[1],C1,0,0,0),   P0[14],P0[15],P1[0],P1[1],   pw1[2]=PKW(P0,12),pw1[3]=PKW(P0,14), pw1); \
    GAPA(C0=__builtin_amdgcn_mfma_f32_32x32x16_bf16(kf[4],qr[2],C0,0,0,0),   P1[2],P1[3],P1[4],P1[5],     pw2[0]=PKW(P1,0), pw2[1]=PKW(P1,2), pw2); \
    VREQ(0); \
    GAPA(C1=__builtin_amdgcn_mfma_f32_32x32x16_bf16(kf[5],qr[2],C1,0,0,0),   P1[6],P1[7],P1[8],P1[9],     pw2[2]=PKW(P1,4), pw2[3]=PKW(P1,6), pw2); \
    VREQ(1); \
    GAPA(C0=__builtin_amdgcn_mfma_f32_32x32x16_bf16(kf[6],qr[3],C0,0,0,0),   P1[10],P1[11],P1[12],P1[13], pw3[0]=PKW(P1,8), pw3[1]=PKW(P1,10), pw3); \
    GAPA(C1=__builtin_amdgcn_mfma_f32_32x32x16_bf16(kf[7],qr[3],C1,0,0,0),   P1[14],P1[15],0.f,0.f,       pw3[2]=PKW(P1,12),pw3[3]=PKW(P1,14), pw3); \
    l_reg+=sacc; \
    if(GK){DMA_K((t)+3,sl_cur);} if(GV){DMA_V((t)+1,sl_next);} \
    CMASK(C0,C1,t); \
    { float a=MX3(C0[0],C0[1],C1[0]),b=MX3(C0[2],C0[3],C1[1]); a=MX3(a,C1[2],C1[3]); \
      _Pragma("unroll") for(int r=4;r<16;r+=4){a=MX3(a,C0[r],C0[r+1]);b=MX3(b,C0[r+2],C0[r+3]);a=MX3(a,C1[r],C1[r+1]);b=MX3(b,C1[r+2],C1[r+3]);} \
      float rm=__builtin_fmaxf(a,b); { auto rr=__builtin_amdgcn_permlane32_swap(__float_as_uint(rm),__float_as_uint(rm),false,false); rm=__builtin_fmaxf(__uint_as_float(rr[0]),__uint_as_float(rr[1])); } \
      resc=false; \
      if(__builtin_expect(__any(rm>(float)THRL),0)){ const float dl=__builtin_fmaxf(rm,0.f); mhat+=dl; \
        _Pragma("unroll") for(int r=0;r<16;++r){C0[r]-=dl;C1[r]-=dl;} \
        _Pragma("unroll") for(int r=0;r<16;++r)negm[r]=-mhat; asm volatile("":"+v"(negm)); \
        const float f=__builtin_amdgcn_exp2f(-dl); l_reg*=f; if(hi==0)wsf[r32]=f; resc=true; } } \
    SBAR(); \
    GAPB(1,2, 0,0,0, C0,0); \
    GAPB(1,3, 0,1,1, C0,2); \
    GAPB(1,4, 0,2,2, C0,4); \
    GAPB(1,5, 0,3,3, C0,6); \
    KRD(GL,0); GAPB(1,6, 1,0,4, C0,8); \
    GAPB(1,7, 1,1,5, C0,10); \
    KRD(GL,1); GAPB(1,8, 1,2,6, C0,12); \
    GAPB(1,9, 1,3,7, C0,14); \
    KRD(GL,2); GAPB(1,10, 2,0,8, C1,0); \
    GAPB(1,11, 2,1,9, C1,2); \
    KRD(GL,3); GAPB(1,12, 2,2,10, C1,4); \
    GAPB(1,13, 2,3,11, C1,6); \
    GAPB(1,14, 3,0,12, C1,8); \
    GAPB(1,15, 3,1,13, C1,10); \
    GAPB(0,0, 3,2,14, C1,12); \
    GAPB(0,0, 3,3,15, C1,14); \
    }while(0)
  #define WBS() do{ if constexpr(DUAL){WAIT_BAR(4);}else{WAIT_BAR(3);} }while(0)
  if(!DUAL && wid>=4) __builtin_amdgcn_s_setprio(1);
  int t=1;
  #undef CMASK
  #define CMASK(P0,P1,t) do{}while(0)
  for(;t+5<NT;t+=2){
    STEP(pB0,pB1,pA0,pA1,t,true,true,true);     WBS(); RESC(); ROT();
    STEP(pA0,pA1,pB0,pB1,t+1,true,true,true);   WBS(); RESC(); ROT();
  }
  #undef CMASK
  #define CMASK(P0,P1,t) do{ if(MASKED){ const int jb_=(t)-(NT-4); if(jb_>=vis){ _Pragma("unroll") for(int r_=0;r_<16;++r_){P0[r_]=-INFINITY;P1[r_]=-INFINITY;} } } }while(0)
  #define ENDW(tt) do{ if((tt)+3<NT){WBS();} else if((tt)+2<NT){WAIT_BAR(2);} else {WAIT_BAR(0);} }while(0)
  for(;t+1<NT;t+=2){
    STEP(pB0,pB1,pA0,pA1,t,(t+3<NT),(t+1<NT),(t+1<NT));       ENDW(t);   RESC(); ROT();
    STEP(pA0,pA1,pB0,pB1,t+1,(t+4<NT),(t+2<NT),(t+2<NT));     ENDW(t+1); RESC(); ROT();
  }
  { float sacc=pA0[0]+pA0[1]; _Pragma("unroll") for(int r=2;r<16;++r)sacc+=pA0[r]; _Pragma("unroll") for(int r=0;r<16;++r)sacc+=pA1[r]; l_reg+=sacc;
    pw0=(u32x4){PKW(pA0,0),PKW(pA0,2),PKW(pA0,4),PKW(pA0,6)};pw1=(u32x4){PKW(pA0,8),PKW(pA0,10),PKW(pA0,12),PKW(pA0,14)};pw2=(u32x4){PKW(pA1,0),PKW(pA1,2),PKW(pA1,4),PKW(pA1,6)};pw3=(u32x4){PKW(pA1,8),PKW(pA1,10),PKW(pA1,12),PKW(pA1,14)};
    SBAR(); pv4(o,vb0+2*sl_prev,PAF(0),PAF(1),PAF(2),PAF(3)); }
  #undef PKW
  #undef PAF
  #undef VFW
  #undef PIN
  #undef MX3
  #undef GAPA
  #undef GAPB
  #undef EX
  #undef VRW
  #undef VREQ
  #undef FJ
  #undef KRD
  #undef STEP
  #undef ENDW
  #undef WBS
  __builtin_amdgcn_s_setprio(0);
  {auto rr=__builtin_amdgcn_permlane32_swap(__float_as_uint(l_reg),__float_as_uint(l_reg),false,false);l_reg=__uint_as_float(rr[0])+__uint_as_float(rr[1]);}
  if(hi==0)wsf[32+r32]=l_reg;asm volatile("s_waitcnt lgkmcnt(0)":::"memory");
  float rli[16];
  #pragma unroll
  for(int r=0;r<16;++r)rli[r]=__builtin_amdgcn_rcpf(wsf[32+crow(r,hi)]);
  bf16*Ow=Oin+cmap*128+(long)((DUAL?(wid&1):wid)*QBLK)*OPITCH;
  bf16*stg=(bf16*)(shm+LOST)+(DUAL?(wid&3):wid)*2048;
  if(do_store){
  u32x4 o2v[2][4];
  #pragma unroll
  for(int hf=0;hf<2;++hf){
    #pragma unroll
    for(int r=0;r<16;++r){const int orow=crow(r,hi);
      #pragma unroll
      for(int d0=0;d0<2;++d0)stg[orow*64+d0*32+r32]=__float2bfloat16(o[2*hf+d0][r]*rli[r]);}
    asm volatile("s_waitcnt lgkmcnt(0)":::"memory");
    #pragma unroll
    for(int i=0;i<4;++i){const int row=i*8+(lane>>3),ch=lane&7; const u32x4 v=*(const u32x4*)(stg+row*64+ch*8);
      if constexpr(FIN){ o2v[hf][i]=v; } else { ATTN_STORE16(Ow+(long)row*OPITCH+hf*64+ch*8,v); } }
    asm volatile("s_waitcnt lgkmcnt(0)":::"memory");
  }
  if constexpr(FIN){
    asm volatile("s_waitcnt vmcnt(0)":::"memory");
    ArgsP ka=KARG(); unsigned char*wsb=ka->ws;
    const bf16*fO1=(const bf16*)(wsb+WS_OP)+(size_t)fin.qrow*2048+(size_t)(fin.h*2)*128; const bf16*fZA=(const bf16*)(wsb+WS_ZA)+(size_t)fin.qrow*1024+fin.h*128;
    const float*fsw=ka->in[I_SUBLN]+fin.l*128; bf16*fOX=(bf16*)(wsb+WS_OX)+(size_t)fin.qrow*2048+1024+fin.h*128;
    const float flam=((const float*)(wsb+WS_MISC))[fin.l], foml=((const float*)(wsb+WS_MISC))[8+fin.l];
    const int ch=lane&7;
    #pragma unroll
    for(int i=0;i<4;++i){ const long grow=(long)(wid*QBLK+i*8+(lane>>3));
      float d[2][8]; float ss=0.f;
      #pragma unroll
      for(int hf=0;hf<2;++hf){ const u32x4 a=*(const u32x4*)(fO1+grow*OPITCH+hf*64+ch*8); const u32x4 b=o2v[hf][i];
        const unsigned aw[4]={a.x,a.y,a.z,a.w}, bw[4]={b.x,b.y,b.z,b.w};
        #pragma unroll
        for(int e=0;e<4;++e){ d[hf][2*e]=__uint_as_float(aw[e]<<16)-flam*__uint_as_float(bw[e]<<16); d[hf][2*e+1]=__uint_as_float(aw[e]&0xffff0000u)-flam*__uint_as_float(bw[e]&0xffff0000u); }
        #pragma unroll
        for(int e=0;e<8;++e)ss+=d[hf][e]*d[hf][e]; }
      ss+=__shfl_xor(ss,1); ss+=__shfl_xor(ss,2); ss+=__shfl_xor(ss,4);
      const float scale=rsqrtf(ss*(1.0f/128.0f)+1e-6f)*foml;
      #pragma unroll
      for(int hf=0;hf<2;++hf){ const u32x4 z=*(const u32x4*)(fZA+grow*DM+hf*64+ch*8); const float*swp=fsw+hf*64+ch*8;
        const unsigned zw[4]={z.x,z.y,z.z,z.w}; unsigned ow[4];
        #pragma unroll
        for(int e=0;e<4;++e){ const float v0=d[hf][2*e]*scale*swp[2*e]*__uint_as_float(zw[e]<<16), v1=d[hf][2*e+1]*scale*swp[2*e+1]*__uint_as_float(zw[e]&0xffff0000u); ow[e]=cvtpk_s(v0,v1); }
        ATTN_STORE16(fOX+grow*OPITCH+hf*64+ch*8,((u32x4){ow[0],ow[1],ow[2],ow[3]})); }
    }
  }
  }
  if constexpr(DUAL){ asm volatile("s_waitcnt vmcnt(0)":::"memory"); }
  asm volatile("s_waitcnt lgkmcnt(0)\n\ts_barrier":::"memory");
  #undef DMA_K
  #undef DMA_V
  #undef CMASK
  #undef START
  #undef RESC
  #undef ROT
}
#undef SBAR
#undef WAIT_BAR
}

#define GAS __attribute__((address_space(1)))
#define LAS __attribute__((address_space(3)))
typedef unsigned short bf16;
typedef unsigned v4u __attribute__((ext_vector_type(4)));
typedef float f32x4 __attribute__((ext_vector_type(4)));
typedef short bf16x8 __attribute__((ext_vector_type(8)));
typedef GAS unsigned gu32;
typedef GAS unsigned long long gu64;
#define RLX_AGENT __ATOMIC_RELAXED, __HIP_MEMORY_SCOPE_AGENT
#define LDS_WAIT() asm volatile("s_waitcnt lgkmcnt(0)" ::: "memory")
#define VM_WAIT() asm volatile("s_waitcnt vmcnt(0)" ::: "memory")
__device__ __forceinline__ unsigned long long rt() { return __builtin_amdgcn_s_memrealtime(); }
__device__ __forceinline__ unsigned f2bf(float f) { unsigned u = __builtin_bit_cast(unsigned, f); return (u + 0x7fffu + ((u >> 16) & 1u)) >> 16; }
__device__ __forceinline__ unsigned pk2(float lo, float hi) { return f2bf(lo) | (f2bf(hi) << 16); }

#define XB_TMO      128
#define XB_XCNT(j)  (256  + 64 * (j))
#define XB_XSUB(j)  (1280 + 64 * (j))
#define XB_XGEN(j)  (2304 + 64 * (j))
#define XB_TOP      3328
#define XB_TOPGEN   3392
#define XCD_BAR_WORDS 3456
#define XB_SPIN_CAP (1u << 18)

__device__ __forceinline__ unsigned xb_ld(unsigned* p)              { return __hip_atomic_load(p, __ATOMIC_RELAXED, __HIP_MEMORY_SCOPE_AGENT); }
__device__ __forceinline__ unsigned xb_add(unsigned* p, unsigned v) { return __hip_atomic_fetch_add(p, v, __ATOMIC_RELAXED, __HIP_MEMORY_SCOPE_AGENT); }
__device__ __forceinline__ unsigned xb_xcc_id() { return (unsigned)__builtin_amdgcn_s_getreg((3 << 11) | 20) & 0xFu; }
#define XB_SPIN(cond, bar) do { unsigned _sp = 0; while (cond) { __builtin_amdgcn_s_sleep(1); \
    if ((++_sp & 255u) == 0u) { if (xb_ld(&(bar)[XB_TMO])) break; if (_sp > XB_SPIN_CAP) { atomicAdd(&(bar)[XB_TMO], 1u); break; } } } } while (0)

struct XcdBarrier {
    unsigned* bar; unsigned x;
    volatile LAS unsigned* st;
};

__device__ __forceinline__ XcdBarrier xcd_barrier_post(unsigned* bar, volatile LAS unsigned* st) {
    XcdBarrier b; b.bar = bar; b.x = xb_xcc_id(); b.st = st;
    if (threadIdx.x == 0) (void)xb_add(&bar[XB_XCNT(b.x)], 1u);
    return b;
}
__device__ __forceinline__ void xcd_barrier_complete(unsigned* bar, unsigned x, unsigned& nloc, unsigned& nx) {
    const unsigned G = gridDim.x * gridDim.y * gridDim.z;
    unsigned sum, cnt, mine, sp = 0u;
    for (;;) {
        sum = 0u; cnt = 0u; mine = 0u;
#pragma unroll
        for (unsigned j = 0; j < 16; ++j) { const unsigned c = xb_ld(&bar[XB_XCNT(j)]); sum += c; cnt += (c > 0u) ? 1u : 0u; mine = (j == x) ? c : mine; }
        if (sum == G) break;
        __builtin_amdgcn_s_sleep(1);
        if ((++sp & 255u) == 0u) { if (xb_ld(&bar[XB_TMO])) break; if (sp > XB_SPIN_CAP) { atomicAdd(&bar[XB_TMO], 1u); break; } }
    }
    nloc = mine > 0u ? mine : 1u; nx = cnt > 0u ? cnt : 1u;
}

__device__ __forceinline__ void xcd_barrier(const XcdBarrier& b) {
    asm volatile("s_waitcnt vmcnt(0)" ::: "memory");
    __syncthreads();
    if (threadIdx.x == 0) {
        unsigned* bar = b.bar;
        __builtin_amdgcn_s_waitcnt(0);
        unsigned nloc = b.st[0], nx = b.st[1];
        if (nloc == 0u) { xcd_barrier_complete(bar, b.x, nloc, nx); b.st[0] = nloc; b.st[1] = nx; }
        const unsigned old = xb_add(&bar[XB_XSUB(b.x)], 1u);
        const unsigned gen = old / nloc;
        if (old + 1u == (gen + 1u) * nloc) {
            __builtin_amdgcn_fence(__ATOMIC_RELEASE, "agent");
            asm volatile("s_waitcnt vmcnt(0)" ::: "memory");
            const unsigned og = xb_add(&bar[XB_TOP], 1u);
            const unsigned tg = og / nx;
            if (og + 1u == (tg + 1u) * nx) xb_add(&bar[XB_TOPGEN], 1u);
            else XB_SPIN(xb_ld(&bar[XB_TOPGEN]) == tg, bar);
            __builtin_amdgcn_fence(__ATOMIC_ACQUIRE, "agent");
            xb_add(&bar[XB_XGEN(b.x)], 1u);
            asm volatile("s_waitcnt vmcnt(0)" ::: "memory");
        } else {
            XB_SPIN(xb_ld(&bar[XB_XGEN(b.x)]) == gen, bar);
            __builtin_amdgcn_fence(__ATOMIC_ACQUIRE, "agent");
            asm volatile("s_waitcnt vmcnt(0)" ::: "memory");
        }
    }
    __syncthreads();
}

constexpr int NWAVES = 8;
constexpr int RING_OFF = 0, RING_BYTES = 131072;
constexpr int LDSCTL_OFF = RING_BYTES, MISC_OFF = LDSCTL_OFF + 320;
constexpr int LDS_BYTES = 147456;
static_assert(MISC_OFF + 128 <= LDS_BYTES, "LDS map");
constexpr int N_PHASES = 2 + 4 * DEPTH;

__device__ __forceinline__ float wave_sum(float v) {
#pragma unroll
    for (int o = 1; o < 64; o <<= 1) v += __shfl_xor(v, o);
    return v;
}
__device__ __forceinline__ v4u pack8f(const f32x4 a, const f32x4 b) { v4u w; w.x = pk2(a[0], a[1]); w.y = pk2(a[2], a[3]); w.z = pk2(b[0], b[1]); w.w = pk2(b[2], b[3]); return w; }
__device__ __forceinline__ float bflo(unsigned w) { return __uint_as_float(w << 16); }
__device__ __forceinline__ float bfhi(unsigned w) { return __uint_as_float(w & 0xffff0000u); }

__host__ __device__ __forceinline__ int colmap_in(int np) {
    if (np >= 2048 && np < 4096) { const int g = np >> 6, j = np & 63, a = j >> 5, fq = (j >> 3) & 3, n = (j >> 2) & 1, e = j & 3; return (g << 6) + 32 * n + 16 * a + 4 * fq + e; }
    if (np >= 6144) { const int w = np - 6144, j8 = w >> 8, half = (w >> 7) & 1, cc = w & 127; return 6144 + half * 1024 + 128 * j8 + cc; }
    return np;
}
template <bool MAPPED>
__device__ __forceinline__ void p0_item(const float* W, int N, const float* kscale, bf16* WT, int ldk, int koff, LAS float* scr, int kb, int nb, int lane) {
    const int k0 = 64 * kb, n0 = 32 * nb; const int np = n0 + (lane & 31); const int src = MAPPED ? colmap_in(np) : np;
#pragma unroll
    for (int i = 0; i < 32; ++i) { const int kk = 2 * i + (lane >> 5); float v = W[(size_t)(k0 + kk) * N + src]; if (kscale) v *= kscale[k0 + kk]; scr[kk * 33 + (lane & 31)] = v; }
    LDS_WAIT(); asm volatile("" ::: "memory");
    const int c = lane & 7;
#pragma unroll
    for (int j = 0; j < 4; ++j) { const int n = (lane >> 3) + 8 * j; const LAS float* s = scr + (8 * c) * 33 + n;
        v4u o; o.x = pk2(s[0 * 33], s[1 * 33]); o.y = pk2(s[2 * 33], s[3 * 33]); o.z = pk2(s[4 * 33], s[5 * 33]); o.w = pk2(s[6 * 33], s[7 * 33]);
        *(GAS v4u*)(WT + (size_t)(n0 + n) * ldk + koff + k0 + 8 * c) = o; }
    LDS_WAIT(); asm volatile("" ::: "memory");
}

__device__ __forceinline__ void cache_convert(ArgsP args, int lc, int c_lo, int n_ch, int tid0, int nth) {
    unsigned char* ws = args->ws;
    bf16* KS = (bf16*)(ws + WS_KS) + (size_t)lc * NDB * KSROWS * D; bf16* VS = (bf16*)(ws + WS_VS) + (size_t)lc * NDB * KSROWS * D;
    const float* ck = args->in[I_CK] + (size_t)lc * NDB * PAST * D; const float* cv = args->in[I_CV] + (size_t)lc * NDB * PAST * D;
    for (int c0 = c_lo + tid0; c0 < c_lo + n_ch; c0 += 4 * nth) {
        f32x4 klo[4], khi[4], vlo[4], vhi[4];
#pragma unroll
        for (int u = 0; u < 4; ++u) { const int c = c0 + u * nth; if (c < c_lo + n_ch) { const int row = c >> 7, chn = c & 127;
            const int gq = chn >> 3, q8 = chn & 7, d0 = 16 * (q8 >> 2) + 4 * (q8 & 3); const float* s = ck + (size_t)row * D + 64 * gq + d0; const float* sv = cv + (size_t)row * D + 8 * chn;
            klo[u] = __builtin_nontemporal_load((const GAS f32x4*)s); khi[u] = __builtin_nontemporal_load((const GAS f32x4*)(s + 32)); vlo[u] = __builtin_nontemporal_load((const GAS f32x4*)sv); vhi[u] = __builtin_nontemporal_load((const GAS f32x4*)(sv + 4)); } }
#pragma unroll
        for (int u = 0; u < 4; ++u) { const int c = c0 + u * nth; if (c < c_lo + n_ch) { const int row = c >> 7, chn = c & 127; const size_t drow = ((size_t)(row >> 11) * KSROWS + (row & 2047)) * D;
            *(GAS v4u*)(KS + drow + 8 * chn) = pack8f(klo[u], khi[u]); *(GAS v4u*)(VS + drow + 8 * chn) = pack8f(vlo[u], vhi[u]); } }
    }
}

__device__ __forceinline__ void cache_convert_head(ArgsP args, int lc, int db, int h, int tid0, int nth) {
    unsigned char* ws = args->ws;
    bf16* KS = (bf16*)(ws + WS_KS) + (size_t)(lc * NDB + db) * KSROWS * D; bf16* VS = (bf16*)(ws + WS_VS) + (size_t)(lc * NDB + db) * KSROWS * D;
    const float* ck = args->in[I_CK] + (size_t)(lc * NDB + db) * PAST * D; const float* cv = args->in[I_CV] + (size_t)(lc * NDB + db) * PAST * D;
    constexpr int NCHK = PAST * 16;
    for (int c0 = tid0; c0 < NCHK; c0 += 4 * nth) {
        f32x4 klo[4], khi[4], vlo[4], vhi[4];
#pragma unroll
        for (int u = 0; u < 4; ++u) { const int c = c0 + u * nth; if (c < NCHK) { const int row = c >> 4, chn = h * 16 + (c & 15);
            const int gq = chn >> 3, q8 = chn & 7, d0 = 16 * (q8 >> 2) + 4 * (q8 & 3); const float* s = ck + (size_t)row * D + 64 * gq + d0; const float* sv = cv + (size_t)row * D + 8 * chn;
            klo[u] = __builtin_nontemporal_load((const GAS f32x4*)s); khi[u] = __builtin_nontemporal_load((const GAS f32x4*)(s + 32)); vlo[u] = __builtin_nontemporal_load((const GAS f32x4*)sv); vhi[u] = __builtin_nontemporal_load((const GAS f32x4*)(sv + 4)); } }
#pragma unroll
        for (int u = 0; u < 4; ++u) { const int c = c0 + u * nth; if (c < NCHK) { const int row = c >> 4, chn = h * 16 + (c & 15); const size_t drow = (size_t)row * D;
            *(GAS v4u*)(KS + drow + 8 * chn) = pack8f(klo[u], khi[u]); *(GAS v4u*)(VS + drow + 8 * chn) = pack8f(vlo[u], vhi[u]); } }
    }
}

__device__ __forceinline__ void p0_prologue(ArgsP args, LAS unsigned char* lds, int lane, int wave, int vcu, int G) {
    unsigned char* ws = args->ws;
    LAS float* scr = (LAS float*)(lds + RING_OFF + wave * 16384);
    const int gw = vcu * NWAVES + wave, NGW = G * NWAVES;
    constexpr int IT_L = 2048 + 256 + 256 + 256 + 64;
    typedef float f32x2_t __attribute__((ext_vector_type(2)));
    struct WItem { const float* src; const float* ksc; bf16* dst; int N, ldk; };
    auto decode = [&](int it) -> WItem {
        const int l = it / IT_L; int r = it % IT_L; unsigned char* wl = ws + WS_W + (size_t)l * W_LAYER;
        const float* W; const float* kscale = nullptr; bf16* WT; int N, ldk, koff = 0, kb, nb; bool mapped = false;
        if (r < 2048) { W = args->in[I_WIN] + (size_t)l * D * INC; N = INC; kscale = args->in[I_NW] + l * D; WT = (bf16*)(wl + W_IN); ldk = D; kb = r >> 7; nb = r & 127; mapped = true; }
        else if (r < 2048 + 256) { r -= 2048; W = args->in[I_WPR] + (size_t)l * D * D; N = D; WT = (bf16*)(wl + W_PROJ); ldk = 2 * D; kb = r >> 4; nb = r & 15; }
        else if (r < 2048 + 512) { r -= 2048 + 256; W = args->in[I_WPA] + (size_t)l * D * D; N = D; WT = (bf16*)(wl + W_PROJ); ldk = 2 * D; koff = D; kb = r >> 4; nb = r & 15; }
        else if (r < 2048 + 768) { r -= 2048 + 512; W = args->in[I_WOUT] + (size_t)l * D * D; N = D; WT = (bf16*)(wl + W_OUT); ldk = D; kb = r >> 4; nb = r & 15; }
        else { r -= 2048 + 768; const int gate = r >> 5, blk = (r >> 2) & 7; kb = (r >> 1) & 1; nb = r & 1;
            W = args->in[gate ? I_WIG : I_WRG] + (size_t)(l * 8 + blk) * 16384; N = 128; WT = (bf16*)(wl + W_G) + (size_t)(blk * 2 + gate) * 16384; ldk = 128; }
        const int k0 = 64 * kb, n0 = 64 * nb, np = n0 + 2 * (lane & 31), srcc = mapped ? colmap_in(np) : np;
        WItem w; w.src = W + (size_t)k0 * N + srcc; w.ksc = kscale ? kscale + k0 + 8 * (lane & 7) : nullptr; w.dst = WT + (size_t)n0 * ldk + koff + k0; w.N = N; w.ldk = ldk; return w; };
    auto wload = [&](const WItem& w, f32x2_t (&v)[32]) {
#pragma unroll
        for (int i = 0; i < 32; ++i) v[i] = *(const GAS f32x2_t*)(w.src + (size_t)(2 * i + (lane >> 5)) * w.N); };
    auto wstore = [&](const WItem& w, const f32x2_t (&v)[32]) {
        f32x4 ka = (f32x4){1.f, 1.f, 1.f, 1.f}, kb2 = ka;
        if (w.ksc) { ka = *(const GAS f32x4*)w.ksc; kb2 = *(const GAS f32x4*)(w.ksc + 4); }
#pragma unroll
        for (int par = 0; par < 2; ++par) {
#pragma unroll
            for (int i = 0; i < 32; ++i) scr[(2 * i + (lane >> 5)) * 33 + (lane & 31)] = v[i][par];
            LDS_WAIT(); asm volatile("" ::: "memory");
            const int c = lane & 7;
#pragma unroll
            for (int j = 0; j < 4; ++j) { const int n = (lane >> 3) + 8 * j; const LAS float* sp = scr + (8 * c) * 33 + n;
                v4u o; o.x = pk2(sp[0 * 33] * ka[0], sp[1 * 33] * ka[1]); o.y = pk2(sp[2 * 33] * ka[2], sp[3 * 33] * ka[3]); o.z = pk2(sp[4 * 33] * kb2[0], sp[5 * 33] * kb2[1]); o.w = pk2(sp[6 * 33] * kb2[2], sp[7 * 33] * kb2[3]);
                *(GAS v4u*)(w.dst + (size_t)(2 * n + par) * w.ldk + 8 * c) = o; }
            LDS_WAIT(); asm volatile("" ::: "memory"); } };
    for (int it = gw; it < DEPTH * IT_L; it += 2 * NGW) {
        const bool hb = it + NGW < DEPTH * IT_L;
        const WItem wa = decode(it), wb = decode(hb ? it + NGW : it);
        f32x2_t va[32], vb[32];
        wload(wa, va); wload(wb, vb);
        wstore(wa, va); if (hb) wstore(wb, vb);
    }
    { bf16* HB = (bf16*)(ws + WS_HB); float* SSQ = (float*)(ws + WS_SSQ);
      for (int row0 = gw; row0 < M; row0 += 4 * NGW) {
        f32x4 v[4][4]; float sv[4]; bool ok[4];
#pragma unroll
        for (int u = 0; u < 4; ++u) { const int row = row0 + u * NGW; ok[u] = row < M;
            const float* src = !ok[u] ? nullptr : row < ROW_S ? args->in[I_XP] + (size_t)row * D : row < ROW_M ? args->in[I_XS] + (size_t)(row - ROW_S) * D : (row - ROW_M) < NMETA ? args->in[I_META] + (size_t)(row - ROW_M) * D : nullptr;
#pragma unroll
            for (int j = 0; j < 4; ++j) v[u][j] = src ? ((const GAS f32x4*)src)[lane + 64 * j] : (f32x4){0.f, 0.f, 0.f, 0.f}; }
#pragma unroll
        for (int u = 0; u < 4; ++u) { float s = 0.f;
#pragma unroll
            for (int j = 0; j < 4; ++j) s += (v[u][j].x * v[u][j].x + v[u][j].y * v[u][j].y) + (v[u][j].z * v[u][j].z + v[u][j].w * v[u][j].w);
            sv[u] = wave_sum(s); }
#pragma unroll
        for (int u = 0; u < 4; ++u) if (ok[u]) { const int row = row0 + u * NGW;
#pragma unroll
            for (int j = 0; j < 4; ++j) ((GAS unsigned long long*)(HB + (size_t)row * D))[lane + 64 * j] = (unsigned long long)pk2(v[u][j].x, v[u][j].y) | ((unsigned long long)pk2(v[u][j].z, v[u][j].w) << 32);
            if (lane < 16) SSQ[(size_t)row * 16 + lane] = lane == 0 ? sv[u] : 0.f; }
      } }
    const int gtid = gw * 64 + lane, NTH = NGW * 64;
    { float* TC = (float*)(ws + WS_TCOS); float* TS = (float*)(ws + WS_TSIN);
      for (int idx = gtid; idx < TP * 32; idx += NTH) {
        const int pos = idx >> 5, i = idx & 31;
        double th = 1.0; for (int k = 0; k < i; ++k) th *= 0.74989420933245582730;
        const double t2 = th * th; double cb = 1.0, sb = th, tc = 1.0, tsn = th;
#pragma unroll 1
        for (int k = 1; k <= 11; ++k) { tc *= -t2 / (double)((2 * k - 1) * (2 * k)); tsn *= -t2 / (double)((2 * k) * (2 * k + 1)); cb += tc; sb += tsn; }
        double cr = 1.0, sr = 0.0;
#pragma unroll 1
        for (int bit = 0; bit < 13; ++bit) { if ((pos >> bit) & 1) { const double c2 = cr * cb - sr * sb, s2 = sr * cb + cr * sb; cr = c2; sr = s2; } const double c3 = cb * cb - sb * sb, s3 = 2.0 * cb * sb; cb = c3; sb = s3; }
        TC[idx] = (float)cr; TS[idx] = (float)sr;
      } }
    if (gw < DEPTH) { const int l = gw; const float s1 = wave_sum(args->in[I_LQ1][l * 64 + lane] * args->in[I_LK1][l * 64 + lane]), s2 = wave_sum(args->in[I_LQ2][l * 64 + lane] * args->in[I_LK2][l * 64 + lane]);
        if (lane == 0) { const float li = 0.8f - 0.6f * expf(-0.3f * (float)l); ((float*)(ws + WS_MISC))[l] = expf(s1) - expf(s2) + li; ((float*)(ws + WS_MISC))[8 + l] = 1.0f - li; } }
    { bf16* KP = (bf16*)(ws + WS_KP); bf16* VP = (bf16*)(ws + WS_VP);
      for (int c = gtid; c < NB * 48 * 128; c += NTH) { const int b = c / (48 * 128), rr = (c / 128) % 48, chn = c & 127; const size_t off = ((size_t)b * KPROWS + 16 + rr) * D + 8 * chn;
        *(GAS v4u*)(KP + off) = (v4u){0u, 0u, 0u, 0u}; *(GAS v4u*)(VP + off) = (v4u){0u, 0u, 0u, 0u}; } }
}

constexpr int RNN_XS = 0, RNN_XC = 36864, RNN_XA = 71680;
constexpr int CW_CNTA = 12288, CW_CNTB = 14336;
constexpr int CW_FLAG = 16384;
constexpr size_t MISC_CARRY = 131072;
#define RNN_BAR() do { asm volatile("s_waitcnt lgkmcnt(0)" ::: "memory"); __builtin_amdgcn_s_barrier(); asm volatile("" ::: "memory"); } while (0)
__device__ __forceinline__ void rnn_prefetch(ArgsP args, const bf16* XR, int l, int pmode, int seq, int n, size_t row0, int tid, v4u (&pf)[3]) {
#pragma unroll
    for (int k = 0; k < 3; ++k) { const int id = tid + k * NWAVES * 64, i = id >> 4, c8 = id & 15;
        if (id < 67 * 16) {
            if (i >= 3 || pmode == 0) pf[k] = __builtin_nontemporal_load((const GAS v4u*)(XR + (row0 + i - 3) * D + 128 * n + 8 * c8));
            else if (pmode == 1) pf[k] = *(const GAS v4u*)(XR + ((size_t)ROW_M + 13 + i) * D + 128 * n + 8 * c8);
            else if (pmode == 2) { const float* sc = args->in[I_SC] + ((size_t)(l * NDB + seq) * 3 + i) * D + 128 * n + 8 * c8; pf[k] = pack8f(*(const GAS f32x4*)sc, *(const GAS f32x4*)(sc + 4)); }
            else pf[k] = (v4u){0u, 0u, 0u, 0u};
        } }
}
__device__ __forceinline__ void rnn_unit(ArgsP args, int l, int kind, int seq, int n, int g, LAS unsigned char* lds, int tid, int lane, int wid) {
    unsigned char* ws = args->ws;
    LAS float* XS = (LAS float*)(lds + RNN_XS); LAS float* XC = (LAS float*)(lds + RNN_XC); LAS bf16* XA = (LAS bf16*)(lds + RNN_XA);
    const bf16* XR = (const bf16*)(ws + WS_XR); const bf16* ZR = (const bf16*)(ws + WS_ZR); bf16* OX = (bf16*)(ws + WS_OX);
    const int q = lane >> 4, cl = lane & 15, cc = 16 * wid + cl, ch = 128 * n + cc;
    const float brg = args->in[I_BRG][l * D + ch], big = args->in[I_BIG][l * D + ch];
    float sp; { const float x = -args->in[I_LAM][l * D + ch]; sp = fmaxf(x, 0.f) + log1pf(__expf(-fabsf(x))); }
    const int c2 = tid & 127, rg = tid >> 7, chc = 128 * n + c2;
    const float cw0 = args->in[I_CW][(l * 4 + 0) * D + chc], cw1 = args->in[I_CW][(l * 4 + 1) * D + chc], cw2 = args->in[I_CW][(l * 4 + 2) * D + chc], cw3 = args->in[I_CW][(l * 4 + 3) * D + chc], cb = args->in[I_CB][l * D + chc];
    const bf16* wg = (const bf16*)(ws + WS_W + (size_t)l * W_LAYER + W_G) + (size_t)(n * 2) * 16384;
    bf16x8 Br[4], Bi[4];
#pragma unroll
    for (int ks = 0; ks < 4; ++ks) { Br[ks] = *(const bf16x8*)(wg + (size_t)cc * 128 + 32 * ks + 8 * q); Bi[ks] = *(const bf16x8*)(wg + 16384 + (size_t)cc * 128 + 32 * ks + 8 * q); }
    const int ntiles = kind == 0 ? 16 : 1;
    const int jstart = (kind == 0 && g == 0) ? -1 : 0;
    const size_t rowbase = kind == 0 ? (size_t)seq * SEQ + (size_t)g * 1024 : kind == 1 ? (size_t)ROW_S + (size_t)seq * DSQ : (size_t)ROW_M;
    float* carry = (float*)(ws + WS_MISC + MISC_CARRY) + (size_t)((((l * NB + seq) * 8 + n) * 4) + g) * 128;
    gu32* flag = (gu32*)(ws + WS_CTL) + CW_FLAG + 64 * ((((l * NB + seq) * 8 + n) * 4) + g);
    float hrun = 0.f;
    if (kind == 1) hrun = args->in[I_SR][(size_t)(l * NDB + seq) * D + ch];
    v4u pf[3] = {{0u, 0u, 0u, 0u}, {0u, 0u, 0u, 0u}, {0u, 0u, 0u, 0u}};
    rnn_prefetch(args, XR, l, jstart < 0 ? 3 : (kind == 0 ? 0 : kind == 1 ? 2 : 3), seq, n, jstart < 0 ? (size_t)ROW_M : rowbase, tid, pf);
    if (kind == 0 && g > 0) {
        if (tid == 0) { unsigned spn = 0u; while (__hip_atomic_load(flag - 64, RLX_AGENT) == 0u) { __builtin_amdgcn_s_sleep(2); if (++spn > (1u << 22)) { __hip_atomic_store((gu32*)(ws + WS_CTL) + CW_TMO, 0xC0DEu, RLX_AGENT); break; } }
            __builtin_amdgcn_fence(__ATOMIC_ACQUIRE, "agent"); asm volatile("s_waitcnt vmcnt(0)" ::: "memory"); }
        __syncthreads();
        hrun = __hip_atomic_load(carry - 128 + cc, RLX_AGENT);
    }
    for (int j = jstart; j < ntiles; ++j) {
        const bool pre = j < 0;
        const size_t row0 = pre ? (size_t)ROW_M : rowbase + 64 * j;
        const int nvalid = (pre || kind == 2) ? NMETA : 64;
#pragma unroll
        for (int k = 0; k < 3; ++k) { const int id = tid + k * NWAVES * 64, i = id >> 4, c8 = id & 15;
            if (id < 67 * 16) { const v4u w = pf[k];
                *(LAS f32x4*)(XS + i * 132 + 8 * c8) = (f32x4){bflo(w.x), bfhi(w.x), bflo(w.y), bfhi(w.y)}; *(LAS f32x4*)(XS + i * 132 + 8 * c8 + 4) = (f32x4){bflo(w.z), bfhi(w.z), bflo(w.w), bfhi(w.w)}; } }
        if (j + 1 < ntiles) rnn_prefetch(args, XR, l, pre ? 1 : 0, seq, n, rowbase + 64 * (j + 1), tid, pf);
        v4u zf[2] = {{0u, 0u, 0u, 0u}, {0u, 0u, 0u, 0u}};
        if (!pre) {
#pragma unroll
            for (int k = 0; k < 2; ++k) { const int id = tid + k * NWAVES * 64, r = id >> 4, c8 = id & 15; zf[k] = __builtin_nontemporal_load((const GAS v4u*)(ZR + (row0 + r) * D + 128 * n + 8 * c8)); } }
        RNN_BAR();
        { const int rb = 16 * rg; float x0 = XS[(rb + 0) * 132 + c2], x1 = XS[(rb + 1) * 132 + c2], x2 = XS[(rb + 2) * 132 + c2];
#pragma unroll
          for (int r = 0; r < 16; ++r) { const float x3 = XS[(rb + r + 3) * 132 + c2]; const float xc = (((cb + x0 * cw0) + x1 * cw1) + x2 * cw2) + x3 * cw3;
              XC[(rb + r) * 132 + c2] = xc; XA[(rb + r) * 136 + c2] = (bf16)f2bf(xc); x0 = x1; x1 = x2; x2 = x3; } }
        RNN_BAR();
#pragma unroll
        for (int mt = 0; mt < 4; ++mt) {
            f32x4 ar = {0.f, 0.f, 0.f, 0.f}, ai = {0.f, 0.f, 0.f, 0.f};
#pragma unroll
            for (int ks = 0; ks < 4; ++ks) { const bf16x8 A = *(const LAS bf16x8*)(XA + (16 * mt + cl) * 136 + 32 * ks + 8 * q);
                ar = __builtin_amdgcn_mfma_f32_16x16x32_bf16(A, Br[ks], ar, 0, 0, 0); ai = __builtin_amdgcn_mfma_f32_16x16x32_bf16(A, Bi[ks], ai, 0, 0, 0); }
            float a[4], b[4];
#pragma unroll
            for (int i = 0; i < 4; ++i) { const int r = 16 * mt + 4 * q + i; const float xc = XC[r * 132 + cc];
                const float rr = __builtin_amdgcn_rcpf(1.0f + __expf(-(ar[i] + brg))), ii = __builtin_amdgcn_rcpf(1.0f + __expf(-(ai[i] + big)));
                const float av = __expf(-8.0f * rr * sp); a[i] = av; b[i] = __builtin_amdgcn_sqrtf(fmaxf((1.0f - av) * (1.0f + av), 0.f)) * ii * xc;
                if (r >= nvalid) { a[i] = 1.f; b[i] = 0.f; } }
            const float A4 = (a[0] * a[1]) * (a[2] * a[3]), B4 = ((b[0] * a[1] + b[1]) * a[2] + b[2]) * a[3] + b[3];
            float Ai = A4, Bi2 = B4;
            { const float ua = __shfl_up(Ai, 16), ub = __shfl_up(Bi2, 16); if (q >= 1) { Bi2 = Ai * ub + Bi2; Ai = ua * Ai; } }
            { const float ua = __shfl_up(Ai, 32), ub = __shfl_up(Bi2, 32); if (q >= 2) { Bi2 = Ai * ub + Bi2; Ai = ua * Ai; } }
            float Ae = __shfl_up(Ai, 16), Be = __shfl_up(Bi2, 16); if (q == 0) { Ae = 1.f; Be = 0.f; }
            const float At = __shfl(Ai, 48 + cl), Bt = __shfl(Bi2, 48 + cl);
            float h = Ae * hrun + Be;
#pragma unroll
            for (int i = 0; i < 4; ++i) { h = a[i] * h + b[i]; XC[(16 * mt + 4 * q + i) * 132 + cc] = h; }
            hrun = At * hrun + Bt;
        }
        RNN_BAR();
        if (!pre) {
#pragma unroll
            for (int k = 0; k < 2; ++k) { const int id = tid + k * NWAVES * 64, r = id >> 4, c8 = id & 15;
                const f32x4 h0 = *(const LAS f32x4*)(XC + r * 132 + 8 * c8), h1 = *(const LAS f32x4*)(XC + r * 132 + 8 * c8 + 4);
                const v4u z = zf[k];
                const f32x4 o0 = h0 * (f32x4){bflo(z.x), bfhi(z.x), bflo(z.y), bfhi(z.y)}, o1 = h1 * (f32x4){bflo(z.z), bfhi(z.z), bflo(z.w), bfhi(z.w)};
                *(GAS v4u*)(OX + (row0 + r) * 2 * D + 128 * n + 8 * c8) = pack8f(o0, o1); }
        }
    }
    const bool publish = (kind == 0 && g < 3);
    if (q == 0) {
        if (kind == 0 && g == 3) args->out[O_RP + (size_t)(l * NB + seq) * D + ch] = hrun;
        if (kind == 1) args->out[O_RS + (size_t)(l * NDB + seq) * D + ch] = hrun;
        if (publish) __hip_atomic_store(carry + cc, hrun, RLX_AGENT);
    }
    if (publish) asm volatile("s_waitcnt vmcnt(0)" ::: "memory");
    RNN_BAR();
    if (publish && tid == 0) __hip_atomic_store(flag, 1u, RLX_AGENT);
}
__device__ __forceinline__ void attn_finish(ArgsP args, int l, size_t row0, int h, int nw, int lane, int wid) {
    if (wid >= nw) return;
    unsigned char* ws = args->ws;
    asm volatile("s_waitcnt vmcnt(0)" ::: "memory");
    const float lam = ((const float*)(ws + WS_MISC))[l], oml = ((const float*)(ws + WS_MISC))[8 + l];
    int ln = lane; asm volatile("" : "+v"(ln));
    const int r = ln >> 1, half = ln & 1; const size_t row = row0 + 32 * wid + r;
    const bf16* p1 = (const bf16*)(ws + WS_OP) + row * 2048 + (size_t)(h * 2) * 128 + half * 64; const bf16* p2 = p1 + 128;
    float d[64]; float ss = 0.f;
#pragma unroll
    for (int k = 0; k < 8; ++k) { const v4u a = *(const GAS v4u*)(p1 + 8 * k), b = *(const GAS v4u*)(p2 + 8 * k);
        d[8 * k + 0] = bflo(a.x) - lam * bflo(b.x); d[8 * k + 1] = bfhi(a.x) - lam * bfhi(b.x); d[8 * k + 2] = bflo(a.y) - lam * bflo(b.y); d[8 * k + 3] = bfhi(a.y) - lam * bfhi(b.y);
        d[8 * k + 4] = bflo(a.z) - lam * bflo(b.z); d[8 * k + 5] = bfhi(a.z) - lam * bfhi(b.z); d[8 * k + 6] = bflo(a.w) - lam * bflo(b.w); d[8 * k + 7] = bfhi(a.w) - lam * bfhi(b.w);
#pragma unroll
        for (int e = 0; e < 8; ++e) ss += d[8 * k + e] * d[8 * k + e]; }
    ss += __shfl_xor(ss, 1);
    const float scale = rsqrtf(ss * (1.0f / 128.0f) + EPS) * oml;
    const bf16* za = (const bf16*)(ws + WS_ZA) + row * D + h * 128 + half * 64; const float* sw = args->in[I_SUBLN] + l * 128 + half * 64;
    bf16* od = (bf16*)(ws + WS_OX) + row * 2 * D + D + h * 128 + half * 64;
#pragma unroll
    for (int k = 0; k < 8; ++k) { const v4u z = *(const GAS v4u*)(za + 8 * k); const f32x4 w0 = *(const GAS f32x4*)(sw + 8 * k), w1 = *(const GAS f32x4*)(sw + 8 * k + 4);
        f32x4 o0, o1;
        o0[0] = d[8 * k + 0] * scale * w0[0] * bflo(z.x); o0[1] = d[8 * k + 1] * scale * w0[1] * bfhi(z.x); o0[2] = d[8 * k + 2] * scale * w0[2] * bflo(z.y); o0[3] = d[8 * k + 3] * scale * w0[3] * bfhi(z.y);
        o1[0] = d[8 * k + 4] * scale * w1[0] * bflo(z.z); o1[1] = d[8 * k + 5] * scale * w1[1] * bfhi(z.z); o1[2] = d[8 * k + 6] * scale * w1[2] * bflo(z.w); o1[3] = d[8 * k + 7] * scale * w1[3] * bfhi(z.w);
        *(GAS v4u*)(od + 8 * k) = pack8f(o0, o1); }
}
__device__ __forceinline__ void attn_super(ArgsP args, int l, int kind, int a, int h, int qb, char* shm, int lane, int wid) {
    typedef attn_body::bf16 abf;
    unsigned char* ws = args->ws;
    const abf* Q = (const abf*)(ws + WS_Q); abf* OP = (abf*)(ws + WS_OP);
    size_t qrow; const abf* Kb; const abf* Vb; int NT, vis, qwaves;
    if (kind == 0)      { qrow = (size_t)a * SEQ + (size_t)qb * 256; Kb = (const abf*)(ws + WS_KP) + (size_t)a * KPROWS * D; Vb = (const abf*)(ws + WS_VP) + (size_t)a * KPROWS * D; NT = 4 * qb + 5; vis = (wid >> 1) + 1; qwaves = 8; }
    else if (kind == 1) { qrow = (size_t)ROW_S + (size_t)a * DSQ; Kb = (const abf*)(ws + WS_KS) + (size_t)(l * NDB + a) * KSROWS * D; Vb = (const abf*)(ws + WS_VS) + (size_t)(l * NDB + a) * KSROWS * D; NT = 33; vis = 4; qwaves = 2; }
    else                { qrow = (size_t)ROW_M; Kb = (const abf*)(ws + WS_KP); Vb = (const abf*)(ws + WS_VP); NT = 5; vis = 0; qwaves = 8; }
    const attn128::Fin nofin{0, 0, 0u};
    if (kind == 1) {
        attn128::attn_unit128<8, false, true, false>(Q + qrow * D + (h * 2) * 64, Kb + (h * 2) * 64, Vb + h * 128, OP + qrow * 2048 + (h * 2) * 128, NT, vis, qwaves, shm, nofin);
        attn_finish(args, l, qrow, h, qwaves, lane, wid);
    } else {
        attn128::attn_unit128<8, true, false, false>(Q + qrow * D + (h * 2) * 64, Kb + (h * 2) * 64, Vb + h * 128, OP + qrow * 2048 + (h * 2) * 128, NT, vis, qwaves, shm, nofin);
        const attn128::Fin fin{l, h, (unsigned)qrow};
        attn128::attn_unit128<8, true, false, true>(Q + qrow * D + (h * 2 + 1) * 64, Kb + (h * 2 + 1) * 64, Vb + h * 128, OP + qrow * 2048 + (h * 2 + 1) * 128, NT, vis, qwaves, shm, fin);
    }
}

__global__ void __launch_bounds__(NWAVES * 64, 2) hawk_fwd(Args args) {
    extern __shared__ __attribute__((aligned(16))) unsigned char lds_raw[];
    LAS unsigned char* lds = (LAS unsigned char*)lds_raw;
    volatile LAS unsigned* MISC = (volatile LAS unsigned*)(lds + MISC_OFF);
    const int tid = threadIdx.x;
    const int G = gridDim.x; const int bx = blockIdx.x; const int vcu = (G % 8 == 0) ? (bx % 8) * (G / 8) + bx / 8 : bx;
    for (int u = tid; u < (LDS_BYTES - LDSCTL_OFF) / 4; u += NWAVES * 64) ((LAS unsigned*)(lds + LDSCTL_OFF))[u] = 0u;
    __syncthreads();
#if MK_PER_PHASE
#define GRID_BAR() do { if (tid == 0) __hip_atomic_store((gu32*)(KARG()->ws + WS_CTL) + CW_TMO, 0xBADBA0u, RLX_AGENT); } while (0)
#else
    (void)xcd_barrier_post((unsigned*)((gu32*)(KARG()->ws + WS_CTL) + CW_BAR), MISC + 8);
#define GRID_BAR() do { XcdBarrier bar_; bar_.bar = (unsigned*)((gu32*)(KARG()->ws + WS_CTL) + CW_BAR); bar_.x = xb_xcc_id(); bar_.st = MISC + 8; xcd_barrier(bar_); } while (0)
#endif
    const int lo = KARG()->ph_lo, hi = KARG()->ph_hi;
#if MK_PROBE
#define TACC() ((unsigned long long*)(KARG()->ws + WS_MISC + 32768))
    if (blockIdx.x == 0 && tid == 0) { unsigned long long* ta = TACC(); for (int k = 0; k < 16; ++k) ta[k] = 0ull; ta[16] = __builtin_amdgcn_s_memrealtime(); }
#define TMARK(k) do { if (blockIdx.x == 0 && tid == 0) { unsigned long long* ta = TACC(); const unsigned long long now = __builtin_amdgcn_s_memrealtime(); ta[k] += now - ta[16]; ta[16] = now; } } while (0)
#else
#define TMARK(k) do {} while (0)
#endif
#define IN(k) (lo <= (k) && (k) < hi)
#ifndef PHMASK
#define PHMASK 0xff
#endif
#define PH(b) ((PHMASK >> (b)) & 1)
#define BOTH(k) (IN(k) && IN((k) + 1))
    typedef pg8::bf16_t pb;
    for (int rep_ = 0; rep_ < MK_REP_P0; ++rep_)
    if (PH(0) && IN(0)) { int tid_l = tid; asm volatile("" : "+v"(tid_l)); p0_prologue(KARG(), lds, tid_l & 63, __builtin_amdgcn_readfirstlane(tid_l >> 6), vcu, G); if (BOTH(0) || rep_ + 1 < MK_REP_P0) GRID_BAR(); TMARK(0); }

    for (int l = 0; l < DEPTH; ++l) {
        const int pbase = 1 + 4 * l;
        for (int rep_ = 0; rep_ < MK_REP_P1; ++rep_)
        if (PH(1) && IN(pbase)) {
            ArgsP args = KARG(); unsigned char* ws = args->ws; unsigned char* wl = ws + WS_W + (size_t)l * W_LAYER;
            pg8::Gemm g{(const pb*)(ws + WS_HB), (const pb*)(wl + W_IN), D, D, 0};
#if MK_KPROBE
            pg8::TwoPartOrder S; S.init(M, INC, G, bx);
#else
            pg8::StaticOrder S; S.init(M, INC, G, bx);
#endif
            pg8::EpiIn E{l, ws, args->out};
#if MK_STAGGER
            if ((blockIdx.x >> 3) & 1) { __builtin_amdgcn_s_sleep(127); __builtin_amdgcn_s_sleep(127); __builtin_amdgcn_s_sleep(127); __builtin_amdgcn_s_sleep(127); }
#endif
            #if MK_KPROBE
            pg8::gemm_phase<pg8::EpiIn, pg8::TwoPartOrder, true, true>(lds + RING_OFF, g, S, E);
#else
            pg8::gemm_phase<pg8::EpiIn, pg8::StaticOrder, MK_ALIGN_P1, true>(lds + RING_OFF, g, S, E);
#endif
            TMARK(7); if (BOTH(pbase) || rep_ + 1 < MK_REP_P1) GRID_BAR(); TMARK(1);
        }
        for (int rep_ = 0; rep_ < MK_REP_P3; ++rep_)
        if ((PH(3) || PH(4)) && IN(pbase + 1)) {
            const int xcd0 = (int)(xb_xcc_id() & 7u);
            for (int probe = 0; probe < 8; ++probe) {
              const int qx = (xcd0 + probe) & 7;
              if (probe == 1) {
                  int tid_c = tid; asm volatile("" : "+v"(tid_c));
                  if (tid_c < 64) { unsigned hv = 216u; if (tid_c < 8) hv = __hip_atomic_load((gu32*)(KARG()->ws + WS_CTL) + CW_QUEUE + 64 * ((l + 4 * rep_) * 8 + ((xcd0 + tid_c) & 7)), RLX_AGENT);
                      const unsigned long long lm = __ballot(hv < 216u); if (tid_c == 0) MISC[1] = (unsigned)lm; }
                  __syncthreads();
              }
              if (probe >= 1 && !((MISC[1] >> probe) & 1u)) continue;
              for (;;) {
                ArgsP args = KARG();
                int tid_l = tid; asm volatile("" : "+v"(tid_l)); const int lane_l = tid_l & 63, wave_l = __builtin_amdgcn_readfirstlane(tid_l >> 6);
                if (tid_l == 0) MISC[0] = __hip_atomic_fetch_add((gu32*)(args->ws + WS_CTL) + CW_QUEUE + 64 * ((l + 4 * rep_) * 8 + qx), 1u, RLX_AGENT);
                __syncthreads();
                const int idx = (int)MISC[0];
                __syncthreads();
                if (idx >= 216) break;
                int sig = -1;
                if (idx < 8) rnn_unit(args, l, 0, qx, idx, 0, lds + RING_OFF, tid_l, lane_l, wave_l);
                else if (idx < 24) { const int db = 2 * qx + ((idx - 8) >> 3);
                    cache_convert_head(args, l, db, (idx - 8) & 7, tid_l, NWAVES * 64); asm volatile("s_waitcnt vmcnt(0)" ::: "memory"); __syncthreads();
                    attn_super(args, l, 1, db, (idx - 8) & 7, 0, (char*)lds_raw + RING_OFF, lane_l, wave_l); sig = db >> 2; }
                else if (idx == 24) { attn_super(args, l, 2, 0, qx, 0, (char*)lds_raw + RING_OFF, lane_l, wave_l); sig = 4; }
                else if (idx >= 32 && idx < 56) rnn_unit(args, l, 0, qx, (idx - 32) & 7, 1 + ((idx - 32) >> 3), lds + RING_OFF, tid_l, lane_l, wave_l);
                else if (idx >= 56 && idx < 72) { const int db = 2 * qx + ((idx - 56) >> 3); rnn_unit(args, l, 1, db, (idx - 56) & 7, 0, lds + RING_OFF, tid_l, lane_l, wave_l); sig = db >> 2; }
                else if (idx == 72) { rnn_unit(args, l, 2, 0, qx, 0, lds + RING_OFF, tid_l, lane_l, wave_l); sig = 4; }
                else if (idx >= 73 && idx < 89) { }
                else if ((idx >= 105 && idx < 108) || (idx >= 130 && idx < 133)) {
                    const bool isC = idx >= 130; const int k = isC ? idx - 130 : idx - 105;
                    if (k < 2 || qx < 4) {
                        const int panel = k < 2 ? (qx >> 1) : 4, pn = k < 2 ? 2 * (qx & 1) + k : qx, pm = 128 + panel;
                        gu32* cw = (gu32*)(args->ws + WS_CTL) + (isC ? CW_CNTB : CW_CNTA) + 64 * (l * 8 + panel);
                        const unsigned want = isC ? 4u : (panel < 4 ? 64u : 16u);
                        if (tid_l == 0) { unsigned spn = 0u; while (__hip_atomic_load(cw, RLX_AGENT) < want) { __builtin_amdgcn_s_sleep(4); if (++spn > (1u << 22)) { __hip_atomic_store((gu32*)(args->ws + WS_CTL) + CW_TMO, 0xC0DFu, RLX_AGENT); break; } }
                            __builtin_amdgcn_fence(__ATOMIC_ACQUIRE, "agent"); asm volatile("s_waitcnt vmcnt(0)" ::: "memory"); }
                        __syncthreads();
                        unsigned char* ws = args->ws; unsigned char* wl = ws + WS_W + (size_t)l * W_LAYER;
                        if (!isC) { pg8::Gemm g{(const pb*)(ws + WS_OX), (const pb*)(wl + W_PROJ), 2 * D, D, D}; pg8::OneUnit S{pm, pn, 2}; pg8::EpiProj E{ws};
                            pg8::gemm_phase<pg8::EpiProj, pg8::OneUnit, true, true>(lds + RING_OFF, g, S, E);
                            asm volatile("s_waitcnt vmcnt(0)" ::: "memory"); __syncthreads();
                            if (tid_l == 0) { __builtin_amdgcn_fence(__ATOMIC_RELEASE, "agent"); asm volatile("s_waitcnt vmcnt(0)" ::: "memory");     __hip_atomic_fetch_add((gu32*)(ws + WS_CTL) + CW_CNTB + 64 * (l * 8 + panel), 1u, RLX_AGENT); } }
                        else { pg8::Gemm g{(const pb*)(ws + WS_MB), (const pb*)(wl + W_OUT), D, D, 0}; pg8::OneUnit S{pm, pn, 1}; pg8::EpiOut E{ws};
                            pg8::gemm_phase<pg8::EpiOut, pg8::OneUnit, true, true>(lds + RING_OFF, g, S, E); }
                    }
                }
                else { const int i = idx < 32 ? idx - 25 : idx < 105 ? idx - 89 + 7 : idx < 130 ? idx - 108 + 23 : idx - 133 + 45, r = i & 31;
                    (void)r; attn_super(args, l, 0, qx, i & 7, 15 - (i >> 3), (char*)lds_raw + RING_OFF, lane_l, wave_l); }
                if (sig >= 0) { asm volatile("s_waitcnt vmcnt(0)" ::: "memory"); __syncthreads();
                    if (tid_l == 0) { __builtin_amdgcn_fence(__ATOMIC_RELEASE, "agent"); asm volatile("s_waitcnt vmcnt(0)" ::: "memory");     __hip_atomic_fetch_add((gu32*)(args->ws + WS_CTL) + CW_CNTA + 64 * (l * 8 + sig), 1u, RLX_AGENT); } }
              }
            }
            TMARK(8); if (BOTH(pbase + 1) || rep_ + 1 < MK_REP_P3) GRID_BAR(); TMARK(3);
        }
        for (int rep_ = 0; rep_ < MK_REP_P4; ++rep_)
        if (PH(5) && IN(pbase + 2)) {
            ArgsP args = KARG(); unsigned char* ws = args->ws; unsigned char* wl = ws + WS_W + (size_t)l * W_LAYER;
            pg8::Gemm g{(const pb*)(ws + WS_OX), (const pb*)(wl + W_PROJ), 2 * D, D, D}; pg8::TwoPartOrder S; S.init(MP, D, G, bx);
            pg8::EpiProj E{ws};
            pg8::gemm_phase<pg8::EpiProj, pg8::TwoPartOrder, true, true>(lds + RING_OFF, g, S, E);
            TMARK(9); if (BOTH(pbase + 2) || rep_ + 1 < MK_REP_P4) GRID_BAR(); TMARK(4);
        }
#define P5_BODY() do { ArgsP args = KARG(); unsigned char* ws = args->ws; unsigned char* wl = ws + WS_W + (size_t)l * W_LAYER; \
            pg8::Gemm g{(const pb*)(ws + WS_MB), (const pb*)(wl + W_OUT), D, D, 0}; pg8::StaticOrder S; S.init(MP, D, G, bx); \
            pg8::EpiOut E{ws}; \
            pg8::gemm_phase<pg8::EpiOut, pg8::StaticOrder, true, true>(lds + RING_OFF, g, S, E); } while (0)
        if (PH(6) && IN(pbase + 3)) {
#if MK_REP_P5 == 2
            P5_BODY(); GRID_BAR();
#endif
            P5_BODY();
            if (BOTH(pbase + 3)) GRID_BAR(); TMARK(5);
        }
    }
    if (PH(7) && IN(N_PHASES - 1)) {
        ArgsP args = KARG(); unsigned char* ws = args->ws;
        int tid_l = tid; asm volatile("" : "+v"(tid_l)); const int lane = tid_l & 63, wave = __builtin_amdgcn_readfirstlane(tid_l >> 6);
        const bf16* HB = (const bf16*)(ws + WS_HB); const float* fw = args->in[I_FNW];
        const int gw = vcu * NWAVES + wave, NGW = G * NWAVES;
        f32x4 w4[4];
#pragma unroll
        for (int j = 0; j < 4; ++j) w4[j] = ((const GAS f32x4*)fw)[lane + 64 * j];
        for (int row = gw; row < ROW_M; row += NGW) {
            f32x4 v[4]; float s = 0.f;
#pragma unroll
            for (int j = 0; j < 4; ++j) { const unsigned long long w = ((const GAS unsigned long long*)(HB + (size_t)row * D))[lane + 64 * j]; const unsigned lo = (unsigned)w, hi = (unsigned)(w >> 32);
                v[j] = (f32x4){bflo(lo), bfhi(lo), bflo(hi), bfhi(hi)}; s += (v[j].x * v[j].x + v[j].y * v[j].y) + (v[j].z * v[j].z + v[j].w * v[j].w); }
            const float rs = rsqrtf(wave_sum(s) * (1.0f / 1024.0f) + EPS);
            float* o = args->out + (row < ROW_S ? O_YP + (size_t)row * D : O_YS + (size_t)(row - ROW_S) * D);
#pragma unroll
            for (int j = 0; j < 4; ++j) ((GAS f32x4*)o)[lane + 64 * j] = v[j] * rs * w4[j];
        }
    }
#if MK_PROBE
    GRID_BAR(); TMARK(6);
    if (blockIdx.x == 0) {
        __syncthreads();
        const size_t offs[10] = {O_YP, O_YS, O_KP, O_VP, O_CP, O_RP, O_KS, O_VS, O_CS, O_RS};
#pragma unroll
        for (int k = 0; k < 10; ++k) { unsigned long long t = TACC()[k]; if (k == 1) t += TACC()[7]; if (k == 3) t += TACC()[8]; if (k == 4) t += TACC()[9];
            unsigned n = (unsigned)(t / 100ull); if (n > 30000u) n = 30000u;
            unsigned* o = (unsigned*)(KARG()->out + offs[k]); for (unsigned i = tid; i < n; i += NWAVES * 64) o[i] = 0xAAAAAAAAu; }
    }
#endif
#undef IN
#undef BOTH
}

extern "C" void kernel_launch(void* const* d_in, const int* in_sizes, int n_in, void* d_out, int out_size, void* d_ws, size_t ws_size, hipStream_t stream) {
    static int grid = 0;
    if (grid == 0) {
        if (n_in != 25 || (size_t)out_size != O_END || ws_size < WS_END) { fprintf(stderr, "kernel_launch: unexpected shapes (n_in %d, out %d, ws %zu); nothing launched\n", n_in, out_size, ws_size); grid = -1; return; }
        int dev = 0, cus = 0, per_cu = 0;
        if (hipGetDevice(&dev) != hipSuccess || hipDeviceGetAttribute(&cus, hipDeviceAttributeMultiprocessorCount, dev) != hipSuccess) { grid = -1; return; }
        if (hipFuncSetAttribute((const void*)hawk_fwd, hipFuncAttributeMaxDynamicSharedMemorySize, LDS_BYTES) != hipSuccess) { fprintf(stderr, "kernel_launch: hipFuncSetAttribute failed\n"); grid = -1; return; }
        if (hipOccupancyMaxActiveBlocksPerMultiprocessor(&per_cu, (const void*)hawk_fwd, NWAVES * 64, LDS_BYTES) != hipSuccess || per_cu < 1) { fprintf(stderr, "kernel_launch: occupancy query reports %d workgroups per CU\n", per_cu); }
        (void)hipGetLastError();
        grid = cus;
    }
    if (grid < 0) return;
    if (hipMemsetAsync((char*)d_ws + WS_CTL, 0, CTL_ZERO_BYTES, stream) != hipSuccess) return;
    Args a{};
    for (int i = 0; i < 25; ++i) a.in[i] = (const float*)d_in[i];
    a.out = (float*)d_out; a.ws = (unsigned char*)d_ws;
#if MK_PER_PHASE
    for (int p = 0; p < N_PHASES; ++p) { a.ph_lo = p; a.ph_hi = p + 1; a.li = p; hipLaunchKernelGGL(hawk_fwd, dim3(grid), dim3(NWAVES * 64), LDS_BYTES, stream, a); }
#else
    a.ph_lo = 0; a.ph_hi = N_PHASES; a.li = 0;
    hipLaunchKernelGGL(hawk_fwd, dim3(grid), dim3(NWAVES * 64), LDS_BYTES, stream, a);
#endif
    const hipError_t le = hipPeekAtLastError();
    if (le != hipSuccess) fprintf(stderr, "kernel_launch: launch failed: %s\n", hipGetErrorName(le));
}
```

```cpp
#include <hip/hip_runtime.h>
#include <hip/hip_bf16.h>
#include <cstdio>
#include <cstdint>
#include <cmath>

#ifndef MK_PROBE
#define MK_PROBE 0
#endif
#ifndef MK_REP_P0
#define MK_REP_P0 1
#endif
#ifndef MK_REP_P1
#define MK_REP_P1 1
#endif
#ifndef MK_REP_P2
#define MK_REP_P2 1
#endif
#ifndef MK_REP_P3
#define MK_REP_P3 1
#endif
#ifndef MK_REP_P4
#define MK_REP_P4 1
#endif
#ifndef MK_REP_P5
#define MK_REP_P5 1
#endif
#ifndef MK_ALIGN_P1
#define MK_ALIGN_P1 true
#endif
#ifndef MK_EPI2
#define MK_EPI2 0
#endif
#ifndef MK_KPROBE
#define MK_KPROBE 0
#endif
#ifndef MK_STAGGER
#define MK_STAGGER 0
#endif
#ifndef MK_PER_PHASE
#define MK_PER_PHASE 0
#endif

constexpr int D = 1024, NB = 8, SEQ = 4096, DEPTH = 4, NDB = 16, DSQ = 64, PAST = 2048, NMETA = 16, NH = 8, INC = 8192;
constexpr int MP = NB * SEQ;
constexpr int MSM = NDB * DSQ;
constexpr int ROW_S = MP, ROW_M = MP + MSM;
constexpr int M = ROW_M + 256;
constexpr int TP = NMETA + SEQ;
constexpr int KPROWS = 64 + SEQ;
constexpr int KSROWS = PAST + DSQ;
constexpr float EPS = 1e-6f;
constexpr float QSCALE = 0.125f * 1.4426950408889634f;

constexpr size_t O_YP = 0, O_YS = 33554432, O_KP = 34603008, O_VP = 169345024, O_CP = 304087040, O_RP = 304185344,
                 O_KS = 304218112, O_VS = 308412416, O_CS = 312606720, O_RS = 312803328, O_END = 312868864;

constexpr size_t MiB = 1u << 20;
constexpr size_t WS_CTL = 0, CTL_ZERO_BYTES = 1 * MiB;
constexpr size_t WS_TCOS = 1 * MiB, WS_TSIN = 2 * MiB;
constexpr size_t WS_MISC = 3 * MiB;
constexpr size_t WS_W = 4 * MiB, W_LAYER = 24 * MiB, W_IN = 0, W_PROJ = 16 * MiB, W_OUT = 20 * MiB, W_G = 22 * MiB;
constexpr size_t WS_HRES = 100 * MiB;
constexpr size_t WS_HB = 233 * MiB;
constexpr size_t WS_SSQ = 300 * MiB;
constexpr size_t WS_XR = 303 * MiB, WS_ZR = 370 * MiB, WS_Q = 437 * MiB, WS_ZA = 504 * MiB, WS_RHO = 571 * MiB, WS_SGA = 638 * MiB;
constexpr size_t WS_OX = 705 * MiB;
constexpr size_t WS_MB = 838 * MiB;
constexpr size_t WS_OP = 905 * MiB;
constexpr size_t WS_KP = 1038 * MiB, WS_VP = 1103 * MiB;
constexpr size_t WS_KS = 1168 * MiB, WS_VS = 1432 * MiB;
constexpr size_t WS_HRES2 = 1696 * MiB;
constexpr size_t WS_END = 1830 * MiB;
static_assert(WS_HRES + (size_t)M * D * 4 <= WS_HB && WS_HB + (size_t)M * D * 2 <= WS_SSQ && WS_SSQ + (size_t)M * 64 <= WS_XR, "ws map 1");
static_assert(WS_XR + (size_t)M * D * 2 <= WS_ZR && WS_SGA + (size_t)M * D * 2 <= WS_OX && WS_OX + (size_t)M * 4096 <= WS_MB && WS_MB + (size_t)M * 2048 <= WS_OP, "ws map 2");
static_assert(WS_OP + (size_t)M * 4096 <= WS_KP && WS_KP + (size_t)NB * KPROWS * 2048 <= WS_VP && WS_VP + (size_t)NB * KPROWS * 2048 <= WS_KS, "ws map 3");
static_assert(WS_KS + (size_t)DEPTH * NDB * KSROWS * 2048 <= WS_VS && WS_VS + (size_t)DEPTH * NDB * KSROWS * 2048 <= WS_END, "ws map 4");
constexpr int CW_TMO = 0, CW_CODE = 1;
constexpr int CW_QUEUE = 64;
constexpr int CW_BAR = 8192;

struct Args { const float* in[25]; float* out; unsigned char* ws; int ph_lo, ph_hi, li, pad; };
#define CAS __attribute__((address_space(4)))
typedef const CAS struct Args* ArgsP;
#define KARG() ({ ArgsP p_ = (ArgsP)__builtin_amdgcn_kernarg_segment_ptr(); asm volatile("" : "+s"(p_)); p_; })
enum { I_XP = 0, I_XS, I_CK, I_CV, I_SC, I_SR, I_META, I_NW, I_WIN, I_CW, I_CB, I_WRG, I_BRG, I_WIG, I_BIG, I_LAM, I_LQ1, I_LK1, I_LQ2, I_LK2, I_SUBLN, I_WPR, I_WPA, I_WOUT, I_FNW };


namespace pg8 {
#define PG8_LAS __attribute__((address_space(3)))
typedef unsigned short bf16_t;
typedef short bf16x8 __attribute__((ext_vector_type(8)));
typedef float f32x4 __attribute__((ext_vector_type(4)));
typedef unsigned u32x4 __attribute__((ext_vector_type(4)));
typedef unsigned u32x2 __attribute__((ext_vector_type(2)));
constexpr int BM = 256, BK = 64, HALF = 128, HTB = HALF * BK * 2  , STAGE_BYTES = 8 * HTB, NXCD = 8, WGM = 4;

__host__ __device__ __forceinline__ int lds_byte(int r, int c) { const int st = (r >> 4) * 2 + (c >> 5), rr = r & 15, cc = c & 31, ob = rr * 64 + cc * 2; return st * 1024 + (ob ^ (((ob >> 9) & 1) << 5)); }
__host__ __device__ __forceinline__ void stage_rc(int b, int& R, int& C) { const int st = b / 1024, sb = b % 1024, swz = sb ^ (((sb >> 9) & 1) << 5); R = (st >> 1) * 16 + swz / 64; C = (st & 1) * 32 + (swz % 64) / 2; }
__host__ __device__ __forceinline__ int perm32(int rho) { const int n = rho >> 4, i = rho & 15; return 8 * (i >> 2) + 4 * n + (i & 3); }

struct Unit { int pm, pn, kh; };
struct Gemm { const bf16_t* A; const bf16_t* Bt; int ld, kt, ks; };

struct StaticOrder {
    int nM, nN, nwg, G, c;
    __host__ __device__ void init(int M_, int N_, int G_, int c_) { nM = M_ / BM; nN = N_ / BM; nwg = nM * nN; G = G_; c = c_; }
    __host__ __device__ bool next(int i, Unit& u) const {
        const long L = (long)i * G + c; if (L >= nwg) return false;
        int wgid = (int)L; { const int q = nwg / NXCD, r = nwg % NXCD, xcd = wgid % NXCD, off = wgid / NXCD; wgid = (xcd < r ? xcd * (q + 1) : r * (q + 1) + (xcd - r) * q) + off; }
        const int nig = WGM * nN, gid = wgid / nig, fm = gid * WGM, gsz = (nM - fm) < WGM ? (nM - fm) : WGM;
        u.pm = fm + ((wgid % nig) % gsz); u.pn = (wgid % nig) / gsz;
        u.kh = 0; return true;
    }
    __device__ __forceinline__ void a_ready(const Unit&) const {}
    __device__ __forceinline__ void done(const Unit&) const {}
};
struct OneUnit {
    int pm, pn, nk;
    __host__ __device__ bool next(int i, Unit& u) const { if (i >= nk) return false; u.pm = pm; u.pn = pn; u.kh = i; return true; }
    __device__ __forceinline__ void a_ready(const Unit&) const {}
    __device__ __forceinline__ void done(const Unit&) const {}
};
struct TwoPartOrder {
    StaticOrder S;
    __host__ __device__ void init(int M_, int N_, int G_, int c_) { S.init(M_, N_, G_, c_); }
    __host__ __device__ bool next(int i, Unit& u) const { if (!S.next(i >> 1, u)) return false; u.kh = i & 1; return true; }
    __device__ __forceinline__ void a_ready(const Unit&) const {}
    __device__ __forceinline__ void done(const Unit&) const {}
};
__device__ __forceinline__ unsigned cvt_pk_bf16(float lo, float hi) { unsigned r; asm volatile("v_cvt_pk_bf16_f32 %0, %1, %2" : "=v"(r) : "v"(lo), "v"(hi)); return r; }
__device__ __forceinline__ float bf_lo(unsigned w) { return __uint_as_float(w << 16); }
__device__ __forceinline__ float bf_hi(unsigned w) { return __uint_as_float(w & 0xffff0000u); }
__device__ __forceinline__ float sigm(float x) { return __builtin_amdgcn_rcpf(1.0f + __expf(-x)); }
__device__ __forceinline__ u32x4 pack8(const f32x4 a, const f32x4 b) { u32x4 w; w.x = cvt_pk_bf16(a[0], a[1]); w.y = cvt_pk_bf16(a[2], a[3]); w.z = cvt_pk_bf16(b[0], b[1]); w.w = cvt_pk_bf16(b[2], b[3]); return w; }

struct EpiIn {
    static constexpr bool PERM = true, AFTER_DRAIN = false, TWO_PART = (MK_KPROBE != 0);
    int l; unsigned char* ws; float* out;
    __device__ __forceinline__ void mid(f32x4 (&)[2][2][4][2], const Unit&, int, int, int, int) const {}
    __device__ __forceinline__ void operator()(const f32x4 (&acc)[2][2][4][2], const Unit& u, int wr, int wc, int fr_in, int fq_in) const {
        int fr = fr_in, fq = fq_in; asm volatile("" : "+v"(fr), "+v"(fq));
        const float* ssq = (const float*)(ws + WS_SSQ); const float* tcos = (const float*)(ws + WS_TCOS); const float* tsin = (const float*)(ws + WS_TSIN);
        bf16_t* XR = (bf16_t*)(ws + WS_XR); bf16_t* ZR = (bf16_t*)(ws + WS_ZR); bf16_t* Q = (bf16_t*)(ws + WS_Q); bf16_t* ZA = (bf16_t*)(ws + WS_ZA); bf16_t* RHO = (bf16_t*)(ws + WS_RHO); bf16_t* SGA = (bf16_t*)(ws + WS_SGA);
        bf16_t* KP = (bf16_t*)(ws + WS_KP); bf16_t* VP = (bf16_t*)(ws + WS_VP); bf16_t* KS = (bf16_t*)(ws + WS_KS) + (size_t)l * NDB * KSROWS * D; bf16_t* VS = (bf16_t*)(ws + WS_VS) + (size_t)l * NDB * KSROWS * D;
        const int part = u.pn >> 2, pm = u.pm;
        const int ct = (u.pn & 3) * 256 + wc * 32 + 8 * fq;
        const int a = wc & 1;
        float rsv[2][4];
        { f32x4 sq[2][4];
#pragma unroll
          for (int ai = 0; ai < 2; ++ai)
#pragma unroll
            for (int m = 0; m < 4; ++m) sq[ai][m] = *(const f32x4*)(ssq + ((size_t)pm * BM + ai * HALF + wr * 64 + m * 16 + fr) * 16 + 4 * fq);
#pragma unroll
          for (int ai = 0; ai < 2; ++ai)
#pragma unroll
            for (int m = 0; m < 4; ++m) { float t = (sq[ai][m][0] + sq[ai][m][1]) + (sq[ai][m][2] + sq[ai][m][3]); t += __shfl_xor(t, 16); t += __shfl_xor(t, 32); rsv[ai][m] = rsqrtf(t * (1.0f / 1024.0f) + EPS) * (MK_KPROBE ? 0.5f : 1.0f); } }
        asm volatile("" ::: "memory");
#pragma unroll
        for (int ai = 0; ai < 2; ++ai) {
#pragma unroll
            for (int m = 0; m < 4; ++m) {
                const int r = ai * HALF + wr * 64 + m * 16 + fr; const size_t grow = (size_t)pm * BM + r;
                const float rs = rsv[ai][m];
                int pos, nrep = 1; size_t krow, frow; bool valid = true;
                if (pm < 128) { const int b = pm >> 4, t = (pm & 15) * 256 + r; pos = NMETA + t; krow = (size_t)b * KPROWS + 64 + t; frow = (size_t)(l * NB + b) * TP + NMETA + t; }
                else if (pm < 132) { const int idx = (pm - 128) * 256 + r, db = idx >> 6, s = idx & 63; pos = NMETA + PAST + s; krow = (size_t)db * KSROWS + PAST + s; frow = (size_t)(l * NDB + db) * DSQ + s; }
                else { pos = r & 15; krow = (size_t)(r & 15); frow = (size_t)(l * NB) * TP + (r & 15); nrep = NB; valid = r < NMETA; }
                const bool smp = (pm >= 128 && pm < 132);
                if (part == 0) {
                    bf16_t* rowp = XR + grow * D + ct;
#pragma unroll
                    for (int bj = 0; bj < 2; ++bj) { const f32x4 v0 = acc[ai][bj][m][0] * rs, v1 = acc[ai][bj][m][1] * rs; *(u32x4*)(rowp + bj * HALF) = pack8(v0, v1); }
                    if (m == 3 && fr >= 13) {
                        float* dst = nullptr;
                        if (pm < 128) { if ((pm & 15) == 15 && ai == 1 && wr == 1) dst = out + O_CP + ((size_t)(l * NB + (pm >> 4)) * 3 + (fr - 13)) * D; }
                        else if (pm < 132) { const int db = ((pm - 128) * 256 + r) >> 6; dst = out + O_CS + ((size_t)(l * NDB + db) * 3 + (fr - 13)) * D; }
                        if (dst) {
#pragma unroll
                            for (int bj = 0; bj < 2; ++bj) { *(f32x4*)(dst + ct + bj * HALF) = acc[ai][bj][m][0] * rs; *(f32x4*)(dst + ct + bj * HALF + 4) = acc[ai][bj][m][1] * rs; }
                        }
                    }
                } else if (part == 1 || part == 5) {
                    bf16_t* rowp = (part == 1 ? ZR : ZA) + grow * D + ct;
#pragma unroll
                    for (int bj = 0; bj < 2; ++bj) { f32x4 v0 = acc[ai][bj][m][0] * rs, v1 = acc[ai][bj][m][1] * rs;
#pragma unroll
                        for (int e = 0; e < 4; ++e) { v0[e] = v0[e] * sigm(v0[e]); v1[e] = v1[e] * sigm(v1[e]); }
                        *(u32x4*)(rowp + bj * HALF) = pack8(v0, v1); }
                } else if (part == 2 || part == 3) {
                    const size_t ci = (size_t)pos * 32 + 16 * a + 4 * fq; const f32x4 c4 = *(const f32x4*)(tcos + ci), s4 = *(const f32x4*)(tsin + ci);
#pragma unroll
                    for (int bj = 0; bj < 2; ++bj) { const f32x4 x1 = acc[ai][bj][m][0] * rs, x2 = acc[ai][bj][m][1] * rs; const f32x4 o1 = x1 * c4 - x2 * s4, o2 = x2 * c4 + x1 * s4;
                        if (part == 2) { *(u32x4*)(Q + grow * D + ct + bj * HALF) = pack8(o1 * QSCALE, o2 * QSCALE); }
                        else if (valid) {
                            const int oc = 64 * (4 * (u.pn & 3) + 2 * bj + (wc >> 1)) + 16 * a + 4 * fq;
                            const u32x4 w = pack8(o1, o2);
                            bf16_t* kd = (smp ? KS : KP) + krow * D + ct + bj * HALF; float* fd = out + (smp ? O_KS : O_KP) + frow * D + oc;
                            for (int rep = 0; rep < nrep; ++rep) { *(u32x4*)(kd + (size_t)rep * KPROWS * D) = w; *(f32x4*)(fd + (size_t)rep * TP * D) = o1; *(f32x4*)(fd + (size_t)rep * TP * D + 32) = o2; }
                        } }
                } else if (part == 4) {
                    if (valid) {
#pragma unroll
                        for (int bj = 0; bj < 2; ++bj) { const f32x4 v0 = acc[ai][bj][m][0] * rs, v1 = acc[ai][bj][m][1] * rs; const u32x4 w = pack8(v0, v1);
                            bf16_t* vd = (smp ? VS : VP) + krow * D + ct + bj * HALF; float* fd = out + (smp ? O_VS : O_VP) + frow * D + ct + bj * HALF;
                            for (int rep = 0; rep < nrep; ++rep) { *(u32x4*)(vd + (size_t)rep * KPROWS * D) = w; *(f32x4*)(fd + (size_t)rep * TP * D) = v0; *(f32x4*)(fd + (size_t)rep * TP * D + 4) = v1; } }
                    }
                } else {
                    const int gc = 128 * (u.pn - 24) + wc * 32 + 8 * fq;
                    f32x4 rho[2], sga[2];
#pragma unroll
                    for (int n = 0; n < 2; ++n) { const f32x4 gr = acc[ai][0][m][n] * rs, ga = acc[ai][1][m][n] * rs;
#pragma unroll
                        for (int e = 0; e < 4; ++e) { const float er = __expf(-fminf(fmaxf(gr[e], -30.f), 30.f)), ea = __expf(-fminf(fmaxf(ga[e], -30.f), 30.f));
                            rho[n][e] = (1.0f + ea) * __builtin_amdgcn_rcpf(1.0f + er); sga[n][e] = __builtin_amdgcn_rcpf(1.0f + ea); } }
                    *(u32x4*)(RHO + grow * D + gc) = pack8(rho[0], rho[1]); *(u32x4*)(SGA + grow * D + gc) = pack8(sga[0], sga[1]);
                }
                asm volatile("" ::: "memory");
            }
        }
    }
};

struct EpiProj {
    static constexpr bool PERM = true, AFTER_DRAIN = false, TWO_PART = true;
    unsigned char* ws;
    __device__ __forceinline__ void mid(f32x4 (&acc)[2][2][4][2], const Unit& u, int wr, int wc, int fr_in, int fq_in) const {
        int fr = fr_in, fq = fq_in; asm volatile("" : "+v"(fr), "+v"(fq));
        const bf16_t* RHO = (const bf16_t*)(ws + WS_RHO);
        const int c0 = u.pn * BM + wc * 32 + 8 * fq;
        u32x4 wv[2][4][2];
#pragma unroll
        for (int ai = 0; ai < 2; ++ai)
#pragma unroll
            for (int m = 0; m < 4; ++m)
#pragma unroll
                for (int bj = 0; bj < 2; ++bj) wv[ai][m][bj] = *(const u32x4*)(RHO + ((size_t)u.pm * BM + ai * HALF + wr * 64 + m * 16 + fr) * D + c0 + bj * HALF);
#pragma unroll
        for (int ai = 0; ai < 2; ++ai)
#pragma unroll
            for (int m = 0; m < 4; ++m)
#pragma unroll
                for (int bj = 0; bj < 2; ++bj) { const u32x4 w = wv[ai][m][bj];
                    acc[ai][bj][m][0] *= (f32x4){bf_lo(w.x), bf_hi(w.x), bf_lo(w.y), bf_hi(w.y)}; acc[ai][bj][m][1] *= (f32x4){bf_lo(w.z), bf_hi(w.z), bf_lo(w.w), bf_hi(w.w)}; }
    }
    __device__ __forceinline__ void operator()(const f32x4 (&acc)[2][2][4][2], const Unit& u, int wr, int wc, int fr_in, int fq_in) const {
        int fr = fr_in, fq = fq_in; asm volatile("" : "+v"(fr), "+v"(fq));
        const bf16_t* SGA = (const bf16_t*)(ws + WS_SGA); bf16_t* MB = (bf16_t*)(ws + WS_MB);
        const int c0 = u.pn * BM + wc * 32 + 8 * fq;
        u32x4 wv[2][4][2];
#pragma unroll
        for (int ai = 0; ai < 2; ++ai)
#pragma unroll
            for (int m = 0; m < 4; ++m)
#pragma unroll
                for (int bj = 0; bj < 2; ++bj) wv[ai][m][bj] = *(const u32x4*)(SGA + ((size_t)u.pm * BM + ai * HALF + wr * 64 + m * 16 + fr) * D + c0 + bj * HALF);
        asm volatile("" ::: "memory");
#pragma unroll
        for (int ai = 0; ai < 2; ++ai)
#pragma unroll
            for (int m = 0; m < 4; ++m) { const size_t grow = (size_t)u.pm * BM + ai * HALF + wr * 64 + m * 16 + fr;
#pragma unroll
                for (int bj = 0; bj < 2; ++bj) { const u32x4 w = wv[ai][m][bj];
                    const f32x4 v0 = acc[ai][bj][m][0] * (f32x4){bf_lo(w.x), bf_hi(w.x), bf_lo(w.y), bf_hi(w.y)}, v1 = acc[ai][bj][m][1] * (f32x4){bf_lo(w.z), bf_hi(w.z), bf_lo(w.w), bf_hi(w.w)};
                    *(u32x4*)(MB + grow * D + c0 + bj * HALF) = pack8(v0, v1); }
                if (m & 1) asm volatile("" ::: "memory"); }
    }
};

struct EpiOut {
    static constexpr bool PERM = true, AFTER_DRAIN = false, TWO_PART = false;
    unsigned char* ws;
    __device__ __forceinline__ void mid(f32x4 (&)[2][2][4][2], const Unit&, int, int, int, int) const {}
    __device__ __forceinline__ void operator()(const f32x4 (&acc)[2][2][4][2], const Unit& u, int wr, int wc, int fr_in, int fq_in) const {
        int fr = fr_in, fq = fq_in; asm volatile("" : "+v"(fr), "+v"(fq));
        bf16_t* HB = (bf16_t*)(ws + WS_HB); float* ssq = (float*)(ws + WS_SSQ);
        const int c0 = u.pn * BM + wc * 32 + 8 * fq;
        u32x4 hin[2][4][2];
#pragma unroll
        for (int ai = 0; ai < 2; ++ai)
#pragma unroll
            for (int m = 0; m < 4; ++m)
#pragma unroll
                for (int bj = 0; bj < 2; ++bj) hin[ai][m][bj] = *(const u32x4*)(HB + ((size_t)u.pm * BM + ai * HALF + wr * 64 + m * 16 + fr) * D + c0 + bj * HALF);
        asm volatile("" ::: "memory");
#pragma unroll
        for (int ai = 0; ai < 2; ++ai)
#pragma unroll
            for (int m = 0; m < 4; ++m) { const size_t grow = (size_t)u.pm * BM + ai * HALF + wr * 64 + m * 16 + fr; float ss = 0.f;
#pragma unroll
                for (int bj = 0; bj < 2; ++bj) { const u32x4 w = hin[ai][m][bj];
                    const f32x4 v0 = (f32x4){bf_lo(w.x), bf_hi(w.x), bf_lo(w.y), bf_hi(w.y)} + acc[ai][bj][m][0], v1 = (f32x4){bf_lo(w.z), bf_hi(w.z), bf_lo(w.w), bf_hi(w.w)} + acc[ai][bj][m][1];
                    *(u32x4*)(HB + grow * D + c0 + bj * HALF) = pack8(v0, v1);
                    ss += ((v0[0] * v0[0] + v0[1] * v0[1]) + (v0[2] * v0[2] + v0[3] * v0[3])) + ((v1[0] * v1[0] + v1[1] * v1[1]) + (v1[2] * v1[2] + v1[3] * v1[3])); }
                ss += __shfl_xor(ss, 16); ss += __shfl_xor(ss, 32);
                if (fq == 0) ssq[grow * 16 + u.pn * 4 + wc] = ss;
            }
    }
};
template <class Epi, class Sched, bool ALIGN_EPI = false, bool SP2 = false>
__device__ __forceinline__ void gemm_phase(PG8_LAS unsigned char* lds, const Gemm g, const Sched& S, const Epi& E) {
    int tid_o = threadIdx.x; asm volatile("" : "+v"(tid_o));
    const int tid = tid_o, wid = __builtin_amdgcn_readfirstlane(tid >> 6), lane = tid & 63, wr = wid >> 2, wc = wid & 3, fr = lane & 15, fq = lane >> 4;
    const int K = g.ld, nt = g.kt / BK; const size_t khb = (size_t)g.ks * 2;
    unsigned voffA[2], voffB[2];
#pragma unroll
    for (int i = 0; i < 2; ++i) { int R, C; stage_rc(tid * 16 + i * 8192, R, C); const int Rb = Epi::PERM ? ((R & ~31) + perm32(R & 31)) : R;
        voffA[i] = (unsigned)(R * K + C) * 2u; voffB[i] = (unsigned)(Rb * K + C) * 2u; }
    const size_t kstep = (size_t)(BK * 2);
    const size_t hstep = (size_t)HALF * K * 2;
    const size_t tstep = 2 * hstep;
    const unsigned ldsw = (unsigned)wid * 1024u;
    const int aoff = lds_byte(wr * 64 + fr, fq * 8), boff = lds_byte(wc * 32 + fr, fq * 8);
#define PG8_SA(b, h) (((b) * 2 + (h)) * HTB)
#define PG8_SB(b, h) ((4 + (b) * 2 + (h)) * HTB)
#define PG8_STAGE(bufoff, gbase, voff) do { _Pragma("unroll") for (int _i = 0; _i < 2; ++_i) \
        __builtin_amdgcn_global_load_lds((const unsigned*)((const char*)(gbase) + (voff)[_i]), (PG8_LAS unsigned*)(lds + (bufoff) + ldsw + _i * 8192), 16, 0, 0); } while (0)
#define PG8_LDA(dst, b, h) do { _Pragma("unroll") for (int m = 0; m < 4; ++m) _Pragma("unroll") for (int k = 0; k < 2; ++k) dst[m][k] = *(const PG8_LAS bf16x8*)(lds + PG8_SA(b, h) + aoff + m * 2048 + k * 1024); } while (0)
#define PG8_LDB(dst, b, h) do { _Pragma("unroll") for (int n = 0; n < 2; ++n) _Pragma("unroll") for (int k = 0; k < 2; ++k) dst[n][k] = *(const PG8_LAS bf16x8*)(lds + PG8_SB(b, h) + boff + n * 2048 + k * 1024); } while (0)
#define PG8_MMA(ai, bj, At, Bt) do { __builtin_amdgcn_s_setprio(1); _Pragma("unroll") for (int m = 0; m < 4; ++m) _Pragma("unroll") for (int n = 0; n < 2; ++n) _Pragma("unroll") for (int k = 0; k < 2; ++k) \
        acc[ai][bj][m][n] = __builtin_amdgcn_mfma_f32_16x16x32_bf16(Bt[n][k], At[m][k], acc[ai][bj][m][n], 0, 0, 0); __builtin_amdgcn_s_setprio(0); } while (0)
#define PG8_WAIT_V(n) asm volatile("s_waitcnt vmcnt(" #n ")" ::: "memory")
#define PG8_WAIT_L(n) asm volatile("s_waitcnt lgkmcnt(" #n ")" ::: "memory")
#define PG8_BAR __builtin_amdgcn_s_barrier()
#define PG8_SCHED __builtin_amdgcn_sched_barrier(0)
    Unit cur, nxt; int ui = 0;
    if (!S.next(0, cur)) return;
    f32x4 acc[2][2][4][2];
#pragma unroll
    for (int a = 0; a < 2; ++a)
#pragma unroll
        for (int b = 0; b < 2; ++b)
#pragma unroll
            for (int m = 0; m < 4; ++m)
#pragma unroll
                for (int n = 0; n < 2; ++n) acc[a][b][m][n] = (f32x4){0.f, 0.f, 0.f, 0.f};
    bf16x8 At[4][2], B0[2][2], B1[2][2];
    const char* cA = (const char*)g.A + (size_t)cur.pm * tstep + (size_t)cur.kh * khb; const char* cB = (const char*)g.Bt + (size_t)cur.pn * tstep + (size_t)cur.kh * khb;
    S.a_ready(cur);
    if constexpr (SP2) {
        PG8_STAGE(PG8_SB(0, 0), cB, voffB); PG8_STAGE(PG8_SB(0, 1), cB + hstep, voffB); PG8_STAGE(PG8_SA(0, 0), cA, voffA); PG8_STAGE(PG8_SA(0, 1), cA + hstep, voffA);
        if (wr == 1) PG8_BAR;
        PG8_WAIT_V(2); PG8_BAR;
        PG8_STAGE(PG8_SB(1, 0), cB + kstep, voffB); PG8_STAGE(PG8_SA(1, 0), cA + kstep, voffA); PG8_STAGE(PG8_SB(1, 1), cB + hstep + kstep, voffB);
        PG8_WAIT_V(6); PG8_BAR;
    } else {
        PG8_STAGE(PG8_SB(0, 0), cB, voffB); PG8_STAGE(PG8_SA(0, 0), cA, voffA); PG8_STAGE(PG8_SB(0, 1), cB + hstep, voffB); PG8_STAGE(PG8_SA(0, 1), cA + hstep, voffA);
        if (wr == 1) PG8_BAR;
        PG8_WAIT_V(4); PG8_BAR;
        PG8_STAGE(PG8_SB(1, 0), cB + kstep, voffB); PG8_STAGE(PG8_SA(1, 0), cA + kstep, voffA); PG8_STAGE(PG8_SB(1, 1), cB + hstep + kstep, voffB);
        PG8_WAIT_V(6); PG8_BAR;
    }
    for (;;) {
        const bool has_next = S.next(ui + 1, nxt);
        const char* nA = has_next ? (const char*)g.A + (size_t)nxt.pm * tstep + (size_t)nxt.kh * khb : cA; const char* nB = has_next ? (const char*)g.Bt + (size_t)nxt.pn * tstep + (size_t)nxt.kh * khb : cB;
        for (int t = 0; t < nt; t += 2) {
            const bool last = (t == nt - 2);
            const char* a1 = cA + (size_t)(t + 1) * kstep;
            const char* a2 = last ? nA : cA + (size_t)(t + 2) * kstep; const char* b2 = last ? nB : cB + (size_t)(t + 2) * kstep;
            const char* a3 = a2 + kstep; const char* b3 = b2 + kstep;
            if (last && has_next) S.a_ready(nxt);
            if constexpr (SP2) {
            PG8_LDB(B0, 0, 0); PG8_LDB(B1, 0, 1); PG8_SCHED; PG8_LDA(At, 0, 0); PG8_STAGE(PG8_SA(1, 1), a1 + hstep, voffA);
            PG8_WAIT_V(8); PG8_WAIT_L(0); PG8_BAR; PG8_MMA(0, 0, At, B0); PG8_MMA(0, 1, At, B1); PG8_BAR; PG8_SCHED;
            PG8_LDA(At, 0, 1); PG8_STAGE(PG8_SB(0, 0), b2, voffB); PG8_STAGE(PG8_SB(0, 1), b2 + hstep, voffB); PG8_STAGE(PG8_SA(0, 0), a2, voffA);
            PG8_WAIT_V(8); PG8_WAIT_L(0); PG8_BAR; PG8_MMA(1, 0, At, B0); PG8_MMA(1, 1, At, B1); PG8_BAR; PG8_SCHED;
            PG8_LDB(B0, 1, 0); PG8_LDB(B1, 1, 1); PG8_SCHED; PG8_LDA(At, 1, 0); PG8_STAGE(PG8_SA(0, 1), a2 + hstep, voffA);
            PG8_WAIT_V(8); PG8_WAIT_L(0); PG8_BAR; PG8_MMA(0, 0, At, B0); PG8_MMA(0, 1, At, B1); PG8_BAR; PG8_SCHED;
            PG8_LDA(At, 1, 1); PG8_STAGE(PG8_SB(1, 0), b3, voffB); PG8_STAGE(PG8_SB(1, 1), b3 + hstep, voffB); PG8_STAGE(PG8_SA(1, 0), a3, voffA);
            PG8_WAIT_V(8); PG8_WAIT_L(0); PG8_BAR; PG8_MMA(1, 0, At, B0); PG8_MMA(1, 1, At, B1); PG8_BAR; PG8_SCHED;
            } else {
            PG8_LDB(B0, 0, 0); PG8_SCHED; PG8_LDA(At, 0, 0); PG8_STAGE(PG8_SA(1, 1), a1 + hstep, voffA);
            PG8_WAIT_L(8); PG8_BAR; PG8_WAIT_L(0); PG8_MMA(0, 0, At, B0); PG8_BAR; PG8_SCHED;
            PG8_LDB(B1, 0, 1); PG8_STAGE(PG8_SB(0, 0), b2, voffB);
            PG8_BAR; PG8_WAIT_L(0); PG8_MMA(0, 1, At, B1); PG8_BAR;
            PG8_LDA(At, 0, 1); PG8_STAGE(PG8_SA(0, 0), a2, voffA);
            PG8_BAR; PG8_WAIT_L(0); PG8_MMA(1, 0, At, B0); PG8_BAR; PG8_SCHED;
            PG8_STAGE(PG8_SB(0, 1), b2 + hstep, voffB);
            PG8_WAIT_V(6); PG8_BAR; PG8_MMA(1, 1, At, B1); PG8_BAR;
            PG8_LDB(B0, 1, 0); PG8_SCHED; PG8_LDA(At, 1, 0); PG8_STAGE(PG8_SA(0, 1), a2 + hstep, voffA);
            PG8_WAIT_L(8); PG8_BAR; PG8_WAIT_L(0); PG8_MMA(0, 0, At, B0); PG8_BAR; PG8_SCHED;
            PG8_LDB(B1, 1, 1); PG8_STAGE(PG8_SB(1, 0), b3, voffB);
            PG8_BAR; PG8_WAIT_L(0); PG8_MMA(0, 1, At, B1); PG8_BAR;
            PG8_LDA(At, 1, 1); PG8_STAGE(PG8_SA(1, 0), a3, voffA);
            PG8_BAR; PG8_WAIT_L(0); PG8_MMA(1, 0, At, B0); PG8_BAR; PG8_SCHED;
            PG8_STAGE(PG8_SB(1, 1), b3 + hstep, voffB);
            PG8_WAIT_V(6); PG8_BAR; PG8_MMA(1, 1, At, B1); PG8_BAR;
            }
        }
        if constexpr (ALIGN_EPI) { if (wr == 0) PG8_BAR; }
        bool keep = false;
        if constexpr (Epi::TWO_PART) { if (cur.kh == 0) { E.mid(acc, cur, wr, wc, fr, fq); keep = true; } else { E(acc, cur, wr, wc, fr, fq); } } else { E(acc, cur, wr, wc, fr, fq); }
        S.done(cur);
        if (!has_next) break;
        if (!keep) {
#pragma unroll
        for (int a = 0; a < 2; ++a)
#pragma unroll
            for (int b = 0; b < 2; ++b)
#pragma unroll
                for (int m = 0; m < 4; ++m)
#pragma unroll
                    for (int n = 0; n < 2; ++n) acc[a][b][m][n] = (f32x4){0.f, 0.f, 0.f, 0.f};
        }
        cur = nxt; cA = nA; cB = nB; ++ui;
        if constexpr (ALIGN_EPI) { if (wr == 1) PG8_BAR; }
    }
    PG8_WAIT_V(0);
    if constexpr (!ALIGN_EPI) { if (wr == 0) PG8_BAR; }
    PG8_BAR;
#undef PG8_SA
#undef PG8_SB
#undef PG8_STAGE
#undef PG8_LDA
#undef PG8_LDB
#undef PG8_MMA
#undef PG8_WAIT_V
#undef PG8_WAIT_L
#undef PG8_BAR
#undef PG8_SCHED
}
}

#include <hip/hip_bf16.h>
#include <cmath>
namespace attn_body {
using bf16=__hip_bfloat16;
using bf16x8=__attribute__((ext_vector_type(8)))short;
using s16x4=__attribute__((ext_vector_type(4)))short;
using f32x16=__attribute__((ext_vector_type(16)))float;
using u32x4=__attribute__((ext_vector_type(4)))unsigned;
constexpr int D=64,DM=1024,OPITCH=2048;
constexpr int NW=8,QBLK=32,QB=QBLK*NW,KVBLK=64;
constexpr int ATTN_PITCH=DM, ATTN_UNIT_ROWS=QB;
__device__ __forceinline__ int crow(int r,int hi){return (r&3)+8*(r>>2)+4*hi;}
#define SBAR() __builtin_amdgcn_sched_barrier(0)
__device__ __forceinline__ void cmask(f32x16&p0,f32x16&p1,int jb,int qrel,int hi){
  const float NEG=-INFINITY; int kb=64*jb+4*hi;
  #pragma unroll
  for(int r=0;r<16;++r){int kv=kb+(r&3)+8*(r>>2); if(kv>qrel)p0[r]=NEG; if(kv+32>qrel)p1[r]=NEG;}
}

constexpr int NSLOT=3, SLOTB=8192;
constexpr int LDS_K=0, LDS_V=NSLOT*SLOTB, LDS_WS=2*NSLOT*SLOTB, LDS_OST=LDS_WS+NW*64*4, LDS_BYTES=LDS_OST+NW*4096;
constexpr float C2=0.125f*1.4426950408889634f;
__device__ __forceinline__ void glds16(const void*gsrc,unsigned lds_dst){unsigned keep;
  asm volatile("s_mov_b32 %0, m0\n\ts_mov_b32 m0, %2\n\ts_nop 0\n\tglobal_load_lds_dwordx4 %1, off\n\ts_mov_b32 m0, %0":"=&s"(keep):"v"(gsrc),"s"(lds_dst):"memory");}
__device__ __forceinline__ float max3f(float a,float b,float c){float r;asm("v_max3_f32 %0, %1, %2, %3":"=v"(r):"v"(a),"v"(b),"v"(c));return r;}
__device__ __forceinline__ float max2f(float a,float b){float r;asm("v_max_f32_e32 %0, %1, %2":"=v"(r):"v"(a),"v"(b));return r;}
__device__ __forceinline__ float fadd_s(float a,float b){float r;asm("v_add_f32_e32 %0, %1, %2":"=v"(r):"v"(a),"v"(b));return r;}
__device__ __forceinline__ float fsub_s(float a,float b){float r;asm("v_sub_f32_e32 %0, %1, %2":"=v"(r):"v"(a),"v"(b));return r;}
typedef float f32x2_t __attribute__((ext_vector_type(2))); typedef __bf16 bf16x2_t __attribute__((ext_vector_type(2)));
__device__ __forceinline__ unsigned cvtpk_s(float lo,float hi){f32x2_t v={lo,hi};bf16x2_t b=__builtin_convertvector(v,bf16x2_t);return __builtin_bit_cast(unsigned,b);}
#define WAIT_BAR(N) asm volatile("s_waitcnt vmcnt(" #N ") lgkmcnt(0)\n\ts_barrier":::"memory")

__device__ __forceinline__ void qkt(f32x16&p0,f32x16&p1,const char*Kslot,const bf16x8*qr,const f32x16&negm,int r32,int hi){
  const char*kb=Kslot+hi*1024+r32*16;
  #pragma unroll
  for(int d0=0;d0<4;++d0){
    const bf16x8 b0=*reinterpret_cast<const bf16x8*>(kb+d0*2048);
    const bf16x8 b1=*reinterpret_cast<const bf16x8*>(kb+d0*2048+512);
    if(d0==0){p0=__builtin_amdgcn_mfma_f32_32x32x16_bf16(b0,qr[0],negm,0,0,0);p1=__builtin_amdgcn_mfma_f32_32x32x16_bf16(b1,qr[0],negm,0,0,0);}
    else{p0=__builtin_amdgcn_mfma_f32_32x32x16_bf16(b0,qr[d0],p0,0,0,0);p1=__builtin_amdgcn_mfma_f32_32x32x16_bf16(b1,qr[d0],p1,0,0,0);}}
}
typedef __attribute__((address_space(3))) const char* lds_cptr;
typedef short v4i16_t __attribute__((ext_vector_type(4)));
__device__ __forceinline__ void kload8(bf16x8*kf,lds_cptr kp){
  kf[0]=*(const __attribute__((address_space(3))) bf16x8*)(kp);      kf[1]=*(const __attribute__((address_space(3))) bf16x8*)(kp+512);
  kf[2]=*(const __attribute__((address_space(3))) bf16x8*)(kp+2048); kf[3]=*(const __attribute__((address_space(3))) bf16x8*)(kp+2560);
  kf[4]=*(const __attribute__((address_space(3))) bf16x8*)(kp+4096); kf[5]=*(const __attribute__((address_space(3))) bf16x8*)(kp+4608);
  kf[6]=*(const __attribute__((address_space(3))) bf16x8*)(kp+6144); kf[7]=*(const __attribute__((address_space(3))) bf16x8*)(kp+6656);
}
__device__ __forceinline__ void kload2(bf16x8*kf,lds_cptr kp,int j){ kf[2*j]=*(const __attribute__((address_space(3))) bf16x8*)(kp+j*2048); kf[2*j+1]=*(const __attribute__((address_space(3))) bf16x8*)(kp+j*2048+512); }
__device__ __forceinline__ s16x4 vtr(lds_cptr p){ return __builtin_bit_cast(s16x4,__builtin_amdgcn_ds_read_tr16_b64_v4i16((__attribute__((address_space(3))) v4i16_t*)p)); }
__device__ __forceinline__ float rowmax(const f32x16&p0,const f32x16&p1){
  float a=max3f(p0[0],p0[1],p1[0]),b=max3f(p0[2],p0[3],p1[1]);a=max3f(a,p1[2],p1[3]);
  #pragma unroll
  for(int r=4;r<16;r+=4){a=max3f(a,p0[r],p0[r+1]);b=max3f(b,p0[r+2],p0[r+3]);a=max3f(a,p1[r],p1[r+1]);b=max3f(b,p1[r+2],p1[r+3]);}
  const float m=max2f(a,b);
  auto rr=__builtin_amdgcn_permlane32_swap(__float_as_uint(m),__float_as_uint(m),false,false);
  return max2f(__uint_as_float(rr[0]),__uint_as_float(rr[1]));
}
__device__ __forceinline__ void pv(f32x16*o,int vb,bf16x8 pa0,bf16x8 pa1,bf16x8 pa2,bf16x8 pa3){
  #pragma unroll
  for(int d0=0;d0<2;++d0){s16x4 lo[4],hi[4];
    #pragma unroll
    for(int ks=0;ks<4;++ks){
      asm volatile("ds_read_b64_tr_b16 %0,%1 offset:%c2":"=&v"(lo[ks]):"v"(vb),"i"(d0*4096+ks*1024):"memory");
      asm volatile("ds_read_b64_tr_b16 %0,%1 offset:%c2":"=&v"(hi[ks]):"v"(vb),"i"(d0*4096+ks*1024+512):"memory");}
    asm volatile("s_waitcnt lgkmcnt(0)":::"memory");SBAR();
    #define PK(k) (bf16x8){lo[k][0],lo[k][1],lo[k][2],lo[k][3],hi[k][0],hi[k][1],hi[k][2],hi[k][3]}
    o[d0]=__builtin_amdgcn_mfma_f32_32x32x16_bf16(pa0,PK(0),o[d0],0,0,0);
    o[d0]=__builtin_amdgcn_mfma_f32_32x32x16_bf16(pa1,PK(1),o[d0],0,0,0);
    o[d0]=__builtin_amdgcn_mfma_f32_32x32x16_bf16(pa2,PK(2),o[d0],0,0,0);
    o[d0]=__builtin_amdgcn_mfma_f32_32x32x16_bf16(pa3,PK(3),o[d0],0,0,0);
    #undef PK
  }
}

#ifndef ATTN_STORE16
#define ATTN_STORE16(p,v) (*(u32x4*)(p)=(v))
#endif
template<int THRL,bool MASKED> __device__ __forceinline__ void attn_unit(const bf16*Qin,const bf16*__restrict__ Kh,const bf16*__restrict__ Vh,bf16*Oin,const int NT,const int vis,const int qwaves,char*shm){
  int tid_o=threadIdx.x; asm volatile("":"+v"(tid_o));
  const int tid=tid_o,lane=tid&63,r32=lane&31,hi=lane>>5; const int wid=__builtin_amdgcn_readfirstlane(tid>>6);
  const bf16*Qw=Qin+(long)((wid&(qwaves-1))*QBLK)*DM;
  const unsigned lds0=(unsigned)(uintptr_t)shm;
  float*wsf=(float*)(shm+LDS_WS)+wid*64;
  const bf16*ksrc=Kh+(long)lane*DM+wid*8;
  const bf16*vsrc=Vh+(long)(16*(wid&3)+(lane>>2))*DM+(wid>>2)*32+(lane&3)*8;
  const unsigned kdst=lds0+LDS_K+wid*1024, vdst=lds0+LDS_V+wid*1024;
  #define DMA_K(t,slot) glds16(ksrc+(long)(t)*KVBLK*DM,(unsigned)__builtin_amdgcn_readfirstlane(kdst+(slot)))
  #define DMA_V(t,slot) glds16(vsrc+(long)(t)*KVBLK*DM,(unsigned)__builtin_amdgcn_readfirstlane(vdst+(slot)))
  const int vb0=(int)(lds0+LDS_V)+((lane>>4)&1)*32+(lane&3)*8+(4*hi+((lane&15)>>2))*64;
  const char*Kbase=shm+LDS_K; bf16x8 kf[8];
  const lds_cptr shm3=(lds_cptr)shm; const lds_cptr kp0=shm3+LDS_K+hi*1024+r32*16; const lds_cptr vp0=shm3+LDS_V+((lane>>4)&1)*32+(lane&3)*8+(4*hi+((lane&15)>>2))*64;
  DMA_K(0,0);DMA_V(0,0);DMA_K(1,SLOTB);
  bf16x8 qr[4];
  #pragma unroll
  for(int d0=0;d0<4;++d0)qr[d0]=*reinterpret_cast<const bf16x8*>(&Qw[(long)r32*DM+d0*16+hi*8]);
  float mhat=0.f,l_reg=0.f;f32x16 o[2];o[0]=f32x16{};o[1]=f32x16{};f32x16 negm=f32x16{};asm volatile("":"+v"(negm));
  #define CMASK(P0,P1,t) do{ if(MASKED){ const int jb_=(t)-(NT-4); if(jb_>=vis){ _Pragma("unroll") for(int r_=0;r_<16;++r_){P0[r_]=-INFINITY;P1[r_]=-INFINITY;} } } }while(0)
  bool resc=false;
  #define START(P0,P1) do{ const float rm=rowmax(P0,P1); resc=false; \
    { const float dl=rm; mhat=fadd_s(mhat,dl); \
      _Pragma("unroll") for(int r=0;r<16;++r){P0[r]=fsub_s(P0[r],dl);P1[r]=fsub_s(P1[r],dl);} \
      _Pragma("unroll") for(int r=0;r<16;++r)negm[r]=-mhat; asm volatile("":"+v"(negm)); } \
    _Pragma("unroll") for(int r=0;r<16;++r)P0[r]=__builtin_amdgcn_exp2f(P0[r]); }while(0)
  #define RESC() do{ if(resc){ asm volatile("s_waitcnt lgkmcnt(0)":::"memory"); \
      _Pragma("unroll") for(int d_=0;d_<2;++d_) _Pragma("unroll") for(int r=0;r<16;++r)o[d_][r]*=wsf[crow(r,hi)]; } }while(0)
  f32x16 pA0,pA1,pB0,pB1;
  int sl_prev=0,sl_cur=0,sl_next=SLOTB;
  #define ROT() do{sl_prev=sl_cur;sl_cur=sl_next;sl_next=(sl_next==(NSLOT-1)*SLOTB)?0:sl_next+SLOTB;}while(0)
  DMA_K(2,2*SLOTB);
  WAIT_BAR(3);
  qkt(pA0,pA1,Kbase,qr,negm,r32,hi);asm volatile("s_nop 15\n\ts_nop 7":"+v"(pA0),"+v"(pA1));
  if(MASKED){ _Pragma("unroll") for(int r_=8;r_<16;++r_)pA0[r_]=-INFINITY; _Pragma("unroll") for(int r_=0;r_<16;++r_)pA1[r_]=-INFINITY; }
  START(pA0,pA1);
  _Pragma("unroll") for(int r=0;r<16;++r)pA1[r]=__builtin_amdgcn_exp2f(pA1[r]);
  WAIT_BAR(0);
  DMA_K(3,0);DMA_V(1,SLOTB);
  ROT();
  kload8(kf,kp0+sl_cur);
  WAIT_BAR(2);
  s16x4 vlo[8],vhi[8]; u32x4 pw0,pw1,pw2,pw3;
  #define PKW(P,B) cvtpk_s(P[B],P[B+1])
  #define PAF(k) __builtin_bit_cast(bf16x8,pw##k)
  #define VFR(i) (bf16x8){vlo[i][0],vlo[i][1],vlo[i][2],vlo[i][3],vhi[i][0],vhi[i][1],vhi[i][2],vhi[i][3]}
  #define PIN(x) asm volatile("":"+v"(x))
  #define MX3(a,b,c) __builtin_fmaxf(__builtin_fmaxf((a),(b)),(c))
  #define GAPA(MF,A0,A1,A2,A3,W0,W1,PW) do{ MF; sacc+=A0; sacc+=A1; sacc+=A2; sacc+=A3; PIN(sacc); W0; W1; PIN(PW); SBAR(); }while(0)
  #define EX(v) __builtin_amdgcn_exp2f(v)
  #define GAPB(MF,X,B) do{ MF; X[B]=EX(X[B]); X[B+1]=EX(X[B+1]); X[B+2]=EX(X[B+2]); X[B+3]=EX(X[B+3]); PIN(X); SBAR(); }while(0)
  #define VRD(i) do{ vlo[i]=vtr(vp_+(((i)>>2)*4096+((i)&3)*1024)); vhi[i]=vtr(vp_+(((i)>>2)*4096+((i)&3)*1024+512)); }while(0)
  #define KRD(G,j) do{ if(G){ kload2(kf,kp0+sl_next,j); SBAR(); } }while(0)
  #define STEP(C0,C1,P0,P1,t,GK,GV,GL) do{ SBAR(); \
    const lds_cptr vp_=vp0+sl_prev; \
    VRD(0); SBAR(); float sacc=(P0[0]+P0[1]); \
    GAPA(C0=__builtin_amdgcn_mfma_f32_32x32x16_bf16(kf[0],qr[0],negm,0,0,0), P0[2],P0[3],P0[4],P0[5],     pw0[0]=PKW(P0,0), pw0[1]=PKW(P0,2), pw0); \
    VRD(4); SBAR(); GAPA(C1=__builtin_amdgcn_mfma_f32_32x32x16_bf16(kf[1],qr[0],negm,0,0,0), P0[6],P0[7],P0[8],P0[9],     pw0[2]=PKW(P0,4), pw0[3]=PKW(P0,6), pw0); \
    VRD(1); SBAR(); GAPA(C0=__builtin_amdgcn_mfma_f32_32x32x16_bf16(kf[2],qr[1],C0,0,0,0),   P0[10],P0[11],P0[12],P0[13], pw1[0]=PKW(P0,8), pw1[1]=PKW(P0,10), pw1); \
    VRD(5); SBAR(); GAPA(C1=__builtin_amdgcn_mfma_f32_32x32x16_bf16(kf[3],qr[1],C1,0,0,0),   P0[14],P0[15],P1[0],P1[1],   pw1[2]=PKW(P0,12),pw1[3]=PKW(P0,14), pw1); \
    VRD(2); SBAR(); GAPA(C0=__builtin_amdgcn_mfma_f32_32x32x16_bf16(kf[4],qr[2],C0,0,0,0),   P1[2],P1[3],P1[4],P1[5],     pw2[0]=PKW(P1,0), pw2[1]=PKW(P1,2), pw2); \
    VRD(6); SBAR(); GAPA(C1=__builtin_amdgcn_mfma_f32_32x32x16_bf16(kf[5],qr[2],C1,0,0,0),   P1[6],P1[7],P1[8],P1[9],     pw2[2]=PKW(P1,4), pw2[3]=PKW(P1,6), pw2); \
    VRD(3); SBAR(); GAPA(C0=__builtin_amdgcn_mfma_f32_32x32x16_bf16(kf[6],qr[3],C0,0,0,0),   P1[10],P1[11],P1[12],P1[13], pw3[0]=PKW(P1,8), pw3[1]=PKW(P1,10), pw3); \
    VRD(7); SBAR(); GAPA(C1=__builtin_amdgcn_mfma_f32_32x32x16_bf16(kf[7],qr[3],C1,0,0,0),   P1[14],P1[15],0.f,0.f,       pw3[2]=PKW(P1,12),pw3[3]=PKW(P1,14), pw3); \
    l_reg+=sacc; \
    if(GK){DMA_K((t)+3,sl_cur);} if(GV){DMA_V((t)+1,sl_next);} \
    CMASK(C0,C1,t); \
    { float a=MX3(C0[0],C0[1],C1[0]),b=MX3(C0[2],C0[3],C1[1]); a=MX3(a,C1[2],C1[3]); \
      _Pragma("unroll") for(int r=4;r<16;r+=4){a=MX3(a,C0[r],C0[r+1]);b=MX3(b,C0[r+2],C0[r+3]);a=MX3(a,C1[r],C1[r+1]);b=MX3(b,C1[r+2],C1[r+3]);} \
      float rm=__builtin_fmaxf(a,b); { auto rr=__builtin_amdgcn_permlane32_swap(__float_as_uint(rm),__float_as_uint(rm),false,false); rm=__builtin_fmaxf(__uint_as_float(rr[0]),__uint_as_float(rr[1])); } \
      resc=false; \
      if(__builtin_expect(__any(rm>(float)THRL),0)){ const float dl=__builtin_fmaxf(rm,0.f); mhat+=dl; \
        _Pragma("unroll") for(int r=0;r<16;++r){C0[r]-=dl;C1[r]-=dl;} \
        _Pragma("unroll") for(int r=0;r<16;++r)negm[r]=-mhat; asm volatile("":"+v"(negm)); \
        const float f=__builtin_amdgcn_exp2f(-dl); l_reg*=f; if(hi==0)wsf[r32]=f; resc=true; } } \
    SBAR(); \
    GAPB(o[0]=__builtin_amdgcn_mfma_f32_32x32x16_bf16(PAF(0),VFR(0),o[0],0,0,0), C0,0); \
    GAPB(o[1]=__builtin_amdgcn_mfma_f32_32x32x16_bf16(PAF(0),VFR(4),o[1],0,0,0), C0,4); \
    KRD(GL,0); GAPB(o[0]=__builtin_amdgcn_mfma_f32_32x32x16_bf16(PAF(1),VFR(1),o[0],0,0,0), C0,8); \
    KRD(GL,1); GAPB(o[1]=__builtin_amdgcn_mfma_f32_32x32x16_bf16(PAF(1),VFR(5),o[1],0,0,0), C0,12); \
    KRD(GL,2); GAPB(o[0]=__builtin_amdgcn_mfma_f32_32x32x16_bf16(PAF(2),VFR(2),o[0],0,0,0), C1,0); \
    KRD(GL,3); GAPB(o[1]=__builtin_amdgcn_mfma_f32_32x32x16_bf16(PAF(2),VFR(6),o[1],0,0,0), C1,4); \
    GAPB(o[0]=__builtin_amdgcn_mfma_f32_32x32x16_bf16(PAF(3),VFR(3),o[0],0,0,0), C1,8); \
    GAPB(o[1]=__builtin_amdgcn_mfma_f32_32x32x16_bf16(PAF(3),VFR(7),o[1],0,0,0), C1,12); \
    }while(0)
  int t=1;
  #undef CMASK
  #define CMASK(P0,P1,t) do{}while(0)
  for(;t+5<NT;t+=2){
    STEP(pB0,pB1,pA0,pA1,t,true,true,true);     WAIT_BAR(2); RESC(); ROT();
    STEP(pA0,pA1,pB0,pB1,t+1,true,true,true);   WAIT_BAR(2); RESC(); ROT();
  }
  #undef CMASK
  #define CMASK(P0,P1,t) do{ if(MASKED){ const int jb_=(t)-(NT-4); if(jb_>=vis){ _Pragma("unroll") for(int r_=0;r_<16;++r_){P0[r_]=-INFINITY;P1[r_]=-INFINITY;} } } }while(0)
  #define ENDW(tt) do{ if((tt)+3<NT){WAIT_BAR(2);} else if((tt)+2<NT){WAIT_BAR(1);} else {WAIT_BAR(0);} }while(0)
  for(;t+1<NT;t+=2){
    STEP(pB0,pB1,pA0,pA1,t,(t+3<NT),(t+1<NT),(t+1<NT));       ENDW(t);   RESC(); ROT();
    STEP(pA0,pA1,pB0,pB1,t+1,(t+4<NT),(t+2<NT),(t+2<NT));     ENDW(t+1); RESC(); ROT();
  }
  { float sacc=pA0[0]+pA0[1]; _Pragma("unroll") for(int r=2;r<16;++r)sacc+=pA0[r]; _Pragma("unroll") for(int r=0;r<16;++r)sacc+=pA1[r]; l_reg+=sacc;
    pw0=(u32x4){PKW(pA0,0),PKW(pA0,2),PKW(pA0,4),PKW(pA0,6)};pw1=(u32x4){PKW(pA0,8),PKW(pA0,10),PKW(pA0,12),PKW(pA0,14)};pw2=(u32x4){PKW(pA1,0),PKW(pA1,2),PKW(pA1,4),PKW(pA1,6)};pw3=(u32x4){PKW(pA1,8),PKW(pA1,10),PKW(pA1,12),PKW(pA1,14)};
    SBAR(); pv(o,vb0+sl_prev,PAF(0),PAF(1),PAF(2),PAF(3)); }
  #undef PKW
  #undef PAF
  #undef VFR
  #undef PIN
  #undef MX3
  #undef GAPA
  #undef GAPB
  #undef EX
  #undef VRD
  #undef KRD
  #undef STEP
  #undef ENDW
  {auto rr=__builtin_amdgcn_permlane32_swap(__float_as_uint(l_reg),__float_as_uint(l_reg),false,false);l_reg=__uint_as_float(rr[0])+__uint_as_float(rr[1]);}
  if(hi==0)wsf[32+r32]=l_reg;asm volatile("s_waitcnt lgkmcnt(0)":::"memory");
  float rli[16];
  #pragma unroll
  for(int r=0;r<16;++r)rli[r]=__builtin_amdgcn_rcpf(wsf[32+crow(r,hi)]);
  bf16*Ow=Oin+(long)(wid*QBLK)*OPITCH;
  { bf16*stg=(bf16*)(shm+LDS_OST)+wid*2048;
    #pragma unroll
    for(int r=0;r<16;++r){const int orow=crow(r,hi);
      #pragma unroll
      for(int d0=0;d0<2;++d0)stg[orow*64+d0*32+r32]=__float2bfloat16(o[d0][r]*rli[r]);}
    asm volatile("s_waitcnt lgkmcnt(0)":::"memory");
    #pragma unroll
    for(int i=0;i<4;++i){const int row=i*8+(lane>>3),ch=lane&7; const u32x4 v=*(const u32x4*)(stg+row*64+ch*8); if(wid<qwaves)ATTN_STORE16(Ow+(long)row*OPITCH+ch*8,v);} }
  asm volatile("s_waitcnt lgkmcnt(0)\n\ts_barrier":::"memory");
  #undef DMA_K
  #undef DMA_V
  #undef CMASK
  #undef START
  #undef RESC
  #undef ROT
}
constexpr int ATTN_LDS_BYTES=LDS_BYTES;
#undef SBAR
#undef WAIT_BAR
}

namespace attn128 {
using namespace attn_body;
#define SBAR() __builtin_amdgcn_sched_barrier(0)
#define WAIT_BAR(N) asm volatile("s_waitcnt vmcnt(" #N ") lgkmcnt(0)\n\ts_barrier":::"memory")
constexpr int VSLOTB=16384;
constexpr int L_K=0, L_V=NSLOT*SLOTB, L_WS=L_V+NSLOT*VSLOTB, L_OST=L_WS+NW*64*4, L_BYTES=L_OST+NW*4096;
__device__ __forceinline__ void pv4(f32x16*o,int vb,bf16x8 pa0,bf16x8 pa1,bf16x8 pa2,bf16x8 pa3){
  #pragma unroll
  for(int d0=0;d0<4;++d0){s16x4 lo[4],hi[4];
    #pragma unroll
    for(int ks=0;ks<4;++ks){
      asm volatile("ds_read_b64_tr_b16 %0,%1 offset:%c2":"=&v"(lo[ks]):"v"(vb),"i"(d0*4096+ks*1024):"memory");
      asm volatile("ds_read_b64_tr_b16 %0,%1 offset:%c2":"=&v"(hi[ks]):"v"(vb),"i"(d0*4096+ks*1024+512):"memory");}
    asm volatile("s_waitcnt lgkmcnt(0)":::"memory");SBAR();
    #define PK(k) (bf16x8){lo[k][0],lo[k][1],lo[k][2],lo[k][3],hi[k][0],hi[k][1],hi[k][2],hi[k][3]}
    o[d0]=__builtin_amdgcn_mfma_f32_32x32x16_bf16(pa0,PK(0),o[d0],0,0,0);
    o[d0]=__builtin_amdgcn_mfma_f32_32x32x16_bf16(pa1,PK(1),o[d0],0,0,0);
    o[d0]=__builtin_amdgcn_mfma_f32_32x32x16_bf16(pa2,PK(2),o[d0],0,0,0);
    o[d0]=__builtin_amdgcn_mfma_f32_32x32x16_bf16(pa3,PK(3),o[d0],0,0,0);
    #undef PK
  }
}
struct Fin { int l, h; unsigned qrow; };
template<int THRL,bool MASKED,bool DUAL,bool FIN> __device__ __forceinline__ void attn_unit128(const bf16*Qin,const bf16*__restrict__ Kh,const bf16*__restrict__ Vh,bf16*Oin,const int NT,const int vis,const int qwaves,char*shm,const Fin fin){
  int tid_o=threadIdx.x; asm volatile("":"+v"(tid_o));
  const int tid=tid_o,lane=tid&63,r32=lane&31,hi=lane>>5; const int wid=__builtin_amdgcn_readfirstlane(tid>>6);
  constexpr int KSL=DUAL?2:1;
  constexpr int LK=0, LV=NSLOT*SLOTB*KSL, LWS=LV+NSLOT*VSLOTB, LOST=LWS+NW*64*4;
  const int cmap=DUAL?((wid>>1)&1):0, qgrp=DUAL?(wid&1):(wid&(qwaves-1)); const bool do_store=DUAL?(wid<4):(wid<qwaves);
  const bf16*Qw=Qin+cmap*64+(long)(qgrp*QBLK)*DM;
  const unsigned lds0=(unsigned)(uintptr_t)shm;
  float*wsf=(float*)(shm+LWS)+wid*64;
  const bf16*ksrc=Kh+(long)lane*DM+wid*8;
  const bf16*vsrc=Vh+(long)(16*(wid&3)+(lane>>2))*DM+(wid>>2)*32+(lane&3)*8;
  const unsigned kdst=lds0+LK+wid*1024, vdst=lds0+LV+wid*1024;
  #define DMA_K(t,slot) do{ glds16(ksrc+(long)(t)*KVBLK*DM,(unsigned)__builtin_amdgcn_readfirstlane(kdst+KSL*(slot))); if(DUAL) glds16(ksrc+(long)(t)*KVBLK*DM+64,(unsigned)__builtin_amdgcn_readfirstlane(kdst+KSL*(slot)+8192)); }while(0)
  #define DMA_V(t,slot) do{ glds16(vsrc+(long)(t)*KVBLK*DM,(unsigned)__builtin_amdgcn_readfirstlane(vdst+2*(slot))); glds16(vsrc+(long)(t)*KVBLK*DM+64,(unsigned)__builtin_amdgcn_readfirstlane(vdst+2*(slot)+8192)); }while(0)
  const int vb0=(int)(lds0+LV)+((lane>>4)&1)*32+(lane&3)*8+(4*hi+((lane&15)>>2))*64;
  const char*Kbase=shm+LK+cmap*8192; bf16x8 kf[8];
  const lds_cptr shm3=(lds_cptr)shm; const lds_cptr kp0=shm3+LK+cmap*8192+hi*1024+r32*16; const lds_cptr vp0=shm3+LV+((lane>>4)&1)*32+(lane&3)*8+(4*hi+((lane&15)>>2))*64;
  DMA_K(0,0);DMA_V(0,0);DMA_K(1,SLOTB);
  bf16x8 qr[4];
  #pragma unroll
  for(int d0=0;d0<4;++d0)qr[d0]=*reinterpret_cast<const bf16x8*>(&Qw[(long)r32*DM+d0*16+hi*8]);
  float mhat=0.f,l_reg=0.f;f32x16 o[4];o[0]=f32x16{};o[1]=f32x16{};o[2]=f32x16{};o[3]=f32x16{};f32x16 negm=f32x16{};asm volatile("":"+v"(negm));
  #define CMASK(P0,P1,t) do{ if(MASKED){ const int jb_=(t)-(NT-4); if(jb_>=vis){ _Pragma("unroll") for(int r_=0;r_<16;++r_){P0[r_]=-INFINITY;P1[r_]=-INFINITY;} } } }while(0)
  bool resc=false;
  #define START(P0,P1) do{ const float rm=rowmax(P0,P1); resc=false; \
    { const float dl=rm; mhat=fadd_s(mhat,dl); \
      _Pragma("unroll") for(int r=0;r<16;++r){P0[r]=fsub_s(P0[r],dl);P1[r]=fsub_s(P1[r],dl);} \
      _Pragma("unroll") for(int r=0;r<16;++r)negm[r]=-mhat; asm volatile("":"+v"(negm)); } \
    _Pragma("unroll") for(int r=0;r<16;++r)P0[r]=__builtin_amdgcn_exp2f(P0[r]); }while(0)
  #define RESC() do{ if(resc){ asm volatile("s_waitcnt lgkmcnt(0)":::"memory"); \
      _Pragma("unroll") for(int d_=0;d_<4;++d_) _Pragma("unroll") for(int r=0;r<16;++r)o[d_][r]*=wsf[crow(r,hi)]; } }while(0)
  f32x16 pA0,pA1,pB0,pB1;
  int sl_prev=0,sl_cur=0,sl_next=SLOTB;
  #define ROT() do{sl_prev=sl_cur;sl_cur=sl_next;sl_next=(sl_next==(NSLOT-1)*SLOTB)?0:sl_next+SLOTB;}while(0)
  DMA_K(2,2*SLOTB);
  if constexpr(DUAL){WAIT_BAR(6);}else{WAIT_BAR(4);}
  { const f32x16 zc=f32x16{}; qkt(pA0,pA1,Kbase,qr,zc,r32,hi); } asm volatile("s_nop 15\n\ts_nop 7":"+v"(pA0),"+v"(pA1));
  if(MASKED){ _Pragma("unroll") for(int r_=8;r_<16;++r_)pA0[r_]=-INFINITY; _Pragma("unroll") for(int r_=0;r_<16;++r_)pA1[r_]=-INFINITY; }
  START(pA0,pA1);
  _Pragma("unroll") for(int r=0;r<16;++r)pA1[r]=__builtin_amdgcn_exp2f(pA1[r]);
  WAIT_BAR(0);
  DMA_K(3,0);DMA_V(1,SLOTB);
  ROT();
  kload8(kf,kp0+KSL*sl_cur);
  if constexpr(DUAL){WAIT_BAR(4);}else{WAIT_BAR(3);}
  s16x4 wlo[3],whi[3]; u32x4 pw0,pw1,pw2,pw3;
  #define PKW(P,B) cvtpk_s(P[B],P[B+1])
  #define PAF(k) __builtin_bit_cast(bf16x8,pw##k)
  #define VFW(s) (bf16x8){wlo[s][0],wlo[s][1],wlo[s][2],wlo[s][3],whi[s][0],whi[s][1],whi[s][2],whi[s][3]}
  #define PIN(x) asm volatile("":"+v"(x))
  #define MX3(a,b,c) __builtin_fmaxf(__builtin_fmaxf((a),(b)),(c))
  #define GAPA(MF,A0,A1,A2,A3,W0,W1,PW) do{ MF; sacc+=A0; sacc+=A1; sacc+=A2; sacc+=A3; PIN(sacc); W0; W1; PIN(PW); SBAR(); }while(0)
  #define EX(v) __builtin_amdgcn_exp2f(v)
  #define VRW(s,f) do{ wlo[s]=vtr(vp_+(((f)>>2)*4096+((f)&3)*1024)); whi[s]=vtr(vp_+(((f)>>2)*4096+((f)&3)*1024+512)); }while(0)
  #define KRD(G,j) do{ if(G){ kload2(kf,kp0+KSL*sl_next,j); SBAR(); } }while(0)
  #define FJ(j) ((((j)&3)<<2)|((j)>>2))
  #define VREQ(j) do{ VRW((j)%3,FJ(j)); SBAR(); }while(0)
  #define GAPB(RD,JN,KQ,QD,JU,X,B) do{ if(RD){ VREQ(JN); } o[QD]=__builtin_amdgcn_mfma_f32_32x32x16_bf16(PAF(KQ),VFW((JU)%3),o[QD],0,0,0); X[B]=EX(X[B]); X[B+1]=EX(X[B+1]); PIN(X); SBAR(); }while(0)
  #define STEP(C0,C1,P0,P1,t,GK,GV,GL) do{ SBAR(); \
    const lds_cptr vp_=vp0+2*sl_prev; \
    float sacc=(P0[0]+P0[1]); \
    GAPA(C0=__builtin_amdgcn_mfma_f32_32x32x16_bf16(kf[0],qr[0],negm,0,0,0), P0[2],P0[3],P0[4],P0[5],     pw0[0]=PKW(P0,0), pw0[1]=PKW(P0,2), pw0); \
    GAPA(C1=__builtin_amdgcn_mfma_f32_32x32x16_bf16(kf[1],qr[0],negm,0,0,0), P0[6],P0[7],P0[8],P0[9],     pw0[2]=PKW(P0,4), pw0[3]=PKW(P0,6), pw0); \
    GAPA(C0=__builtin_amdgcn_mfma_f32_32x32x16_bf16(kf[2],qr[1],C0,0,0,0),   P0[10],P0[11],P0[12],P0[13], pw1[0]=PKW(P0,8), pw1[1]=PKW(P0,10), pw1); \
    GAPA(C1=__builtin_amdgcn_mfma_f32_32x32x16_bf16(kf[3],qr[1],C1,0,0,0),   P0[14],P0[15],P1[0],P1[1],   pw1[2]=PKW(P0,12),pw1[3]=PKW(P0,14), pw1); \
    GAPA(C0=__builtin_amdgcn_mfma_f32_32x32x16_bf16(kf[4],qr[2],C0,0,0,0),   P1[2],P1[3],P1[4],P1[5],     pw2[0]=PKW(P1,0), pw2[1]=PKW(P1,2), pw2); \
    VREQ(0); \
    GAPA(C1=__builtin_amdgcn_mfma_f32_32x32x16_bf16(kf[5],qr[2],C1,0,0,0),   P1[6],P1[7],P1[8],P1[9],     pw2[2]=PKW(P1,4), pw2[3]=PKW(P1,6), pw2); \
    VREQ(1); \
    GAPA(C0=__builtin_amdgcn_mfma_f32_32x32x16_bf16(kf[6],qr[3],C0,0,0,0),   P1[10],P1[11],P1[12],P1[13], pw3[0]=PKW(P1,8), pw3[1]=PKW(P1,10), pw3); \
    GAPA(C1=__builtin_amdgcn_mfma_f32_32x32x16_bf16(kf[7],qr[3],C1,0,0,0),   P1[14],P1[15],0.f,0.f,       pw3[2]=PKW(P1,12),pw3[3]=PKW(P1,14), pw3); \
    l_reg+=sacc; \
    if(GK){DMA_K((t)+3,sl_cur);} if(GV){DMA_V((t)+1,sl_next);} \
    CMASK(C0,C1,t); \
    { float a=MX3(C0[0],C0[1],C1[0]),b=MX3(C0[2],C0[3],C1[1]); a=MX3(a,C1[2],C1[3]); \
      _Pragma("unroll") for(int r=4;r<16;r+=4){a=MX3(a,C0[r],C0[r+1]);b=MX3(b,C0[r+2],C0[r+3]);a=MX3(a,C1[r],C1[r+1]);b=MX3(b,C1[r+2],C1[r+3]);} \
      float rm=__builtin_fmaxf(a,b); { auto rr=__builtin_amdgcn_permlane32_swap(__float_as_uint(rm),__float_as_uint(rm),false,false); rm=__builtin_fmaxf(__uint_as_float(rr[0]),__uint_as_float(rr[1])); } \
      resc=false; \
      if(__builtin_expect(__any(rm>(float)THRL),0)){ const float dl=__builtin_fmaxf(rm,0.f); mhat+=dl; \
        _Pragma("unroll") for(int r=0;r<16;++r){C0[r]-=dl;C1[r]-=dl;} \
        _Pragma("unroll") for(int r=0;r<16;++r)negm[r]=-mhat; asm volatile("":"+v"(negm)); \
        const float f=__builtin_amdgcn_exp2f(-dl); l_reg*=f; if(hi==0)wsf[r32]=f; resc=true; } } \
    SBAR(); \
    GAPB(1,2, 0,0,0, C0,0); \
    GAPB(1,3, 0,1,1, C0,2); \
    GAPB(1,4, 0,2,2, C0,4); \
    GAPB(1,5, 0,3,3, C0,6); \
    KRD(GL,0); GAPB(1,6, 1,0,4, C0,8); \
    GAPB(1,7, 1,1,5, C0,10); \
    KRD(GL,1); GAPB(1,8, 1,2,6, C0,12); \
    GAPB(1,9, 1,3,7, C0,14); \
    KRD(GL,2); GAPB(1,10, 2,0,8, C1,0); \
    GAPB(1,11, 2,1,9, C1,2); \
    KRD(GL,3); GAPB(1,12, 2,2,10, C1,4); \
    GAPB(1,13, 2,3,11, C1,6); \
    GAPB(1,14, 3,0,12, C1,8); \
    GAPB(1,15, 3,1,13, C1,10); \
    GAPB(0,0, 3,2,14, C1,12); \
    GAPB(0,0, 3,3,15, C1,14); \
    }while(0)
  #define WBS() do{ if constexpr(DUAL){WAIT_BAR(4);}else{WAIT_BAR(3);} }while(0)
  if(!DUAL && wid>=4) __builtin_amdgcn_s_setprio(1);
  int t=1;
  #undef CMASK
  #define CMASK(P0,P1,t) do{}while(0)
  for(;t+5<NT;t+=2){
    STEP(pB0,pB1,pA0,pA1,t,true,true,true);     WBS(); RESC(); ROT();
    STEP(pA0,pA1,pB0,pB1,t+1,true,true,true);   WBS(); RESC(); ROT();
  }
  #undef CMASK
  #define CMASK(P0,P1,t) do{ if(MASKED){ const int jb_=(t)-(NT-4); if(jb_>=vis){ _Pragma("unroll") for(int r_=0;r_<16;++r_){P0[r_]=-INFINITY;P1[r_]=-INFINITY;} } } }while(0)
  #define ENDW(tt) do{ if((tt)+3<NT){WBS();} else if((tt)+2<NT){WAIT_BAR(2);} else {WAIT_BAR(0);} }while(0)
  for(;t+1<NT;t+=2){
    STEP(pB0,pB1,pA0,pA1,t,(t+3<NT),(t+1<NT),(t+1<NT));       ENDW(t);   RESC(); ROT();
    STEP(pA0,pA1,pB0,pB1,t+1,(t+4<NT),(t+2<NT),(t+2<NT));     ENDW(t+1); RESC(); ROT();
  }
  { float sacc=pA0[0]+pA0[1]; _Pragma("unroll") for(int r=2;r<16;++r)sacc+=pA0[r]; _Pragma("unroll") for(int r=0;r<16;++r)sacc+=pA1[r]; l_reg+=sacc;
    pw0=(u32x4){PKW(pA0,0),PKW(pA0,2),PKW(pA0,4),PKW(pA0,6)};pw1=(u32x4){PKW(pA0,8),PKW(pA0,10),PKW(pA0,12),PKW(pA0,14)};pw2=(u32x4){PKW(pA1,0),PKW(pA1,2),PKW(pA1,4),PKW(pA1,6)};pw3=(u32x4){PKW(pA1,8),PKW(pA1,10),PKW(pA1,12),PKW(pA1,14)};
    SBAR(); pv4(o,vb0+2*sl_prev,PAF(0),PAF(1),PAF(2),PAF(3)); }
  #undef PKW
  #undef PAF
  #undef VFW
  #undef PIN
  #undef MX3
  #undef GAPA
  #undef GAPB
  #undef EX
  #undef VRW
  #undef VREQ
  #undef FJ
  #undef KRD
  #undef STEP
  #undef ENDW
  #undef WBS
  __builtin_amdgcn_s_setprio(0);
  {auto rr=__builtin_amdgcn_permlane32_swap(__float_as_uint(l_reg),__float_as_uint(l_reg),false,false);l_reg=__uint_as_float(rr[0])+__uint_as_float(rr[1]);}
  if(hi==0)wsf[32+r32]=l_reg;asm volatile("s_waitcnt lgkmcnt(0)":::"memory");
  float rli[16];
  #pragma unroll
  for(int r=0;r<16;++r)rli[r]=__builtin_amdgcn_rcpf(wsf[32+crow(r,hi)]);
  bf16*Ow=Oin+cmap*128+(long)((DUAL?(wid&1):wid)*QBLK)*OPITCH;
  bf16*stg=(bf16*)(shm+LOST)+(DUAL?(wid&3):wid)*2048;
  if(do_store){
  u32x4 o2v[2][4];
  #pragma unroll
  for(int hf=0;hf<2;++hf){
    #pragma unroll
    for(int r=0;r<16;++r){const int orow=crow(r,hi);
      #pragma unroll
      for(int d0=0;d0<2;++d0)stg[orow*64+d0*32+r32]=__float2bfloat16(o[2*hf+d0][r]*rli[r]);}
    asm volatile("s_waitcnt lgkmcnt(0)":::"memory");
    #pragma unroll
    for(int i=0;i<4;++i){const int row=i*8+(lane>>3),ch=lane&7; const u32x4 v=*(const u32x4*)(stg+row*64+ch*8);
      if constexpr(FIN){ o2v[hf][i]=v; } else { ATTN_STORE16(Ow+(long)row*OPITCH+hf*64+ch*8,v); } }
    asm volatile("s_waitcnt lgkmcnt(0)":::"memory");
  }
  if constexpr(FIN){
    asm volatile("s_waitcnt vmcnt(0)":::"memory");
    ArgsP ka=KARG(); unsigned char*wsb=ka->ws;
    const bf16*fO1=(const bf16*)(wsb+WS_OP)+(size_t)fin.qrow*2048+(size_t)(fin.h*2)*128; const bf16*fZA=(const bf16*)(wsb+WS_ZA)+(size_t)fin.qrow*1024+fin.h*128;
    const float*fsw=ka->in[I_SUBLN]+fin.l*128; bf16*fOX=(bf16*)(wsb+WS_OX)+(size_t)fin.qrow*2048+1024+fin.h*128;
    const float flam=((const float*)(wsb+WS_MISC))[fin.l], foml=((const float*)(wsb+WS_MISC))[8+fin.l];
    const int ch=lane&7;
    #pragma unroll
    for(int i=0;i<4;++i){ const long grow=(long)(wid*QBLK+i*8+(lane>>3));
      float d[2][8]; float ss=0.f;
      #pragma unroll
      for(int hf=0;hf<2;++hf){ const u32x4 a=*(const u32x4*)(fO1+grow*OPITCH+hf*64+ch*8); const u32x4 b=o2v[hf][i];
        const unsigned aw[4]={a.x,a.y,a.z,a.w}, bw[4]={b.x,b.y,b.z,b.w};
        #pragma unroll
        for(int e=0;e<4;++e){ d[hf][2*e]=__uint_as_float(aw[e]<<16)-flam*__uint_as_float(bw[e]<<16); d[hf][2*e+1]=__uint_as_float(aw[e]&0xffff0000u)-flam*__uint_as_float(bw[e]&0xffff0000u); }
        #pragma unroll
        for(int e=0;e<8;++e)ss+=d[hf][e]*d[hf][e]; }
      ss+=__shfl_xor(ss,1); ss+=__shfl_xor(ss,2); ss+=__shfl_xor(ss,4);
      const float scale=rsqrtf(ss*(1.0f/128.0f)+1e-6f)*foml;
      #pragma unroll
      for(int hf=0;hf<2;++hf){ const u32x4 z=*(const u32x4*)(fZA+grow*DM+hf*64+ch*8); const float*swp=fsw+hf*64+ch*8;
        const unsigned zw[4]={z.x,z.y,z.z,z.w}; unsigned ow[4];
        #pragma unroll
        for(int e=0;e<4;++e){ const float v0=d[hf][2*e]*scale*swp[2*e]*__uint_as_float(zw[e]<<16), v1=d[hf][2*e+1]*scale*swp[2*e+1]*__uint_as_float(zw[e]&0xffff0000u); ow[e]=cvtpk_s(v0,v1); }
        ATTN_STORE16(fOX+grow*OPITCH+hf*64+ch*8,((u32x4){ow[0],ow[1],ow[2],ow[3]})); }
    }
  }
  }
  if constexpr(DUAL){ asm volatile("s_waitcnt vmcnt(0)":::"memory"); }
  asm volatile("s_waitcnt lgkmcnt(0)\n\ts_barrier":::"memory");
  #undef DMA_K
  #undef DMA_V
  #undef CMASK
  #undef START
  #undef RESC
  #undef ROT
}
#undef SBAR
#undef WAIT_BAR
}

#define GAS __attribute__((address_space(1)))
#define LAS __attribute__((address_space(3)))
typedef unsigned short bf16;
typedef unsigned v4u __attribute__((ext_vector_type(4)));
typedef float f32x4 __attribute__((ext_vector_type(4)));
typedef short bf16x8 __attribute__((ext_vector_type(8)));
typedef GAS unsigned gu32;
typedef GAS unsigned long long gu64;
#define RLX_AGENT __ATOMIC_RELAXED, __HIP_MEMORY_SCOPE_AGENT
#define LDS_WAIT() asm volatile("s_waitcnt lgkmcnt(0)" ::: "memory")
#define VM_WAIT() asm volatile("s_waitcnt vmcnt(0)" ::: "memory")
__device__ __forceinline__ unsigned long long rt() { return __builtin_amdgcn_s_memrealtime(); }
__device__ __forceinline__ unsigned f2bf(float f) { unsigned u = __builtin_bit_cast(unsigned, f); return (u + 0x7fffu + ((u >> 16) & 1u)) >> 16; }
__device__ __forceinline__ unsigned pk2(float lo, float hi) { return f2bf(lo) | (f2bf(hi) << 16); }
typedef float f32p2_t __attribute__((ext_vector_type(2))); typedef __bf16 bf16p2_t __attribute__((ext_vector_type(2)));
__device__ __forceinline__ unsigned pk2h(float lo, float hi) { const f32p2_t v = {lo, hi}; const bf16p2_t b = __builtin_convertvector(v, bf16p2_t); return __builtin_bit_cast(unsigned, b); }

#define XB_TMO      128
#define XB_XCNT(j)  (256  + 64 * (j))
#define XB_XSUB(j)  (1280 + 64 * (j))
#define XB_XGEN(j)  (2304 + 64 * (j))
#define XB_TOP      3328
#define XB_TOPGEN   3392
#define XCD_BAR_WORDS 3456
#define XB_SPIN_CAP (1u << 18)

__device__ __forceinline__ unsigned xb_ld(unsigned* p)              { return __hip_atomic_load(p, __ATOMIC_RELAXED, __HIP_MEMORY_SCOPE_AGENT); }
__device__ __forceinline__ unsigned xb_add(unsigned* p, unsigned v) { return __hip_atomic_fetch_add(p, v, __ATOMIC_RELAXED, __HIP_MEMORY_SCOPE_AGENT); }
__device__ __forceinline__ unsigned xb_xcc_id() { return (unsigned)__builtin_amdgcn_s_getreg((3 << 11) | 20) & 0xFu; }
#define XB_SPIN(cond, bar) do { unsigned _sp = 0; while (cond) { __builtin_amdgcn_s_sleep(1); \
    if ((++_sp & 255u) == 0u) { if (xb_ld(&(bar)[XB_TMO])) break; if (_sp > XB_SPIN_CAP) { atomicAdd(&(bar)[XB_TMO], 1u); break; } } } } while (0)

struct XcdBarrier {
    unsigned* bar; unsigned x;
    volatile LAS unsigned* st;
};

__device__ __forceinline__ XcdBarrier xcd_barrier_post(unsigned* bar, volatile LAS unsigned* st) {
    XcdBarrier b; b.bar = bar; b.x = xb_xcc_id(); b.st = st;
    if (threadIdx.x == 0) (void)xb_add(&bar[XB_XCNT(b.x)], 1u);
    return b;
}
__device__ __forceinline__ void xcd_barrier_complete(unsigned* bar, unsigned x, unsigned& nloc, unsigned& nx) {
    const unsigned G = gridDim.x * gridDim.y * gridDim.z;
    unsigned sum, cnt, mine, sp = 0u;
    for (;;) {
        sum = 0u; cnt = 0u; mine = 0u;
#pragma unroll
        for (unsigned j = 0; j < 16; ++j) { const unsigned c = xb_ld(&bar[XB_XCNT(j)]); sum += c; cnt += (c > 0u) ? 1u : 0u; mine = (j == x) ? c : mine; }
        if (sum == G) break;
        __builtin_amdgcn_s_sleep(1);
        if ((++sp & 255u) == 0u) { if (xb_ld(&bar[XB_TMO])) break; if (sp > XB_SPIN_CAP) { atomicAdd(&bar[XB_TMO], 1u); break; } }
    }
    nloc = mine > 0u ? mine : 1u; nx = cnt > 0u ? cnt : 1u;
}

__device__ __forceinline__ void xcd_barrier(const XcdBarrier& b) {
    asm volatile("s_waitcnt vmcnt(0)" ::: "memory");
    __syncthreads();
    if (threadIdx.x == 0) {
        unsigned* bar = b.bar;
        __builtin_amdgcn_s_waitcnt(0);
        unsigned nloc = b.st[0], nx = b.st[1];
        if (nloc == 0u) { xcd_barrier_complete(bar, b.x, nloc, nx); b.st[0] = nloc; b.st[1] = nx; }
        const unsigned old = xb_add(&bar[XB_XSUB(b.x)], 1u);
        const unsigned gen = old / nloc;
        if (old + 1u == (gen + 1u) * nloc) {
            __builtin_amdgcn_fence(__ATOMIC_RELEASE, "agent");
            asm volatile("s_waitcnt vmcnt(0)" ::: "memory");
            const unsigned og = xb_add(&bar[XB_TOP], 1u);
            const unsigned tg = og / nx;
            if (og + 1u == (tg + 1u) * nx) xb_add(&bar[XB_TOPGEN], 1u);
            else XB_SPIN(xb_ld(&bar[XB_TOPGEN]) == tg, bar);
            __builtin_amdgcn_fence(__ATOMIC_ACQUIRE, "agent");
            xb_add(&bar[XB_XGEN(b.x)], 1u);
            asm volatile("s_waitcnt vmcnt(0)" ::: "memory");
        } else {
            XB_SPIN(xb_ld(&bar[XB_XGEN(b.x)]) == gen, bar);
            __builtin_amdgcn_fence(__ATOMIC_ACQUIRE, "agent");
            asm volatile("s_waitcnt vmcnt(0)" ::: "memory");
        }
    }
    __syncthreads();
}

constexpr int NWAVES = 8;
constexpr int RING_OFF = 0, RING_BYTES = 131072;
constexpr int LDSCTL_OFF = RING_BYTES, MISC_OFF = LDSCTL_OFF + 320;
constexpr int LDS_BYTES = 147456;
static_assert(MISC_OFF + 128 <= LDS_BYTES, "LDS map");
constexpr int N_PHASES = 2 + 4 * DEPTH;

__device__ __forceinline__ float wave_sum(float v) {
#pragma unroll
    for (int o = 1; o < 64; o <<= 1) v += __shfl_xor(v, o);
    return v;
}
__device__ __forceinline__ v4u pack8f(const f32x4 a, const f32x4 b) { v4u w; w.x = pk2(a[0], a[1]); w.y = pk2(a[2], a[3]); w.z = pk2(b[0], b[1]); w.w = pk2(b[2], b[3]); return w; }
__device__ __forceinline__ float bflo(unsigned w) { return __uint_as_float(w << 16); }
__device__ __forceinline__ float bfhi(unsigned w) { return __uint_as_float(w & 0xffff0000u); }

__host__ __device__ __forceinline__ int colmap_in(int np) {
    if (np >= 2048 && np < 4096) { const int g = np >> 6, j = np & 63, a = j >> 5, fq = (j >> 3) & 3, n = (j >> 2) & 1, e = j & 3; return (g << 6) + 32 * n + 16 * a + 4 * fq + e; }
    if (np >= 6144) { const int w = np - 6144, j8 = w >> 8, half = (w >> 7) & 1, cc = w & 127; return 6144 + half * 1024 + 128 * j8 + cc; }
    return np;
}
template <bool MAPPED>
__device__ __forceinline__ void p0_item(const float* W, int N, const float* kscale, bf16* WT, int ldk, int koff, LAS float* scr, int kb, int nb, int lane) {
    const int k0 = 64 * kb, n0 = 32 * nb; const int np = n0 + (lane & 31); const int src = MAPPED ? colmap_in(np) : np;
#pragma unroll
    for (int i = 0; i < 32; ++i) { const int kk = 2 * i + (lane >> 5); float v = W[(size_t)(k0 + kk) * N + src]; if (kscale) v *= kscale[k0 + kk]; scr[kk * 33 + (lane & 31)] = v; }
    LDS_WAIT(); asm volatile("" ::: "memory");
    const int c = lane & 7;
#pragma unroll
    for (int j = 0; j < 4; ++j) { const int n = (lane >> 3) + 8 * j; const LAS float* s = scr + (8 * c) * 33 + n;
        v4u o; o.x = pk2(s[0 * 33], s[1 * 33]); o.y = pk2(s[2 * 33], s[3 * 33]); o.z = pk2(s[4 * 33], s[5 * 33]); o.w = pk2(s[6 * 33], s[7 * 33]);
        *(GAS v4u*)(WT + (size_t)(n0 + n) * ldk + koff + k0 + 8 * c) = o; }
    LDS_WAIT(); asm volatile("" ::: "memory");
}

__device__ __forceinline__ void cache_convert(ArgsP args, int lc, int c_lo, int n_ch, int tid0, int nth) {
    unsigned char* ws = args->ws;
    bf16* KS = (bf16*)(ws + WS_KS) + (size_t)lc * NDB * KSROWS * D; bf16* VS = (bf16*)(ws + WS_VS) + (size_t)lc * NDB * KSROWS * D;
    const float* ck = args->in[I_CK] + (size_t)lc * NDB * PAST * D; const float* cv = args->in[I_CV] + (size_t)lc * NDB * PAST * D;
    for (int c0 = c_lo + tid0; c0 < c_lo + n_ch; c0 += 4 * nth) {
        f32x4 klo[4], khi[4], vlo[4], vhi[4];
#pragma unroll
        for (int u = 0; u < 4; ++u) { const int c = c0 + u * nth; if (c < c_lo + n_ch) { const int row = c >> 7, chn = c & 127;
            const int gq = chn >> 3, q8 = chn & 7, d0 = 16 * (q8 >> 2) + 4 * (q8 & 3); const float* s = ck + (size_t)row * D + 64 * gq + d0; const float* sv = cv + (size_t)row * D + 8 * chn;
            klo[u] = __builtin_nontemporal_load((const GAS f32x4*)s); khi[u] = __builtin_nontemporal_load((const GAS f32x4*)(s + 32)); vlo[u] = __builtin_nontemporal_load((const GAS f32x4*)sv); vhi[u] = __builtin_nontemporal_load((const GAS f32x4*)(sv + 4)); } }
#pragma unroll
        for (int u = 0; u < 4; ++u) { const int c = c0 + u * nth; if (c < c_lo + n_ch) { const int row = c >> 7, chn = c & 127; const size_t drow = ((size_t)(row >> 11) * KSROWS + (row & 2047)) * D;
            *(GAS v4u*)(KS + drow + 8 * chn) = pack8f(klo[u], khi[u]); *(GAS v4u*)(VS + drow + 8 * chn) = pack8f(vlo[u], vhi[u]); } }
    }
}

__device__ __forceinline__ void cache_convert_head(ArgsP args, int lc, int db, int h, int tid0, int nth) {
    unsigned char* ws = args->ws;
    bf16* KS = (bf16*)(ws + WS_KS) + (size_t)(lc * NDB + db) * KSROWS * D; bf16* VS = (bf16*)(ws + WS_VS) + (size_t)(lc * NDB + db) * KSROWS * D;
    const float* ck = args->in[I_CK] + (size_t)(lc * NDB + db) * PAST * D; const float* cv = args->in[I_CV] + (size_t)(lc * NDB + db) * PAST * D;
    constexpr int NCHK = PAST * 16;
    for (int c0 = tid0; c0 < NCHK; c0 += 4 * nth) {
        f32x4 klo[4], khi[4], vlo[4], vhi[4];
#pragma unroll
        for (int u = 0; u < 4; ++u) { const int c = c0 + u * nth; if (c < NCHK) { const int row = c >> 4, chn = h * 16 + (c & 15);
            const int gq = chn >> 3, q8 = chn & 7, d0 = 16 * (q8 >> 2) + 4 * (q8 & 3); const float* s = ck + (size_t)row * D + 64 * gq + d0; const float* sv = cv + (size_t)row * D + 8 * chn;
            klo[u] = __builtin_nontemporal_load((const GAS f32x4*)s); khi[u] = __builtin_nontemporal_load((const GAS f32x4*)(s + 32)); vlo[u] = __builtin_nontemporal_load((const GAS f32x4*)sv); vhi[u] = __builtin_nontemporal_load((const GAS f32x4*)(sv + 4)); } }
#pragma unroll
        for (int u = 0; u < 4; ++u) { const int c = c0 + u * nth; if (c < NCHK) { const int row = c >> 4, chn = h * 16 + (c & 15); const size_t drow = (size_t)row * D;
            *(GAS v4u*)(KS + drow + 8 * chn) = pack8f(klo[u], khi[u]); *(GAS v4u*)(VS + drow + 8 * chn) = pack8f(vlo[u], vhi[u]); } }
    }
}

__device__ __forceinline__ void p0_prologue(ArgsP args, LAS unsigned char* lds, int lane, int wave, int vcu, int G) {
    unsigned char* ws = args->ws;
    LAS float* scr = (LAS float*)(lds + RING_OFF + wave * 16384);
    const int gw = vcu * NWAVES + wave, NGW = G * NWAVES;
    constexpr int IT_L = 2048 + 256 + 256 + 256 + 64;
    typedef float f32x2_t __attribute__((ext_vector_type(2)));
    struct WItem { const float* src; const float* ksc; bf16* dst; int N, ldk; };
    auto decode = [&](int it) -> WItem {
        const int l = it / IT_L; int r = it % IT_L; unsigned char* wl = ws + WS_W + (size_t)l * W_LAYER;
        const float* W; const float* kscale = nullptr; bf16* WT; int N, ldk, koff = 0, kb, nb; bool mapped = false;
        if (r < 2048) { W = args->in[I_WIN] + (size_t)l * D * INC; N = INC; kscale = args->in[I_NW] + l * D; WT = (bf16*)(wl + W_IN); ldk = D; kb = r >> 7; nb = r & 127; mapped = true; }
        else if (r < 2048 + 256) { r -= 2048; W = args->in[I_WPR] + (size_t)l * D * D; N = D; WT = (bf16*)(wl + W_PROJ); ldk = 2 * D; kb = r >> 4; nb = r & 15; }
        else if (r < 2048 + 512) { r -= 2048 + 256; W = args->in[I_WPA] + (size_t)l * D * D; N = D; WT = (bf16*)(wl + W_PROJ); ldk = 2 * D; koff = D; kb = r >> 4; nb = r & 15; }
        else if (r < 2048 + 768) { r -= 2048 + 512; W = args->in[I_WOUT] + (size_t)l * D * D; N = D; WT = (bf16*)(wl + W_OUT); ldk = D; kb = r >> 4; nb = r & 15; }
        else { r -= 2048 + 768; const int gate = r >> 5, blk = (r >> 2) & 7; kb = (r >> 1) & 1; nb = r & 1;
            W = args->in[gate ? I_WIG : I_WRG] + (size_t)(l * 8 + blk) * 16384; N = 128; WT = (bf16*)(wl + W_G) + (size_t)(blk * 2 + gate) * 16384; ldk = 128; }
        const int k0 = 64 * kb, n0 = 64 * nb, np = n0 + 2 * (lane & 31), srcc = mapped ? colmap_in(np) : np;
        WItem w; w.src = W + (size_t)k0 * N + srcc; w.ksc = kscale ? kscale + k0 + 8 * (lane & 7) : nullptr; w.dst = WT + (size_t)n0 * ldk + koff + k0; w.N = N; w.ldk = ldk; return w; };
    auto wload = [&](const WItem& w, f32x2_t (&v)[32]) {
#pragma unroll
        for (int i = 0; i < 32; ++i) v[i] = *(const GAS f32x2_t*)(w.src + (size_t)(2 * i + (lane >> 5)) * w.N); };
    auto wstore = [&](const WItem& w, const f32x2_t (&v)[32]) {
        f32x4 ka = (f32x4){1.f, 1.f, 1.f, 1.f}, kb2 = ka;
        if (w.ksc) { ka = *(const GAS f32x4*)w.ksc; kb2 = *(const GAS f32x4*)(w.ksc + 4); }
#pragma unroll
        for (int par = 0; par < 2; ++par) {
#pragma unroll
            for (int i = 0; i < 32; ++i) scr[(2 * i + (lane >> 5)) * 33 + (lane & 31)] = v[i][par];
            LDS_WAIT(); asm volatile("" ::: "memory");
            const int c = lane & 7;
#pragma unroll
            for (int j = 0; j < 4; ++j) { const int n = (lane >> 3) + 8 * j; const LAS float* sp = scr + (8 * c) * 33 + n;
                v4u o; o.x = pk2(sp[0 * 33] * ka[0], sp[1 * 33] * ka[1]); o.y = pk2(sp[2 * 33] * ka[2], sp[3 * 33] * ka[3]); o.z = pk2(sp[4 * 33] * kb2[0], sp[5 * 33] * kb2[1]); o.w = pk2(sp[6 * 33] * kb2[2], sp[7 * 33] * kb2[3]);
                *(GAS v4u*)(w.dst + (size_t)(2 * n + par) * w.ldk + 8 * c) = o; }
            LDS_WAIT(); asm volatile("" ::: "memory"); } };
    for (int it = gw; it < DEPTH * IT_L; it += 2 * NGW) {
        const bool hb = it + NGW < DEPTH * IT_L;
        const WItem wa = decode(it), wb = decode(hb ? it + NGW : it);
        f32x2_t va[32], vb[32];
        wload(wa, va); wload(wb, vb);
        wstore(wa, va); if (hb) wstore(wb, vb);
    }
    { bf16* HB = (bf16*)(ws + WS_HB); float* SSQ = (float*)(ws + WS_SSQ);
      for (int row0 = gw; row0 < M; row0 += 4 * NGW) {
        f32x4 v[4][4]; float sv[4]; bool ok[4];
#pragma unroll
        for (int u = 0; u < 4; ++u) { const int row = row0 + u * NGW; ok[u] = row < M;
            const float* src = !ok[u] ? nullptr : row < ROW_S ? args->in[I_XP] + (size_t)row * D : row < ROW_M ? args->in[I_XS] + (size_t)(row - ROW_S) * D : (row - ROW_M) < NMETA ? args->in[I_META] + (size_t)(row - ROW_M) * D : nullptr;
#pragma unroll
            for (int j = 0; j < 4; ++j) v[u][j] = src ? ((const GAS f32x4*)src)[lane + 64 * j] : (f32x4){0.f, 0.f, 0.f, 0.f}; }
#pragma unroll
        for (int u = 0; u < 4; ++u) { float s = 0.f;
#pragma unroll
            for (int j = 0; j < 4; ++j) s += (v[u][j].x * v[u][j].x + v[u][j].y * v[u][j].y) + (v[u][j].z * v[u][j].z + v[u][j].w * v[u][j].w);
            sv[u] = wave_sum(s); }
#pragma unroll
        for (int u = 0; u < 4; ++u) if (ok[u]) { const int row = row0 + u * NGW;
#pragma unroll
            for (int j = 0; j < 4; ++j) ((GAS unsigned long long*)(HB + (size_t)row * D))[lane + 64 * j] = (unsigned long long)pk2(v[u][j].x, v[u][j].y) | ((unsigned long long)pk2(v[u][j].z, v[u][j].w) << 32);
            if (lane < 16) SSQ[(size_t)row * 16 + lane] = lane == 0 ? sv[u] : 0.f; }
      } }
    const int gtid = gw * 64 + lane, NTH = NGW * 64;
    { float* TC = (float*)(ws + WS_TCOS); float* TS = (float*)(ws + WS_TSIN);
      for (int idx = gtid; idx < TP * 32; idx += NTH) {
        const int pos = idx >> 5, i = idx & 31;
        double th = 1.0; for (int k = 0; k < i; ++k) th *= 0.74989420933245582730;
        const double t2 = th * th; double cb = 1.0, sb = th, tc = 1.0, tsn = th;
#pragma unroll 1
        for (int k = 1; k <= 11; ++k) { tc *= -t2 / (double)((2 * k - 1) * (2 * k)); tsn *= -t2 / (double)((2 * k) * (2 * k + 1)); cb += tc; sb += tsn; }
        double cr = 1.0, sr = 0.0;
#pragma unroll 1
        for (int bit = 0; bit < 13; ++bit) { if ((pos >> bit) & 1) { const double c2 = cr * cb - sr * sb, s2 = sr * cb + cr * sb; cr = c2; sr = s2; } const double c3 = cb * cb - sb * sb, s3 = 2.0 * cb * sb; cb = c3; sb = s3; }
        TC[idx] = (float)cr; TS[idx] = (float)sr;
      } }
    if (gw < DEPTH) { const int l = gw; const float s1 = wave_sum(args->in[I_LQ1][l * 64 + lane] * args->in[I_LK1][l * 64 + lane]), s2 = wave_sum(args->in[I_LQ2][l * 64 + lane] * args->in[I_LK2][l * 64 + lane]);
        if (lane == 0) { const float li = 0.8f - 0.6f * expf(-0.3f * (float)l); ((float*)(ws + WS_MISC))[l] = expf(s1) - expf(s2) + li; ((float*)(ws + WS_MISC))[8 + l] = 1.0f - li; } }
    { bf16* KP = (bf16*)(ws + WS_KP); bf16* VP = (bf16*)(ws + WS_VP);
      for (int c = gtid; c < NB * 48 * 128; c += NTH) { const int b = c / (48 * 128), rr = (c / 128) % 48, chn = c & 127; const size_t off = ((size_t)b * KPROWS + 16 + rr) * D + 8 * chn;
        *(GAS v4u*)(KP + off) = (v4u){0u, 0u, 0u, 0u}; *(GAS v4u*)(VP + off) = (v4u){0u, 0u, 0u, 0u}; } }
}

constexpr int RNN_XS = 0, RNN_XC = 36864, RNN_XA = 71680;
constexpr int CW_CNTA = 12288, CW_CNTB = 14336;
constexpr int CW_FLAG = 16384;
constexpr size_t MISC_CARRY = 131072;
#define RNN_BAR() do { asm volatile("s_waitcnt lgkmcnt(0)" ::: "memory"); __builtin_amdgcn_s_barrier(); asm volatile("" ::: "memory"); } while (0)
__device__ __forceinline__ void rnn_prefetch(ArgsP args, const bf16* XR, int l, int pmode, int seq, int n, size_t row0, int tid, v4u (&pf)[3]) {
#pragma unroll
    for (int k = 0; k < 3; ++k) { const int id = tid + k * NWAVES * 64, i = id >> 4, c8 = id & 15;
        if (id < 67 * 16) {
            if (i >= 3 || pmode == 0) pf[k] = *(const GAS v4u*)(XR + (row0 + i - 3) * D + 128 * n + 8 * c8);
            else if (pmode == 1) pf[k] = *(const GAS v4u*)(XR + ((size_t)ROW_M + 13 + i) * D + 128 * n + 8 * c8);
            else if (pmode == 2) { const float* sc = args->in[I_SC] + ((size_t)(l * NDB + seq) * 3 + i) * D + 128 * n + 8 * c8; pf[k] = pack8f(*(const GAS f32x4*)sc, *(const GAS f32x4*)(sc + 4)); }
            else pf[k] = (v4u){0u, 0u, 0u, 0u};
        } }
}
__device__ __forceinline__ void rnn_unit(ArgsP args, int l, int kind, int seq, int n, int g, LAS unsigned char* lds, int tid, int lane, int wid) {
    unsigned char* ws = args->ws;
    LAS float* XS = (LAS float*)(lds + RNN_XS); LAS float* XC = (LAS float*)(lds + RNN_XC); LAS bf16* XA = (LAS bf16*)(lds + RNN_XA);
    const bf16* XR = (const bf16*)(ws + WS_XR); const bf16* ZR = (const bf16*)(ws + WS_ZR); bf16* OX = (bf16*)(ws + WS_OX);
    const int q = lane >> 4, cl = lane & 15, cc = 16 * wid + cl, ch = 128 * n + cc;
    const float brg = args->in[I_BRG][l * D + ch], big = args->in[I_BIG][l * D + ch];
    float sp; { const float x = -args->in[I_LAM][l * D + ch]; sp = fmaxf(x, 0.f) + log1pf(__expf(-fabsf(x))); }
    const int c2 = tid & 127, rg = tid >> 7, chc = 128 * n + c2;
    const float cw0 = args->in[I_CW][(l * 4 + 0) * D + chc], cw1 = args->in[I_CW][(l * 4 + 1) * D + chc], cw2 = args->in[I_CW][(l * 4 + 2) * D + chc], cw3 = args->in[I_CW][(l * 4 + 3) * D + chc], cb = args->in[I_CB][l * D + chc];
    const bf16* wg = (const bf16*)(ws + WS_W + (size_t)l * W_LAYER + W_G) + (size_t)(n * 2) * 16384;
    bf16x8 Br[4], Bi[4];
#pragma unroll
    for (int ks = 0; ks < 4; ++ks) { Br[ks] = *(const bf16x8*)(wg + (size_t)cc * 128 + 32 * ks + 8 * q); Bi[ks] = *(const bf16x8*)(wg + 16384 + (size_t)cc * 128 + 32 * ks + 8 * q); }
    const int ntiles = kind == 0 ? 16 : 1;
    const int jstart = (kind == 0 && g == 0) ? -1 : 0;
    const size_t rowbase = kind == 0 ? (size_t)seq * SEQ + (size_t)g * 1024 : kind == 1 ? (size_t)ROW_S + (size_t)seq * DSQ : (size_t)ROW_M;
    float* carry = (float*)(ws + WS_MISC + MISC_CARRY) + (size_t)((((l * NB + seq) * 8 + n) * 4) + g) * 128;
    gu32* flag = (gu32*)(ws + WS_CTL) + CW_FLAG + 64 * ((((l * NB + seq) * 8 + n) * 4) + g);
    float hrun = 0.f;
    if (kind == 1) hrun = args->in[I_SR][(size_t)(l * NDB + seq) * D + ch];
    v4u pf[3] = {{0u, 0u, 0u, 0u}, {0u, 0u, 0u, 0u}, {0u, 0u, 0u, 0u}};
    rnn_prefetch(args, XR, l, jstart < 0 ? 3 : (kind == 0 ? 0 : kind == 1 ? 2 : 3), seq, n, jstart < 0 ? (size_t)ROW_M : rowbase, tid, pf);
    if (kind == 0 && g > 0) {
        if (tid == 0) { unsigned spn = 0u; while (__hip_atomic_load(flag - 64, RLX_AGENT) == 0u) { __builtin_amdgcn_s_sleep(2); if (++spn > (1u << 22)) { __hip_atomic_store((gu32*)(ws + WS_CTL) + CW_TMO, 0xC0DEu, RLX_AGENT); break; } }
            __builtin_amdgcn_fence(__ATOMIC_ACQUIRE, "agent"); asm volatile("s_waitcnt vmcnt(0)" ::: "memory"); }
        __syncthreads();
        hrun = __hip_atomic_load(carry - 128 + cc, RLX_AGENT);
    }
    for (int j = jstart; j < ntiles; ++j) {
        const bool pre = j < 0;
        const size_t row0 = pre ? (size_t)ROW_M : rowbase + 64 * j;
        const int nvalid = (pre || kind == 2) ? NMETA : 64;
#pragma unroll
        for (int k = 0; k < 3; ++k) { const int id = tid + k * NWAVES * 64, i = id >> 4, c8 = id & 15;
            if (id < 67 * 16) { const v4u w = pf[k];
                *(LAS f32x4*)(XS + i * 132 + 8 * c8) = (f32x4){bflo(w.x), bfhi(w.x), bflo(w.y), bfhi(w.y)}; *(LAS f32x4*)(XS + i * 132 + 8 * c8 + 4) = (f32x4){bflo(w.z), bfhi(w.z), bflo(w.w), bfhi(w.w)}; } }
        if (j + 1 < ntiles) rnn_prefetch(args, XR, l, pre ? 1 : 0, seq, n, rowbase + 64 * (j + 1), tid, pf);
        v4u zf[2] = {{0u, 0u, 0u, 0u}, {0u, 0u, 0u, 0u}};
        if (!pre) {
#pragma unroll
            for (int k = 0; k < 2; ++k) { const int id = tid + k * NWAVES * 64, r = id >> 4, c8 = id & 15; zf[k] = *(const GAS v4u*)(ZR + (row0 + r) * D + 128 * n + 8 * c8); } }
        RNN_BAR();
        { const int rb = 16 * rg; float x0 = XS[(rb + 0) * 132 + c2], x1 = XS[(rb + 1) * 132 + c2], x2 = XS[(rb + 2) * 132 + c2];
#pragma unroll
          for (int r = 0; r < 16; ++r) { const float x3 = XS[(rb + r + 3) * 132 + c2]; const float xc = (((cb + x0 * cw0) + x1 * cw1) + x2 * cw2) + x3 * cw3;
              XC[(rb + r) * 132 + c2] = xc; XA[(rb + r) * 136 + c2] = (bf16)(pk2h(xc, 0.f) & 0xffffu); x0 = x1; x1 = x2; x2 = x3; } }
        RNN_BAR();
#pragma unroll
        for (int mt = 0; mt < 4; ++mt) {
            f32x4 ar = {0.f, 0.f, 0.f, 0.f}, ai = {0.f, 0.f, 0.f, 0.f};
#pragma unroll
            for (int ks = 0; ks < 4; ++ks) { const bf16x8 A = *(const LAS bf16x8*)(XA + (16 * mt + cl) * 136 + 32 * ks + 8 * q);
                ar = __builtin_amdgcn_mfma_f32_16x16x32_bf16(A, Br[ks], ar, 0, 0, 0); ai = __builtin_amdgcn_mfma_f32_16x16x32_bf16(A, Bi[ks], ai, 0, 0, 0); }
            float a[4], b[4];
#pragma unroll
            for (int i = 0; i < 4; ++i) { const int r = 16 * mt + 4 * q + i; const float xc = XC[r * 132 + cc];
                const float rr = __builtin_amdgcn_rcpf(1.0f + __expf(-(ar[i] + brg))), ii = __builtin_amdgcn_rcpf(1.0f + __expf(-(ai[i] + big)));
                const float av = __expf(-8.0f * rr * sp); a[i] = av; b[i] = __builtin_amdgcn_sqrtf(fmaxf((1.0f - av) * (1.0f + av), 0.f)) * ii * xc;
                if (r >= nvalid) { a[i] = 1.f; b[i] = 0.f; } }
            const float A4 = (a[0] * a[1]) * (a[2] * a[3]), B4 = ((b[0] * a[1] + b[1]) * a[2] + b[2]) * a[3] + b[3];
            float Ai = A4, Bi2 = B4;
            { const float ua = __shfl_up(Ai, 16), ub = __shfl_up(Bi2, 16); if (q >= 1) { Bi2 = Ai * ub + Bi2; Ai = ua * Ai; } }
            { const float ua = __shfl_up(Ai, 32), ub = __shfl_up(Bi2, 32); if (q >= 2) { Bi2 = Ai * ub + Bi2; Ai = ua * Ai; } }
            float Ae = __shfl_up(Ai, 16), Be = __shfl_up(Bi2, 16); if (q == 0) { Ae = 1.f; Be = 0.f; }
            const float At = __shfl(Ai, 48 + cl), Bt = __shfl(Bi2, 48 + cl);
            float h = Ae * hrun + Be;
#pragma unroll
            for (int i = 0; i < 4; ++i) { h = a[i] * h + b[i]; XC[(16 * mt + 4 * q + i) * 132 + cc] = h; }
            hrun = At * hrun + Bt;
        }
        RNN_BAR();
        if (!pre) {
#pragma unroll
            for (int k = 0; k < 2; ++k) { const int id = tid + k * NWAVES * 64, r = id >> 4, c8 = id & 15;
                const f32x4 h0 = *(const LAS f32x4*)(XC + r * 132 + 8 * c8), h1 = *(const LAS f32x4*)(XC + r * 132 + 8 * c8 + 4);
                const v4u z = zf[k];
                const f32x4 o0 = h0 * (f32x4){bflo(z.x), bfhi(z.x), bflo(z.y), bfhi(z.y)}, o1 = h1 * (f32x4){bflo(z.z), bfhi(z.z), bflo(z.w), bfhi(z.w)};
                { v4u ow; ow.x = pk2h(o0[0], o0[1]); ow.y = pk2h(o0[2], o0[3]); ow.z = pk2h(o1[0], o1[1]); ow.w = pk2h(o1[2], o1[3]); *(GAS v4u*)(OX + (row0 + r) * 2 * D + 128 * n + 8 * c8) = ow; } }
        }
    }
    const bool publish = (kind == 0 && g < 3);
    if (q == 0) {
        if (kind == 0 && g == 3) args->out[O_RP + (size_t)(l * NB + seq) * D + ch] = hrun;
        if (kind == 1) args->out[O_RS + (size_t)(l * NDB + seq) * D + ch] = hrun;
        if (publish) __hip_atomic_store(carry + cc, hrun, RLX_AGENT);
    }
    if (publish) asm volatile("s_waitcnt vmcnt(0)" ::: "memory");
    RNN_BAR();
    if (publish && tid == 0) __hip_atomic_store(flag, 1u, RLX_AGENT);
}
__device__ __forceinline__ void attn_finish(ArgsP args, int l, size_t row0, int h, int nw, int lane, int wid) {
    if (wid >= nw) return;
    unsigned char* ws = args->ws;
    asm volatile("s_waitcnt vmcnt(0)" ::: "memory");
    const float lam = ((const float*)(ws + WS_MISC))[l], oml = ((const float*)(ws + WS_MISC))[8 + l];
    int ln = lane; asm volatile("" : "+v"(ln));
    const int r = ln >> 1, half = ln & 1; const size_t row = row0 + 32 * wid + r;
    const bf16* p1 = (const bf16*)(ws + WS_OP) + row * 2048 + (size_t)(h * 2) * 128 + half * 64; const bf16* p2 = p1 + 128;
    float d[64]; float ss = 0.f;
#pragma unroll
    for (int k = 0; k < 8; ++k) { const v4u a = *(const GAS v4u*)(p1 + 8 * k), b = *(const GAS v4u*)(p2 + 8 * k);
        d[8 * k + 0] = bflo(a.x) - lam * bflo(b.x); d[8 * k + 1] = bfhi(a.x) - lam * bfhi(b.x); d[8 * k + 2] = bflo(a.y) - lam * bflo(b.y); d[8 * k + 3] = bfhi(a.y) - lam * bfhi(b.y);
        d[8 * k + 4] = bflo(a.z) - lam * bflo(b.z); d[8 * k + 5] = bfhi(a.z) - lam * bfhi(b.z); d[8 * k + 6] = bflo(a.w) - lam * bflo(b.w); d[8 * k + 7] = bfhi(a.w) - lam * bfhi(b.w);
#pragma unroll
        for (int e = 0; e < 8; ++e) ss += d[8 * k + e] * d[8 * k + e]; }
    ss += __shfl_xor(ss, 1);
    const float scale = rsqrtf(ss * (1.0f / 128.0f) + EPS) * oml;
    const bf16* za = (const bf16*)(ws + WS_ZA) + row * D + h * 128 + half * 64; const float* sw = args->in[I_SUBLN] + l * 128 + half * 64;
    bf16* od = (bf16*)(ws + WS_OX) + row * 2 * D + D + h * 128 + half * 64;
#pragma unroll
    for (int k = 0; k < 8; ++k) { const v4u z = *(const GAS v4u*)(za + 8 * k); const f32x4 w0 = *(const GAS f32x4*)(sw + 8 * k), w1 = *(const GAS f32x4*)(sw + 8 * k + 4);
        f32x4 o0, o1;
        o0[0] = d[8 * k + 0] * scale * w0[0] * bflo(z.x); o0[1] = d[8 * k + 1] * scale * w0[1] * bfhi(z.x); o0[2] = d[8 * k + 2] * scale * w0[2] * bflo(z.y); o0[3] = d[8 * k + 3] * scale * w0[3] * bfhi(z.y);
        o1[0] = d[8 * k + 4] * scale * w1[0] * bflo(z.z); o1[1] = d[8 * k + 5] * scale * w1[1] * bfhi(z.z); o1[2] = d[8 * k + 6] * scale * w1[2] * bflo(z.w); o1[3] = d[8 * k + 7] * scale * w1[3] * bfhi(z.w);
        *(GAS v4u*)(od + 8 * k) = pack8f(o0, o1); }
}
__device__ __forceinline__ void attn_super(ArgsP args, int l, int kind, int a, int h, int qb, char* shm, int lane, int wid) {
    typedef attn_body::bf16 abf;
    unsigned char* ws = args->ws;
    const abf* Q = (const abf*)(ws + WS_Q); abf* OP = (abf*)(ws + WS_OP);
    size_t qrow; const abf* Kb; const abf* Vb; int NT, vis, qwaves;
    if (kind == 0)      { qrow = (size_t)a * SEQ + (size_t)qb * 256; Kb = (const abf*)(ws + WS_KP) + (size_t)a * KPROWS * D; Vb = (const abf*)(ws + WS_VP) + (size_t)a * KPROWS * D; NT = 4 * qb + 5; vis = (wid >> 1) + 1; qwaves = 8; }
    else if (kind == 1) { qrow = (size_t)ROW_S + (size_t)a * DSQ; Kb = (const abf*)(ws + WS_KS) + (size_t)(l * NDB + a) * KSROWS * D; Vb = (const abf*)(ws + WS_VS) + (size_t)(l * NDB + a) * KSROWS * D; NT = 33; vis = 4; qwaves = 2; }
    else                { qrow = (size_t)ROW_M; Kb = (const abf*)(ws + WS_KP); Vb = (const abf*)(ws + WS_VP); NT = 5; vis = 0; qwaves = 8; }
    const attn128::Fin nofin{0, 0, 0u};
    if (kind == 1) {
        attn128::attn_unit128<8, false, true, false>(Q + qrow * D + (h * 2) * 64, Kb + (h * 2) * 64, Vb + h * 128, OP + qrow * 2048 + (h * 2) * 128, NT, vis, qwaves, shm, nofin);
        attn_finish(args, l, qrow, h, qwaves, lane, wid);
    } else {
        attn128::attn_unit128<8, true, false, false>(Q + qrow * D + (h * 2) * 64, Kb + (h * 2) * 64, Vb + h * 128, OP + qrow * 2048 + (h * 2) * 128, NT, vis, qwaves, shm, nofin);
        const attn128::Fin fin{l, h, (unsigned)qrow};
        attn128::attn_unit128<8, true, false, true>(Q + qrow * D + (h * 2 + 1) * 64, Kb + (h * 2 + 1) * 64, Vb + h * 128, OP + qrow * 2048 + (h * 2 + 1) * 128, NT, vis, qwaves, shm, fin);
    }
}

__global__ void __launch_bounds__(NWAVES * 64, 2) hawk_fwd(Args args) {
    extern __shared__ __attribute__((aligned(16))) unsigned char lds_raw[];
    LAS unsigned char* lds = (LAS unsigned char*)lds_raw;
    volatile LAS unsigned* MISC = (volatile LAS unsigned*)(lds + MISC_OFF);
    const int tid = threadIdx.x;
    const int G = gridDim.x; const int bx = blockIdx.x; const int vcu = (G % 8 == 0) ? (bx % 8) * (G / 8) + bx / 8 : bx;
    for (int u = tid; u < (LDS_BYTES - LDSCTL_OFF) / 4; u += NWAVES * 64) ((LAS unsigned*)(lds + LDSCTL_OFF))[u] = 0u;
    __syncthreads();
#if MK_PER_PHASE
#define GRID_BAR() do { if (tid == 0) __hip_atomic_store((gu32*)(KARG()->ws + WS_CTL) + CW_TMO, 0xBADBA0u, RLX_AGENT); } while (0)
#else
    (void)xcd_barrier_post((unsigned*)((gu32*)(KARG()->ws + WS_CTL) + CW_BAR), MISC + 8);
#define GRID_BAR() do { XcdBarrier bar_; bar_.bar = (unsigned*)((gu32*)(KARG()->ws + WS_CTL) + CW_BAR); bar_.x = xb_xcc_id(); bar_.st = MISC + 8; xcd_barrier(bar_); } while (0)
#endif
    const int lo = KARG()->ph_lo, hi = KARG()->ph_hi;
#if MK_PROBE
#define TACC() ((unsigned long long*)(KARG()->ws + WS_MISC + 32768))
    if (blockIdx.x == 0 && tid == 0) { unsigned long long* ta = TACC(); for (int k = 0; k < 16; ++k) ta[k] = 0ull; ta[16] = __builtin_amdgcn_s_memrealtime(); }
#define TMARK(k) do { if (blockIdx.x == 0 && tid == 0) { unsigned long long* ta = TACC(); const unsigned long long now = __builtin_amdgcn_s_memrealtime(); ta[k] += now - ta[16]; ta[16] = now; } } while (0)
#else
#define TMARK(k) do {} while (0)
#endif
#define IN(k) (lo <= (k) && (k) < hi)
#ifndef PHMASK
#define PHMASK 0xff
#endif
#define PH(b) ((PHMASK >> (b)) & 1)
#define BOTH(k) (IN(k) && IN((k) + 1))
    typedef pg8::bf16_t pb;
    for (int rep_ = 0; rep_ < MK_REP_P0; ++rep_)
    if (PH(0) && IN(0)) { int tid_l = tid; asm volatile("" : "+v"(tid_l)); p0_prologue(KARG(), lds, tid_l & 63, __builtin_amdgcn_readfirstlane(tid_l >> 6), vcu, G); if (BOTH(0) || rep_ + 1 < MK_REP_P0) GRID_BAR(); TMARK(0); }

    for (int l = 0; l < DEPTH; ++l) {
        const int pbase = 1 + 4 * l;
        for (int rep_ = 0; rep_ < MK_REP_P1; ++rep_)
        if (PH(1) && IN(pbase)) {
            ArgsP args = KARG(); unsigned char* ws = args->ws; unsigned char* wl = ws + WS_W + (size_t)l * W_LAYER;
            pg8::Gemm g{(const pb*)(ws + WS_HB), (const pb*)(wl + W_IN), D, D, 0};
#if MK_KPROBE
            pg8::TwoPartOrder S; S.init(M, INC, G, bx);
#else
            pg8::StaticOrder S; S.init(M, INC, G, bx);
#endif
            pg8::EpiIn E{l, ws, args->out};
#if MK_STAGGER
            if ((blockIdx.x >> 3) & 1) { __builtin_amdgcn_s_sleep(127); __builtin_amdgcn_s_sleep(127); __builtin_amdgcn_s_sleep(127); __builtin_amdgcn_s_sleep(127); }
#endif
            #if MK_KPROBE
            pg8::gemm_phase<pg8::EpiIn, pg8::TwoPartOrder, true, true>(lds + RING_OFF, g, S, E);
#else
            pg8::gemm_phase<pg8::EpiIn, pg8::StaticOrder, MK_ALIGN_P1, true>(lds + RING_OFF, g, S, E);
#endif
            TMARK(7); if (BOTH(pbase) || rep_ + 1 < MK_REP_P1) GRID_BAR(); TMARK(1);
        }
        for (int rep_ = 0; rep_ < MK_REP_P3; ++rep_)
        if ((PH(3) || PH(4)) && IN(pbase + 1)) {
            const int xcd0 = (int)(xb_xcc_id() & 7u);
            for (int probe = 0; probe < 8; ++probe) {
              const int qx = (xcd0 + probe) & 7;
              if (probe == 1) {
                  int tid_c = tid; asm volatile("" : "+v"(tid_c));
                  if (tid_c < 64) { unsigned hv = 216u; if (tid_c < 8) hv = __hip_atomic_load((gu32*)(KARG()->ws + WS_CTL) + CW_QUEUE + 64 * ((l + 4 * rep_) * 8 + ((xcd0 + tid_c) & 7)), RLX_AGENT);
                      const unsigned long long lm = __ballot(hv < 216u); if (tid_c == 0) MISC[1] = (unsigned)lm; }
                  __syncthreads();
              }
              if (probe >= 1 && !((MISC[1] >> probe) & 1u)) continue;
              for (;;) {
                ArgsP args = KARG();
                int tid_l = tid; asm volatile("" : "+v"(tid_l)); const int lane_l = tid_l & 63, wave_l = __builtin_amdgcn_readfirstlane(tid_l >> 6);
                if (tid_l == 0) MISC[0] = __hip_atomic_fetch_add((gu32*)(args->ws + WS_CTL) + CW_QUEUE + 64 * ((l + 4 * rep_) * 8 + qx), 1u, RLX_AGENT);
                __syncthreads();
                const int idx = (int)MISC[0];
                __syncthreads();
                if (idx >= 216) break;
                int sig = -1;
                if (idx < 8) rnn_unit(args, l, 0, qx, idx, 0, lds + RING_OFF, tid_l, lane_l, wave_l);
                else if (idx < 24) { const int db = 2 * qx + ((idx - 8) >> 3);
                    cache_convert_head(args, l, db, (idx - 8) & 7, tid_l, NWAVES * 64); asm volatile("s_waitcnt vmcnt(0)" ::: "memory"); __syncthreads();
                    attn_super(args, l, 1, db, (idx - 8) & 7, 0, (char*)lds_raw + RING_OFF, lane_l, wave_l); sig = db >> 2; }
                else if (idx == 24) { attn_super(args, l, 2, 0, qx, 0, (char*)lds_raw + RING_OFF, lane_l, wave_l); sig = 4; }
                else if (idx >= 32 && idx < 56) rnn_unit(args, l, 0, qx, (idx - 32) & 7, 1 + ((idx - 32) >> 3), lds + RING_OFF, tid_l, lane_l, wave_l);
                else if (idx >= 56 && idx < 72) { const int db = 2 * qx + ((idx - 56) >> 3); rnn_unit(args, l, 1, db, (idx - 56) & 7, 0, lds + RING_OFF, tid_l, lane_l, wave_l); sig = db >> 2; }
                else if (idx == 72) { rnn_unit(args, l, 2, 0, qx, 0, lds + RING_OFF, tid_l, lane_l, wave_l); sig = 4; }
                else if (idx >= 73 && idx < 89) { }
                else if ((idx >= 105 && idx < 108) || (idx >= 130 && idx < 133)) {
                    const bool isC = idx >= 130; const int k = isC ? idx - 130 : idx - 105;
                    if (k < 2 || qx < 4) {
                        const int panel = k < 2 ? (qx >> 1) : 4, pn = k < 2 ? 2 * (qx & 1) + k : qx, pm = 128 + panel;
                        gu32* cw = (gu32*)(args->ws + WS_CTL) + (isC ? CW_CNTB : CW_CNTA) + 64 * (l * 8 + panel);
                        const unsigned want = isC ? 4u : (panel < 4 ? 64u : 16u);
                        if (tid_l == 0) { unsigned spn = 0u; while (__hip_atomic_load(cw, RLX_AGENT) < want) { __builtin_amdgcn_s_sleep(4); if (++spn > (1u << 22)) { __hip_atomic_store((gu32*)(args->ws + WS_CTL) + CW_TMO, 0xC0DFu, RLX_AGENT); break; } }
                            __builtin_amdgcn_fence(__ATOMIC_ACQUIRE, "agent"); asm volatile("s_waitcnt vmcnt(0)" ::: "memory"); }
                        __syncthreads();
                        unsigned char* ws = args->ws; unsigned char* wl = ws + WS_W + (size_t)l * W_LAYER;
                        if (!isC) { pg8::Gemm g{(const pb*)(ws + WS_OX), (const pb*)(wl + W_PROJ), 2 * D, D, D}; pg8::OneUnit S{pm, pn, 2}; pg8::EpiProj E{ws};
                            pg8::gemm_phase<pg8::EpiProj, pg8::OneUnit, true, true>(lds + RING_OFF, g, S, E);
                            asm volatile("s_waitcnt vmcnt(0)" ::: "memory"); __syncthreads();
                            if (tid_l == 0) { __builtin_amdgcn_fence(__ATOMIC_RELEASE, "agent"); asm volatile("s_waitcnt vmcnt(0)" ::: "memory");     __hip_atomic_fetch_add((gu32*)(ws + WS_CTL) + CW_CNTB + 64 * (l * 8 + panel), 1u, RLX_AGENT); } }
                        else { pg8::Gemm g{(const pb*)(ws + WS_MB), (const pb*)(wl + W_OUT), D, D, 0}; pg8::OneUnit S{pm, pn, 1}; pg8::EpiOut E{ws};
                            pg8::gemm_phase<pg8::EpiOut, pg8::OneUnit, true, true>(lds + RING_OFF, g, S, E); }
                    }
                }
                else { const int i = idx < 32 ? idx - 25 : idx < 105 ? idx - 89 + 7 : idx < 130 ? idx - 108 + 23 : idx - 133 + 45, r = i & 31;
                    (void)r; attn_super(args, l, 0, qx, i & 7, 15 - (i >> 3), (char*)lds_raw + RING_OFF, lane_l, wave_l); }
                if (sig >= 0) { asm volatile("s_waitcnt vmcnt(0)" ::: "memory"); __syncthreads();
                    if (tid_l == 0) { __builtin_amdgcn_fence(__ATOMIC_RELEASE, "agent"); asm volatile("s_waitcnt vmcnt(0)" ::: "memory");     __hip_atomic_fetch_add((gu32*)(args->ws + WS_CTL) + CW_CNTA + 64 * (l * 8 + sig), 1u, RLX_AGENT); } }
              }
            }
            TMARK(8); if (BOTH(pbase + 1) || rep_ + 1 < MK_REP_P3) GRID_BAR(); TMARK(3);
        }
        for (int rep_ = 0; rep_ < MK_REP_P4; ++rep_)
        if (PH(5) && IN(pbase + 2)) {
            ArgsP args = KARG(); unsigned char* ws = args->ws; unsigned char* wl = ws + WS_W + (size_t)l * W_LAYER;
            pg8::Gemm g{(const pb*)(ws + WS_OX), (const pb*)(wl + W_PROJ), 2 * D, D, D}; pg8::TwoPartOrder S; S.init(MP, D, G, bx);
            pg8::EpiProj E{ws};
            pg8::gemm_phase<pg8::EpiProj, pg8::TwoPartOrder, true, true>(lds + RING_OFF, g, S, E);
            TMARK(9); if (BOTH(pbase + 2) || rep_ + 1 < MK_REP_P4) GRID_BAR(); TMARK(4);
        }
#define P5_BODY() do { ArgsP args = KARG(); unsigned char* ws = args->ws; unsigned char* wl = ws + WS_W + (size_t)l * W_LAYER; \
            pg8::Gemm g{(const pb*)(ws + WS_MB), (const pb*)(wl + W_OUT), D, D, 0}; pg8::StaticOrder S; S.init(MP, D, G, bx); \
            pg8::EpiOut E{ws}; \
            pg8::gemm_phase<pg8::EpiOut, pg8::StaticOrder, true, true>(lds + RING_OFF, g, S, E); } while (0)
        if (PH(6) && IN(pbase + 3)) {
#if MK_REP_P5 == 2
            P5_BODY(); GRID_BAR();
#endif
            P5_BODY();
            if (BOTH(pbase + 3)) GRID_BAR(); TMARK(5);
        }
    }
    if (PH(7) && IN(N_PHASES - 1)) {
        ArgsP args = KARG(); unsigned char* ws = args->ws;
        int tid_l = tid; asm volatile("" : "+v"(tid_l)); const int lane = tid_l & 63, wave = __builtin_amdgcn_readfirstlane(tid_l >> 6);
        const bf16* HB = (const bf16*)(ws + WS_HB); const float* fw = args->in[I_FNW];
        const int gw = vcu * NWAVES + wave, NGW = G * NWAVES;
        f32x4 w4[4];
#pragma unroll
        for (int j = 0; j < 4; ++j) w4[j] = ((const GAS f32x4*)fw)[lane + 64 * j];
        for (int row = gw; row < ROW_M; row += NGW) {
            f32x4 v[4]; float s = 0.f;
#pragma unroll
            for (int j = 0; j < 4; ++j) { const unsigned long long w = ((const GAS unsigned long long*)(HB + (size_t)row * D))[lane + 64 * j]; const unsigned lo = (unsigned)w, hi = (unsigned)(w >> 32);
                v[j] = (f32x4){bflo(lo), bfhi(lo), bflo(hi), bfhi(hi)}; s += (v[j].x * v[j].x + v[j].y * v[j].y) + (v[j].z * v[j].z + v[j].w * v[j].w); }
            const float rs = rsqrtf(wave_sum(s) * (1.0f / 1024.0f) + EPS);
            float* o = args->out + (row < ROW_S ? O_YP + (size_t)row * D : O_YS + (size_t)(row - ROW_S) * D);
#pragma unroll
            for (int j = 0; j < 4; ++j) ((GAS f32x4*)o)[lane + 64 * j] = v[j] * rs * w4[j];
        }
    }
#if MK_PROBE
    GRID_BAR(); TMARK(6);
    if (blockIdx.x == 0) {
        __syncthreads();
        const size_t offs[10] = {O_YP, O_YS, O_KP, O_VP, O_CP, O_RP, O_KS, O_VS, O_CS, O_RS};
#pragma unroll
        for (int k = 0; k < 10; ++k) { unsigned long long t = TACC()[k]; if (k == 1) t += TACC()[7]; if (k == 3) t += TACC()[8]; if (k == 4) t += TACC()[9];
            unsigned n = (unsigned)(t / 100ull); if (n > 30000u) n = 30000u;
            unsigned* o = (unsigned*)(KARG()->out + offs[k]); for (unsigned i = tid; i < n; i += NWAVES * 64) o[i] = 0xAAAAAAAAu; }
    }
#endif
#undef IN
#undef BOTH
}

extern "C" void kernel_launch(void* const* d_in, const int* in_sizes, int n_in, void* d_out, int out_size, void* d_ws, size_t ws_size, hipStream_t stream) {
    static int grid = 0;
    if (grid == 0) {
        if (n_in != 25 || (size_t)out_size != O_END || ws_size < WS_END) { fprintf(stderr, "kernel_launch: unexpected shapes (n_in %d, out %d, ws %zu); nothing launched\n", n_in, out_size, ws_size); grid = -1; return; }
        int dev = 0, cus = 0, per_cu = 0;
        if (hipGetDevice(&dev) != hipSuccess || hipDeviceGetAttribute(&cus, hipDeviceAttributeMultiprocessorCount, dev) != hipSuccess) { grid = -1; return; }
        if (hipFuncSetAttribute((const void*)hawk_fwd, hipFuncAttributeMaxDynamicSharedMemorySize, LDS_BYTES) != hipSuccess) { fprintf(stderr, "kernel_launch: hipFuncSetAttribute failed\n"); grid = -1; return; }
        if (hipOccupancyMaxActiveBlocksPerMultiprocessor(&per_cu, (const void*)hawk_fwd, NWAVES * 64, LDS_BYTES) != hipSuccess || per_cu < 1) { fprintf(stderr, "kernel_launch: occupancy query reports %d workgroups per CU\n", per_cu); }
        (void)hipGetLastError();
        grid = cus;
    }
    if (grid < 0) return;
    if (hipMemsetAsync((char*)d_ws + WS_CTL, 0, CTL_ZERO_BYTES, stream) != hipSuccess) return;
    Args a{};
    for (int i = 0; i < 25; ++i) a.in[i] = (const float*)d_in[i];
    a.out = (float*)d_out; a.ws = (unsigned char*)d_ws;
#if MK_PER_PHASE
    for (int p = 0; p < N_PHASES; ++p) { a.ph_lo = p; a.ph_hi = p + 1; a.li = p; hipLaunchKernelGGL(hawk_fwd, dim3(grid), dim3(NWAVES * 64), LDS_BYTES, stream, a); }
#else
    a.ph_lo = 0; a.ph_hi = N_PHASES; a.li = 0;
    hipLaunchKernelGGL(hawk_fwd, dim3(grid), dim3(NWAVES * 64), LDS_BYTES, stream, a);
#endif
    const hipError_t le = hipPeekAtLastError();
    if (le != hipSuccess) fprintf(stderr, "kernel_launch: launch failed: %s\n", hipGetErrorName(le));
}
```

```cpp
#include <hip/hip_runtime.h>
#include <hip/hip_bf16.h>
#include <cstdio>
#include <cstdint>
#include <cmath>

#ifndef MK_PROBE
#define MK_PROBE 0
#endif
#ifndef MK_REP_P0
#define MK_REP_P0 1
#endif
#ifndef MK_REP_P1
#define MK_REP_P1 1
#endif
#ifndef MK_REP_P2
#define MK_REP_P2 1
#endif
#ifndef MK_REP_P3
#define MK_REP_P3 1
#endif
#ifndef MK_REP_P4
#define MK_REP_P4 1
#endif
#ifndef MK_REP_P5
#define MK_REP_P5 1
#endif
#ifndef MK_ALIGN_P1
#define MK_ALIGN_P1 true
#endif
#ifndef MK_EPI2
#define MK_EPI2 0
#endif
#ifndef MK_KPROBE
#define MK_KPROBE 0
#endif
#ifndef MK_STAGGER
#define MK_STAGGER 0
#endif
#ifndef MK_PER_PHASE
#define MK_PER_PHASE 0
#endif

constexpr int D = 1024, NB = 8, SEQ = 4096, DEPTH = 4, NDB = 16, DSQ = 64, PAST = 2048, NMETA = 16, NH = 8, INC = 8192;
constexpr int MP = NB * SEQ;
constexpr int MSM = NDB * DSQ;
constexpr int ROW_S = MP, ROW_M = MP + MSM;
constexpr int M = ROW_M + 256;
constexpr int TP = NMETA + SEQ;
constexpr int KPROWS = 64 + SEQ;
constexpr int KSROWS = PAST + DSQ;
constexpr float EPS = 1e-6f;
constexpr float QSCALE = 0.125f * 1.4426950408889634f;

constexpr size_t O_YP = 0, O_YS = 33554432, O_KP = 34603008, O_VP = 169345024, O_CP = 304087040, O_RP = 304185344,
                 O_KS = 304218112, O_VS = 308412416, O_CS = 312606720, O_RS = 312803328, O_END = 312868864;

constexpr size_t MiB = 1u << 20;
constexpr size_t WS_CTL = 0, CTL_ZERO_BYTES = 1 * MiB;
constexpr size_t WS_TCOS = 1 * MiB, WS_TSIN = 2 * MiB;
constexpr size_t WS_MISC = 3 * MiB;
constexpr size_t WS_W = 4 * MiB, W_LAYER = 24 * MiB, W_IN = 0, W_PROJ = 16 * MiB, W_OUT = 20 * MiB, W_G = 22 * MiB;
constexpr size_t WS_HRES = 100 * MiB;
constexpr size_t WS_HB = 233 * MiB;
constexpr size_t WS_SSQ = 300 * MiB;
constexpr size_t WS_XR = 303 * MiB, WS_ZR = 370 * MiB, WS_Q = 437 * MiB, WS_ZA = 504 * MiB, WS_RHO = 571 * MiB, WS_SGA = 638 * MiB;
constexpr size_t WS_OX = 705 * MiB;
constexpr size_t WS_MB = 838 * MiB;
constexpr size_t WS_OP = 905 * MiB;
constexpr size_t WS_KP = 1038 * MiB, WS_VP = 1103 * MiB;
constexpr size_t WS_KS = 1168 * MiB, WS_VS = 1432 * MiB;
constexpr size_t WS_HRES2 = 1696 * MiB;
constexpr size_t WS_END = 1830 * MiB;
static_assert(WS_HRES + (size_t)M * D * 4 <= WS_HB && WS_HB + (size_t)M * D * 2 <= WS_SSQ && WS_SSQ + (size_t)M * 64 <= WS_XR, "ws map 1");
static_assert(WS_XR + (size_t)M * D * 2 <= WS_ZR && WS_SGA + (size_t)M * D * 2 <= WS_OX && WS_OX + (size_t)M * 4096 <= WS_MB && WS_MB + (size_t)M * 2048 <= WS_OP, "ws map 2");
static_assert(WS_OP + (size_t)M * 4096 <= WS_KP && WS_KP + (size_t)NB * KPROWS * 2048 <= WS_VP && WS_VP + (size_t)NB * KPROWS * 2048 <= WS_KS, "ws map 3");
static_assert(WS_KS + (size_t)DEPTH * NDB * KSROWS * 2048 <= WS_VS && WS_VS + (size_t)DEPTH * NDB * KSROWS * 2048 <= WS_END, "ws map 4");
constexpr int CW_TMO = 0, CW_CODE = 1;
constexpr int CW_QUEUE = 64;
constexpr int CW_BAR = 8192;

struct Args { const float* in[25]; float* out; unsigned char* ws; int ph_lo, ph_hi, li, pad; };
#define CAS __attribute__((address_space(4)))
typedef const CAS struct Args* ArgsP;
#define KARG() ({ ArgsP p_ = (ArgsP)__builtin_amdgcn_kernarg_segment_ptr(); asm volatile("" : "+s"(p_)); p_; })
enum { I_XP = 0, I_XS, I_CK, I_CV, I_SC, I_SR, I_META, I_NW, I_WIN, I_CW, I_CB, I_WRG, I_BRG, I_WIG, I_BIG, I_LAM, I_LQ1, I_LK1, I_LQ2, I_LK2, I_SUBLN, I_WPR, I_WPA, I_WOUT, I_FNW };


namespace pg8 {
#define PG8_LAS __attribute__((address_space(3)))
typedef unsigned short bf16_t;
typedef short bf16x8 __attribute__((ext_vector_type(8)));
typedef float f32x4 __attribute__((ext_vector_type(4)));
typedef unsigned u32x4 __attribute__((ext_vector_type(4)));
typedef unsigned u32x2 __attribute__((ext_vector_type(2)));
constexpr int BM = 256, BK = 64, HALF = 128, HTB = HALF * BK * 2  , STAGE_BYTES = 8 * HTB, NXCD = 8, WGM = 4;

__host__ __device__ __forceinline__ int lds_byte(int r, int c) { const int st = (r >> 4) * 2 + (c >> 5), rr = r & 15, cc = c & 31, ob = rr * 64 + cc * 2; return st * 1024 + (ob ^ (((ob >> 9) & 1) << 5)); }
__host__ __device__ __forceinline__ void stage_rc(int b, int& R, int& C) { const int st = b / 1024, sb = b % 1024, swz = sb ^ (((sb >> 9) & 1) << 5); R = (st >> 1) * 16 + swz / 64; C = (st & 1) * 32 + (swz % 64) / 2; }
__host__ __device__ __forceinline__ int perm32(int rho) { const int n = rho >> 4, i = rho & 15; return 8 * (i >> 2) + 4 * n + (i & 3); }

struct Unit { int pm, pn, kh; };
struct Gemm { const bf16_t* A; const bf16_t* Bt; int ld, kt, ks; };

struct StaticOrder {
    int nM, nN, nwg, G, c;
    __host__ __device__ void init(int M_, int N_, int G_, int c_) { nM = M_ / BM; nN = N_ / BM; nwg = nM * nN; G = G_; c = c_; }
    __host__ __device__ bool next(int i, Unit& u) const {
        const long L = (long)i * G + c; if (L >= nwg) return false;
        int wgid = (int)L; { const int q = nwg / NXCD, r = nwg % NXCD, xcd = wgid % NXCD, off = wgid / NXCD; wgid = (xcd < r ? xcd * (q + 1) : r * (q + 1) + (xcd - r) * q) + off; }
        const int nig = WGM * nN, gid = wgid / nig, fm = gid * WGM, gsz = (nM - fm) < WGM ? (nM - fm) : WGM;
        u.pm = fm + ((wgid % nig) % gsz); u.pn = (wgid % nig) / gsz;
        u.kh = 0; return true;
    }
    __device__ __forceinline__ void a_ready(const Unit&) const {}
    __device__ __forceinline__ void done(const Unit&) const {}
};
struct OneUnit {
    int pm, pn, nk;
    __host__ __device__ bool next(int i, Unit& u) const { if (i >= nk) return false; u.pm = pm; u.pn = pn; u.kh = i; return true; }
    __device__ __forceinline__ void a_ready(const Unit&) const {}
    __device__ __forceinline__ void done(const Unit&) const {}
};
struct TwoPartOrder {
    StaticOrder S;
    __host__ __device__ void init(int M_, int N_, int G_, int c_) { S.init(M_, N_, G_, c_); }
    __host__ __device__ bool next(int i, Unit& u) const { if (!S.next(i >> 1, u)) return false; u.kh = i & 1; return true; }
    __device__ __forceinline__ void a_ready(const Unit&) const {}
    __device__ __forceinline__ void done(const Unit&) const {}
};
__device__ __forceinline__ unsigned cvt_pk_bf16(float lo, float hi) { unsigned r; asm volatile("v_cvt_pk_bf16_f32 %0, %1, %2" : "=v"(r) : "v"(lo), "v"(hi)); return r; }
__device__ __forceinline__ float bf_lo(unsigned w) { return __uint_as_float(w << 16); }
__device__ __forceinline__ float bf_hi(unsigned w) { return __uint_as_float(w & 0xffff0000u); }
__device__ __forceinline__ float sigm(float x) { return __builtin_amdgcn_rcpf(1.0f + __expf(-x)); }
__device__ __forceinline__ u32x4 pack8(const f32x4 a, const f32x4 b) { u32x4 w; w.x = cvt_pk_bf16(a[0], a[1]); w.y = cvt_pk_bf16(a[2], a[3]); w.z = cvt_pk_bf16(b[0], b[1]); w.w = cvt_pk_bf16(b[2], b[3]); return w; }

struct EpiIn {
    static constexpr bool PERM = true, AFTER_DRAIN = false, TWO_PART = (MK_KPROBE != 0);
    int l; unsigned char* ws; float* out;
    __device__ __forceinline__ void mid(f32x4 (&)[2][2][4][2], const Unit&, int, int, int, int) const {}
    __device__ __forceinline__ void operator()(const f32x4 (&acc)[2][2][4][2], const Unit& u, int wr, int wc, int fr_in, int fq_in) const {
        int fr = fr_in, fq = fq_in; asm volatile("" : "+v"(fr), "+v"(fq));
        const float* ssq = (const float*)(ws + WS_SSQ); const float* tcos = (const float*)(ws + WS_TCOS); const float* tsin = (const float*)(ws + WS_TSIN);
        bf16_t* XR = (bf16_t*)(ws + WS_XR); bf16_t* ZR = (bf16_t*)(ws + WS_ZR); bf16_t* Q = (bf16_t*)(ws + WS_Q); bf16_t* ZA = (bf16_t*)(ws + WS_ZA); bf16_t* RHO = (bf16_t*)(ws + WS_RHO); bf16_t* SGA = (bf16_t*)(ws + WS_SGA);
        bf16_t* KP = (bf16_t*)(ws + WS_KP); bf16_t* VP = (bf16_t*)(ws + WS_VP); bf16_t* KS = (bf16_t*)(ws + WS_KS) + (size_t)l * NDB * KSROWS * D; bf16_t* VS = (bf16_t*)(ws + WS_VS) + (size_t)l * NDB * KSROWS * D;
        const int part = u.pn >> 2, pm = u.pm;
        const int ct = (u.pn & 3) * 256 + wc * 32 + 8 * fq;
        const int a = wc & 1;
        float rsv[2][4];
        { f32x4 sq[2][4];
#pragma unroll
          for (int ai = 0; ai < 2; ++ai)
#pragma unroll
            for (int m = 0; m < 4; ++m) sq[ai][m] = *(const f32x4*)(ssq + ((size_t)pm * BM + ai * HALF + wr * 64 + m * 16 + fr) * 16 + 4 * fq);
#pragma unroll
          for (int ai = 0; ai < 2; ++ai)
#pragma unroll
            for (int m = 0; m < 4; ++m) { float t = (sq[ai][m][0] + sq[ai][m][1]) + (sq[ai][m][2] + sq[ai][m][3]); t += __shfl_xor(t, 16); t += __shfl_xor(t, 32); rsv[ai][m] = rsqrtf(t * (1.0f / 1024.0f) + EPS) * (MK_KPROBE ? 0.5f : 1.0f); } }
        asm volatile("" ::: "memory");
#pragma unroll
        for (int ai = 0; ai < 2; ++ai) {
#pragma unroll
            for (int m = 0; m < 4; ++m) {
                const int r = ai * HALF + wr * 64 + m * 16 + fr; const size_t grow = (size_t)pm * BM + r;
                const float rs = rsv[ai][m];
                int pos, nrep = 1; size_t krow, frow; bool valid = true;
                if (pm < 128) { const int b = pm >> 4, t = (pm & 15) * 256 + r; pos = NMETA + t; krow = (size_t)b * KPROWS + 64 + t; frow = (size_t)(l * NB + b) * TP + NMETA + t; }
                else if (pm < 132) { const int idx = (pm - 128) * 256 + r, db = idx >> 6, s = idx & 63; pos = NMETA + PAST + s; krow = (size_t)db * KSROWS + PAST + s; frow = (size_t)(l * NDB + db) * DSQ + s; }
                else { pos = r & 15; krow = (size_t)(r & 15); frow = (size_t)(l * NB) * TP + (r & 15); nrep = NB; valid = r < NMETA; }
                const bool smp = (pm >= 128 && pm < 132);
                if (part == 0) {
                    bf16_t* rowp = XR + grow * D + ct;
#pragma unroll
                    for (int bj = 0; bj < 2; ++bj) { const f32x4 v0 = acc[ai][bj][m][0] * rs, v1 = acc[ai][bj][m][1] * rs; *(u32x4*)(rowp + bj * HALF) = pack8(v0, v1); }
                    if (m == 3 && fr >= 13) {
                        float* dst = nullptr;
                        if (pm < 128) { if ((pm & 15) == 15 && ai == 1 && wr == 1) dst = out + O_CP + ((size_t)(l * NB + (pm >> 4)) * 3 + (fr - 13)) * D; }
                        else if (pm < 132) { const int db = ((pm - 128) * 256 + r) >> 6; dst = out + O_CS + ((size_t)(l * NDB + db) * 3 + (fr - 13)) * D; }
                        if (dst) {
#pragma unroll
                            for (int bj = 0; bj < 2; ++bj) { *(f32x4*)(dst + ct + bj * HALF) = acc[ai][bj][m][0] * rs; *(f32x4*)(dst + ct + bj * HALF + 4) = acc[ai][bj][m][1] * rs; }
                        }
                    }
                } else if (part == 1 || part == 5) {
                    bf16_t* rowp = (part == 1 ? ZR : ZA) + grow * D + ct;
#pragma unroll
                    for (int bj = 0; bj < 2; ++bj) { f32x4 v0 = acc[ai][bj][m][0] * rs, v1 = acc[ai][bj][m][1] * rs;
#pragma unroll
                        for (int e = 0; e < 4; ++e) { v0[e] = v0[e] * sigm(v0[e]); v1[e] = v1[e] * sigm(v1[e]); }
                        *(u32x4*)(rowp + bj * HALF) = pack8(v0, v1); }
                } else if (part == 2 || part == 3) {
                    const size_t ci = (size_t)pos * 32 + 16 * a + 4 * fq; const f32x4 c4 = *(const f32x4*)(tcos + ci), s4 = *(const f32x4*)(tsin + ci);
#pragma unroll
                    for (int bj = 0; bj < 2; ++bj) { const f32x4 x1 = acc[ai][bj][m][0] * rs, x2 = acc[ai][bj][m][1] * rs; const f32x4 o1 = x1 * c4 - x2 * s4, o2 = x2 * c4 + x1 * s4;
                        if (part == 2) { *(u32x4*)(Q + grow * D + ct + bj * HALF) = pack8(o1 * QSCALE, o2 * QSCALE); }
                        else if (valid) {
                            const int oc = 64 * (4 * (u.pn & 3) + 2 * bj + (wc >> 1)) + 16 * a + 4 * fq;
                            const u32x4 w = pack8(o1, o2);
                            bf16_t* kd = (smp ? KS : KP) + krow * D + ct + bj * HALF; float* fd = out + (smp ? O_KS : O_KP) + frow * D + oc;
                            for (int rep = 0; rep < nrep; ++rep) { *(u32x4*)(kd + (size_t)rep * KPROWS * D) = w; *(f32x4*)(fd + (size_t)rep * TP * D) = o1; *(f32x4*)(fd + (size_t)rep * TP * D + 32) = o2; }
                        } }
                } else if (part == 4) {
                    if (valid) {
#pragma unroll
                        for (int bj = 0; bj < 2; ++bj) { const f32x4 v0 = acc[ai][bj][m][0] * rs, v1 = acc[ai][bj][m][1] * rs; const u32x4 w = pack8(v0, v1);
                            bf16_t* vd = (smp ? VS : VP) + krow * D + ct + bj * HALF; float* fd = out + (smp ? O_VS : O_VP) + frow * D + ct + bj * HALF;
                            for (int rep = 0; rep < nrep; ++rep) { *(u32x4*)(vd + (size_t)rep * KPROWS * D) = w; *(f32x4*)(fd + (size_t)rep * TP * D) = v0; *(f32x4*)(fd + (size_t)rep * TP * D + 4) = v1; } }
                    }
                } else {
                    const int gc = 128 * (u.pn - 24) + wc * 32 + 8 * fq;
                    f32x4 rho[2], sga[2];
#pragma unroll
                    for (int n = 0; n < 2; ++n) { const f32x4 gr = acc[ai][0][m][n] * rs, ga = acc[ai][1][m][n] * rs;
#pragma unroll
                        for (int e = 0; e < 4; ++e) { const float er = __expf(-fminf(fmaxf(gr[e], -30.f), 30.f)), ea = __expf(-fminf(fmaxf(ga[e], -30.f), 30.f));
                            rho[n][e] = (1.0f + ea) * __builtin_amdgcn_rcpf(1.0f + er); sga[n][e] = __builtin_amdgcn_rcpf(1.0f + ea); } }
                    *(u32x4*)(RHO + grow * D + gc) = pack8(rho[0], rho[1]); *(u32x4*)(SGA + grow * D + gc) = pack8(sga[0], sga[1]);
                }
                asm volatile("" ::: "memory");
            }
        }
    }
};

struct EpiProj {
    static constexpr bool PERM = true, AFTER_DRAIN = false, TWO_PART = true;
    unsigned char* ws;
    __device__ __forceinline__ void mid(f32x4 (&acc)[2][2][4][2], const Unit& u, int wr, int wc, int fr_in, int fq_in) const {
        int fr = fr_in, fq = fq_in; asm volatile("" : "+v"(fr), "+v"(fq));
        const bf16_t* RHO = (const bf16_t*)(ws + WS_RHO);
        const int c0 = u.pn * BM + wc * 32 + 8 * fq;
        u32x4 wv[2][4][2];
#pragma unroll
        for (int ai = 0; ai < 2; ++ai)
#pragma unroll
            for (int m = 0; m < 4; ++m)
#pragma unroll
                for (int bj = 0; bj < 2; ++bj) wv[ai][m][bj] = *(const u32x4*)(RHO + ((size_t)u.pm * BM + ai * HALF + wr * 64 + m * 16 + fr) * D + c0 + bj * HALF);
#pragma unroll
        for (int ai = 0; ai < 2; ++ai)
#pragma unroll
            for (int m = 0; m < 4; ++m)
#pragma unroll
                for (int bj = 0; bj < 2; ++bj) { const u32x4 w = wv[ai][m][bj];
                    acc[ai][bj][m][0] *= (f32x4){bf_lo(w.x), bf_hi(w.x), bf_lo(w.y), bf_hi(w.y)}; acc[ai][bj][m][1] *= (f32x4){bf_lo(w.z), bf_hi(w.z), bf_lo(w.w), bf_hi(w.w)}; }
    }
    __device__ __forceinline__ void operator()(const f32x4 (&acc)[2][2][4][2], const Unit& u, int wr, int wc, int fr_in, int fq_in) const {
        int fr = fr_in, fq = fq_in; asm volatile("" : "+v"(fr), "+v"(fq));
        const bf16_t* SGA = (const bf16_t*)(ws + WS_SGA); bf16_t* MB = (bf16_t*)(ws + WS_MB);
        const int c0 = u.pn * BM + wc * 32 + 8 * fq;
        u32x4 wv[2][4][2];
#pragma unroll
        for (int ai = 0; ai < 2; ++ai)
#pragma unroll
            for (int m = 0; m < 4; ++m)
#pragma unroll
                for (int bj = 0; bj < 2; ++bj) wv[ai][m][bj] = *(const u32x4*)(SGA + ((size_t)u.pm * BM + ai * HALF + wr * 64 + m * 16 + fr) * D + c0 + bj * HALF);
        asm volatile("" ::: "memory");
#pragma unroll
        for (int ai = 0; ai < 2; ++ai)
#pragma unroll
            for (int m = 0; m < 4; ++m) { const size_t grow = (size_t)u.pm * BM + ai * HALF + wr * 64 + m * 16 + fr;
#pragma unroll
                for (int bj = 0; bj < 2; ++bj) { const u32x4 w = wv[ai][m][bj];
                    const f32x4 v0 = acc[ai][bj][m][0] * (f32x4){bf_lo(w.x), bf_hi(w.x), bf_lo(w.y), bf_hi(w.y)}, v1 = acc[ai][bj][m][1] * (f32x4){bf_lo(w.z), bf_hi(w.z), bf_lo(w.w), bf_hi(w.w)};
                    *(u32x4*)(MB + grow * D + c0 + bj * HALF) = pack8(v0, v1); }
                if (m & 1) asm volatile("" ::: "memory"); }
    }
};

struct EpiOut {
    static constexpr bool PERM = true, AFTER_DRAIN = false, TWO_PART = false;
    unsigned char* ws;
    __device__ __forceinline__ void mid(f32x4 (&)[2][2][4][2], const Unit&, int, int, int, int) const {}
    __device__ __forceinline__ void operator()(const f32x4 (&acc)[2][2][4][2], const Unit& u, int wr, int wc, int fr_in, int fq_in) const {
        int fr = fr_in, fq = fq_in; asm volatile("" : "+v"(fr), "+v"(fq));
        bf16_t* HB = (bf16_t*)(ws + WS_HB); float* ssq = (float*)(ws + WS_SSQ);
        const int c0 = u.pn * BM + wc * 32 + 8 * fq;
        u32x4 hin[2][4][2];
#pragma unroll
        for (int ai = 0; ai < 2; ++ai)
#pragma unroll
            for (int m = 0; m < 4; ++m)
#pragma unroll
                for (int bj = 0; bj < 2; ++bj) hin[ai][m][bj] = *(const u32x4*)(HB + ((size_t)u.pm * BM + ai * HALF + wr * 64 + m * 16 + fr) * D + c0 + bj * HALF);
        asm volatile("" ::: "memory");
#pragma unroll
        for (int ai = 0; ai < 2; ++ai)
#pragma unroll
            for (int m = 0; m < 4; ++m) { const size_t grow = (size_t)u.pm * BM + ai * HALF + wr * 64 + m * 16 + fr; float ss = 0.f;
#pragma unroll
                for (int bj = 0; bj < 2; ++bj) { const u32x4 w = hin[ai][m][bj];
                    const f32x4 v0 = (f32x4){bf_lo(w.x), bf_hi(w.x), bf_lo(w.y), bf_hi(w.y)} + acc[ai][bj][m][0], v1 = (f32x4){bf_lo(w.z), bf_hi(w.z), bf_lo(w.w), bf_hi(w.w)} + acc[ai][bj][m][1];
                    *(u32x4*)(HB + grow * D + c0 + bj * HALF) = pack8(v0, v1);
                    ss += ((v0[0] * v0[0] + v0[1] * v0[1]) + (v0[2] * v0[2] + v0[3] * v0[3])) + ((v1[0] * v1[0] + v1[1] * v1[1]) + (v1[2] * v1[2] + v1[3] * v1[3])); }
                ss += __shfl_xor(ss, 16); ss += __shfl_xor(ss, 32);
                if (fq == 0) ssq[grow * 16 + u.pn * 4 + wc] = ss;
            }
    }
};
template <class Epi, class Sched, bool ALIGN_EPI = false, bool SP2 = false>
__device__ __forceinline__ void gemm_phase(PG8_LAS unsigned char* lds, const Gemm g, const Sched& S, const Epi& E) {
    int tid_o = threadIdx.x; asm volatile("" : "+v"(tid_o));
    const int tid = tid_o, wid = __builtin_amdgcn_readfirstlane(tid >> 6), lane = tid & 63, wr = wid >> 2, wc = wid & 3, fr = lane & 15, fq = lane >> 4;
    const int K = g.ld, nt = g.kt / BK; const size_t khb = (size_t)g.ks * 2;
    unsigned voffA[2], voffB[2];
#pragma unroll
    for (int i = 0; i < 2; ++i) { int R, C; stage_rc(tid * 16 + i * 8192, R, C); const int Rb = Epi::PERM ? ((R & ~31) + perm32(R & 31)) : R;
        voffA[i] = (unsigned)(R * K + C) * 2u; voffB[i] = (unsigned)(Rb * K + C) * 2u; }
    const size_t kstep = (size_t)(BK * 2);
    const size_t hstep = (size_t)HALF * K * 2;
    const size_t tstep = 2 * hstep;
    const unsigned ldsw = (unsigned)wid * 1024u;
    const int aoff = lds_byte(wr * 64 + fr, fq * 8), boff = lds_byte(wc * 32 + fr, fq * 8);
#define PG8_SA(b, h) (((b) * 2 + (h)) * HTB)
#define PG8_SB(b, h) ((4 + (b) * 2 + (h)) * HTB)
#define PG8_STAGE(bufoff, gbase, voff) do { _Pragma("unroll") for (int _i = 0; _i < 2; ++_i) \
        __builtin_amdgcn_global_load_lds((const unsigned*)((const char*)(gbase) + (voff)[_i]), (PG8_LAS unsigned*)(lds + (bufoff) + ldsw + _i * 8192), 16, 0, 0); } while (0)
#define PG8_LDA(dst, b, h) do { _Pragma("unroll") for (int m = 0; m < 4; ++m) _Pragma("unroll") for (int k = 0; k < 2; ++k) dst[m][k] = *(const PG8_LAS bf16x8*)(lds + PG8_SA(b, h) + aoff + m * 2048 + k * 1024); } while (0)
#define PG8_LDB(dst, b, h) do { _Pragma("unroll") for (int n = 0; n < 2; ++n) _Pragma("unroll") for (int k = 0; k < 2; ++k) dst[n][k] = *(const PG8_LAS bf16x8*)(lds + PG8_SB(b, h) + boff + n * 2048 + k * 1024); } while (0)
#define PG8_MMA(ai, bj, At, Bt) do { __builtin_amdgcn_s_setprio(1); _Pragma("unroll") for (int m = 0; m < 4; ++m) _Pragma("unroll") for (int n = 0; n < 2; ++n) _Pragma("unroll") for (int k = 0; k < 2; ++k) \
        acc[ai][bj][m][n] = __builtin_amdgcn_mfma_f32_16x16x32_bf16(Bt[n][k], At[m][k], acc[ai][bj][m][n], 0, 0, 0); __builtin_amdgcn_s_setprio(0); } while (0)
#define PG8_WAIT_V(n) asm volatile("s_waitcnt vmcnt(" #n ")" ::: "memory")
#define PG8_WAIT_L(n) asm volatile("s_waitcnt lgkmcnt(" #n ")" ::: "memory")
#define PG8_BAR __builtin_amdgcn_s_barrier()
#define PG8_SCHED __builtin_amdgcn_sched_barrier(0)
    Unit cur, nxt; int ui = 0;
    if (!S.next(0, cur)) return;
    f32x4 acc[2][2][4][2];
#pragma unroll
    for (int a = 0; a < 2; ++a)
#pragma unroll
        for (int b = 0; b < 2; ++b)
#pragma unroll
            for (int m = 0; m < 4; ++m)
#pragma unroll
                for (int n = 0; n < 2; ++n) acc[a][b][m][n] = (f32x4){0.f, 0.f, 0.f, 0.f};
    bf16x8 At[4][2], B0[2][2], B1[2][2];
    const char* cA = (const char*)g.A + (size_t)cur.pm * tstep + (size_t)cur.kh * khb; const char* cB = (const char*)g.Bt + (size_t)cur.pn * tstep + (size_t)cur.kh * khb;
    S.a_ready(cur);
    if constexpr (SP2) {
        PG8_STAGE(PG8_SB(0, 0), cB, voffB); PG8_STAGE(PG8_SB(0, 1), cB + hstep, voffB); PG8_STAGE(PG8_SA(0, 0), cA, voffA); PG8_STAGE(PG8_SA(0, 1), cA + hstep, voffA);
        if (wr == 1) PG8_BAR;
        PG8_WAIT_V(2); PG8_BAR;
        PG8_STAGE(PG8_SB(1, 0), cB + kstep, voffB); PG8_STAGE(PG8_SA(1, 0), cA + kstep, voffA); PG8_STAGE(PG8_SB(1, 1), cB + hstep + kstep, voffB);
        PG8_WAIT_V(6); PG8_BAR;
    } else {
        PG8_STAGE(PG8_SB(0, 0), cB, voffB); PG8_STAGE(PG8_SA(0, 0), cA, voffA); PG8_STAGE(PG8_SB(0, 1), cB + hstep, voffB); PG8_STAGE(PG8_SA(0, 1), cA + hstep, voffA);
        if (wr == 1) PG8_BAR;
        PG8_WAIT_V(4); PG8_BAR;
        PG8_STAGE(PG8_SB(1, 0), cB + kstep, voffB); PG8_STAGE(PG8_SA(1, 0), cA + kstep, voffA); PG8_STAGE(PG8_SB(1, 1), cB + hstep + kstep, voffB);
        PG8_WAIT_V(6); PG8_BAR;
    }
    for (;;) {
        const bool has_next = S.next(ui + 1, nxt);
        const char* nA = has_next ? (const char*)g.A + (size_t)nxt.pm * tstep + (size_t)nxt.kh * khb : cA; const char* nB = has_next ? (const char*)g.Bt + (size_t)nxt.pn * tstep + (size_t)nxt.kh * khb : cB;
        for (int t = 0; t < nt; t += 2) {
            const bool last = (t == nt - 2);
            const char* a1 = cA + (size_t)(t + 1) * kstep;
            const char* a2 = last ? nA : cA + (size_t)(t + 2) * kstep; const char* b2 = last ? nB : cB + (size_t)(t + 2) * kstep;
            const char* a3 = a2 + kstep; const char* b3 = b2 + kstep;
            if (last && has_next) S.a_ready(nxt);
            if constexpr (SP2) {
            PG8_LDB(B0, 0, 0); PG8_LDB(B1, 0, 1); PG8_SCHED; PG8_LDA(At, 0, 0); PG8_STAGE(PG8_SA(1, 1), a1 + hstep, voffA);
            PG8_WAIT_V(8); PG8_WAIT_L(0); PG8_BAR; PG8_MMA(0, 0, At, B0); PG8_MMA(0, 1, At, B1); PG8_BAR; PG8_SCHED;
            PG8_LDA(At, 0, 1); PG8_STAGE(PG8_SB(0, 0), b2, voffB); PG8_STAGE(PG8_SB(0, 1), b2 + hstep, voffB); PG8_STAGE(PG8_SA(0, 0), a2, voffA);
            PG8_WAIT_V(8); PG8_WAIT_L(0); PG8_BAR; PG8_MMA(1, 0, At, B0); PG8_MMA(1, 1, At, B1); PG8_BAR; PG8_SCHED;
            PG8_LDB(B0, 1, 0); PG8_LDB(B1, 1, 1); PG8_SCHED; PG8_LDA(At, 1, 0); PG8_STAGE(PG8_SA(0, 1), a2 + hstep, voffA);
            PG8_WAIT_V(8); PG8_WAIT_L(0); PG8_BAR; PG8_MMA(0, 0, At, B0); PG8_MMA(0, 1, At, B1); PG8_BAR; PG8_SCHED;
            PG8_LDA(At, 1, 1); PG8_STAGE(PG8_SB(1, 0), b3, voffB); PG8_STAGE(PG8_SB(1, 1), b3 + hstep, voffB); PG8_STAGE(PG8_SA(1, 0), a3, voffA);
            PG8_WAIT_V(8); PG8_WAIT_L(0); PG8_BAR; PG8_MMA(1, 0, At, B0); PG8_MMA(1, 1, At, B1); PG8_BAR; PG8_SCHED;
            } else {
            PG8_LDB(B0, 0, 0); PG8_SCHED; PG8_LDA(At, 0, 0); PG8_STAGE(PG8_SA(1, 1), a1 + hstep, voffA);
            PG8_WAIT_L(8); PG8_BAR; PG8_WAIT_L(0); PG8_MMA(0, 0, At, B0); PG8_BAR; PG8_SCHED;
            PG8_LDB(B1, 0, 1); PG8_STAGE(PG8_SB(0, 0), b2, voffB);
            PG8_BAR; PG8_WAIT_L(0); PG8_MMA(0, 1, At, B1); PG8_BAR;
            PG8_LDA(At, 0, 1); PG8_STAGE(PG8_SA(0, 0), a2, voffA);
            PG8_BAR; PG8_WAIT_L(0); PG8_MMA(1, 0, At, B0); PG8_BAR; PG8_SCHED;
            PG8_STAGE(PG8_SB(0, 1), b2 + hstep, voffB);
            PG8_WAIT_V(6); PG8_BAR; PG8_MMA(1, 1, At, B1); PG8_BAR;
            PG8_LDB(B0, 1, 0); PG8_SCHED; PG8_LDA(At, 1, 0); PG8_STAGE(PG8_SA(0, 1), a2 + hstep, voffA);
            PG8_WAIT_L(8); PG8_BAR; PG8_WAIT_L(0); PG8_MMA(0, 0, At, B0); PG8_BAR; PG8_SCHED;
            PG8_LDB(B1, 1, 1); PG8_STAGE(PG8_SB(1, 0), b3, voffB);
            PG8_BAR; PG8_WAIT_L(0); PG8_MMA(0, 1, At, B1); PG8_BAR;
            PG8_LDA(At, 1, 1); PG8_STAGE(PG8_SA(1, 0), a3, voffA);
            PG8_BAR; PG8_WAIT_L(0); PG8_MMA(1, 0, At, B0); PG8_BAR; PG8_SCHED;
            PG8_STAGE(PG8_SB(1, 1), b3 + hstep, voffB);
            PG8_WAIT_V(6); PG8_BAR; PG8_MMA(1, 1, At, B1); PG8_BAR;
            }
        }
        if constexpr (ALIGN_EPI) { if (wr == 0) PG8_BAR; }
        bool keep = false;
        if constexpr (Epi::TWO_PART) { if (cur.kh == 0) { E.mid(acc, cur, wr, wc, fr, fq); keep = true; } else { E(acc, cur, wr, wc, fr, fq); } } else { E(acc, cur, wr, wc, fr, fq); }
        S.done(cur);
        if (!has_next) break;
        if (!keep) {
#pragma unroll
        for (int a = 0; a < 2; ++a)
#pragma unroll
            for (int b = 0; b < 2; ++b)
#pragma unroll
                for (int m = 0; m < 4; ++m)
#pragma unroll
                    for (int n = 0; n < 2; ++n) acc[a][b][m][n] = (f32x4){0.f, 0.f, 0.f, 0.f};
        }
        cur = nxt; cA = nA; cB = nB; ++ui;
        if constexpr (ALIGN_EPI) { if (wr == 1) PG8_BAR; }
    }
    PG8_WAIT_V(0);
    if constexpr (!ALIGN_EPI) { if (wr == 0) PG8_BAR; }
    PG8_BAR;
#undef PG8_SA
#undef PG8_SB
#undef PG8_STAGE
#undef PG8_LDA
#undef PG8_LDB
#undef PG8_MMA
#undef PG8_WAIT_V
#undef PG8_WAIT_L
#undef PG8_BAR
#undef PG8_SCHED
}
}

#include <hip/hip_bf16.h>
#include <cmath>
namespace attn_body {
using bf16=__hip_bfloat16;
using bf16x8=__attribute__((ext_vector_type(8)))short;
using s16x4=__attribute__((ext_vector_type(4)))short;
using f32x16=__attribute__((ext_vector_type(16)))float;
using u32x4=__attribute__((ext_vector_type(4)))unsigned;
constexpr int D=64,DM=1024,OPITCH=2048;
constexpr int NW=8,QBLK=32,QB=QBLK*NW,KVBLK=64;
constexpr int ATTN_PITCH=DM, ATTN_UNIT_ROWS=QB;
__device__ __forceinline__ int crow(int r,int hi){return (r&3)+8*(r>>2)+4*hi;}
#define SBAR() __builtin_amdgcn_sched_barrier(0)
__device__ __forceinline__ void cmask(f32x16&p0,f32x16&p1,int jb,int qrel,int hi){
  const float NEG=-INFINITY; int kb=64*jb+4*hi;
  #pragma unroll
  for(int r=0;r<16;++r){int kv=kb+(r&3)+8*(r>>2); if(kv>qrel)p0[r]=NEG; if(kv+32>qrel)p1[r]=NEG;}
}

constexpr int NSLOT=3, SLOTB=8192;
constexpr int LDS_K=0, LDS_V=NSLOT*SLOTB, LDS_WS=2*NSLOT*SLOTB, LDS_OST=LDS_WS+NW*64*4, LDS_BYTES=LDS_OST+NW*4096;
constexpr float C2=0.125f*1.4426950408889634f;
__device__ __forceinline__ void glds16(const void*gsrc,unsigned lds_dst){unsigned keep;
  asm volatile("s_mov_b32 %0, m0\n\ts_mov_b32 m0, %2\n\ts_nop 0\n\tglobal_load_lds_dwordx4 %1, off\n\ts_mov_b32 m0, %0":"=&s"(keep):"v"(gsrc),"s"(lds_dst):"memory");}
__device__ __forceinline__ float max3f(float a,float b,float c){float r;asm("v_max3_f32 %0, %1, %2, %3":"=v"(r):"v"(a),"v"(b),"v"(c));return r;}
__device__ __forceinline__ float max2f(float a,float b){float r;asm("v_max_f32_e32 %0, %1, %2":"=v"(r):"v"(a),"v"(b));return r;}
__device__ __forceinline__ float fadd_s(float a,float b){float r;asm("v_add_f32_e32 %0, %1, %2":"=v"(r):"v"(a),"v"(b));return r;}
__device__ __forceinline__ float fsub_s(float a,float b){float r;asm("v_sub_f32_e32 %0, %1, %2":"=v"(r):"v"(a),"v"(b));return r;}
typedef float f32x2_t __attribute__((ext_vector_type(2))); typedef __bf16 bf16x2_t __attribute__((ext_vector_type(2)));
__device__ __forceinline__ unsigned cvtpk_s(float lo,float hi){f32x2_t v={lo,hi};bf16x2_t b=__builtin_convertvector(v,bf16x2_t);return __builtin_bit_cast(unsigned,b);}
#define WAIT_BAR(N) asm volatile("s_waitcnt vmcnt(" #N ") lgkmcnt(0)\n\ts_barrier":::"memory")

__device__ __forceinline__ void qkt(f32x16&p0,f32x16&p1,const char*Kslot,const bf16x8*qr,const f32x16&negm,int r32,int hi){
  const char*kb=Kslot+hi*1024+r32*16;
  #pragma unroll
  for(int d0=0;d0<4;++d0){
    const bf16x8 b0=*reinterpret_cast<const bf16x8*>(kb+d0*2048);
    const bf16x8 b1=*reinterpret_cast<const bf16x8*>(kb+d0*2048+512);
    if(d0==0){p0=__builtin_amdgcn_mfma_f32_32x32x16_bf16(b0,qr[0],negm,0,0,0);p1=__builtin_amdgcn_mfma_f32_32x32x16_bf16(b1,qr[0],negm,0,0,0);}
    else{p0=__builtin_amdgcn_mfma_f32_32x32x16_bf16(b0,qr[d0],p0,0,0,0);p1=__builtin_amdgcn_mfma_f32_32x32x16_bf16(b1,qr[d0],p1,0,0,0);}}
}
typedef __attribute__((address_space(3))) const char* lds_cptr;
typedef short v4i16_t __attribute__((ext_vector_type(4)));
__device__ __forceinline__ void kload8(bf16x8*kf,lds_cptr kp){
  kf[0]=*(const __attribute__((address_space(3))) bf16x8*)(kp);      kf[1]=*(const __attribute__((address_space(3))) bf16x8*)(kp+512);
  kf[2]=*(const __attribute__((address_space(3))) bf16x8*)(kp+2048); kf[3]=*(const __attribute__((address_space(3))) bf16x8*)(kp+2560);
  kf[4]=*(const __attribute__((address_space(3))) bf16x8*)(kp+4096); kf[5]=*(const __attribute__((address_space(3))) bf16x8*)(kp+4608);
  kf[6]=*(const __attribute__((address_space(3))) bf16x8*)(kp+6144); kf[7]=*(const __attribute__((address_space(3))) bf16x8*)(kp+6656);
}
__device__ __forceinline__ void kload2(bf16x8*kf,lds_cptr kp,int j){ kf[2*j]=*(const __attribute__((address_space(3))) bf16x8*)(kp+j*2048); kf[2*j+1]=*(const __attribute__((address_space(3))) bf16x8*)(kp+j*2048+512); }
__device__ __forceinline__ s16x4 vtr(lds_cptr p){ return __builtin_bit_cast(s16x4,__builtin_amdgcn_ds_read_tr16_b64_v4i16((__attribute__((address_space(3))) v4i16_t*)p)); }
__device__ __forceinline__ float rowmax(const f32x16&p0,const f32x16&p1){
  float a=max3f(p0[0],p0[1],p1[0]),b=max3f(p0[2],p0[3],p1[1]);a=max3f(a,p1[2],p1[3]);
  #pragma unroll
  for(int r=4;r<16;r+=4){a=max3f(a,p0[r],p0[r+1]);b=max3f(b,p0[r+2],p0[r+3]);a=max3f(a,p1[r],p1[r+1]);b=max3f(b,p1[r+2],p1[r+3]);}
  const float m=max2f(a,b);
  auto rr=__builtin_amdgcn_permlane32_swap(__float_as_uint(m),__float_as_uint(m),false,false);
  return max2f(__uint_as_float(rr[0]),__uint_as_float(rr[1]));
}
__device__ __forceinline__ void pv(f32x16*o,int vb,bf16x8 pa0,bf16x8 pa1,bf16x8 pa2,bf16x8 pa3){
  #pragma unroll
  for(int d0=0;d0<2;++d0){s16x4 lo[4],hi[4];
    #pragma unroll
    for(int ks=0;ks<4;++ks){
      asm volatile("ds_read_b64_tr_b16 %0,%1 offset:%c2":"=&v"(lo[ks]):"v"(vb),"i"(d0*4096+ks*1024):"memory");
      asm volatile("ds_read_b64_tr_b16 %0,%1 offset:%c2":"=&v"(hi[ks]):"v"(vb),"i"(d0*4096+ks*1024+512):"memory");}
    asm volatile("s_waitcnt lgkmcnt(0)":::"memory");SBAR();
    #define PK(k) (bf16x8){lo[k][0],lo[k][1],lo[k][2],lo[k][3],hi[k][0],hi[k][1],hi[k][2],hi[k][3]}
    o[d0]=__builtin_amdgcn_mfma_f32_32x32x16_bf16(pa0,PK(0),o[d0],0,0,0);
    o[d0]=__builtin_amdgcn_mfma_f32_32x32x16_bf16(pa1,PK(1),o[d0],0,0,0);
    o[d0]=__builtin_amdgcn_mfma_f32_32x32x16_bf16(pa2,PK(2),o[d0],0,0,0);
    o[d0]=__builtin_amdgcn_mfma_f32_32x32x16_bf16(pa3,PK(3),o[d0],0,0,0);
    #undef PK
  }
}

#ifndef ATTN_STORE16
#define ATTN_STORE16(p,v) (*(u32x4*)(p)=(v))
#endif
template<int THRL,bool MASKED> __device__ __forceinline__ void attn_unit(const bf16*Qin,const bf16*__restrict__ Kh,const bf16*__restrict__ Vh,bf16*Oin,const int NT,const int vis,const int qwaves,char*shm){
  int tid_o=threadIdx.x; asm volatile("":"+v"(tid_o));
  const int tid=tid_o,lane=tid&63,r32=lane&31,hi=lane>>5; const int wid=__builtin_amdgcn_readfirstlane(tid>>6);
  const bf16*Qw=Qin+(long)((wid&(qwaves-1))*QBLK)*DM;
  const unsigned lds0=(unsigned)(uintptr_t)shm;
  float*wsf=(float*)(shm+LDS_WS)+wid*64;
  const bf16*ksrc=Kh+(long)lane*DM+wid*8;
  const bf16*vsrc=Vh+(long)(16*(wid&3)+(lane>>2))*DM+(wid>>2)*32+(lane&3)*8;
  const unsigned kdst=lds0+LDS_K+wid*1024, vdst=lds0+LDS_V+wid*1024;
  #define DMA_K(t,slot) glds16(ksrc+(long)(t)*KVBLK*DM,(unsigned)__builtin_amdgcn_readfirstlane(kdst+(slot)))
  #define DMA_V(t,slot) glds16(vsrc+(long)(t)*KVBLK*DM,(unsigned)__builtin_amdgcn_readfirstlane(vdst+(slot)))
  const int vb0=(int)(lds0+LDS_V)+((lane>>4)&1)*32+(lane&3)*8+(4*hi+((lane&15)>>2))*64;
  const char*Kbase=shm+LDS_K; bf16x8 kf[8];
  const lds_cptr shm3=(lds_cptr)shm; const lds_cptr kp0=shm3+LDS_K+hi*1024+r32*16; const lds_cptr vp0=shm3+LDS_V+((lane>>4)&1)*32+(lane&3)*8+(4*hi+((lane&15)>>2))*64;
  DMA_K(0,0);DMA_V(0,0);DMA_K(1,SLOTB);
  bf16x8 qr[4];
  #pragma unroll
  for(int d0=0;d0<4;++d0)qr[d0]=*reinterpret_cast<const bf16x8*>(&Qw[(long)r32*DM+d0*16+hi*8]);
  float mhat=0.f,l_reg=0.f;f32x16 o[2];o[0]=f32x16{};o[1]=f32x16{};f32x16 negm=f32x16{};asm volatile("":"+v"(negm));
  #define CMASK(P0,P1,t) do{ if(MASKED){ const int jb_=(t)-(NT-4); if(jb_>=vis){ _Pragma("unroll") for(int r_=0;r_<16;++r_){P0[r_]=-INFINITY;P1[r_]=-INFINITY;} } } }while(0)
  bool resc=false;
  #define START(P0,P1) do{ const float rm=rowmax(P0,P1); resc=false; \
    { const float dl=rm; mhat=fadd_s(mhat,dl); \
      _Pragma("unroll") for(int r=0;r<16;++r){P0[r]=fsub_s(P0[r],dl);P1[r]=fsub_s(P1[r],dl);} \
      _Pragma("unroll") for(int r=0;r<16;++r)negm[r]=-mhat; asm volatile("":"+v"(negm)); } \
    _Pragma("unroll") for(int r=0;r<16;++r)P0[r]=__builtin_amdgcn_exp2f(P0[r]); }while(0)
  #define RESC() do{ if(resc){ asm volatile("s_waitcnt lgkmcnt(0)":::"memory"); \
      _Pragma("unroll") for(int d_=0;d_<2;++d_) _Pragma("unroll") for(int r=0;r<16;++r)o[d_][r]*=wsf[crow(r,hi)]; } }while(0)
  f32x16 pA0,pA1,pB0,pB1;
  int sl_prev=0,sl_cur=0,sl_next=SLOTB;
  #define ROT() do{sl_prev=sl_cur;sl_cur=sl_next;sl_next=(sl_next==(NSLOT-1)*SLOTB)?0:sl_next+SLOTB;}while(0)
  DMA_K(2,2*SLOTB);
  WAIT_BAR(3);
  qkt(pA0,pA1,Kbase,qr,negm,r32,hi);asm volatile("s_nop 15\n\ts_nop 7":"+v"(pA0),"+v"(pA1));
  if(MASKED){ _Pragma("unroll") for(int r_=8;r_<16;++r_)pA0[r_]=-INFINITY; _Pragma("unroll") for(int r_=0;r_<16;++r_)pA1[r_]=-INFINITY; }
  START(pA0,pA1);
  _Pragma("unroll") for(int r=0;r<16;++r)pA1[r]=__builtin_amdgcn_exp2f(pA1[r]);
  WAIT_BAR(0);
  DMA_K(3,0);DMA_V(1,SLOTB);
  ROT();
  kload8(kf,kp0+sl_cur);
  WAIT_BAR(2);
  s16x4 vlo[8],vhi[8]; u32x4 pw0,pw1,pw2,pw3;
  #define PKW(P,B) cvtpk_s(P[B],P[B+1])
  #define PAF(k) __builtin_bit_cast(bf16x8,pw##k)
  #define VFR(i) (bf16x8){vlo[i][0],vlo[i][1],vlo[i][2],vlo[i][3],vhi[i][0],vhi[i][1],vhi[i][2],vhi[i][3]}
  #define PIN(x) asm volatile("":"+v"(x))
  #define MX3(a,b,c) __builtin_fmaxf(__builtin_fmaxf((a),(b)),(c))
  #define GAPA(MF,A0,A1,A2,A3,W0,W1,PW) do{ MF; sacc+=A0; sacc+=A1; sacc+=A2; sacc+=A3; PIN(sacc); W0; W1; PIN(PW); SBAR(); }while(0)
  #define EX(v) __builtin_amdgcn_exp2f(v)
  #define GAPB(MF,X,B) do{ MF; X[B]=EX(X[B]); X[B+1]=EX(X[B+1]); X[B+2]=EX(X[B+2]); X[B+3]=EX(X[B+3]); PIN(X); SBAR(); }while(0)
  #define VRD(i) do{ vlo[i]=vtr(vp_+(((i)>>2)*4096+((i)&3)*1024)); vhi[i]=vtr(vp_+(((i)>>2)*4096+((i)&3)*1024+512)); }while(0)
  #define KRD(G,j) do{ if(G){ kload2(kf,kp0+sl_next,j); SBAR(); } }while(0)
  #define STEP(C0,C1,P0,P1,t,GK,GV,GL) do{ SBAR(); \
    const lds_cptr vp_=vp0+sl_prev; \
    VRD(0); SBAR(); float sacc=(P0[0]+P0[1]); \
    GAPA(C0=__builtin_amdgcn_mfma_f32_32x32x16_bf16(kf[0],qr[0],negm,0,0,0), P0[2],P0[3],P0[4],P0[5],     pw0[0]=PKW(P0,0), pw0[1]=PKW(P0,2), pw0); \
    VRD(4); SBAR(); GAPA(C1=__builtin_amdgcn_mfma_f32_32x32x16_bf16(kf[1],qr[0],negm,0,0,0), P0[6],P0[7],P0[8],P0[9],     pw0[2]=PKW(P0,4), pw0[3]=PKW(P0,6), pw0); \
    VRD(1); SBAR(); GAPA(C0=__builtin_amdgcn_mfma_f32_32x32x16_bf16(kf[2],qr[1],C0,0,0,0),   P0[10],P0[11],P0[12],P0[13], pw1[0]=PKW(P0,8), pw1[1]=PKW(P0,10), pw1); \
    VRD(5); SBAR(); GAPA(C1=__builtin_amdgcn_mfma_f32_32x32x16_bf16(kf[3],qr[1],C1,0,0,0),   P0[14],P0[15],P1[0],P1[1],   pw1[2]=PKW(P0,12),pw1[3]=PKW(P0,14), pw1); \
    VRD(2); SBAR(); GAPA(C0=__builtin_amdgcn_mfma_f32_32x32x16_bf16(kf[4],qr[2],C0,0,0,0),   P1[2],P1[3],P1[4],P1[5],     pw2[0]=PKW(P1,0), pw2[1]=PKW(P1,2), pw2); \
    VRD(6); SBAR(); GAPA(C1=__builtin_amdgcn_mfma_f32_32x32x16_bf16(kf[5],qr[2],C1,0,0,0),   P1[6],P1[7],P1[8],P1[9],     pw2[2]=PKW(P1,4), pw2[3]=PKW(P1,6), pw2); \
    VRD(3); SBAR(); GAPA(C0=__builtin_amdgcn_mfma_f32_32x32x16_bf16(kf[6],qr[3],C0,0,0,0),   P1[10],P1[11],P1[12],P1[13], pw3[0]=PKW(P1,8), pw3[1]=PKW(P1,10), pw3); \
    VRD(7); SBAR(); GAPA(C1=__builtin_amdgcn_mfma_f32_32x32x16_bf16(kf[7],qr[3],C1,0,0,0),   P1[14],P1[15],0.f,0.f,       pw3[2]=PKW(P1,12),pw3[3]=PKW(P1,14), pw3); \
    l_reg+=sacc; \
    if(GK){DMA_K((t)+3,sl_cur);} if(GV){DMA_V((t)+1,sl_next);} \
    CMASK(C0,C1,t); \
    { float a=MX3(C0[0],C0[1],C1[0]),b=MX3(C0[2],C0[3],C1[1]); a=MX3(a,C1[2],C1[3]); \
      _Pragma("unroll") for(int r=4;r<16;r+=4){a=MX3(a,C0[r],C0[r+1]);b=MX3(b,C0[r+2],C0[r+3]);a=MX3(a,C1[r],C1[r+1]);b=MX3(b,C1[r+2],C1[r+3]);} \
      float rm=__builtin_fmaxf(a,b); { auto rr=__builtin_amdgcn_permlane32_swap(__float_as_uint(rm),__float_as_uint(rm),false,false); rm=__builtin_fmaxf(__uint_as_float(rr[0]),__uint_as_float(rr[1])); } \
      resc=false; \
      if(__builtin_expect(__any(rm>(float)THRL),0)){ const float dl=__builtin_fmaxf(rm,0.f); mhat+=dl; \
        _Pragma("unroll") for(int r=0;r<16;++r){C0[r]-=dl;C1[r]-=dl;} \
        _Pragma("unroll") for(int r=0;r<16;++r)negm[r]=-mhat; asm volatile("":"+v"(negm)); \
        const float f=__builtin_amdgcn_exp2f(-dl); l_reg*=f; if(hi==0)wsf[r32]=f; resc=true; } } \
    SBAR(); \
    GAPB(o[0]=__builtin_amdgcn_mfma_f32_32x32x16_bf16(PAF(0),VFR(0),o[0],0,0,0), C0,0); \
    GAPB(o[1]=__builtin_amdgcn_mfma_f32_32x32x16_bf16(PAF(0),VFR(4),o[1],0,0,0), C0,4); \
    KRD(GL,0); GAPB(o[0]=__builtin_amdgcn_mfma_f32_32x32x16_bf16(PAF(1),VFR(1),o[0],0,0,0), C0,8); \
    KRD(GL,1); GAPB(o[1]=__builtin_amdgcn_mfma_f32_32x32x16_bf16(PAF(1),VFR(5),o[1],0,0,0), C0,12); \
    KRD(GL,2); GAPB(o[0]=__builtin_amdgcn_mfma_f32_32x32x16_bf16(PAF(2),VFR(2),o[0],0,0,0), C1,0); \
    KRD(GL,3); GAPB(o[1]=__builtin_amdgcn_mfma_f32_32x32x16_bf16(PAF(2),VFR(6),o[1],0,0,0), C1,4); \
    GAPB(o[0]=__builtin_amdgcn_mfma_f32_32x32x16_bf16(PAF(3),VFR(3),o[0],0,0,0), C1,8); \
    GAPB(o[1]=__builtin_amdgcn_mfma_f32_32x32x16_bf16(PAF(3),VFR(7),o[1],0,0,0), C1,12); \
    }while(0)
  int t=1;
  #undef CMASK
  #define CMASK(P0,P1,t) do{}while(0)
  for(;t+5<NT;t+=2){
    STEP(pB0,pB1,pA0,pA1,t,true,true,true);     WAIT_BAR(2); RESC(); ROT();
    STEP(pA0,pA1,pB0,pB1,t+1,true,true,true);   WAIT_BAR(2); RESC(); ROT();
  }
  #undef CMASK
  #define CMASK(P0,P1,t) do{ if(MASKED){ const int jb_=(t)-(NT-4); if(jb_>=vis){ _Pragma("unroll") for(int r_=0;r_<16;++r_){P0[r_]=-INFINITY;P1[r_]=-INFINITY;} } } }while(0)
  #define ENDW(tt) do{ if((tt)+3<NT){WAIT_BAR(2);} else if((tt)+2<NT){WAIT_BAR(1);} else {WAIT_BAR(0);} }while(0)
  for(;t+1<NT;t+=2){
    STEP(pB0,pB1,pA0,pA1,t,(t+3<NT),(t+1<NT),(t+1<NT));       ENDW(t);   RESC(); ROT();
    STEP(pA0,pA1,pB0,pB1,t+1,(t+4<NT),(t+2<NT),(t+2<NT));     ENDW(t+1); RESC(); ROT();
  }
  { float sacc=pA0[0]+pA0[1]; _Pragma("unroll") for(int r=2;r<16;++r)sacc+=pA0[r]; _Pragma("unroll") for(int r=0;r<16;++r)sacc+=pA1[r]; l_reg+=sacc;
    pw0=(u32x4){PKW(pA0,0),PKW(pA0,2),PKW(pA0,4),PKW(pA0,6)};pw1=(u32x4){PKW(pA0,8),PKW(pA0,10),PKW(pA0,12),PKW(pA0,14)};pw2=(u32x4){PKW(pA1,0),PKW(pA1,2),PKW(pA1,4),PKW(pA1,6)};pw3=(u32x4){PKW(pA1,8),PKW(pA1,10),PKW(pA1,12),PKW(pA1,14)};
    SBAR(); pv(o,vb0+sl_prev,PAF(0),PAF(1),PAF(2),PAF(3)); }
  #undef PKW
  #undef PAF
  #undef VFR
  #undef PIN
  #undef MX3
  #undef GAPA
  #undef GAPB
  #undef EX
  #undef VRD
  #undef KRD
  #undef STEP
  #undef ENDW
  {auto rr=__builtin_amdgcn_permlane32_swap(__float_as_uint(l_reg),__float_as_uint(l_reg),false,false);l_reg=__uint_as_float(rr[0])+__uint_as_float(rr[1]);}
  if(hi==0)wsf[32+r32]=l_reg;asm volatile("s_waitcnt lgkmcnt(0)":::"memory");
  float rli[16];
  #pragma unroll
  for(int r=0;r<16;++r)rli[r]=__builtin_amdgcn_rcpf(wsf[32+crow(r,hi)]);
  bf16*Ow=Oin+(long)(wid*QBLK)*OPITCH;
  { bf16*stg=(bf16*)(shm+LDS_OST)+wid*2048;
    #pragma unroll
    for(int r=0;r<16;++r){const int orow=crow(r,hi);
      #pragma unroll
      for(int d0=0;d0<2;++d0)stg[orow*64+d0*32+r32]=__float2bfloat16(o[d0][r]*rli[r]);}
    asm volatile("s_waitcnt lgkmcnt(0)":::"memory");
    #pragma unroll
    for(int i=0;i<4;++i){const int row=i*8+(lane>>3),ch=lane&7; const u32x4 v=*(const u32x4*)(stg+row*64+ch*8); if(wid<qwaves)ATTN_STORE16(Ow+(long)row*OPITCH+ch*8,v);} }
  asm volatile("s_waitcnt lgkmcnt(0)\n\ts_barrier":::"memory");
  #undef DMA_K
  #undef DMA_V
  #undef CMASK
  #undef START
  #undef RESC
  #undef ROT
}
constexpr int ATTN_LDS_BYTES=LDS_BYTES;
#undef SBAR
#undef WAIT_BAR
}

namespace attn128 {
using namespace attn_body;
#define SBAR() __builtin_amdgcn_sched_barrier(0)
#define WAIT_BAR(N) asm volatile("s_waitcnt vmcnt(" #N ") lgkmcnt(0)\n\ts_barrier":::"memory")
constexpr int VSLOTB=16384;
constexpr int L_K=0, L_V=NSLOT*SLOTB, L_WS=L_V+NSLOT*VSLOTB, L_OST=L_WS+NW*64*4, L_BYTES=L_OST+NW*4096;
__device__ __forceinline__ void pv4(f32x16*o,int vb,bf16x8 pa0,bf16x8 pa1,bf16x8 pa2,bf16x8 pa3){
  #pragma unroll
  for(int d0=0;d0<4;++d0){s16x4 lo[4],hi[4];
    #pragma unroll
    for(int ks=0;ks<4;++ks){
      asm volatile("ds_read_b64_tr_b16 %0,%1 offset:%c2":"=&v"(lo[ks]):"v"(vb),"i"(d0*4096+ks*1024):"memory");
      asm volatile("ds_read_b64_tr_b16 %0,%1 offset:%c2":"=&v"(hi[ks]):"v"(vb),"i"(d0*4096+ks*1024+512):"memory");}
    asm volatile("s_waitcnt lgkmcnt(0)":::"memory");SBAR();
    #define PK(k) (bf16x8){lo[k][0],lo[k][1],lo[k][2],lo[k][3],hi[k][0],hi[k][1],hi[k][2],hi[k][3]}
    o[d0]=__builtin_amdgcn_mfma_f32_32x32x16_bf16(pa0,PK(0),o[d0],0,0,0);
    o[d0]=__builtin_amdgcn_mfma_f32_32x32x16_bf16(pa1,PK(1),o[d0],0,0,0);
    o[d0]=__builtin_amdgcn_mfma_f32_32x32x16_bf16(pa2,PK(2),o[d0],0,0,0);
    o[d0]=__builtin_amdgcn_mfma_f32_32x32x16_bf16(pa3,PK(3),o[d0],0,0,0);
    #undef PK
  }
}
struct Fin { int l, h; unsigned qrow; };
template<int THRL,bool MASKED,bool DUAL,bool FIN> __device__ __forceinline__ void attn_unit128(const bf16*Qin,const bf16*__restrict__ Kh,const bf16*__restrict__ Vh,bf16*Oin,const int NT,const int vis,const int qwaves,char*shm,const Fin fin){
  int tid_o=threadIdx.x; asm volatile("":"+v"(tid_o));
  const int tid=tid_o,lane=tid&63,r32=lane&31,hi=lane>>5; const int wid=__builtin_amdgcn_readfirstlane(tid>>6);
  constexpr int KSL=DUAL?2:1;
  constexpr int LK=0, LV=NSLOT*SLOTB*KSL, LWS=LV+NSLOT*VSLOTB, LOST=LWS+NW*64*4;
  const int cmap=DUAL?((wid>>1)&1):0, qgrp=DUAL?(wid&1):(wid&(qwaves-1)); const bool do_store=DUAL?(wid<4):(wid<qwaves);
  const bf16*Qw=Qin+cmap*64+(long)(qgrp*QBLK)*DM;
  const unsigned lds0=(unsigned)(uintptr_t)shm;
  float*wsf=(float*)(shm+LWS)+wid*64;
  const bf16*ksrc=Kh+(long)lane*DM+wid*8;
  const bf16*vsrc=Vh+(long)(16*(wid&3)+(lane>>2))*DM+(wid>>2)*32+(lane&3)*8;
  const unsigned kdst=lds0+LK+wid*1024, vdst=lds0+LV+wid*1024;
  #define DMA_K(t,slot) do{ glds16(ksrc+(long)(t)*KVBLK*DM,(unsigned)__builtin_amdgcn_readfirstlane(kdst+KSL*(slot))); if(DUAL) glds16(ksrc+(long)(t)*KVBLK*DM+64,(unsigned)__builtin_amdgcn_readfirstlane(kdst+KSL*(slot)+8192)); }while(0)
  #define DMA_V(t,slot) do{ glds16(vsrc+(long)(t)*KVBLK*DM,(unsigned)__builtin_amdgcn_readfirstlane(vdst+2*(slot))); glds16(vsrc+(long)(t)*KVBLK*DM+64,(unsigned)__builtin_amdgcn_readfirstlane(vdst+2*(slot)+8192)); }while(0)
  const int vb0=(int)(lds0+LV)+((lane>>4)&1)*32+(lane&3)*8+(4*hi+((lane&15)>>2))*64;
  const char*Kbase=shm+LK+cmap*8192; bf16x8 kf[8];
  const lds_cptr shm3=(lds_cptr)shm; const lds_cptr kp0=shm3+LK+cmap*8192+hi*1024+r32*16; const lds_cptr vp0=shm3+LV+((lane>>4)&1)*32+(lane&3)*8+(4*hi+((lane&15)>>2))*64;
  DMA_K(0,0);DMA_V(0,0);DMA_K(1,SLOTB);
  bf16x8 qr[4];
  #pragma unroll
  for(int d0=0;d0<4;++d0)qr[d0]=*reinterpret_cast<const bf16x8*>(&Qw[(long)r32*DM+d0*16+hi*8]);
  float mhat=0.f,l_reg=0.f;f32x16 o[4];o[0]=f32x16{};o[1]=f32x16{};o[2]=f32x16{};o[3]=f32x16{};f32x16 negm=f32x16{};asm volatile("":"+v"(negm));
  #define CMASK(P0,P1,t) do{ if(MASKED){ const int jb_=(t)-(NT-4); if(jb_>=vis){ _Pragma("unroll") for(int r_=0;r_<16;++r_){P0[r_]=-INFINITY;P1[r_]=-INFINITY;} } } }while(0)
  bool resc=false;
  #define START(P0,P1) do{ const float rm=rowmax(P0,P1); resc=false; \
    { const float dl=rm; mhat=fadd_s(mhat,dl); \
      _Pragma("unroll") for(int r=0;r<16;++r){P0[r]=fsub_s(P0[r],dl);P1[r]=fsub_s(P1[r],dl);} \
      _Pragma("unroll") for(int r=0;r<16;++r)negm[r]=-mhat; asm volatile("":"+v"(negm)); } \
    _Pragma("unroll") for(int r=0;r<16;++r)P0[r]=__builtin_amdgcn_exp2f(P0[r]); }while(0)
  #define RESC() do{ if(resc){ asm volatile("s_waitcnt lgkmcnt(0)":::"memory"); \
      _Pragma("unroll") for(int d_=0;d_<4;++d_) _Pragma("unroll") for(int r=0;r<16;++r)o[d_][r]*=wsf[crow(r,hi)]; } }while(0)
  f32x16 pA0,pA1,pB0,pB1;
  int sl_prev=0,sl_cur=0,sl_next=SLOTB;
  #define ROT() do{sl_prev=sl_cur;sl_cur=sl_next;sl_next=(sl_next==(NSLOT-1)*SLOTB)?0:sl_next+SLOTB;}while(0)
  DMA_K(2,2*SLOTB);
  if constexpr(DUAL){WAIT_BAR(6);}else{WAIT_BAR(4);}
  { const f32x16 zc=f32x16{}; qkt(pA0,pA1,Kbase,qr,zc,r32,hi); } asm volatile("s_nop 15\n\ts_nop 7":"+v"(pA0),"+v"(pA1));
  if(MASKED){ _Pragma("unroll") for(int r_=8;r_<16;++r_)pA0[r_]=-INFINITY; _Pragma("unroll") for(int r_=0;r_<16;++r_)pA1[r_]=-INFINITY; }
  START(pA0,pA1);
  _Pragma("unroll") for(int r=0;r<16;++r)pA1[r]=__builtin_amdgcn_exp2f(pA1[r]);
  WAIT_BAR(0);
  DMA_K(3,0);DMA_V(1,SLOTB);
  ROT();
  kload8(kf,kp0+KSL*sl_cur);
  if constexpr(DUAL){WAIT_BAR(4);}else{WAIT_BAR(3);}
  s16x4 wlo[3],whi[3]; u32x4 pw0,pw1,pw2,pw3;
  #define PKW(P,B) cvtpk_s(P[B],P[B+1])
  #define PAF(k) __builtin_bit_cast(bf16x8,pw##k)
  #define VFW(s) (bf16x8){wlo[s][0],wlo[s][1],wlo[s][2],wlo[s][3],whi[s][0],whi[s][1],whi[s][2],whi[s][3]}
  #define PIN(x) asm volatile("":"+v"(x))
  #define MX3(a,b,c) __builtin_fmaxf(__builtin_fmaxf((a),(b)),(c))
  #define GAPA(MF,A0,A1,A2,A3,W0,W1,PW) do{ MF; sacc+=A0; sacc+=A1; sacc+=A2; sacc+=A3; PIN(sacc); W0; W1; PIN(PW); SBAR(); }while(0)
  #define EX(v) __builtin_amdgcn_exp2f(v)
  #define VRW(s,f) do{ wlo[s]=vtr(vp_+(((f)>>2)*4096+((f)&3)*1024)); whi[s]=vtr(vp_+(((f)>>2)*4096+((f)&3)*1024+512)); }while(0)
  #define KRD(G,j) do{ if(G){ kload2(kf,kp0+KSL*sl_next,j); SBAR(); } }while(0)
  #define FJ(j) ((((j)&3)<<2)|((j)>>2))
  #define VREQ(j) do{ VRW((j)%3,FJ(j)); SBAR(); }while(0)
  #define GAPB(RD,JN,KQ,QD,JU,X,B) do{ if(RD){ VREQ(JN); } o[QD]=__builtin_amdgcn_mfma_f32_32x32x16_bf16(PAF(KQ),VFW((JU)%3),o[QD],0,0,0); X[B]=EX(X[B]); X[B+1]=EX(X[B+1]); PIN(X); SBAR(); }while(0)
  #define STEP(C0,C1,P0,P1,t,GK,GV,GL) do{ SBAR(); \
    const lds_cptr vp_=vp0+2*sl_prev; \
    float sacc=(P0[0]+P0[1]); \
    GAPA(C0=__builtin_amdgcn_mfma_f32_32x32x16_bf16(kf[0],qr[0],negm,0,0,0), P0[2],P0[3],P0[4],P0[5],     pw0[0]=PKW(P0,0), pw0[1]=PKW(P0,2), pw0); \
    GAPA(C1=__builtin_amdgcn_mfma_f32_32x32x16_bf16(kf[1],qr[0],negm,0,0,0), P0[6],P0[7],P0[8],P0[9],     pw0[2]=PKW(P0,4), pw0[3]=PKW(P0,6), pw0); \
    GAPA(C0=__builtin_amdgcn_mfma_f32_32x32x16_bf16(kf[2],qr[1],C0,0,0,0),   P0[10],P0[11],P0[12],P0[13], pw1[0]=PKW(P0,8), pw1[1]=PKW(P0,10), pw1); \
    GAPA(C1=__builtin_amdgcn_mfma_f32_32x32x16_bf16(kf[3],qr[1],C1,0,0,0),   P0[14],P0[15],P1[0],P1[1],   pw1[2]=PKW(P0,12),pw1[3]=PKW(P0,14), pw1); \
    GAPA(C0=__builtin_amdgcn_mfma_f32_32x32x16_bf16(kf[4],qr[2],C0,0,0,0),   P1[2],P1[3],P1[4],P1[5],     pw2[0]=PKW(P1,0), pw2[1]=PKW(P1,2), pw2); \
    VREQ(0); \
    GAPA(C1=__builtin_amdgcn_mfma_f32_32x32x16_bf16(kf[5],qr[2],C1,0,0,0),   P1[6],P1[7],P1[8],P1[9],     pw2[2]=PKW(P1,4), pw2[3]=PKW(P1,6), pw2); \
    VREQ(1); \
    GAPA(C0=__builtin_amdgcn_mfma_f32_32x32x16_bf16(kf[6],qr[3],C0,0,0,0),   P1[10],P1[11],P1[12],P1[13], pw3[0]=PKW(P1,8), pw3[1]=PKW(P1,10), pw3); \
    GAPA(C1=__builtin_amdgcn_mfma_f32_32x32x16_bf16(kf[7],qr[3],C1,0,0,0),   P1[14],P1[15],0.f,0.f,       pw3[2]=PKW(P1,12),pw3[3]=PKW(P1,14), pw3); \
    l_reg+=sacc; \
    if(GK){DMA_K((t)+3,sl_cur);} if(GV){DMA_V((t)+1,sl_next);} \
    CMASK(C0,C1,t); \
    { float a=MX3(C0[0],C0[1],C1[0]),b=MX3(C0[2],C0[3],C1[1]); a=MX3(a,C1[2],C1[3]); \
      _Pragma("unroll") for(int r=4;r<16;r+=4){a=MX3(a,C0[r],C0[r+1]);b=MX3(b,C0[r+2],C0[r+3]);a=MX3(a,C1[r],C1[r+1]);b=MX3(b,C1[r+2],C1[r+3]);} \
      float rm=__builtin_fmaxf(a,b); { auto rr=__builtin_amdgcn_permlane32_swap(__float_as_uint(rm),__float_as_uint(rm),false,false); rm=__builtin_fmaxf(__uint_as_float(rr[0]),__uint_as_float(rr[1])); } \
      resc=false; \
      if(__builtin_expect(__any(rm>(float)THRL),0)){ const float dl=__builtin_fmaxf(rm,0.f); mhat+=dl; \
        _Pragma("unroll") for(int r=0;r<16;++r){C0[r]-=dl;C1[r]-=dl;} \
        _Pragma("unroll") for(int r=0;r<16;++r)negm[r]=-mhat; asm volatile("":"+v"(negm)); \
        const float f=__builtin_amdgcn_exp2f(-dl); l_reg*=f; if(hi==0)wsf[r32]=f; resc=true; } } \
    SBAR(); \
    GAPB(1,2, 0,0,0, C0,0); \
    GAPB(1,3, 0,1,1, C0,2); \
    GAPB(1,4, 0,2,2, C0,4); \
    GAPB(1,5, 0,3,3, C0,6); \
    KRD(GL,0); GAPB(1,6, 1,0,4, C0,8); \
    GAPB(1,7, 1,1,5, C0,10); \
    KRD(GL,1); GAPB(1,8, 1,2,6, C0,12); \
    GAPB(1,9, 1,3,7, C0,14); \
    KRD(GL,2); GAPB(1,10, 2,0,8, C1,0); \
    GAPB(1,11, 2,1,9, C1,2); \
    KRD(GL,3); GAPB(1,12, 2,2,10, C1,4); \
    GAPB(1,13, 2,3,11, C1,6); \
    GAPB(1,14, 3,0,12, C1,8); \
    GAPB(1,15, 3,1,13, C1,10); \
    GAPB(0,0, 3,2,14, C1,12); \
    GAPB(0,0, 3,3,15, C1,14); \
    }while(0)
  #define WBS() do{ if constexpr(DUAL){WAIT_BAR(4);}else{WAIT_BAR(3);} }while(0)
  if(!DUAL && wid>=4) __builtin_amdgcn_s_setprio(1);
  int t=1;
  #undef CMASK
  #define CMASK(P0,P1,t) do{}while(0)
  for(;t+5<NT;t+=2){
    STEP(pB0,pB1,pA0,pA1,t,true,true,true);     WBS(); RESC(); ROT();
    STEP(pA0,pA1,pB0,pB1,t+1,true,true,true);   WBS(); RESC(); ROT();
  }
  #undef CMASK
  #define CMASK(P0,P1,t) do{ if(MASKED){ const int jb_=(t)-(NT-4); if(jb_>=vis){ _Pragma("unroll") for(int r_=0;r_<16;++r_){P0[r_]=-INFINITY;P1[r_]=-INFINITY;} } } }while(0)
  #define ENDW(tt) do{ if((tt)+3<NT){WBS();} else if((tt)+2<NT){WAIT_BAR(2);} else {WAIT_BAR(0);} }while(0)
  for(;t+1<NT;t+=2){
    STEP(pB0,pB1,pA0,pA1,t,(t+3<NT),(t+1<NT),(t+1<NT));       ENDW(t);   RESC(); ROT();
    STEP(pA0,pA1,pB0,pB1,t+1,(t+4<NT),(t+2<NT),(t+2<NT));     ENDW(t+1); RESC(); ROT();
  }
  { float sacc=pA0[0]+pA0[1]; _Pragma("unroll") for(int r=2;r<16;++r)sacc+=pA0[r]; _Pragma("unroll") for(int r=0;r<16;++r)sacc+=pA1[r]; l_reg+=sacc;
    pw0=(u32x4){PKW(pA0,0),PKW(pA0,2),PKW(pA0,4),PKW(pA0,6)};pw1=(u32x4){PKW(pA0,8),PKW(pA0,10),PKW(pA0,12),PKW(pA0,14)};pw2=(u32x4){PKW(pA1,0),PKW(pA1,2),PKW(pA1,4),PKW(pA1,6)};pw3=(u32x4){PKW(pA1,8),PKW(pA1,10),PKW(pA1,12),PKW(pA1,14)};
    SBAR(); pv4(o,vb0+2*sl_prev,PAF(0),PAF(1),PAF(2),PAF(3)); }
  #undef PKW
  #undef PAF
  #undef VFW
  #undef PIN
  #undef MX3
  #undef GAPA
  #undef GAPB
  #undef EX
  #undef VRW
  #undef VREQ
  #undef FJ
  #undef KRD
  #undef STEP
  #undef ENDW
  #undef WBS
  __builtin_amdgcn_s_setprio(0);
  {auto rr=__builtin_amdgcn_permlane32_swap(__float_as_uint(l_reg),__float_as_uint(l_reg),false,false);l_reg=__uint_as_float(rr[0])+__uint_as_float(rr[1]);}
  if(hi==0)wsf[32+r32]=l_reg;asm volatile("s_waitcnt lgkmcnt(0)":::"memory");
  float rli[16];
  #pragma unroll
  for(int r=0;r<16;++r)rli[r]=__builtin_amdgcn_rcpf(wsf[32+crow(r,hi)]);
  bf16*Ow=Oin+cmap*128+(long)((DUAL?(wid&1):wid)*QBLK)*OPITCH;
  bf16*stg=(bf16*)(shm+LOST)+(DUAL?(wid&3):wid)*2048;
  if(do_store){
  u32x4 o2v[2][4];
  #pragma unroll
  for(int hf=0;hf<2;++hf){
    #pragma unroll
    for(int r=0;r<16;++r){const int orow=crow(r,hi);
      #pragma unroll
      for(int d0=0;d0<2;++d0)stg[orow*64+d0*32+r32]=__float2bfloat16(o[2*hf+d0][r]*rli[r]);}
    asm volatile("s_waitcnt lgkmcnt(0)":::"memory");
    #pragma unroll
    for(int i=0;i<4;++i){const int row=i*8+(lane>>3),ch=lane&7; const u32x4 v=*(const u32x4*)(stg+row*64+ch*8);
      if constexpr(FIN){ o2v[hf][i]=v; } else { ATTN_STORE16(Ow+(long)row*OPITCH+hf*64+ch*8,v); } }
    asm volatile("s_waitcnt lgkmcnt(0)":::"memory");
  }
  if constexpr(FIN){
    asm volatile("s_waitcnt vmcnt(0)":::"memory");
    ArgsP ka=KARG(); unsigned char*wsb=ka->ws;
    const bf16*fO1=(const bf16*)(wsb+WS_OP)+(size_t)fin.qrow*2048+(size_t)(fin.h*2)*128; const bf16*fZA=(const bf16*)(wsb+WS_ZA)+(size_t)fin.qrow*1024+fin.h*128;
    const float*fsw=ka->in[I_SUBLN]+fin.l*128; bf16*fOX=(bf16*)(wsb+WS_OX)+(size_t)fin.qrow*2048+1024+fin.h*128;
    const float flam=((const float*)(wsb+WS_MISC))[fin.l], foml=((const float*)(wsb+WS_MISC))[8+fin.l];
    const int ch=lane&7;
    #pragma unroll
    for(int i=0;i<4;++i){ const long grow=(long)(wid*QBLK+i*8+(lane>>3));
      float d[2][8]; float ss=0.f;
      #pragma unroll
      for(int hf=0;hf<2;++hf){ const u32x4 a=*(const u32x4*)(fO1+grow*OPITCH+hf*64+ch*8); const u32x4 b=o2v[hf][i];
        const unsigned aw[4]={a.x,a.y,a.z,a.w}, bw[4]={b.x,b.y,b.z,b.w};
        #pragma unroll
        for(int e=0;e<4;++e){ d[hf][2*e]=__uint_as_float(aw[e]<<16)-flam*__uint_as_float(bw[e]<<16); d[hf][2*e+1]=__uint_as_float(aw[e]&0xffff0000u)-flam*__uint_as_float(bw[e]&0xffff0000u); }
        #pragma unroll
        for(int e=0;e<8;++e)ss+=d[hf][e]*d[hf][e]; }
      ss+=__shfl_xor(ss,1); ss+=__shfl_xor(ss,2); ss+=__shfl_xor(ss,4);
      const float scale=rsqrtf(ss*(1.0f/128.0f)+1e-6f)*foml;
      #pragma unroll
      for(int hf=0;hf<2;++hf){ const u32x4 z=*(const u32x4*)(fZA+grow*DM+hf*64+ch*8); const float*swp=fsw+hf*64+ch*8;
        const unsigned zw[4]={z.x,z.y,z.z,z.w}; unsigned ow[4];
        #pragma unroll
        for(int e=0;e<4;++e){ const float v0=d[hf][2*e]*scale*swp[2*e]*__uint_as_float(zw[e]<<16), v1=d[hf][2*e+1]*scale*swp[2*e+1]*__uint_as_float(zw[e]&0xffff0000u); ow[e]=cvtpk_s(v0,v1); }
        ATTN_STORE16(fOX+grow*OPITCH+hf*64+ch*8,((u32x4){ow[0],ow[1],ow[2],ow[3]})); }
    }
  }
  }
  if constexpr(DUAL){ asm volatile("s_waitcnt vmcnt(0)":::"memory"); }
  asm volatile("s_waitcnt lgkmcnt(0)\n\ts_barrier":::"memory");
  #undef DMA_K
  #undef DMA_V
  #undef CMASK
  #undef START
  #undef RESC
  #undef ROT
}
#undef SBAR
#undef WAIT_BAR
}

#define GAS __attribute__((address_space(1)))
#define LAS __attribute__((address_space(3)))
typedef unsigned short bf16;
typedef unsigned v4u __attribute__((ext_vector_type(4)));
typedef float f32x4 __attribute__((ext_vector_type(4)));
typedef short bf16x8 __attribute__((ext_vector_type(8)));
typedef GAS unsigned gu32;
typedef GAS unsigned long long gu64;
#define RLX_AGENT __ATOMIC_RELAXED, __HIP_MEMORY_SCOPE_AGENT
#define LDS_WAIT() asm volatile("s_waitcnt lgkmcnt(0)" ::: "memory")
#define VM_WAIT() asm volatile("s_waitcnt vmcnt(0)" ::: "memory")
__device__ __forceinline__ unsigned long long rt() { return __builtin_amdgcn_s_memrealtime(); }
__device__ __forceinline__ unsigned f2bf(float f) { unsigned u = __builtin_bit_cast(unsigned, f); return (u + 0x7fffu + ((u >> 16) & 1u)) >> 16; }
__device__ __forceinline__ unsigned pk2(float lo, float hi) { return f2bf(lo) | (f2bf(hi) << 16); }

#define XB_TMO      128
#define XB_XCNT(j)  (256  + 64 * (j))
#define XB_XSUB(j)  (1280 + 64 * (j))
#define XB_XGEN(j)  (2304 + 64 * (j))
#define XB_TOP      3328
#define XB_TOPGEN   3392
#define XCD_BAR_WORDS 3456
#define XB_SPIN_CAP (1u << 18)

__device__ __forceinline__ unsigned xb_ld(unsigned* p)              { return __hip_atomic_load(p, __ATOMIC_RELAXED, __HIP_MEMORY_SCOPE_AGENT); }
__device__ __forceinline__ unsigned xb_add(unsigned* p, unsigned v) { return __hip_atomic_fetch_add(p, v, __ATOMIC_RELAXED, __HIP_MEMORY_SCOPE_AGENT); }
__device__ __forceinline__ unsigned xb_xcc_id() { return (unsigned)__builtin_amdgcn_s_getreg((3 << 11) | 20) & 0xFu; }
#define XB_SPIN(cond, bar) do { unsigned _sp = 0; while (cond) { __builtin_amdgcn_s_sleep(1); \
    if ((++_sp & 255u) == 0u) { if (xb_ld(&(bar)[XB_TMO])) break; if (_sp > XB_SPIN_CAP) { atomicAdd(&(bar)[XB_TMO], 1u); break; } } } } while (0)

struct XcdBarrier {
    unsigned* bar; unsigned x;
    volatile LAS unsigned* st;
};

__device__ __forceinline__ XcdBarrier xcd_barrier_post(unsigned* bar, volatile LAS unsigned* st) {
    XcdBarrier b; b.bar = bar; b.x = xb_xcc_id(); b.st = st;
    if (threadIdx.x == 0) (void)xb_add(&bar[XB_XCNT(b.x)], 1u);
    return b;
}
__device__ __forceinline__ void xcd_barrier_complete(unsigned* bar, unsigned x, unsigned& nloc, unsigned& nx) {
    const unsigned G = gridDim.x * gridDim.y * gridDim.z;
    unsigned sum, cnt, mine, sp = 0u;
    for (;;) {
        sum = 0u; cnt = 0u; mine = 0u;
#pragma unroll
        for (unsigned j = 0; j < 16; ++j) { const unsigned c = xb_ld(&bar[XB_XCNT(j)]); sum += c; cnt += (c > 0u) ? 1u : 0u; mine = (j == x) ? c : mine; }
        if (sum == G) break;
        __builtin_amdgcn_s_sleep(1);
        if ((++sp & 255u) == 0u) { if (xb_ld(&bar[XB_TMO])) break; if (sp > XB_SPIN_CAP) { atomicAdd(&bar[XB_TMO], 1u); break; } }
    }
    nloc = mine > 0u ? mine : 1u; nx = cnt > 0u ? cnt : 1u;
}

__device__ __forceinline__ void xcd_barrier(const XcdBarrier& b) {
    asm volatile("s_waitcnt vmcnt(0)" ::: "memory");
    __syncthreads();
    if (threadIdx.x == 0) {
        unsigned* bar = b.bar;
        __builtin_amdgcn_s_waitcnt(0);
        unsigned nloc = b.st[0], nx = b.st[1];
        if (nloc == 0u) { xcd_barrier_complete(bar, b.x, nloc, nx); b.st[0] = nloc; b.st[1] = nx; }
        const unsigned old = xb_add(&bar[XB_XSUB(b.x)], 1u);
        const unsigned gen = old / nloc;
        if (old + 1u == (gen + 1u) * nloc) {
            __builtin_amdgcn_fence(__ATOMIC_RELEASE, "agent");
            asm volatile("s_waitcnt vmcnt(0)" ::: "memory");
            const unsigned og = xb_add(&bar[XB_TOP], 1u);
            const unsigned tg = og / nx;
            if (og + 1u == (tg + 1u) * nx) xb_add(&bar[XB_TOPGEN], 1u);
            else XB_SPIN(xb_ld(&bar[XB_TOPGEN]) == tg, bar);
            __builtin_amdgcn_fence(__ATOMIC_ACQUIRE, "agent");
            xb_add(&bar[XB_XGEN(b.x)], 1u);
            asm volatile("s_waitcnt vmcnt(0)" ::: "memory");
        } else {
            XB_SPIN(xb_ld(&bar[XB_XGEN(b.x)]) == gen, bar);
            __builtin_amdgcn_fence(__ATOMIC_ACQUIRE, "agent");
            asm volatile("s_waitcnt vmcnt(0)" ::: "memory");
        }
    }
    __syncthreads();
}

constexpr int NWAVES = 8;
constexpr int RING_OFF = 0, RING_BYTES = 131072;
constexpr int LDSCTL_OFF = RING_BYTES, MISC_OFF = LDSCTL_OFF + 320;
constexpr int LDS_BYTES = 147456;
static_assert(MISC_OFF + 128 <= LDS_BYTES, "LDS map");
constexpr int N_PHASES = 2 + 4 * DEPTH;

__device__ __forceinline__ float wave_sum(float v) {
#pragma unroll
    for (int o = 1; o < 64; o <<= 1) v += __shfl_xor(v, o);
    return v;
}
__device__ __forceinline__ v4u pack8f(const f32x4 a, const f32x4 b) { v4u w; w.x = pk2(a[0], a[1]); w.y = pk2(a[2], a[3]); w.z = pk2(b[0], b[1]); w.w = pk2(b[2], b[3]); return w; }
__device__ __forceinline__ float bflo(unsigned w) { return __uint_as_float(w << 16); }
__device__ __forceinline__ float bfhi(unsigned w) { return __uint_as_float(w & 0xffff0000u); }

__host__ __device__ __forceinline__ int colmap_in(int np) {
    if (np >= 2048 && np < 4096) { const int g = np >> 6, j = np & 63, a = j >> 5, fq = (j >> 3) & 3, n = (j >> 2) & 1, e = j & 3; return (g << 6) + 32 * n + 16 * a + 4 * fq + e; }
    if (np >= 6144) { const int w = np - 6144, j8 = w >> 8, half = (w >> 7) & 1, cc = w & 127; return 6144 + half * 1024 + 128 * j8 + cc; }
    return np;
}
template <bool MAPPED>
__device__ __forceinline__ void p0_item(const float* W, int N, const float* kscale, bf16* WT, int ldk, int koff, LAS float* scr, int kb, int nb, int lane) {
    const int k0 = 64 * kb, n0 = 32 * nb; const int np = n0 + (lane & 31); const int src = MAPPED ? colmap_in(np) : np;
#pragma unroll
    for (int i = 0; i < 32; ++i) { const int kk = 2 * i + (lane >> 5); float v = W[(size_t)(k0 + kk) * N + src]; if (kscale) v *= kscale[k0 + kk]; scr[kk * 33 + (lane & 31)] = v; }
    LDS_WAIT(); asm volatile("" ::: "memory");
    const int c = lane & 7;
#pragma unroll
    for (int j = 0; j < 4; ++j) { const int n = (lane >> 3) + 8 * j; const LAS float* s = scr + (8 * c) * 33 + n;
        v4u o; o.x = pk2(s[0 * 33], s[1 * 33]); o.y = pk2(s[2 * 33], s[3 * 33]); o.z = pk2(s[4 * 33], s[5 * 33]); o.w = pk2(s[6 * 33], s[7 * 33]);
        *(GAS v4u*)(WT + (size_t)(n0 + n) * ldk + koff + k0 + 8 * c) = o; }
    LDS_WAIT(); asm volatile("" ::: "memory");
}

__device__ __forceinline__ void cache_convert(ArgsP args, int lc, int c_lo, int n_ch, int tid0, int nth) {
    unsigned char* ws = args->ws;
    bf16* KS = (bf16*)(ws + WS_KS) + (size_t)lc * NDB * KSROWS * D; bf16* VS = (bf16*)(ws + WS_VS) + (size_t)lc * NDB * KSROWS * D;
    const float* ck = args->in[I_CK] + (size_t)lc * NDB * PAST * D; const float* cv = args->in[I_CV] + (size_t)lc * NDB * PAST * D;
    for (int c0 = c_lo + tid0; c0 < c_lo + n_ch; c0 += 4 * nth) {
        f32x4 klo[4], khi[4], vlo[4], vhi[4];
#pragma unroll
        for (int u = 0; u < 4; ++u) { const int c = c0 + u * nth; if (c < c_lo + n_ch) { const int row = c >> 7, chn = c & 127;
            const int gq = chn >> 3, q8 = chn & 7, d0 = 16 * (q8 >> 2) + 4 * (q8 & 3); const float* s = ck + (size_t)row * D + 64 * gq + d0; const float* sv = cv + (size_t)row * D + 8 * chn;
            klo[u] = __builtin_nontemporal_load((const GAS f32x4*)s); khi[u] = __builtin_nontemporal_load((const GAS f32x4*)(s + 32)); vlo[u] = __builtin_nontemporal_load((const GAS f32x4*)sv); vhi[u] = __builtin_nontemporal_load((const GAS f32x4*)(sv + 4)); } }
#pragma unroll
        for (int u = 0; u < 4; ++u) { const int c = c0 + u * nth; if (c < c_lo + n_ch) { const int row = c >> 7, chn = c & 127; const size_t drow = ((size_t)(row >> 11) * KSROWS + (row & 2047)) * D;
            *(GAS v4u*)(KS + drow + 8 * chn) = pack8f(klo[u], khi[u]); *(GAS v4u*)(VS + drow + 8 * chn) = pack8f(vlo[u], vhi[u]); } }
    }
}

__device__ __forceinline__ void cache_convert_head(ArgsP args, int lc, int db, int h, int tid0, int nth) {
    unsigned char* ws = args->ws;
    bf16* KS = (bf16*)(ws + WS_KS) + (size_t)(lc * NDB + db) * KSROWS * D; bf16* VS = (bf16*)(ws + WS_VS) + (size_t)(lc * NDB + db) * KSROWS * D;
    const float* ck = args->in[I_CK] + (size_t)(lc * NDB + db) * PAST * D; const float* cv = args->in[I_CV] + (size_t)(lc * NDB + db) * PAST * D;
    constexpr int NCHK = PAST * 16;
    for (int c0 = tid0; c0 < NCHK; c0 += 4 * nth) {
        f32x4 klo[4], khi[4], vlo[4], vhi[4];
#pragma unroll
        for (int u = 0; u < 4; ++u) { const int c = c0 + u * nth; if (c < NCHK) { const int row = c >> 4, chn = h * 16 + (c & 15);
            const int gq = chn >> 3, q8 = chn & 7, d0 = 16 * (q8 >> 2) + 4 * (q8 & 3); const float* s = ck + (size_t)row * D + 64 * gq + d0; const float* sv = cv + (size_t)row * D + 8 * chn;
            klo[u] = __builtin_nontemporal_load((const GAS f32x4*)s); khi[u] = __builtin_nontemporal_load((const GAS f32x4*)(s + 32)); vlo[u] = __builtin_nontemporal_load((const GAS f32x4*)sv); vhi[u] = __builtin_nontemporal_load((const GAS f32x4*)(sv + 4)); } }
#pragma unroll
        for (int u = 0; u < 4; ++u) { const int c = c0 + u * nth; if (c < NCHK) { const int row = c >> 4, chn = h * 16 + (c & 15); const size_t drow = (size_t)row * D;
            *(GAS v4u*)(KS + drow + 8 * chn) = pack8f(klo[u], khi[u]); *(GAS v4u*)(VS + drow + 8 * chn) = pack8f(vlo[u], vhi[u]); } }
    }
}

__device__ __forceinline__ void p0_prologue(ArgsP args, LAS unsigned char* lds, int lane, int wave, int vcu, int G) {
    unsigned char* ws = args->ws;
    LAS float* scr = (LAS float*)(lds + RING_OFF + wave * 16384);
    const int gw = vcu * NWAVES + wave, NGW = G * NWAVES;
    constexpr int IT_L = 2048 + 256 + 256 + 256 + 64;
    typedef float f32x2_t __attribute__((ext_vector_type(2)));
    struct WItem { const float* src; const float* ksc; bf16* dst; int N, ldk; };
    auto decode = [&](int it) -> WItem {
        const int l = it / IT_L; int r = it % IT_L; unsigned char* wl = ws + WS_W + (size_t)l * W_LAYER;
        const float* W; const float* kscale = nullptr; bf16* WT; int N, ldk, koff = 0, kb, nb; bool mapped = false;
        if (r < 2048) { W = args->in[I_WIN] + (size_t)l * D * INC; N = INC; kscale = args->in[I_NW] + l * D; WT = (bf16*)(wl + W_IN); ldk = D; kb = r >> 7; nb = r & 127; mapped = true; }
        else if (r < 2048 + 256) { r -= 2048; W = args->in[I_WPR] + (size_t)l * D * D; N = D; WT = (bf16*)(wl + W_PROJ); ldk = 2 * D; kb = r >> 4; nb = r & 15; }
        else if (r < 2048 + 512) { r -= 2048 + 256; W = args->in[I_WPA] + (size_t)l * D * D; N = D; WT = (bf16*)(wl + W_PROJ); ldk = 2 * D; koff = D; kb = r >> 4; nb = r & 15; }
        else if (r < 2048 + 768) { r -= 2048 + 512; W = args->in[I_WOUT] + (size_t)l * D * D; N = D; WT = (bf16*)(wl + W_OUT); ldk = D; kb = r >> 4; nb = r & 15; }
        else { r -= 2048 + 768; const int gate = r >> 5, blk = (r >> 2) & 7; kb = (r >> 1) & 1; nb = r & 1;
            W = args->in[gate ? I_WIG : I_WRG] + (size_t)(l * 8 + blk) * 16384; N = 128; WT = (bf16*)(wl + W_G) + (size_t)(blk * 2 + gate) * 16384; ldk = 128; }
        const int k0 = 64 * kb, n0 = 64 * nb, np = n0 + 2 * (lane & 31), srcc = mapped ? colmap_in(np) : np;
        WItem w; w.src = W + (size_t)k0 * N + srcc; w.ksc = kscale ? kscale + k0 + 8 * (lane & 7) : nullptr; w.dst = WT + (size_t)n0 * ldk + koff + k0; w.N = N; w.ldk = ldk; return w; };
    auto wload = [&](const WItem& w, f32x2_t (&v)[32]) {
#pragma unroll
        for (int i = 0; i < 32; ++i) v[i] = *(const GAS f32x2_t*)(w.src + (size_t)(2 * i + (lane >> 5)) * w.N); };
    auto wstore = [&](const WItem& w, const f32x2_t (&v)[32]) {
        f32x4 ka = (f32x4){1.f, 1.f, 1.f, 1.f}, kb2 = ka;
        if (w.ksc) { ka = *(const GAS f32x4*)w.ksc; kb2 = *(const GAS f32x4*)(w.ksc + 4); }
#pragma unroll
        for (int par = 0; par < 2; ++par) {
#pragma unroll
            for (int i = 0; i < 32; ++i) scr[(2 * i + (lane >> 5)) * 33 + (lane & 31)] = v[i][par];
            LDS_WAIT(); asm volatile("" ::: "memory");
            const int c = lane & 7;
#pragma unroll
            for (int j = 0; j < 4; ++j) { const int n = (lane >> 3) + 8 * j; const LAS float* sp = scr + (8 * c) * 33 + n;
                v4u o; o.x = pk2(sp[0 * 33] * ka[0], sp[1 * 33] * ka[1]); o.y = pk2(sp[2 * 33] * ka[2], sp[3 * 33] * ka[3]); o.z = pk2(sp[4 * 33] * kb2[0], sp[5 * 33] * kb2[1]); o.w = pk2(sp[6 * 33] * kb2[2], sp[7 * 33] * kb2[3]);
                *(GAS v4u*)(w.dst + (size_t)(2 * n + par) * w.ldk + 8 * c) = o; }
            LDS_WAIT(); asm volatile("" ::: "memory"); } };
    for (int it = gw; it < DEPTH * IT_L; it += 2 * NGW) {
        const bool hb = it + NGW < DEPTH * IT_L;
        const WItem wa = decode(it), wb = decode(hb ? it + NGW : it);
        f32x2_t va[32], vb[32];
        wload(wa, va); wload(wb, vb);
        wstore(wa, va); if (hb) wstore(wb, vb);
    }
    { bf16* HB = (bf16*)(ws + WS_HB); float* SSQ = (float*)(ws + WS_SSQ);
      for (int row0 = gw; row0 < M; row0 += 4 * NGW) {
        f32x4 v[4][4]; float sv[4]; bool ok[4];
#pragma unroll
        for (int u = 0; u < 4; ++u) { const int row = row0 + u * NGW; ok[u] = row < M;
            const float* src = !ok[u] ? nullptr : row < ROW_S ? args->in[I_XP] + (size_t)row * D : row < ROW_M ? args->in[I_XS] + (size_t)(row - ROW_S) * D : (row - ROW_M) < NMETA ? args->in[I_META] + (size_t)(row - ROW_M) * D : nullptr;
#pragma unroll
            for (int j = 0; j < 4; ++j) v[u][j] = src ? ((const GAS f32x4*)src)[lane + 64 * j] : (f32x4){0.f, 0.f, 0.f, 0.f}; }
#pragma unroll
        for (int u = 0; u < 4; ++u) { float s = 0.f;
#pragma unroll
            for (int j = 0; j < 4; ++j) s += (v[u][j].x * v[u][j].x + v[u][j].y * v[u][j].y) + (v[u][j].z * v[u][j].z + v[u][j].w * v[u][j].w);
            sv[u] = wave_sum(s); }
#pragma unroll
        for (int u = 0; u < 4; ++u) if (ok[u]) { const int row = row0 + u * NGW;
#pragma unroll
            for (int j = 0; j < 4; ++j) ((GAS unsigned long long*)(HB + (size_t)row * D))[lane + 64 * j] = (unsigned long long)pk2(v[u][j].x, v[u][j].y) | ((unsigned long long)pk2(v[u][j].z, v[u][j].w) << 32);
            if (lane < 16) SSQ[(size_t)row * 16 + lane] = lane == 0 ? sv[u] : 0.f; }
      } }
    const int gtid = gw * 64 + lane, NTH = NGW * 64;
    { float* TC = (float*)(ws + WS_TCOS); float* TS = (float*)(ws + WS_TSIN);
      for (int idx = gtid; idx < TP * 32; idx += NTH) {
        const int pos = idx >> 5, i = idx & 31;
        double th = 1.0; for (int k = 0; k < i; ++k) th *= 0.74989420933245582730;
        const double t2 = th * th; double cb = 1.0, sb = th, tc = 1.0, tsn = th;
#pragma unroll 1
        for (int k = 1; k <= 11; ++k) { tc *= -t2 / (double)((2 * k - 1) * (2 * k)); tsn *= -t2 / (double)((2 * k) * (2 * k + 1)); cb += tc; sb += tsn; }
        double cr = 1.0, sr = 0.0;
#pragma unroll 1
        for (int bit = 0; bit < 13; ++bit) { if ((pos >> bit) & 1) { const double c2 = cr * cb - sr * sb, s2 = sr * cb + cr * sb; cr = c2; sr = s2; } const double c3 = cb * cb - sb * sb, s3 = 2.0 * cb * sb; cb = c3; sb = s3; }
        TC[idx] = (float)cr; TS[idx] = (float)sr;
      } }
    if (gw < DEPTH) { const int l = gw; const float s1 = wave_sum(args->in[I_LQ1][l * 64 + lane] * args->in[I_LK1][l * 64 + lane]), s2 = wave_sum(args->in[I_LQ2][l * 64 + lane] * args->in[I_LK2][l * 64 + lane]);
        if (lane == 0) { const float li = 0.8f - 0.6f * expf(-0.3f * (float)l); ((float*)(ws + WS_MISC))[l] = expf(s1) - expf(s2) + li; ((float*)(ws + WS_MISC))[8 + l] = 1.0f - li; } }
    { bf16* KP = (bf16*)(ws + WS_KP); bf16* VP = (bf16*)(ws + WS_VP);
      for (int c = gtid; c < NB * 48 * 128; c += NTH) { const int b = c / (48 * 128), rr = (c / 128) % 48, chn = c & 127; const size_t off = ((size_t)b * KPROWS + 16 + rr) * D + 8 * chn;
        *(GAS v4u*)(KP + off) = (v4u){0u, 0u, 0u, 0u}; *(GAS v4u*)(VP + off) = (v4u){0u, 0u, 0u, 0u}; } }
}

constexpr int RNN_XS = 0, RNN_XC = 36864, RNN_XA = 71680;
constexpr int CW_CNTA = 12288, CW_CNTB = 14336;
constexpr int CW_FLAG = 16384;
constexpr size_t MISC_CARRY = 131072;
#define RNN_BAR() do { asm volatile("s_waitcnt lgkmcnt(0)" ::: "memory"); __builtin_amdgcn_s_barrier(); asm volatile("" ::: "memory"); } while (0)
__device__ __forceinline__ void rnn_prefetch(ArgsP args, const bf16* XR, int l, int pmode, int seq, int n, size_t row0, int tid, v4u (&pf)[3]) {
#pragma unroll
    for (int k = 0; k < 3; ++k) { const int id = tid + k * NWAVES * 64, i = id >> 4, c8 = id & 15;
        if (id < 67 * 16) {
            if (i >= 3 || pmode == 0) pf[k] = *(const GAS v4u*)(XR + (row0 + i - 3) * D + 128 * n + 8 * c8);
            else if (pmode == 1) pf[k] = *(const GAS v4u*)(XR + ((size_t)ROW_M + 13 + i) * D + 128 * n + 8 * c8);
            else if (pmode == 2) { const float* sc = args->in[I_SC] + ((size_t)(l * NDB + seq) * 3 + i) * D + 128 * n + 8 * c8; pf[k] = pack8f(*(const GAS f32x4*)sc, *(const GAS f32x4*)(sc + 4)); }
            else pf[k] = (v4u){0u, 0u, 0u, 0u};
        } }
}
__device__ __forceinline__ void rnn_unit(ArgsP args, int l, int kind, int seq, int n, int g, LAS unsigned char* lds, int tid, int lane, int wid) {
    unsigned char* ws = args->ws;
    LAS float* XS = (LAS float*)(lds + RNN_XS); LAS float* XC = (LAS float*)(lds + RNN_XC); LAS bf16* XA = (LAS bf16*)(lds + RNN_XA);
    const bf16* XR = (const bf16*)(ws + WS_XR); const bf16* ZR = (const bf16*)(ws + WS_ZR); bf16* OX = (bf16*)(ws + WS_OX);
    const int q = lane >> 4, cl = lane & 15, cc = 16 * wid + cl, ch = 128 * n + cc;
    const float brg = args->in[I_BRG][l * D + ch], big = args->in[I_BIG][l * D + ch];
    float sp; { const float x = -args->in[I_LAM][l * D + ch]; sp = fmaxf(x, 0.f) + log1pf(__expf(-fabsf(x))); }
    const int c2 = tid & 127, rg = tid >> 7, chc = 128 * n + c2;
    const float cw0 = args->in[I_CW][(l * 4 + 0) * D + chc], cw1 = args->in[I_CW][(l * 4 + 1) * D + chc], cw2 = args->in[I_CW][(l * 4 + 2) * D + chc], cw3 = args->in[I_CW][(l * 4 + 3) * D + chc], cb = args->in[I_CB][l * D + chc];
    const bf16* wg = (const bf16*)(ws + WS_W + (size_t)l * W_LAYER + W_G) + (size_t)(n * 2) * 16384;
    bf16x8 Br[4], Bi[4];
#pragma unroll
    for (int ks = 0; ks < 4; ++ks) { Br[ks] = *(const bf16x8*)(wg + (size_t)cc * 128 + 32 * ks + 8 * q); Bi[ks] = *(const bf16x8*)(wg + 16384 + (size_t)cc * 128 + 32 * ks + 8 * q); }
    const int ntiles = kind == 0 ? 16 : 1;
    const int jstart = (kind == 0 && g == 0) ? -1 : 0;
    const size_t rowbase = kind == 0 ? (size_t)seq * SEQ + (size_t)g * 1024 : kind == 1 ? (size_t)ROW_S + (size_t)seq * DSQ : (size_t)ROW_M;
    float* carry = (float*)(ws + WS_MISC + MISC_CARRY) + (size_t)((((l * NB + seq) * 8 + n) * 4) + g) * 128;
    gu32* flag = (gu32*)(ws + WS_CTL) + CW_FLAG + 64 * ((((l * NB + seq) * 8 + n) * 4) + g);
    float hrun = 0.f;
    if (kind == 1) hrun = args->in[I_SR][(size_t)(l * NDB + seq) * D + ch];
    v4u pf[3] = {{0u, 0u, 0u, 0u}, {0u, 0u, 0u, 0u}, {0u, 0u, 0u, 0u}};
    rnn_prefetch(args, XR, l, jstart < 0 ? 3 : (kind == 0 ? 0 : kind == 1 ? 2 : 3), seq, n, jstart < 0 ? (size_t)ROW_M : rowbase, tid, pf);
    if (kind == 0 && g > 0) {
        if (tid == 0) { unsigned spn = 0u; while (__hip_atomic_load(flag - 64, RLX_AGENT) == 0u) { __builtin_amdgcn_s_sleep(2); if (++spn > (1u << 22)) { __hip_atomic_store((gu32*)(ws + WS_CTL) + CW_TMO, 0xC0DEu, RLX_AGENT); break; } }
            __builtin_amdgcn_fence(__ATOMIC_ACQUIRE, "agent"); asm volatile("s_waitcnt vmcnt(0)" ::: "memory"); }
        __syncthreads();
        hrun = __hip_atomic_load(carry - 128 + cc, RLX_AGENT);
    }
    for (int j = jstart; j < ntiles; ++j) {
        const bool pre = j < 0;
        const size_t row0 = pre ? (size_t)ROW_M : rowbase + 64 * j;
        const int nvalid = (pre || kind == 2) ? NMETA : 64;
#pragma unroll
        for (int k = 0; k < 3; ++k) { const int id = tid + k * NWAVES * 64, i = id >> 4, c8 = id & 15;
            if (id < 67 * 16) { const v4u w = pf[k];
                *(LAS f32x4*)(XS + i * 132 + 8 * c8) = (f32x4){bflo(w.x), bfhi(w.x), bflo(w.y), bfhi(w.y)}; *(LAS f32x4*)(XS + i * 132 + 8 * c8 + 4) = (f32x4){bflo(w.z), bfhi(w.z), bflo(w.w), bfhi(w.w)}; } }
        if (j + 1 < ntiles) rnn_prefetch(args, XR, l, pre ? 1 : 0, seq, n, rowbase + 64 * (j + 1), tid, pf);
        v4u zf[2] = {{0u, 0u, 0u, 0u}, {0u, 0u, 0u, 0u}};
        if (!pre) {
#pragma unroll
            for (int k = 0; k < 2; ++k) { const int id = tid + k * NWAVES * 64, r = id >> 4, c8 = id & 15; zf[k] = *(const GAS v4u*)(ZR + (row0 + r) * D + 128 * n + 8 * c8); } }
        RNN_BAR();
        { const int rb = 16 * rg; float x0 = XS[(rb + 0) * 132 + c2], x1 = XS[(rb + 1) * 132 + c2], x2 = XS[(rb + 2) * 132 + c2];
#pragma unroll
          for (int r = 0; r < 16; ++r) { const float x3 = XS[(rb + r + 3) * 132 + c2]; const float xc = (((cb + x0 * cw0) + x1 * cw1) + x2 * cw2) + x3 * cw3;
              XC[(rb + r) * 132 + c2] = xc; XA[(rb + r) * 136 + c2] = (bf16)f2bf(xc); x0 = x1; x1 = x2; x2 = x3; } }
        RNN_BAR();
#pragma unroll
        for (int mt = 0; mt < 4; ++mt) {
            f32x4 ar = {0.f, 0.f, 0.f, 0.f}, ai = {0.f, 0.f, 0.f, 0.f};
#pragma unroll
            for (int ks = 0; ks < 4; ++ks) { const bf16x8 A = *(const LAS bf16x8*)(XA + (16 * mt + cl) * 136 + 32 * ks + 8 * q);
                ar = __builtin_amdgcn_mfma_f32_16x16x32_bf16(A, Br[ks], ar, 0, 0, 0); ai = __builtin_amdgcn_mfma_f32_16x16x32_bf16(A, Bi[ks], ai, 0, 0, 0); }
            float a[4], b[4];
#pragma unroll
            for (int i = 0; i < 4; ++i) { const int r = 16 * mt + 4 * q + i; const float xc = XC[r * 132 + cc];
                const float er1 = 1.0f + __expf(fminf(-(ar[i] + brg), 40.f)), ei1 = 1.0f + __expf(fminf(-(ai[i] + big), 40.f)); const float tq = __builtin_amdgcn_rcpf(er1 * ei1);
                const float rr = tq * ei1, ii = tq * er1;
                const float av = __expf(-8.0f * rr * sp); a[i] = av; b[i] = __builtin_amdgcn_sqrtf(fmaxf((1.0f - av) * (1.0f + av), 0.f)) * ii * xc;
                if (r >= nvalid) { a[i] = 1.f; b[i] = 0.f; } }
            const float A4 = (a[0] * a[1]) * (a[2] * a[3]), B4 = ((b[0] * a[1] + b[1]) * a[2] + b[2]) * a[3] + b[3];
            float Ai = A4, Bi2 = B4;
            { const float ua = __shfl_up(Ai, 16), ub = __shfl_up(Bi2, 16); if (q >= 1) { Bi2 = Ai * ub + Bi2; Ai = ua * Ai; } }
            { const float ua = __shfl_up(Ai, 32), ub = __shfl_up(Bi2, 32); if (q >= 2) { Bi2 = Ai * ub + Bi2; Ai = ua * Ai; } }
            float Ae = __shfl_up(Ai, 16), Be = __shfl_up(Bi2, 16); if (q == 0) { Ae = 1.f; Be = 0.f; }
            const float At = __shfl(Ai, 48 + cl), Bt = __shfl(Bi2, 48 + cl);
            float h = Ae * hrun + Be;
#pragma unroll
            for (int i = 0; i < 4; ++i) { h = a[i] * h + b[i]; XC[(16 * mt + 4 * q + i) * 132 + cc] = h; }
            hrun = At * hrun + Bt;
        }
        RNN_BAR();
        if (!pre) {
#pragma unroll
            for (int k = 0; k < 2; ++k) { const int id = tid + k * NWAVES * 64, r = id >> 4, c8 = id & 15;
                const f32x4 h0 = *(const LAS f32x4*)(XC + r * 132 + 8 * c8), h1 = *(const LAS f32x4*)(XC + r * 132 + 8 * c8 + 4);
                const v4u z = zf[k];
                const f32x4 o0 = h0 * (f32x4){bflo(z.x), bfhi(z.x), bflo(z.y), bfhi(z.y)}, o1 = h1 * (f32x4){bflo(z.z), bfhi(z.z), bflo(z.w), bfhi(z.w)};
                *(GAS v4u*)(OX + (row0 + r) * 2 * D + 128 * n + 8 * c8) = pack8f(o0, o1); }
        }
    }
    const bool publish = (kind == 0 && g < 3);
    if (q == 0) {
        if (kind == 0 && g == 3) args->out[O_RP + (size_t)(l * NB + seq) * D + ch] = hrun;
        if (kind == 1) args->out[O_RS + (size_t)(l * NDB + seq) * D + ch] = hrun;
        if (publish) __hip_atomic_store(carry + cc, hrun, RLX_AGENT);
    }
    if (publish) asm volatile("s_waitcnt vmcnt(0)" ::: "memory");
    RNN_BAR();
    if (publish && tid == 0) __hip_atomic_store(flag, 1u, RLX_AGENT);
}
__device__ __forceinline__ void attn_finish(ArgsP args, int l, size_t row0, int h, int nw, int lane, int wid) {
    if (wid >= nw) return;
    unsigned char* ws = args->ws;
    asm volatile("s_waitcnt vmcnt(0)" ::: "memory");
    const float lam = ((const float*)(ws + WS_MISC))[l], oml = ((const float*)(ws + WS_MISC))[8 + l];
    int ln = lane; asm volatile("" : "+v"(ln));
    const int r = ln >> 1, half = ln & 1; const size_t row = row0 + 32 * wid + r;
    const bf16* p1 = (const bf16*)(ws + WS_OP) + row * 2048 + (size_t)(h * 2) * 128 + half * 64; const bf16* p2 = p1 + 128;
    float d[64]; float ss = 0.f;
#pragma unroll
    for (int k = 0; k < 8; ++k) { const v4u a = *(const GAS v4u*)(p1 + 8 * k), b = *(const GAS v4u*)(p2 + 8 * k);
        d[8 * k + 0] = bflo(a.x) - lam * bflo(b.x); d[8 * k + 1] = bfhi(a.x) - lam * bfhi(b.x); d[8 * k + 2] = bflo(a.y) - lam * bflo(b.y); d[8 * k + 3] = bfhi(a.y) - lam * bfhi(b.y);
        d[8 * k + 4] = bflo(a.z) - lam * bflo(b.z); d[8 * k + 5] = bfhi(a.z) - lam * bfhi(b.z); d[8 * k + 6] = bflo(a.w) - lam * bflo(b.w); d[8 * k + 7] = bfhi(a.w) - lam * bfhi(b.w);
#pragma unroll
        for (int e = 0; e < 8; ++e) ss += d[8 * k + e] * d[8 * k + e]; }
    ss += __shfl_xor(ss, 1);
    const float scale = rsqrtf(ss * (1.0f / 128.0f) + EPS) * oml;
    const bf16* za = (const bf16*)(ws + WS_ZA) + row * D + h * 128 + half * 64; const float* sw = args->in[I_SUBLN] + l * 128 + half * 64;
    bf16* od = (bf16*)(ws + WS_OX) + row * 2 * D + D + h * 128 + half * 64;
#pragma unroll
    for (int k = 0; k < 8; ++k) { const v4u z = *(const GAS v4u*)(za + 8 * k); const f32x4 w0 = *(const GAS f32x4*)(sw + 8 * k), w1 = *(const GAS f32x4*)(sw + 8 * k + 4);
        f32x4 o0, o1;
        o0[0] = d[8 * k + 0] * scale * w0[0] * bflo(z.x); o0[1] = d[8 * k + 1] * scale * w0[1] * bfhi(z.x); o0[2] = d[8 * k + 2] * scale * w0[2] * bflo(z.y); o0[3] = d[8 * k + 3] * scale * w0[3] * bfhi(z.y);
        o1[0] = d[8 * k + 4] * scale * w1[0] * bflo(z.z); o1[1] = d[8 * k + 5] * scale * w1[1] * bfhi(z.z); o1[2] = d[8 * k + 6] * scale * w1[2] * bflo(z.w); o1[3] = d[8 * k + 7] * scale * w1[3] * bfhi(z.w);
        *(GAS v4u*)(od + 8 * k) = pack8f(o0, o1); }
}
__device__ __forceinline__ void attn_super(ArgsP args, int l, int kind, int a, int h, int qb, char* shm, int lane, int wid) {
    typedef attn_body::bf16 abf;
    unsigned char* ws = args->ws;
    const abf* Q = (const abf*)(ws + WS_Q); abf* OP = (abf*)(ws + WS_OP);
    size_t qrow; const abf* Kb; const abf* Vb; int NT, vis, qwaves;
    if (kind == 0)      { qrow = (size_t)a * SEQ + (size_t)qb * 256; Kb = (const abf*)(ws + WS_KP) + (size_t)a * KPROWS * D; Vb = (const abf*)(ws + WS_VP) + (size_t)a * KPROWS * D; NT = 4 * qb + 5; vis = (wid >> 1) + 1; qwaves = 8; }
    else if (kind == 1) { qrow = (size_t)ROW_S + (size_t)a * DSQ; Kb = (const abf*)(ws + WS_KS) + (size_t)(l * NDB + a) * KSROWS * D; Vb = (const abf*)(ws + WS_VS) + (size_t)(l * NDB + a) * KSROWS * D; NT = 33; vis = 4; qwaves = 2; }
    else                { qrow = (size_t)ROW_M; Kb = (const abf*)(ws + WS_KP); Vb = (const abf*)(ws + WS_VP); NT = 5; vis = 0; qwaves = 8; }
    const attn128::Fin nofin{0, 0, 0u};
    if (kind == 1) {
        attn128::attn_unit128<8, false, true, false>(Q + qrow * D + (h * 2) * 64, Kb + (h * 2) * 64, Vb + h * 128, OP + qrow * 2048 + (h * 2) * 128, NT, vis, qwaves, shm, nofin);
        attn_finish(args, l, qrow, h, qwaves, lane, wid);
    } else {
        attn128::attn_unit128<8, true, false, false>(Q + qrow * D + (h * 2) * 64, Kb + (h * 2) * 64, Vb + h * 128, OP + qrow * 2048 + (h * 2) * 128, NT, vis, qwaves, shm, nofin);
        const attn128::Fin fin{l, h, (unsigned)qrow};
        attn128::attn_unit128<8, true, false, true>(Q + qrow * D + (h * 2 + 1) * 64, Kb + (h * 2 + 1) * 64, Vb + h * 128, OP + qrow * 2048 + (h * 2 + 1) * 128, NT, vis, qwaves, shm, fin);
    }
}

__global__ void __launch_bounds__(NWAVES * 64, 2) hawk_fwd(Args args) {
    extern __shared__ __attribute__((aligned(16))) unsigned char lds_raw[];
    LAS unsigned char* lds = (LAS unsigned char*)lds_raw;
    volatile LAS unsigned* MISC = (volatile LAS unsigned*)(lds + MISC_OFF);
    const int tid = threadIdx.x;
    const int G = gridDim.x; const int bx = blockIdx.x; const int vcu = (G % 8 == 0) ? (bx % 8) * (G / 8) + bx / 8 : bx;
    for (int u = tid; u < (LDS_BYTES - LDSCTL_OFF) / 4; u += NWAVES * 64) ((LAS unsigned*)(lds + LDSCTL_OFF))[u] = 0u;
    __syncthreads();
#if MK_PER_PHASE
#define GRID_BAR() do { if (tid == 0) __hip_atomic_store((gu32*)(KARG()->ws + WS_CTL) + CW_TMO, 0xBADBA0u, RLX_AGENT); } while (0)
#else
    (void)xcd_barrier_post((unsigned*)((gu32*)(KARG()->ws + WS_CTL) + CW_BAR), MISC + 8);
#define GRID_BAR() do { XcdBarrier bar_; bar_.bar = (unsigned*)((gu32*)(KARG()->ws + WS_CTL) + CW_BAR); bar_.x = xb_xcc_id(); bar_.st = MISC + 8; xcd_barrier(bar_); } while (0)
#endif
    const int lo = KARG()->ph_lo, hi = KARG()->ph_hi;
#if MK_PROBE
#define TACC() ((unsigned long long*)(KARG()->ws + WS_MISC + 32768))
    if (blockIdx.x == 0 && tid == 0) { unsigned long long* ta = TACC(); for (int k = 0; k < 16; ++k) ta[k] = 0ull; ta[16] = __builtin_amdgcn_s_memrealtime(); }
#define TMARK(k) do { if (blockIdx.x == 0 && tid == 0) { unsigned long long* ta = TACC(); const unsigned long long now = __builtin_amdgcn_s_memrealtime(); ta[k] += now - ta[16]; ta[16] = now; } } while (0)
#else
#define TMARK(k) do {} while (0)
#endif
#define IN(k) (lo <= (k) && (k) < hi)
#ifndef PHMASK
#define PHMASK 0xff
#endif
#define PH(b) ((PHMASK >> (b)) & 1)
#define BOTH(k) (IN(k) && IN((k) + 1))
    typedef pg8::bf16_t pb;
    for (int rep_ = 0; rep_ < MK_REP_P0; ++rep_)
    if (PH(0) && IN(0)) { int tid_l = tid; asm volatile("" : "+v"(tid_l)); p0_prologue(KARG(), lds, tid_l & 63, __builtin_amdgcn_readfirstlane(tid_l >> 6), vcu, G); if (BOTH(0) || rep_ + 1 < MK_REP_P0) GRID_BAR(); TMARK(0); }

    for (int l = 0; l < DEPTH; ++l) {
        const int pbase = 1 + 4 * l;
        for (int rep_ = 0; rep_ < MK_REP_P1; ++rep_)
        if (PH(1) && IN(pbase)) {
            ArgsP args = KARG(); unsigned char* ws = args->ws; unsigned char* wl = ws + WS_W + (size_t)l * W_LAYER;
            pg8::Gemm g{(const pb*)(ws + WS_HB), (const pb*)(wl + W_IN), D, D, 0};
#if MK_KPROBE
            pg8::TwoPartOrder S; S.init(M, INC, G, bx);
#else
            pg8::StaticOrder S; S.init(M, INC, G, bx);
#endif
            pg8::EpiIn E{l, ws, args->out};
#if MK_STAGGER
            if ((blockIdx.x >> 3) & 1) { __builtin_amdgcn_s_sleep(127); __builtin_amdgcn_s_sleep(127); __builtin_amdgcn_s_sleep(127); __builtin_amdgcn_s_sleep(127); }
#endif
            #if MK_KPROBE
            pg8::gemm_phase<pg8::EpiIn, pg8::TwoPartOrder, true, true>(lds + RING_OFF, g, S, E);
#else
            pg8::gemm_phase<pg8::EpiIn, pg8::StaticOrder, MK_ALIGN_P1, true>(lds + RING_OFF, g, S, E);
#endif
            TMARK(7); if (BOTH(pbase) || rep_ + 1 < MK_REP_P1) GRID_BAR(); TMARK(1);
        }
        for (int rep_ = 0; rep_ < MK_REP_P3; ++rep_)
        if ((PH(3) || PH(4)) && IN(pbase + 1)) {
            const int xcd0 = (int)(xb_xcc_id() & 7u);
            for (int probe = 0; probe < 8; ++probe) {
              const int qx = (xcd0 + probe) & 7;
              if (probe == 1) {
                  int tid_c = tid; asm volatile("" : "+v"(tid_c));
                  if (tid_c < 64) { unsigned hv = 216u; if (tid_c < 8) hv = __hip_atomic_load((gu32*)(KARG()->ws + WS_CTL) + CW_QUEUE + 64 * ((l + 4 * rep_) * 8 + ((xcd0 + tid_c) & 7)), RLX_AGENT);
                      const unsigned long long lm = __ballot(hv < 216u); if (tid_c == 0) MISC[1] = (unsigned)lm; }
                  __syncthreads();
              }
              if (probe >= 1 && !((MISC[1] >> probe) & 1u)) continue;
              for (;;) {
                ArgsP args = KARG();
                int tid_l = tid; asm volatile("" : "+v"(tid_l)); const int lane_l = tid_l & 63, wave_l = __builtin_amdgcn_readfirstlane(tid_l >> 6);
                if (tid_l == 0) MISC[0] = __hip_atomic_fetch_add((gu32*)(args->ws + WS_CTL) + CW_QUEUE + 64 * ((l + 4 * rep_) * 8 + qx), 1u, RLX_AGENT);
                __syncthreads();
                const int idx = (int)MISC[0];
                __syncthreads();
                if (idx >= 216) break;
                int sig = -1;
                if (idx < 8) rnn_unit(args, l, 0, qx, idx, 0, lds + RING_OFF, tid_l, lane_l, wave_l);
                else if (idx < 24) { const int db = 2 * qx + ((idx - 8) >> 3);
                    cache_convert_head(args, l, db, (idx - 8) & 7, tid_l, NWAVES * 64); asm volatile("s_waitcnt vmcnt(0)" ::: "memory"); __syncthreads();
                    attn_super(args, l, 1, db, (idx - 8) & 7, 0, (char*)lds_raw + RING_OFF, lane_l, wave_l); sig = db >> 2; }
                else if (idx == 24) { attn_super(args, l, 2, 0, qx, 0, (char*)lds_raw + RING_OFF, lane_l, wave_l); sig = 4; }
                else if (idx >= 32 && idx < 56) rnn_unit(args, l, 0, qx, (idx - 32) & 7, 1 + ((idx - 32) >> 3), lds + RING_OFF, tid_l, lane_l, wave_l);
                else if (idx >= 56 && idx < 72) { const int db = 2 * qx + ((idx - 56) >> 3); rnn_unit(args, l, 1, db, (idx - 56) & 7, 0, lds + RING_OFF, tid_l, lane_l, wave_l); sig = db >> 2; }
                else if (idx == 72) { rnn_unit(args, l, 2, 0, qx, 0, lds + RING_OFF, tid_l, lane_l, wave_l); sig = 4; }
                else if (idx >= 73 && idx < 89) { }
                else if ((idx >= 105 && idx < 108) || (idx >= 130 && idx < 133)) {
                    const bool isC = idx >= 130; const int k = isC ? idx - 130 : idx - 105;
                    if (k < 2 || qx < 4) {
                        const int panel = k < 2 ? (qx >> 1) : 4, pn = k < 2 ? 2 * (qx & 1) + k : qx, pm = 128 + panel;
                        gu32* cw = (gu32*)(args->ws + WS_CTL) + (isC ? CW_CNTB : CW_CNTA) + 64 * (l * 8 + panel);
                        const unsigned want = isC ? 4u : (panel < 4 ? 64u : 16u);
                        if (tid_l == 0) { unsigned spn = 0u; while (__hip_atomic_load(cw, RLX_AGENT) < want) { __builtin_amdgcn_s_sleep(4); if (++spn > (1u << 22)) { __hip_atomic_store((gu32*)(args->ws + WS_CTL) + CW_TMO, 0xC0DFu, RLX_AGENT); break; } }
                            __builtin_amdgcn_fence(__ATOMIC_ACQUIRE, "agent"); asm volatile("s_waitcnt vmcnt(0)" ::: "memory"); }
                        __syncthreads();
                        unsigned char* ws = args->ws; unsigned char* wl = ws + WS_W + (size_t)l * W_LAYER;
                        if (!isC) { pg8::Gemm g{(const pb*)(ws + WS_OX), (const pb*)(wl + W_PROJ), 2 * D, D, D}; pg8::OneUnit S{pm, pn, 2}; pg8::EpiProj E{ws};
                            pg8::gemm_phase<pg8::EpiProj, pg8::OneUnit, true, true>(lds + RING_OFF, g, S, E);
                            asm volatile("s_waitcnt vmcnt(0)" ::: "memory"); __syncthreads();
                            if (tid_l == 0) { __builtin_amdgcn_fence(__ATOMIC_RELEASE, "agent"); asm volatile("s_waitcnt vmcnt(0)" ::: "memory");     __hip_atomic_fetch_add((gu32*)(ws + WS_CTL) + CW_CNTB + 64 * (l * 8 + panel), 1u, RLX_AGENT); } }
                        else { pg8::Gemm g{(const pb*)(ws + WS_MB), (const pb*)(wl + W_OUT), D, D, 0}; pg8::OneUnit S{pm, pn, 1}; pg8::EpiOut E{ws};
                            pg8::gemm_phase<pg8::EpiOut, pg8::OneUnit, true, true>(lds + RING_OFF, g, S, E); }
                    }
                }
                else { const int i = idx < 32 ? idx - 25 : idx < 105 ? idx - 89 + 7 : idx < 130 ? idx - 108 + 23 : idx - 133 + 45, r = i & 31;
                    (void)r; attn_super(args, l, 0, qx, i & 7, 15 - (i >> 3), (char*)lds_raw + RING_OFF, lane_l, wave_l); }
                if (sig >= 0) { asm volatile("s_waitcnt vmcnt(0)" ::: "memory"); __syncthreads();
                    if (tid_l == 0) { __builtin_amdgcn_fence(__ATOMIC_RELEASE, "agent"); asm volatile("s_waitcnt vmcnt(0)" ::: "memory");     __hip_atomic_fetch_add((gu32*)(args->ws + WS_CTL) + CW_CNTA + 64 * (l * 8 + sig), 1u, RLX_AGENT); } }
              }
            }
            TMARK(8); if (BOTH(pbase + 1) || rep_ + 1 < MK_REP_P3) GRID_BAR(); TMARK(3);
        }
        for (int rep_ = 0; rep_ < MK_REP_P4; ++rep_)
        if (PH(5) && IN(pbase + 2)) {
            ArgsP args = KARG(); unsigned char* ws = args->ws; unsigned char* wl = ws + WS_W + (size_t)l * W_LAYER;
            pg8::Gemm g{(const pb*)(ws + WS_OX), (const pb*)(wl + W_PROJ), 2 * D, D, D}; pg8::TwoPartOrder S; S.init(MP, D, G, bx);
            pg8::EpiProj E{ws};
            pg8::gemm_phase<pg8::EpiProj, pg8::TwoPartOrder, true, true>(lds + RING_OFF, g, S, E);
            TMARK(9); if (BOTH(pbase + 2) || rep_ + 1 < MK_REP_P4) GRID_BAR(); TMARK(4);
        }
#define P5_BODY() do { ArgsP args = KARG(); unsigned char* ws = args->ws; unsigned char* wl = ws + WS_W + (size_t)l * W_LAYER; \
            pg8::Gemm g{(const pb*)(ws + WS_MB), (const pb*)(wl + W_OUT), D, D, 0}; pg8::StaticOrder S; S.init(MP, D, G, bx); \
            pg8::EpiOut E{ws}; \
            pg8::gemm_phase<pg8::EpiOut, pg8::StaticOrder, true, true>(lds + RING_OFF, g, S, E); } while (0)
        if (PH(6) && IN(pbase + 3)) {
#if MK_REP_P5 == 2
            P5_BODY(); GRID_BAR();
#endif
            P5_BODY();
            if (BOTH(pbase + 3)) GRID_BAR(); TMARK(5);
        }
    }
    if (PH(7) && IN(N_PHASES - 1)) {
        ArgsP args = KARG(); unsigned char* ws = args->ws;
        int tid_l = tid; asm volatile("" : "+v"(tid_l)); const int lane = tid_l & 63, wave = __builtin_amdgcn_readfirstlane(tid_l >> 6);
        const bf16* HB = (const bf16*)(ws + WS_HB); const float* fw = args->in[I_FNW];
        const int gw = vcu * NWAVES + wave, NGW = G * NWAVES;
        f32x4 w4[4];
#pragma unroll
        for (int j = 0; j < 4; ++j) w4[j] = ((const GAS f32x4*)fw)[lane + 64 * j];
        for (int row = gw; row < ROW_M; row += NGW) {
            f32x4 v[4]; float s = 0.f;
#pragma unroll
            for (int j = 0; j < 4; ++j) { const unsigned long long w = ((const GAS unsigned long long*)(HB + (size_t)row * D))[lane + 64 * j]; const unsigned lo = (unsigned)w, hi = (unsigned)(w >> 32);
                v[j] = (f32x4){bflo(lo), bfhi(lo), bflo(hi), bfhi(hi)}; s += (v[j].x * v[j].x + v[j].y * v[j].y) + (v[j].z * v[j].z + v[j].w * v[j].w); }
            const float rs = rsqrtf(wave_sum(s) * (1.0f / 1024.0f) + EPS);
            float* o = args->out + (row < ROW_S ? O_YP + (size_t)row * D : O_YS + (size_t)(row - ROW_S) * D);
#pragma unroll
            for (int j = 0; j < 4; ++j) ((GAS f32x4*)o)[lane + 64 * j] = v[j] * rs * w4[j];
        }
    }
#if MK_PROBE
    GRID_BAR(); TMARK(6);
    if (blockIdx.x == 0) {
        __syncthreads();
        const size_t offs[10] = {O_YP, O_YS, O_KP, O_VP, O_CP, O_RP, O_KS, O_VS, O_CS, O_RS};
#pragma unroll
        for (int k = 0; k < 10; ++k) { unsigned long long t = TACC()[k]; if (k == 1) t += TACC()[7]; if (k == 3) t += TACC()[8]; if (k == 4) t += TACC()[9];
            unsigned n = (unsigned)(t / 100ull); if (n > 30000u) n = 30000u;
            unsigned* o = (unsigned*)(KARG()->out + offs[k]); for (unsigned i = tid; i < n; i += NWAVES * 64) o[i] = 0xAAAAAAAAu; }
    }
#endif
#undef IN
#undef BOTH
}

extern "C" void kernel_launch(void* const* d_in, const int* in_sizes, int n_in, void* d_out, int out_size, void* d_ws, size_t ws_size, hipStream_t stream) {
    static int grid = 0;
    if (grid == 0) {
        if (n_in != 25 || (size_t)out_size != O_END || ws_size < WS_END) { fprintf(stderr, "kernel_launch: unexpected shapes (n_in %d, out %d, ws %zu); nothing launched\n", n_in, out_size, ws_size); grid = -1; return; }
        int dev = 0, cus = 0, per_cu = 0;
        if (hipGetDevice(&dev) != hipSuccess || hipDeviceGetAttribute(&cus, hipDeviceAttributeMultiprocessorCount, dev) != hipSuccess) { grid = -1; return; }
        if (hipFuncSetAttribute((const void*)hawk_fwd, hipFuncAttributeMaxDynamicSharedMemorySize, LDS_BYTES) != hipSuccess) { fprintf(stderr, "kernel_launch: hipFuncSetAttribute failed\n"); grid = -1; return; }
        if (hipOccupancyMaxActiveBlocksPerMultiprocessor(&per_cu, (const void*)hawk_fwd, NWAVES * 64, LDS_BYTES) != hipSuccess || per_cu < 1) { fprintf(stderr, "kernel_launch: occupancy query reports %d workgroups per CU\n", per_cu); }
        (void)hipGetLastError();
        grid = cus;
    }
    if (grid < 0) return;
    if (hipMemsetAsync((char*)d_ws + WS_CTL, 0, CTL_ZERO_BYTES, stream) != hipSuccess) return;
    Args a{};
    for (int i = 0; i < 25; ++i) a.in[i] = (const float*)d_in[i];
    a.out = (float*)d_out; a.ws = (unsigned char*)d_ws;
#if MK_PER_PHASE
    for (int p = 0; p < N_PHASES; ++p) { a.ph_lo = p; a.ph_hi = p + 1; a.li = p; hipLaunchKernelGGL(hawk_fwd, dim3(grid), dim3(NWAVES * 64), LDS_BYTES, stream, a); }
#else
    a.ph_lo = 0; a.ph_hi = N_PHASES; a.li = 0;
    hipLaunchKernelGGL(hawk_fwd, dim3(grid), dim3(NWAVES * 64), LDS_BYTES, stream, a);
#endif
    const hipError_t le = hipPeekAtLastError();
    if (le != hipSuccess) fprintf(stderr, "kernel_launch: launch failed: %s\n", hipGetErrorName(le));
}
```

```cpp
#include <hip/hip_runtime.h>
#include <hip/hip_bf16.h>
#include <cstdio>
#include <cstdint>
#include <cmath>

#ifndef MK_PROBE
#define MK_PROBE 0
#endif
#ifndef MK_REP_P0
#define MK_REP_P0 1
#endif
#ifndef MK_REP_P1
#define MK_REP_P1 1
#endif
#ifndef MK_REP_P2
#define MK_REP_P2 1
#endif
#ifndef MK_REP_P3
#define MK_REP_P3 1
#endif
#ifndef MK_REP_P4
#define MK_REP_P4 1
#endif
#ifndef MK_REP_P5
#define MK_REP_P5 1
#endif
#ifndef MK_ALIGN_P1
#define MK_ALIGN_P1 true
#endif
#ifndef MK_EPI2
#define MK_EPI2 0
#endif
#ifndef MK_KPROBE
#define MK_KPROBE 0
#endif
#ifndef MK_STAGGER
#define MK_STAGGER 0
#endif
#ifndef MK_PER_PHASE
#define MK_PER_PHASE 0
#endif

constexpr int D = 1024, NB = 8, SEQ = 4096, DEPTH = 4, NDB = 16, DSQ = 64, PAST = 2048, NMETA = 16, NH = 8, INC = 8192;
constexpr int MP = NB * SEQ;
constexpr int MSM = NDB * DSQ;
constexpr int ROW_S = MP, ROW_M = MP + MSM;
constexpr int M = ROW_M + 256;
constexpr int TP = NMETA + SEQ;
constexpr int KPROWS = 64 + SEQ;
constexpr int KSROWS = PAST + DSQ;
constexpr float EPS = 1e-6f;
constexpr float QSCALE = 0.125f * 1.4426950408889634f;

constexpr size_t O_YP = 0, O_YS = 33554432, O_KP = 34603008, O_VP = 169345024, O_CP = 304087040, O_RP = 304185344,
                 O_KS = 304218112, O_VS = 308412416, O_CS = 312606720, O_RS = 312803328, O_END = 312868864;

constexpr size_t MiB = 1u << 20;
constexpr size_t WS_CTL = 0, CTL_ZERO_BYTES = 1 * MiB;
constexpr size_t WS_TCOS = 1 * MiB, WS_TSIN = 2 * MiB;
constexpr size_t WS_MISC = 3 * MiB;
constexpr size_t WS_W = 4 * MiB, W_LAYER = 24 * MiB, W_IN = 0, W_PROJ = 16 * MiB, W_OUT = 20 * MiB, W_G = 22 * MiB;
constexpr size_t WS_HRES = 100 * MiB;
constexpr size_t WS_HB = 233 * MiB;
constexpr size_t WS_SSQ = 300 * MiB;
constexpr size_t WS_XR = 303 * MiB, WS_ZR = 370 * MiB, WS_Q = 437 * MiB, WS_ZA = 504 * MiB, WS_RHO = 571 * MiB, WS_SGA = 638 * MiB;
constexpr size_t WS_OX = 705 * MiB;
constexpr size_t WS_MB = 838 * MiB;
constexpr size_t WS_OP = 905 * MiB;
constexpr size_t WS_KP = 1038 * MiB, WS_VP = 1103 * MiB;
constexpr size_t WS_KS = 1168 * MiB, WS_VS = 1432 * MiB;
constexpr size_t WS_HRES2 = 1696 * MiB;
constexpr size_t WS_END = 1830 * MiB;
static_assert(WS_HRES + (size_t)M * D * 4 <= WS_HB && WS_HB + (size_t)M * D * 2 <= WS_SSQ && WS_SSQ + (size_t)M * 64 <= WS_XR, "ws map 1");
static_assert(WS_XR + (size_t)M * D * 2 <= WS_ZR && WS_SGA + (size_t)M * D * 2 <= WS_OX && WS_OX + (size_t)M * 4096 <= WS_MB && WS_MB + (size_t)M * 2048 <= WS_OP, "ws map 2");
static_assert(WS_OP + (size_t)M * 4096 <= WS_KP && WS_KP + (size_t)NB * KPROWS * 2048 <= WS_VP && WS_VP + (size_t)NB * KPROWS * 2048 <= WS_KS, "ws map 3");
static_assert(WS_KS + (size_t)DEPTH * NDB * KSROWS * 2048 <= WS_VS && WS_VS + (size_t)DEPTH * NDB * KSROWS * 2048 <= WS_END, "ws map 4");
constexpr int CW_TMO = 0, CW_CODE = 1;
constexpr int CW_QUEUE = 64;
constexpr int CW_BAR = 8192;

struct Args { const float* in[25]; float* out; unsigned char* ws; int ph_lo, ph_hi, li, pad; };
#define CAS __attribute__((address_space(4)))
typedef const CAS struct Args* ArgsP;
#define KARG() ({ ArgsP p_ = (ArgsP)__builtin_amdgcn_kernarg_segment_ptr(); asm volatile("" : "+s"(p_)); p_; })
enum { I_XP = 0, I_XS, I_CK, I_CV, I_SC, I_SR, I_META, I_NW, I_WIN, I_CW, I_CB, I_WRG, I_BRG, I_WIG, I_BIG, I_LAM, I_LQ1, I_LK1, I_LQ2, I_LK2, I_SUBLN, I_WPR, I_WPA, I_WOUT, I_FNW };


namespace pg8 {
#define PG8_LAS __attribute__((address_space(3)))
typedef unsigned short bf16_t;
typedef short bf16x8 __attribute__((ext_vector_type(8)));
typedef float f32x4 __attribute__((ext_vector_type(4)));
typedef unsigned u32x4 __attribute__((ext_vector_type(4)));
typedef unsigned u32x2 __attribute__((ext_vector_type(2)));
constexpr int BM = 256, BK = 64, HALF = 128, HTB = HALF * BK * 2  , STAGE_BYTES = 8 * HTB, NXCD = 8, WGM = 4;

__host__ __device__ __forceinline__ int lds_byte(int r, int c) { const int st = (r >> 4) * 2 + (c >> 5), rr = r & 15, cc = c & 31, ob = rr * 64 + cc * 2; return st * 1024 + (ob ^ (((ob >> 9) & 1) << 5)); }
__host__ __device__ __forceinline__ void stage_rc(int b, int& R, int& C) { const int st = b / 1024, sb = b % 1024, swz = sb ^ (((sb >> 9) & 1) << 5); R = (st >> 1) * 16 + swz / 64; C = (st & 1) * 32 + (swz % 64) / 2; }
__host__ __device__ __forceinline__ int perm32(int rho) { const int n = rho >> 4, i = rho & 15; return 8 * (i >> 2) + 4 * n + (i & 3); }

struct Unit { int pm, pn, kh; };
struct Gemm { const bf16_t* A; const bf16_t* Bt; int ld, kt, ks; };

struct StaticOrder {
    int nM, nN, nwg, G, c;
    __host__ __device__ void init(int M_, int N_, int G_, int c_) { nM = M_ / BM; nN = N_ / BM; nwg = nM * nN; G = G_; c = c_; }
    __host__ __device__ bool next(int i, Unit& u) const {
        const long L = (long)i * G + c; if (L >= nwg) return false;
        int wgid = (int)L; { const int q = nwg / NXCD, r = nwg % NXCD, xcd = wgid % NXCD, off = wgid / NXCD; wgid = (xcd < r ? xcd * (q + 1) : r * (q + 1) + (xcd - r) * q) + off; }
        const int nig = WGM * nN, gid = wgid / nig, fm = gid * WGM, gsz = (nM - fm) < WGM ? (nM - fm) : WGM;
        u.pm = fm + ((wgid % nig) % gsz); u.pn = (wgid % nig) / gsz;
        u.kh = 0; return true;
    }
    __device__ __forceinline__ void a_ready(const Unit&) const {}
    __device__ __forceinline__ void done(const Unit&) const {}
};
struct OneUnit {
    int pm, pn, nk;
    __host__ __device__ bool next(int i, Unit& u) const { if (i >= nk) return false; u.pm = pm; u.pn = pn; u.kh = i; return true; }
    __device__ __forceinline__ void a_ready(const Unit&) const {}
    __device__ __forceinline__ void done(const Unit&) const {}
};
struct TwoPartOrder {
    StaticOrder S;
    __host__ __device__ void init(int M_, int N_, int G_, int c_) { S.init(M_, N_, G_, c_); }
    __host__ __device__ bool next(int i, Unit& u) const { if (!S.next(i >> 1, u)) return false; u.kh = i & 1; return true; }
    __device__ __forceinline__ void a_ready(const Unit&) const {}
    __device__ __forceinline__ void done(const Unit&) const {}
};
__device__ __forceinline__ unsigned cvt_pk_bf16(float lo, float hi) { unsigned r; asm volatile("v_cvt_pk_bf16_f32 %0, %1, %2" : "=v"(r) : "v"(lo), "v"(hi)); return r; }
__device__ __forceinline__ float bf_lo(unsigned w) { return __uint_as_float(w << 16); }
__device__ __forceinline__ float bf_hi(unsigned w) { return __uint_as_float(w & 0xffff0000u); }
__device__ __forceinline__ float sigm(float x) { return __builtin_amdgcn_rcpf(1.0f + __expf(-x)); }
__device__ __forceinline__ u32x4 pack8(const f32x4 a, const f32x4 b) { u32x4 w; w.x = cvt_pk_bf16(a[0], a[1]); w.y = cvt_pk_bf16(a[2], a[3]); w.z = cvt_pk_bf16(b[0], b[1]); w.w = cvt_pk_bf16(b[2], b[3]); return w; }

struct EpiIn {
    static constexpr bool PERM = true, AFTER_DRAIN = false, TWO_PART = (MK_KPROBE != 0);
    int l; unsigned char* ws; float* out;
    __device__ __forceinline__ void mid(f32x4 (&)[2][2][4][2], const Unit&, int, int, int, int) const {}
    __device__ __forceinline__ void operator()(const f32x4 (&acc)[2][2][4][2], const Unit& u, int wr, int wc, int fr_in, int fq_in) const {
        int fr = fr_in, fq = fq_in; asm volatile("" : "+v"(fr), "+v"(fq));
        const float* ssq = (const float*)(ws + WS_SSQ); const float* tcos = (const float*)(ws + WS_TCOS); const float* tsin = (const float*)(ws + WS_TSIN);
        bf16_t* XR = (bf16_t*)(ws + WS_XR); bf16_t* ZR = (bf16_t*)(ws + WS_ZR); bf16_t* Q = (bf16_t*)(ws + WS_Q); bf16_t* ZA = (bf16_t*)(ws + WS_ZA); bf16_t* RHO = (bf16_t*)(ws + WS_RHO); bf16_t* SGA = (bf16_t*)(ws + WS_SGA);
        bf16_t* KP = (bf16_t*)(ws + WS_KP); bf16_t* VP = (bf16_t*)(ws + WS_VP); bf16_t* KS = (bf16_t*)(ws + WS_KS) + (size_t)l * NDB * KSROWS * D; bf16_t* VS = (bf16_t*)(ws + WS_VS) + (size_t)l * NDB * KSROWS * D;
        const int part = u.pn >> 2, pm = u.pm;
        const int ct = (u.pn & 3) * 256 + wc * 32 + 8 * fq;
        const int a = wc & 1;
        float rsv[2][4];
        { f32x4 sq[2][4];
#pragma unroll
          for (int ai = 0; ai < 2; ++ai)
#pragma unroll
            for (int m = 0; m < 4; ++m) sq[ai][m] = *(const f32x4*)(ssq + ((size_t)pm * BM + ai * HALF + wr * 64 + m * 16 + fr) * 16 + 4 * fq);
#pragma unroll
          for (int ai = 0; ai < 2; ++ai)
#pragma unroll
            for (int m = 0; m < 4; ++m) { float t = (sq[ai][m][0] + sq[ai][m][1]) + (sq[ai][m][2] + sq[ai][m][3]); t += __shfl_xor(t, 16); t += __shfl_xor(t, 32); rsv[ai][m] = rsqrtf(t * (1.0f / 1024.0f) + EPS) * (MK_KPROBE ? 0.5f : 1.0f); } }
        asm volatile("" ::: "memory");
#pragma unroll
        for (int ai = 0; ai < 2; ++ai) {
#pragma unroll
            for (int m = 0; m < 4; ++m) {
                const int r = ai * HALF + wr * 64 + m * 16 + fr; const size_t grow = (size_t)pm * BM + r;
                const float rs = rsv[ai][m];
                int pos, nrep = 1; size_t krow, frow; bool valid = true;
                if (pm < 128) { const int b = pm >> 4, t = (pm & 15) * 256 + r; pos = NMETA + t; krow = (size_t)b * KPROWS + 64 + t; frow = (size_t)(l * NB + b) * TP + NMETA + t; }
                else if (pm < 132) { const int idx = (pm - 128) * 256 + r, db = idx >> 6, s = idx & 63; pos = NMETA + PAST + s; krow = (size_t)db * KSROWS + PAST + s; frow = (size_t)(l * NDB + db) * DSQ + s; }
                else { pos = r & 15; krow = (size_t)(r & 15); frow = (size_t)(l * NB) * TP + (r & 15); nrep = NB; valid = r < NMETA; }
                const bool smp = (pm >= 128 && pm < 132);
                if (part == 0) {
                    bf16_t* rowp = XR + grow * D + ct;
#pragma unroll
                    for (int bj = 0; bj < 2; ++bj) { const f32x4 v0 = acc[ai][bj][m][0] * rs, v1 = acc[ai][bj][m][1] * rs; *(u32x4*)(rowp + bj * HALF) = pack8(v0, v1); }
                    if (m == 3 && fr >= 13) {
                        float* dst = nullptr;
                        if (pm < 128) { if ((pm & 15) == 15 && ai == 1 && wr == 1) dst = out + O_CP + ((size_t)(l * NB + (pm >> 4)) * 3 + (fr - 13)) * D; }
                        else if (pm < 132) { const int db = ((pm - 128) * 256 + r) >> 6; dst = out + O_CS + ((size_t)(l * NDB + db) * 3 + (fr - 13)) * D; }
                        if (dst) {
#pragma unroll
                            for (int bj = 0; bj < 2; ++bj) { *(f32x4*)(dst + ct + bj * HALF) = acc[ai][bj][m][0] * rs; *(f32x4*)(dst + ct + bj * HALF + 4) = acc[ai][bj][m][1] * rs; }
                        }
                    }
                } else if (part == 1 || part == 5) {
                    bf16_t* rowp = (part == 1 ? ZR : ZA) + grow * D + ct;
#pragma unroll
                    for (int bj = 0; bj < 2; ++bj) { f32x4 v0 = acc[ai][bj][m][0] * rs, v1 = acc[ai][bj][m][1] * rs;
#pragma unroll
                        for (int e = 0; e < 4; ++e) { v0[e] = v0[e] * sigm(v0[e]); v1[e] = v1[e] * sigm(v1[e]); }
                        *(u32x4*)(rowp + bj * HALF) = pack8(v0, v1); }
                } else if (part == 2 || part == 3) {
                    const size_t ci = (size_t)pos * 32 + 16 * a + 4 * fq; const f32x4 c4 = *(const f32x4*)(tcos + ci), s4 = *(const f32x4*)(tsin + ci);
#pragma unroll
                    for (int bj = 0; bj < 2; ++bj) { const f32x4 x1 = acc[ai][bj][m][0] * rs, x2 = acc[ai][bj][m][1] * rs; const f32x4 o1 = x1 * c4 - x2 * s4, o2 = x2 * c4 + x1 * s4;
                        if (part == 2) { *(u32x4*)(Q + grow * D + ct + bj * HALF) = pack8(o1 * QSCALE, o2 * QSCALE); }
                        else if (valid) {
                            const int oc = 64 * (4 * (u.pn & 3) + 2 * bj + (wc >> 1)) + 16 * a + 4 * fq;
                            const u32x4 w = pack8(o1, o2);
                            bf16_t* kd = (smp ? KS : KP) + krow * D + ct + bj * HALF; float* fd = out + (smp ? O_KS : O_KP) + frow * D + oc;
                            for (int rep = 0; rep < nrep; ++rep) { *(u32x4*)(kd + (size_t)rep * KPROWS * D) = w; *(f32x4*)(fd + (size_t)rep * TP * D) = o1; *(f32x4*)(fd + (size_t)rep * TP * D + 32) = o2; }
                        } }
                } else if (part == 4) {
                    if (valid) {
#pragma unroll
                        for (int bj = 0; bj < 2; ++bj) { const f32x4 v0 = acc[ai][bj][m][0] * rs, v1 = acc[ai][bj][m][1] * rs; const u32x4 w = pack8(v0, v1);
                            bf16_t* vd = (smp ? VS : VP) + krow * D + ct + bj * HALF; float* fd = out + (smp ? O_VS : O_VP) + frow * D + ct + bj * HALF;
                            for (int rep = 0; rep < nrep; ++rep) { *(u32x4*)(vd + (size_t)rep * KPROWS * D) = w; *(f32x4*)(fd + (size_t)rep * TP * D) = v0; *(f32x4*)(fd + (size_t)rep * TP * D + 4) = v1; } }
                    }
                } else {
                    const int gc = 128 * (u.pn - 24) + wc * 32 + 8 * fq;
                    f32x4 rho[2], sga[2];
#pragma unroll
                    for (int n = 0; n < 2; ++n) { const f32x4 gr = acc[ai][0][m][n] * rs, ga = acc[ai][1][m][n] * rs;
#pragma unroll
                        for (int e = 0; e < 4; ++e) { const float er = __expf(-fminf(fmaxf(gr[e], -30.f), 30.f)), ea = __expf(-fminf(fmaxf(ga[e], -30.f), 30.f));
                            rho[n][e] = (1.0f + ea) * __builtin_amdgcn_rcpf(1.0f + er); sga[n][e] = __builtin_amdgcn_rcpf(1.0f + ea); } }
                    *(u32x4*)(RHO + grow * D + gc) = pack8(rho[0], rho[1]); *(u32x4*)(SGA + grow * D + gc) = pack8(sga[0], sga[1]);
                }
            }
        }
    }
};

struct EpiProj {
    static constexpr bool PERM = true, AFTER_DRAIN = false, TWO_PART = true;
    unsigned char* ws;
    __device__ __forceinline__ void mid(f32x4 (&acc)[2][2][4][2], const Unit& u, int wr, int wc, int fr_in, int fq_in) const {
        int fr = fr_in, fq = fq_in; asm volatile("" : "+v"(fr), "+v"(fq));
        const bf16_t* RHO = (const bf16_t*)(ws + WS_RHO);
        const int c0 = u.pn * BM + wc * 32 + 8 * fq;
        u32x4 wv[2][4][2];
#pragma unroll
        for (int ai = 0; ai < 2; ++ai)
#pragma unroll
            for (int m = 0; m < 4; ++m)
#pragma unroll
                for (int bj = 0; bj < 2; ++bj) wv[ai][m][bj] = *(const u32x4*)(RHO + ((size_t)u.pm * BM + ai * HALF + wr * 64 + m * 16 + fr) * D + c0 + bj * HALF);
#pragma unroll
        for (int ai = 0; ai < 2; ++ai)
#pragma unroll
            for (int m = 0; m < 4; ++m)
#pragma unroll
                for (int bj = 0; bj < 2; ++bj) { const u32x4 w = wv[ai][m][bj];
                    acc[ai][bj][m][0] *= (f32x4){bf_lo(w.x), bf_hi(w.x), bf_lo(w.y), bf_hi(w.y)}; acc[ai][bj][m][1] *= (f32x4){bf_lo(w.z), bf_hi(w.z), bf_lo(w.w), bf_hi(w.w)}; }
    }
    __device__ __forceinline__ void operator()(const f32x4 (&acc)[2][2][4][2], const Unit& u, int wr, int wc, int fr_in, int fq_in) const {
        int fr = fr_in, fq = fq_in; asm volatile("" : "+v"(fr), "+v"(fq));
        const bf16_t* SGA = (const bf16_t*)(ws + WS_SGA); bf16_t* MB = (bf16_t*)(ws + WS_MB);
        const int c0 = u.pn * BM + wc * 32 + 8 * fq;
        u32x4 wv[2][4][2];
#pragma unroll
        for (int ai = 0; ai < 2; ++ai)
#pragma unroll
            for (int m = 0; m < 4; ++m)
#pragma unroll
                for (int bj = 0; bj < 2; ++bj) wv[ai][m][bj] = *(const u32x4*)(SGA + ((size_t)u.pm * BM + ai * HALF + wr * 64 + m * 16 + fr) * D + c0 + bj * HALF);
        asm volatile("" ::: "memory");
#pragma unroll
        for (int ai = 0; ai < 2; ++ai)
#pragma unroll
            for (int m = 0; m < 4; ++m) { const size_t grow = (size_t)u.pm * BM + ai * HALF + wr * 64 + m * 16 + fr;
#pragma unroll
                for (int bj = 0; bj < 2; ++bj) { const u32x4 w = wv[ai][m][bj];
                    const f32x4 v0 = acc[ai][bj][m][0] * (f32x4){bf_lo(w.x), bf_hi(w.x), bf_lo(w.y), bf_hi(w.y)}, v1 = acc[ai][bj][m][1] * (f32x4){bf_lo(w.z), bf_hi(w.z), bf_lo(w.w), bf_hi(w.w)};
                    *(u32x4*)(MB + grow * D + c0 + bj * HALF) = pack8(v0, v1); }
                if (m & 1) asm volatile("" ::: "memory"); }
    }
};

struct EpiOut {
    static constexpr bool PERM = true, AFTER_DRAIN = false, TWO_PART = false;
    unsigned char* ws;
    __device__ __forceinline__ void mid(f32x4 (&)[2][2][4][2], const Unit&, int, int, int, int) const {}
    __device__ __forceinline__ void operator()(const f32x4 (&acc)[2][2][4][2], const Unit& u, int wr, int wc, int fr_in, int fq_in) const {
        int fr = fr_in, fq = fq_in; asm volatile("" : "+v"(fr), "+v"(fq));
        bf16_t* HB = (bf16_t*)(ws + WS_HB); float* ssq = (float*)(ws + WS_SSQ);
        const int c0 = u.pn * BM + wc * 32 + 8 * fq;
        u32x4 hin[2][4][2];
#pragma unroll
        for (int ai = 0; ai < 2; ++ai)
#pragma unroll
            for (int m = 0; m < 4; ++m)
#pragma unroll
                for (int bj = 0; bj < 2; ++bj) hin[ai][m][bj] = *(const u32x4*)(HB + ((size_t)u.pm * BM + ai * HALF + wr * 64 + m * 16 + fr) * D + c0 + bj * HALF);
        asm volatile("" ::: "memory");
#pragma unroll
        for (int ai = 0; ai < 2; ++ai)
#pragma unroll
            for (int m = 0; m < 4; ++m) { const size_t grow = (size_t)u.pm * BM + ai * HALF + wr * 64 + m * 16 + fr; float ss = 0.f;
#pragma unroll
                for (int bj = 0; bj < 2; ++bj) { const u32x4 w = hin[ai][m][bj];
                    const f32x4 v0 = (f32x4){bf_lo(w.x), bf_hi(w.x), bf_lo(w.y), bf_hi(w.y)} + acc[ai][bj][m][0], v1 = (f32x4){bf_lo(w.z), bf_hi(w.z), bf_lo(w.w), bf_hi(w.w)} + acc[ai][bj][m][1];
                    *(u32x4*)(HB + grow * D + c0 + bj * HALF) = pack8(v0, v1);
                    ss += ((v0[0] * v0[0] + v0[1] * v0[1]) + (v0[2] * v0[2] + v0[3] * v0[3])) + ((v1[0] * v1[0] + v1[1] * v1[1]) + (v1[2] * v1[2] + v1[3] * v1[3])); }
                ss += __shfl_xor(ss, 16); ss += __shfl_xor(ss, 32);
                if (fq == 0) ssq[grow * 16 + u.pn * 4 + wc] = ss;
            }
    }
};
template <class Epi, class Sched, bool ALIGN_EPI = false, bool SP2 = false>
__device__ __forceinline__ void gemm_phase(PG8_LAS unsigned char* lds, const Gemm g, const Sched& S, const Epi& E) {
    int tid_o = threadIdx.x; asm volatile("" : "+v"(tid_o));
    const int tid = tid_o, wid = __builtin_amdgcn_readfirstlane(tid >> 6), lane = tid & 63, wr = wid >> 2, wc = wid & 3, fr = lane & 15, fq = lane >> 4;
    const int K = g.ld, nt = g.kt / BK; const size_t khb = (size_t)g.ks * 2;
    unsigned voffA[2], voffB[2];
#pragma unroll
    for (int i = 0; i < 2; ++i) { int R, C; stage_rc(tid * 16 + i * 8192, R, C); const int Rb = Epi::PERM ? ((R & ~31) + perm32(R & 31)) : R;
        voffA[i] = (unsigned)(R * K + C) * 2u; voffB[i] = (unsigned)(Rb * K + C) * 2u; }
    const size_t kstep = (size_t)(BK * 2);
    const size_t hstep = (size_t)HALF * K * 2;
    const size_t tstep = 2 * hstep;
    const unsigned ldsw = (unsigned)wid * 1024u;
    const int aoff = lds_byte(wr * 64 + fr, fq * 8), boff = lds_byte(wc * 32 + fr, fq * 8);
#define PG8_SA(b, h) (((b) * 2 + (h)) * HTB)
#define PG8_SB(b, h) ((4 + (b) * 2 + (h)) * HTB)
#define PG8_STAGE(bufoff, gbase, voff) do { _Pragma("unroll") for (int _i = 0; _i < 2; ++_i) \
        __builtin_amdgcn_global_load_lds((const unsigned*)((const char*)(gbase) + (voff)[_i]), (PG8_LAS unsigned*)(lds + (bufoff) + ldsw + _i * 8192), 16, 0, 0); } while (0)
#define PG8_LDA(dst, b, h) do { _Pragma("unroll") for (int m = 0; m < 4; ++m) _Pragma("unroll") for (int k = 0; k < 2; ++k) dst[m][k] = *(const PG8_LAS bf16x8*)(lds + PG8_SA(b, h) + aoff + m * 2048 + k * 1024); } while (0)
#define PG8_LDB(dst, b, h) do { _Pragma("unroll") for (int n = 0; n < 2; ++n) _Pragma("unroll") for (int k = 0; k < 2; ++k) dst[n][k] = *(const PG8_LAS bf16x8*)(lds + PG8_SB(b, h) + boff + n * 2048 + k * 1024); } while (0)
#define PG8_MMA(ai, bj, At, Bt) do { __builtin_amdgcn_s_setprio(1); _Pragma("unroll") for (int m = 0; m < 4; ++m) _Pragma("unroll") for (int n = 0; n < 2; ++n) _Pragma("unroll") for (int k = 0; k < 2; ++k) \
        acc[ai][bj][m][n] = __builtin_amdgcn_mfma_f32_16x16x32_bf16(Bt[n][k], At[m][k], acc[ai][bj][m][n], 0, 0, 0); __builtin_amdgcn_s_setprio(0); } while (0)
#define PG8_WAIT_V(n) asm volatile("s_waitcnt vmcnt(" #n ")" ::: "memory")
#define PG8_WAIT_L(n) asm volatile("s_waitcnt lgkmcnt(" #n ")" ::: "memory")
#define PG8_BAR __builtin_amdgcn_s_barrier()
#define PG8_SCHED __builtin_amdgcn_sched_barrier(0)
    Unit cur, nxt; int ui = 0;
    if (!S.next(0, cur)) return;
    f32x4 acc[2][2][4][2];
#pragma unroll
    for (int a = 0; a < 2; ++a)
#pragma unroll
        for (int b = 0; b < 2; ++b)
#pragma unroll
            for (int m = 0; m < 4; ++m)
#pragma unroll
                for (int n = 0; n < 2; ++n) acc[a][b][m][n] = (f32x4){0.f, 0.f, 0.f, 0.f};
    bf16x8 At[4][2], B0[2][2], B1[2][2];
    const char* cA = (const char*)g.A + (size_t)cur.pm * tstep + (size_t)cur.kh * khb; const char* cB = (const char*)g.Bt + (size_t)cur.pn * tstep + (size_t)cur.kh * khb;
    S.a_ready(cur);
    if constexpr (SP2) {
        PG8_STAGE(PG8_SB(0, 0), cB, voffB); PG8_STAGE(PG8_SB(0, 1), cB + hstep, voffB); PG8_STAGE(PG8_SA(0, 0), cA, voffA); PG8_STAGE(PG8_SA(0, 1), cA + hstep, voffA);
        if (wr == 1) PG8_BAR;
        PG8_WAIT_V(2); PG8_BAR;
        PG8_STAGE(PG8_SB(1, 0), cB + kstep, voffB); PG8_STAGE(PG8_SA(1, 0), cA + kstep, voffA); PG8_STAGE(PG8_SB(1, 1), cB + hstep + kstep, voffB);
        PG8_WAIT_V(6); PG8_BAR;
    } else {
        PG8_STAGE(PG8_SB(0, 0), cB, voffB); PG8_STAGE(PG8_SA(0, 0), cA, voffA); PG8_STAGE(PG8_SB(0, 1), cB + hstep, voffB); PG8_STAGE(PG8_SA(0, 1), cA + hstep, voffA);
        if (wr == 1) PG8_BAR;
        PG8_WAIT_V(4); PG8_BAR;
        PG8_STAGE(PG8_SB(1, 0), cB + kstep, voffB); PG8_STAGE(PG8_SA(1, 0), cA + kstep, voffA); PG8_STAGE(PG8_SB(1, 1), cB + hstep + kstep, voffB);
        PG8_WAIT_V(6); PG8_BAR;
    }
    for (;;) {
        const bool has_next = S.next(ui + 1, nxt);
        const char* nA = has_next ? (const char*)g.A + (size_t)nxt.pm * tstep + (size_t)nxt.kh * khb : cA; const char* nB = has_next ? (const char*)g.Bt + (size_t)nxt.pn * tstep + (size_t)nxt.kh * khb : cB;
        for (int t = 0; t < nt; t += 2) {
            const bool last = (t == nt - 2);
            const char* a1 = cA + (size_t)(t + 1) * kstep;
            const char* a2 = last ? nA : cA + (size_t)(t + 2) * kstep; const char* b2 = last ? nB : cB + (size_t)(t + 2) * kstep;
            const char* a3 = a2 + kstep; const char* b3 = b2 + kstep;
            if (last && has_next) S.a_ready(nxt);
            if constexpr (SP2) {
            PG8_LDB(B0, 0, 0); PG8_LDB(B1, 0, 1); PG8_SCHED; PG8_LDA(At, 0, 0); PG8_STAGE(PG8_SA(1, 1), a1 + hstep, voffA);
            PG8_WAIT_V(8); PG8_WAIT_L(0); PG8_BAR; PG8_MMA(0, 0, At, B0); PG8_MMA(0, 1, At, B1); PG8_BAR; PG8_SCHED;
            PG8_LDA(At, 0, 1); PG8_STAGE(PG8_SB(0, 0), b2, voffB); PG8_STAGE(PG8_SB(0, 1), b2 + hstep, voffB); PG8_STAGE(PG8_SA(0, 0), a2, voffA);
            PG8_WAIT_V(8); PG8_WAIT_L(0); PG8_BAR; PG8_MMA(1, 0, At, B0); PG8_MMA(1, 1, At, B1); PG8_BAR; PG8_SCHED;
            PG8_LDB(B0, 1, 0); PG8_LDB(B1, 1, 1); PG8_SCHED; PG8_LDA(At, 1, 0); PG8_STAGE(PG8_SA(0, 1), a2 + hstep, voffA);
            PG8_WAIT_V(8); PG8_WAIT_L(0); PG8_BAR; PG8_MMA(0, 0, At, B0); PG8_MMA(0, 1, At, B1); PG8_BAR; PG8_SCHED;
            PG8_LDA(At, 1, 1); PG8_STAGE(PG8_SB(1, 0), b3, voffB); PG8_STAGE(PG8_SB(1, 1), b3 + hstep, voffB); PG8_STAGE(PG8_SA(1, 0), a3, voffA);
            PG8_WAIT_V(8); PG8_WAIT_L(0); PG8_BAR; PG8_MMA(1, 0, At, B0); PG8_MMA(1, 1, At, B1); PG8_BAR; PG8_SCHED;
            } else {
            PG8_LDB(B0, 0, 0); PG8_SCHED; PG8_LDA(At, 0, 0); PG8_STAGE(PG8_SA(1, 1), a1 + hstep, voffA);
            PG8_WAIT_L(8); PG8_BAR; PG8_WAIT_L(0); PG8_MMA(0, 0, At, B0); PG8_BAR; PG8_SCHED;
            PG8_LDB(B1, 0, 1); PG8_STAGE(PG8_SB(0, 0), b2, voffB);
            PG8_BAR; PG8_WAIT_L(0); PG8_MMA(0, 1, At, B1); PG8_BAR;
            PG8_LDA(At, 0, 1); PG8_STAGE(PG8_SA(0, 0), a2, voffA);
            PG8_BAR; PG8_WAIT_L(0); PG8_MMA(1, 0, At, B0); PG8_BAR; PG8_SCHED;
            PG8_STAGE(PG8_SB(0, 1), b2 + hstep, voffB);
            PG8_WAIT_V(6); PG8_BAR; PG8_MMA(1, 1, At, B1); PG8_BAR;
            PG8_LDB(B0, 1, 0); PG8_SCHED; PG8_LDA(At, 1, 0); PG8_STAGE(PG8_SA(0, 1), a2 + hstep, voffA);
            PG8_WAIT_L(8); PG8_BAR; PG8_WAIT_L(0); PG8_MMA(0, 0, At, B0); PG8_BAR; PG8_SCHED;
            PG8_LDB(B1, 1, 1); PG8_STAGE(PG8_SB(1, 0), b3, voffB);
            PG8_BAR; PG8_WAIT_L(0); PG8_MMA(0, 1, At, B1); PG8_BAR;
            PG8_LDA(At, 1, 1); PG8_STAGE(PG8_SA(1, 0), a3, voffA);
            PG8_BAR; PG8_WAIT_L(0); PG8_MMA(1, 0, At, B0); PG8_BAR; PG8_SCHED;
            PG8_STAGE(PG8_SB(1, 1), b3 + hstep, voffB);
            PG8_WAIT_V(6); PG8_BAR; PG8_MMA(1, 1, At, B1); PG8_BAR;
            }
        }
        if constexpr (ALIGN_EPI) { if (wr == 0) PG8_BAR; }
        bool keep = false;
        if constexpr (Epi::TWO_PART) { if (cur.kh == 0) { E.mid(acc, cur, wr, wc, fr, fq); keep = true; } else { E(acc, cur, wr, wc, fr, fq); } } else { E(acc, cur, wr, wc, fr, fq); }
        S.done(cur);
        if (!has_next) break;
        if (!keep) {
#pragma unroll
        for (int a = 0; a < 2; ++a)
#pragma unroll
            for (int b = 0; b < 2; ++b)
#pragma unroll
                for (int m = 0; m < 4; ++m)
#pragma unroll
                    for (int n = 0; n < 2; ++n) acc[a][b][m][n] = (f32x4){0.f, 0.f, 0.f, 0.f};
        }
        cur = nxt; cA = nA; cB = nB; ++ui;
        if constexpr (ALIGN_EPI) { if (wr == 1) PG8_BAR; }
    }
    PG8_WAIT_V(0);
    if constexpr (!ALIGN_EPI) { if (wr == 0) PG8_BAR; }
    PG8_BAR;
#undef PG8_SA
#undef PG8_SB
#undef PG8_STAGE
#undef PG8_LDA
#undef PG8_LDB
#undef PG8_MMA
#undef PG8_WAIT_V
#undef PG8_WAIT_L
#undef PG8_BAR
#undef PG8_SCHED
}
}

#include <hip/hip_bf16.h>
#include <cmath>
namespace attn_body {
using bf16=__hip_bfloat16;
using bf16x8=__attribute__((ext_vector_type(8)))short;
using s16x4=__attribute__((ext_vector_type(4)))short;
using f32x16=__attribute__((ext_vector_type(16)))float;
using u32x4=__attribute__((ext_vector_type(4)))unsigned;
constexpr int D=64,DM=1024,OPITCH=2048;
constexpr int NW=8,QBLK=32,QB=QBLK*NW,KVBLK=64;
constexpr int ATTN_PITCH=DM, ATTN_UNIT_ROWS=QB;
__device__ __forceinline__ int crow(int r,int hi){return (r&3)+8*(r>>2)+4*hi;}
#define SBAR() __builtin_amdgcn_sched_barrier(0)
__device__ __forceinline__ void cmask(f32x16&p0,f32x16&p1,int jb,int qrel,int hi){
  const float NEG=-INFINITY; int kb=64*jb+4*hi;
  #pragma unroll
  for(int r=0;r<16;++r){int kv=kb+(r&3)+8*(r>>2); if(kv>qrel)p0[r]=NEG; if(kv+32>qrel)p1[r]=NEG;}
}

constexpr int NSLOT=3, SLOTB=8192;
constexpr int LDS_K=0, LDS_V=NSLOT*SLOTB, LDS_WS=2*NSLOT*SLOTB, LDS_OST=LDS_WS+NW*64*4, LDS_BYTES=LDS_OST+NW*4096;
constexpr float C2=0.125f*1.4426950408889634f;
__device__ __forceinline__ void glds16(const void*gsrc,unsigned lds_dst){unsigned keep;
  asm volatile("s_mov_b32 %0, m0\n\ts_mov_b32 m0, %2\n\ts_nop 0\n\tglobal_load_lds_dwordx4 %1, off\n\ts_mov_b32 m0, %0":"=&s"(keep):"v"(gsrc),"s"(lds_dst):"memory");}
__device__ __forceinline__ float max3f(float a,float b,float c){float r;asm("v_max3_f32 %0, %1, %2, %3":"=v"(r):"v"(a),"v"(b),"v"(c));return r;}
__device__ __forceinline__ float max2f(float a,float b){float r;asm("v_max_f32_e32 %0, %1, %2":"=v"(r):"v"(a),"v"(b));return r;}
__device__ __forceinline__ float fadd_s(float a,float b){float r;asm("v_add_f32_e32 %0, %1, %2":"=v"(r):"v"(a),"v"(b));return r;}
__device__ __forceinline__ float fsub_s(float a,float b){float r;asm("v_sub_f32_e32 %0, %1, %2":"=v"(r):"v"(a),"v"(b));return r;}
typedef float f32x2_t __attribute__((ext_vector_type(2))); typedef __bf16 bf16x2_t __attribute__((ext_vector_type(2)));
__device__ __forceinline__ unsigned cvtpk_s(float lo,float hi){f32x2_t v={lo,hi};bf16x2_t b=__builtin_convertvector(v,bf16x2_t);return __builtin_bit_cast(unsigned,b);}
#define WAIT_BAR(N) asm volatile("s_waitcnt vmcnt(" #N ") lgkmcnt(0)\n\ts_barrier":::"memory")

__device__ __forceinline__ void qkt(f32x16&p0,f32x16&p1,const char*Kslot,const bf16x8*qr,const f32x16&negm,int r32,int hi){
  const char*kb=Kslot+hi*1024+r32*16;
  #pragma unroll
  for(int d0=0;d0<4;++d0){
    const bf16x8 b0=*reinterpret_cast<const bf16x8*>(kb+d0*2048);
    const bf16x8 b1=*reinterpret_cast<const bf16x8*>(kb+d0*2048+512);
    if(d0==0){p0=__builtin_amdgcn_mfma_f32_32x32x16_bf16(b0,qr[0],negm,0,0,0);p1=__builtin_amdgcn_mfma_f32_32x32x16_bf16(b1,qr[0],negm,0,0,0);}
    else{p0=__builtin_amdgcn_mfma_f32_32x32x16_bf16(b0,qr[d0],p0,0,0,0);p1=__builtin_amdgcn_mfma_f32_32x32x16_bf16(b1,qr[d0],p1,0,0,0);}}
}
typedef __attribute__((address_space(3))) const char* lds_cptr;
typedef short v4i16_t __attribute__((ext_vector_type(4)));
__device__ __forceinline__ void kload8(bf16x8*kf,lds_cptr kp){
  kf[0]=*(const __attribute__((address_space(3))) bf16x8*)(kp);      kf[1]=*(const __attribute__((address_space(3))) bf16x8*)(kp+512);
  kf[2]=*(const __attribute__((address_space(3))) bf16x8*)(kp+2048); kf[3]=*(const __attribute__((address_space(3))) bf16x8*)(kp+2560);
  kf[4]=*(const __attribute__((address_space(3))) bf16x8*)(kp+4096); kf[5]=*(const __attribute__((address_space(3))) bf16x8*)(kp+4608);
  kf[6]=*(const __attribute__((address_space(3))) bf16x8*)(kp+6144); kf[7]=*(const __attribute__((address_space(3))) bf16x8*)(kp+6656);
}
__device__ __forceinline__ void kload2(bf16x8*kf,lds_cptr kp,int j){ kf[2*j]=*(const __attribute__((address_space(3))) bf16x8*)(kp+j*2048); kf[2*j+1]=*(const __attribute__((address_space(3))) bf16x8*)(kp+j*2048+512); }
__device__ __forceinline__ s16x4 vtr(lds_cptr p){ return __builtin_bit_cast(s16x4,__builtin_amdgcn_ds_read_tr16_b64_v4i16((__attribute__((address_space(3))) v4i16_t*)p)); }
__device__ __forceinline__ float rowmax(const f32x16&p0,const f32x16&p1){
  float a=max3f(p0[0],p0[1],p1[0]),b=max3f(p0[2],p0[3],p1[1]);a=max3f(a,p1[2],p1[3]);
  #pragma unroll
  for(int r=4;r<16;r+=4){a=max3f(a,p0[r],p0[r+1]);b=max3f(b,p0[r+2],p0[r+3]);a=max3f(a,p1[r],p1[r+1]);b=max3f(b,p1[r+2],p1[r+3]);}
  const float m=max2f(a,b);
  auto rr=__builtin_amdgcn_permlane32_swap(__float_as_uint(m),__float_as_uint(m),false,false);
  return max2f(__uint_as_float(rr[0]),__uint_as_float(rr[1]));
}
__device__ __forceinline__ void pv(f32x16*o,int vb,bf16x8 pa0,bf16x8 pa1,bf16x8 pa2,bf16x8 pa3){
  #pragma unroll
  for(int d0=0;d0<2;++d0){s16x4 lo[4],hi[4];
    #pragma unroll
    for(int ks=0;ks<4;++ks){
      asm volatile("ds_read_b64_tr_b16 %0,%1 offset:%c2":"=&v"(lo[ks]):"v"(vb),"i"(d0*4096+ks*1024):"memory");
      asm volatile("ds_read_b64_tr_b16 %0,%1 offset:%c2":"=&v"(hi[ks]):"v"(vb),"i"(d0*4096+ks*1024+512):"memory");}
    asm volatile("s_waitcnt lgkmcnt(0)":::"memory");SBAR();
    #define PK(k) (bf16x8){lo[k][0],lo[k][1],lo[k][2],lo[k][3],hi[k][0],hi[k][1],hi[k][2],hi[k][3]}
    o[d0]=__builtin_amdgcn_mfma_f32_32x32x16_bf16(pa0,PK(0),o[d0],0,0,0);
    o[d0]=__builtin_amdgcn_mfma_f32_32x32x16_bf16(pa1,PK(1),o[d0],0,0,0);
    o[d0]=__builtin_amdgcn_mfma_f32_32x32x16_bf16(pa2,PK(2),o[d0],0,0,0);
    o[d0]=__builtin_amdgcn_mfma_f32_32x32x16_bf16(pa3,PK(3),o[d0],0,0,0);
    #undef PK
  }
}

#ifndef ATTN_STORE16
#define ATTN_STORE16(p,v) (*(u32x4*)(p)=(v))
#endif
template<int THRL,bool MASKED> __device__ __forceinline__ void attn_unit(const bf16*Qin,const bf16*__restrict__ Kh,const bf16*__restrict__ Vh,bf16*Oin,const int NT,const int vis,const int qwaves,char*shm){
  int tid_o=threadIdx.x; asm volatile("":"+v"(tid_o));
  const int tid=tid_o,lane=tid&63,r32=lane&31,hi=lane>>5; const int wid=__builtin_amdgcn_readfirstlane(tid>>6);
  const bf16*Qw=Qin+(long)((wid&(qwaves-1))*QBLK)*DM;
  const unsigned lds0=(unsigned)(uintptr_t)shm;
  float*wsf=(float*)(shm+LDS_WS)+wid*64;
  const bf16*ksrc=Kh+(long)lane*DM+wid*8;
  const bf16*vsrc=Vh+(long)(16*(wid&3)+(lane>>2))*DM+(wid>>2)*32+(lane&3)*8;
  const unsigned kdst=lds0+LDS_K+wid*1024, vdst=lds0+LDS_V+wid*1024;
  #define DMA_K(t,slot) glds16(ksrc+(long)(t)*KVBLK*DM,(unsigned)__builtin_amdgcn_readfirstlane(kdst+(slot)))
  #define DMA_V(t,slot) glds16(vsrc+(long)(t)*KVBLK*DM,(unsigned)__builtin_amdgcn_readfirstlane(vdst+(slot)))
  const int vb0=(int)(lds0+LDS_V)+((lane>>4)&1)*32+(lane&3)*8+(4*hi+((lane&15)>>2))*64;
  const char*Kbase=shm+LDS_K; bf16x8 kf[8];
  const lds_cptr shm3=(lds_cptr)shm; const lds_cptr kp0=shm3+LDS_K+hi*1024+r32*16; const lds_cptr vp0=shm3+LDS_V+((lane>>4)&1)*32+(lane&3)*8+(4*hi+((lane&15)>>2))*64;
  DMA_K(0,0);DMA_V(0,0);DMA_K(1,SLOTB);
  bf16x8 qr[4];
  #pragma unroll
  for(int d0=0;d0<4;++d0)qr[d0]=*reinterpret_cast<const bf16x8*>(&Qw[(long)r32*DM+d0*16+hi*8]);
  float mhat=0.f,l_reg=0.f;f32x16 o[2];o[0]=f32x16{};o[1]=f32x16{};f32x16 negm=f32x16{};asm volatile("":"+v"(negm));
  #define CMASK(P0,P1,t) do{ if(MASKED){ const int jb_=(t)-(NT-4); if(jb_>=vis){ _Pragma("unroll") for(int r_=0;r_<16;++r_){P0[r_]=-INFINITY;P1[r_]=-INFINITY;} } } }while(0)
  bool resc=false;
  #define START(P0,P1) do{ const float rm=rowmax(P0,P1); resc=false; \
    { const float dl=rm; mhat=fadd_s(mhat,dl); \
      _Pragma("unroll") for(int r=0;r<16;++r){P0[r]=fsub_s(P0[r],dl);P1[r]=fsub_s(P1[r],dl);} \
      _Pragma("unroll") for(int r=0;r<16;++r)negm[r]=-mhat; asm volatile("":"+v"(negm)); } \
    _Pragma("unroll") for(int r=0;r<16;++r)P0[r]=__builtin_amdgcn_exp2f(P0[r]); }while(0)
  #define RESC() do{ if(resc){ asm volatile("s_waitcnt lgkmcnt(0)":::"memory"); \
      _Pragma("unroll") for(int d_=0;d_<2;++d_) _Pragma("unroll") for(int r=0;r<16;++r)o[d_][r]*=wsf[crow(r,hi)]; } }while(0)
  f32x16 pA0,pA1,pB0,pB1;
  int sl_prev=0,sl_cur=0,sl_next=SLOTB;
  #define ROT() do{sl_prev=sl_cur;sl_cur=sl_next;sl_next=(sl_next==(NSLOT-1)*SLOTB)?0:sl_next+SLOTB;}while(0)
  DMA_K(2,2*SLOTB);
  WAIT_BAR(3);
  qkt(pA0,pA1,Kbase,qr,negm,r32,hi);asm volatile("s_nop 15\n\ts_nop 7":"+v"(pA0),"+v"(pA1));
  if(MASKED){ _Pragma("unroll") for(int r_=8;r_<16;++r_)pA0[r_]=-INFINITY; _Pragma("unroll") for(int r_=0;r_<16;++r_)pA1[r_]=-INFINITY; }
  START(pA0,pA1);
  _Pragma("unroll") for(int r=0;r<16;++r)pA1[r]=__builtin_amdgcn_exp2f(pA1[r]);
  WAIT_BAR(0);
  DMA_K(3,0);DMA_V(1,SLOTB);
  ROT();
  kload8(kf,kp0+sl_cur);
  WAIT_BAR(2);
  s16x4 vlo[8],vhi[8]; u32x4 pw0,pw1,pw2,pw3;
  #define PKW(P,B) cvtpk_s(P[B],P[B+1])
  #define PAF(k) __builtin_bit_cast(bf16x8,pw##k)
  #define VFR(i) (bf16x8){vlo[i][0],vlo[i][1],vlo[i][2],vlo[i][3],vhi[i][0],vhi[i][1],vhi[i][2],vhi[i][3]}
  #define PIN(x) asm volatile("":"+v"(x))
  #define MX3(a,b,c) __builtin_fmaxf(__builtin_fmaxf((a),(b)),(c))
  #define GAPA(MF,A0,A1,A2,A3,W0,W1,PW) do{ MF; sacc+=A0; sacc+=A1; sacc+=A2; sacc+=A3; PIN(sacc); W0; W1; PIN(PW); SBAR(); }while(0)
  #define EX(v) __builtin_amdgcn_exp2f(v)
  #define GAPB(MF,X,B) do{ MF; X[B]=EX(X[B]); X[B+1]=EX(X[B+1]); X[B+2]=EX(X[B+2]); X[B+3]=EX(X[B+3]); PIN(X); SBAR(); }while(0)
  #define VRD(i) do{ vlo[i]=vtr(vp_+(((i)>>2)*4096+((i)&3)*1024)); vhi[i]=vtr(vp_+(((i)>>2)*4096+((i)&3)*1024+512)); }while(0)
  #define KRD(G,j) do{ if(G){ kload2(kf,kp0+sl_next,j); SBAR(); } }while(0)
  #define STEP(C0,C1,P0,P1,t,GK,GV,GL) do{ SBAR(); \
    const lds_cptr vp_=vp0+sl_prev; \
    VRD(0); SBAR(); float sacc=(P0[0]+P0[1]); \
    GAPA(C0=__builtin_amdgcn_mfma_f32_32x32x16_bf16(kf[0],qr[0],negm,0,0,0), P0[2],P0[3],P0[4],P0[5],     pw0[0]=PKW(P0,0), pw0[1]=PKW(P0,2), pw0); \
    VRD(4); SBAR(); GAPA(C1=__builtin_amdgcn_mfma_f32_32x32x16_bf16(kf[1],qr[0],negm,0,0,0), P0[6],P0[7],P0[8],P0[9],     pw0[2]=PKW(P0,4), pw0[3]=PKW(P0,6), pw0); \
    VRD(1); SBAR(); GAPA(C0=__builtin_amdgcn_mfma_f32_32x32x16_bf16(kf[2],qr[1],C0,0,0,0),   P0[10],P0[11],P0[12],P0[13], pw1[0]=PKW(P0,8), pw1[1]=PKW(P0,10), pw1); \
    VRD(5); SBAR(); GAPA(C1=__builtin_amdgcn_mfma_f32_32x32x16_bf16(kf[3],qr[1],C1,0,0,0),   P0[14],P0[15],P1[0],P1[1],   pw1[2]=PKW(P0,12),pw1[3]=PKW(P0,14), pw1); \
    VRD(2); SBAR(); GAPA(C0=__builtin_amdgcn_mfma_f32_32x32x16_bf16(kf[4],qr[2],C0,0,0,0),   P1[2],P1[3],P1[4],P1[5],     pw2[0]=PKW(P1,0), pw2[1]=PKW(P1,2), pw2); \
    VRD(6); SBAR(); GAPA(C1=__builtin_amdgcn_mfma_f32_32x32x16_bf16(kf[5],qr[2],C1,0,0,0),   P1[6],P1[7],P1[8],P1[9],     pw2[2]=PKW(P1,4), pw2[3]=PKW(P1,6), pw2); \
    VRD(3); SBAR(); GAPA(C0=__builtin_amdgcn_mfma_f32_32x32x16_bf16(kf[6],qr[3],C0,0,0,0),   P1[10],P1[11],P1[12],P1[13], pw3[0]=PKW(P1,8), pw3[1]=PKW(P1,10), pw3); \
    VRD(7); SBAR(); GAPA(C1=__builtin_amdgcn_mfma_f32_32x32x16_bf16(kf[7],qr[3],C1,0,0,0),   P1[14],P1[15],0.f,0.f,       pw3[2]=PKW(P1,12),pw3[3]=PKW(P1,14), pw3); \
    l_reg+=sacc; \
    if(GK){DMA_K((t)+3,sl_cur);} if(GV){DMA_V((t)+1,sl_next);} \
    CMASK(C0,C1,t); \
    { float a=MX3(C0[0],C0[1],C1[0]),b=MX3(C0[2],C0[3],C1[1]); a=MX3(a,C1[2],C1[3]); \
      _Pragma("unroll") for(int r=4;r<16;r+=4){a=MX3(a,C0[r],C0[r+1]);b=MX3(b,C0[r+2],C0[r+3]);a=MX3(a,C1[r],C1[r+1]);b=MX3(b,C1[r+2],C1[r+3]);} \
      float rm=__builtin_fmaxf(a,b); { auto rr=__builtin_amdgcn_permlane32_swap(__float_as_uint(rm),__float_as_uint(rm),false,false); rm=__builtin_fmaxf(__uint_as_float(rr[0]),__uint_as_float(rr[1])); } \
      resc=false; \
      if(__builtin_expect(__any(rm>(float)THRL),0)){ const float dl=__builtin_fmaxf(rm,0.f); mhat+=dl; \
        _Pragma("unroll") for(int r=0;r<16;++r){C0[r]-=dl;C1[r]-=dl;} \
        _Pragma("unroll") for(int r=0;r<16;++r)negm[r]=-mhat; asm volatile("":"+v"(negm)); \
        const float f=__builtin_amdgcn_exp2f(-dl); l_reg*=f; if(hi==0)wsf[r32]=f; resc=true; } } \
    SBAR(); \
    GAPB(o[0]=__builtin_amdgcn_mfma_f32_32x32x16_bf16(PAF(0),VFR(0),o[0],0,0,0), C0,0); \
    GAPB(o[1]=__builtin_amdgcn_mfma_f32_32x32x16_bf16(PAF(0),VFR(4),o[1],0,0,0), C0,4); \
    KRD(GL,0); GAPB(o[0]=__builtin_amdgcn_mfma_f32_32x32x16_bf16(PAF(1),VFR(1),o[0],0,0,0), C0,8); \
    KRD(GL,1); GAPB(o[1]=__builtin_amdgcn_mfma_f32_32x32x16_bf16(PAF(1),VFR(5),o[1],0,0,0), C0,12); \
    KRD(GL,2); GAPB(o[0]=__builtin_amdgcn_mfma_f32_32x32x16_bf16(PAF(2),VFR(2),o[0],0,0,0), C1,0); \
    KRD(GL,3); GAPB(o[1]=__builtin_amdgcn_mfma_f32_32x32x16_bf16(PAF(2),VFR(6),o[1],0,0,0), C1,4); \
    GAPB(o[0]=__builtin_amdgcn_mfma_f32_32x32x16_bf16(PAF(3),VFR(3),o[0],0,0,0), C1,8); \
    GAPB(o[1]=__builtin_amdgcn_mfma_f32_32x32x16_bf16(PAF(3),VFR(7),o[1],0,0,0), C1,12); \
    }while(0)
  int t=1;
  #undef CMASK
  #define CMASK(P0,P1,t) do{}while(0)
  for(;t+5<NT;t+=2){
    STEP(pB0,pB1,pA0,pA1,t,true,true,true);     WAIT_BAR(2); RESC(); ROT();
    STEP(pA0,pA1,pB0,pB1,t+1,true,true,true);   WAIT_BAR(2); RESC(); ROT();
  }
  #undef CMASK
  #define CMASK(P0,P1,t) do{ if(MASKED){ const int jb_=(t)-(NT-4); if(jb_>=vis){ _Pragma("unroll") for(int r_=0;r_<16;++r_){P0[r_]=-INFINITY;P1[r_]=-INFINITY;} } } }while(0)
  #define ENDW(tt) do{ if((tt)+3<NT){WAIT_BAR(2);} else if((tt)+2<NT){WAIT_BAR(1);} else {WAIT_BAR(0);} }while(0)
  for(;t+1<NT;t+=2){
    STEP(pB0,pB1,pA0,pA1,t,(t+3<NT),(t+1<NT),(t+1<NT));       ENDW(t);   RESC(); ROT();
    STEP(pA0,pA1,pB0,pB1,t+1,(t+4<NT),(t+2<NT),(t+2<NT));     ENDW(t+1); RESC(); ROT();
  }
  { float sacc=pA0[0]+pA0[1]; _Pragma("unroll") for(int r=2;r<16;++r)sacc+=pA0[r]; _Pragma("unroll") for(int r=0;r<16;++r)sacc+=pA1[r]; l_reg+=sacc;
    pw0=(u32x4){PKW(pA0,0),PKW(pA0,2),PKW(pA0,4),PKW(pA0,6)};pw1=(u32x4){PKW(pA0,8),PKW(pA0,10),PKW(pA0,12),PKW(pA0,14)};pw2=(u32x4){PKW(pA1,0),PKW(pA1,2),PKW(pA1,4),PKW(pA1,6)};pw3=(u32x4){PKW(pA1,8),PKW(pA1,10),PKW(pA1,12),PKW(pA1,14)};
    SBAR(); pv(o,vb0+sl_prev,PAF(0),PAF(1),PAF(2),PAF(3)); }
  #undef PKW
  #undef PAF
  #undef VFR
  #undef PIN
  #undef MX3
  #undef GAPA
  #undef GAPB
  #undef EX
  #undef VRD
  #undef KRD
  #undef STEP
  #undef ENDW
  {auto rr=__builtin_amdgcn_permlane32_swap(__float_as_uint(l_reg),__float_as_uint(l_reg),false,false);l_reg=__uint_as_float(rr[0])+__uint_as_float(rr[1]);}
  if(hi==0)wsf[32+r32]=l_reg;asm volatile("s_waitcnt lgkmcnt(0)":::"memory");
  float rli[16];
  #pragma unroll
  for(int r=0;r<16;++r)rli[r]=__builtin_amdgcn_rcpf(wsf[32+crow(r,hi)]);
  bf16*Ow=Oin+(long)(wid*QBLK)*OPITCH;
  { bf16*stg=(bf16*)(shm+LDS_OST)+wid*2048;
    #pragma unroll
    for(int r=0;r<16;++r){const int orow=crow(r,hi);
      #pragma unroll
      for(int d0=0;d0<2;++d0)stg[orow*64+d0*32+r32]=__float2bfloat16(o[d0][r]*rli[r]);}
    asm volatile("s_waitcnt lgkmcnt(0)":::"memory");
    #pragma unroll
    for(int i=0;i<4;++i){const int row=i*8+(lane>>3),ch=lane&7; const u32x4 v=*(const u32x4*)(stg+row*64+ch*8); if(wid<qwaves)ATTN_STORE16(Ow+(long)row*OPITCH+ch*8,v);} }
  asm volatile("s_waitcnt lgkmcnt(0)\n\ts_barrier":::"memory");
  #undef DMA_K
  #undef DMA_V
  #undef CMASK
  #undef START
  #undef RESC
  #undef ROT
}
constexpr int ATTN_LDS_BYTES=LDS_BYTES;
#undef SBAR
#undef WAIT_BAR
}

namespace attn128 {
using namespace attn_body;
#define SBAR() __builtin_amdgcn_sched_barrier(0)
#define WAIT_BAR(N) asm volatile("s_waitcnt vmcnt(" #N ") lgkmcnt(0)\n\ts_barrier":::"memory")
constexpr int VSLOTB=16384;
constexpr int L_K=0, L_V=NSLOT*SLOTB, L_WS=L_V+NSLOT*VSLOTB, L_OST=L_WS+NW*64*4, L_BYTES=L_OST+NW*4096;
__device__ __forceinline__ void pv4(f32x16*o,int vb,bf16x8 pa0,bf16x8 pa1,bf16x8 pa2,bf16x8 pa3){
  #pragma unroll
  for(int d0=0;d0<4;++d0){s16x4 lo[4],hi[4];
    #pragma unroll
    for(int ks=0;ks<4;++ks){
      asm volatile("ds_read_b64_tr_b16 %0,%1 offset:%c2":"=&v"(lo[ks]):"v"(vb),"i"(d0*4096+ks*1024):"memory");
      asm volatile("ds_read_b64_tr_b16 %0,%1 offset:%c2":"=&v"(hi[ks]):"v"(vb),"i"(d0*4096+ks*1024+512):"memory");}
    asm volatile("s_waitcnt lgkmcnt(0)":::"memory");SBAR();
    #define PK(k) (bf16x8){lo[k][0],lo[k][1],lo[k][2],lo[k][3],hi[k][0],hi[k][1],hi[k][2],hi[k][3]}
    o[d0]=__builtin_amdgcn_mfma_f32_32x32x16_bf16(pa0,PK(0),o[d0],0,0,0);
    o[d0]=__builtin_amdgcn_mfma_f32_32x32x16_bf16(pa1,PK(1),o[d0],0,0,0);
    o[d0]=__builtin_amdgcn_mfma_f32_32x32x16_bf16(pa2,PK(2),o[d0],0,0,0);
    o[d0]=__builtin_amdgcn_mfma_f32_32x32x16_bf16(pa3,PK(3),o[d0],0,0,0);
    #undef PK
  }
}
struct Fin { int l, h; unsigned qrow; };
template<int THRL,bool MASKED,bool DUAL,bool FIN> __device__ __forceinline__ void attn_unit128(const bf16*Qin,const bf16*__restrict__ Kh,const bf16*__restrict__ Vh,bf16*Oin,const int NT,const int vis,const int qwaves,char*shm,const Fin fin){
  int tid_o=threadIdx.x; asm volatile("":"+v"(tid_o));
  const int tid=tid_o,lane=tid&63,r32=lane&31,hi=lane>>5; const int wid=__builtin_amdgcn_readfirstlane(tid>>6);
  constexpr int KSL=DUAL?2:1;
  constexpr int LK=0, LV=NSLOT*SLOTB*KSL, LWS=LV+NSLOT*VSLOTB, LOST=LWS+NW*64*4;
  const int cmap=DUAL?((wid>>1)&1):0, qgrp=DUAL?(wid&1):(wid&(qwaves-1)); const bool do_store=DUAL?(wid<4):(wid<qwaves);
  const bf16*Qw=Qin+cmap*64+(long)(qgrp*QBLK)*DM;
  const unsigned lds0=(unsigned)(uintptr_t)shm;
  float*wsf=(float*)(shm+LWS)+wid*64;
  const bf16*ksrc=Kh+(long)lane*DM+wid*8;
  const bf16*vsrc=Vh+(long)(16*(wid&3)+(lane>>2))*DM+(wid>>2)*32+(lane&3)*8;
  const unsigned kdst=lds0+LK+wid*1024, vdst=lds0+LV+wid*1024;
  #define DMA_K(t,slot) do{ glds16(ksrc+(long)(t)*KVBLK*DM,(unsigned)__builtin_amdgcn_readfirstlane(kdst+KSL*(slot))); if(DUAL) glds16(ksrc+(long)(t)*KVBLK*DM+64,(unsigned)__builtin_amdgcn_readfirstlane(kdst+KSL*(slot)+8192)); }while(0)
  #define DMA_V(t,slot) do{ glds16(vsrc+(long)(t)*KVBLK*DM,(unsigned)__builtin_amdgcn_readfirstlane(vdst+2*(slot))); glds16(vsrc+(long)(t)*KVBLK*DM+64,(unsigned)__builtin_amdgcn_readfirstlane(vdst+2*(slot)+8192)); }while(0)
  const int vb0=(int)(lds0+LV)+((lane>>4)&1)*32+(lane&3)*8+(4*hi+((lane&15)>>2))*64;
  const char*Kbase=shm+LK+cmap*8192; bf16x8 kf[8];
  const lds_cptr shm3=(lds_cptr)shm; const lds_cptr kp0=shm3+LK+cmap*8192+hi*1024+r32*16; const lds_cptr vp0=shm3+LV+((lane>>4)&1)*32+(lane&3)*8+(4*hi+((lane&15)>>2))*64;
  DMA_K(0,0);DMA_V(0,0);DMA_K(1,SLOTB);
  bf16x8 qr[4];
  #pragma unroll
  for(int d0=0;d0<4;++d0)qr[d0]=*reinterpret_cast<const bf16x8*>(&Qw[(long)r32*DM+d0*16+hi*8]);
  float mhat=0.f,l_reg=0.f;f32x16 o[4];o[0]=f32x16{};o[1]=f32x16{};o[2]=f32x16{};o[3]=f32x16{};f32x16 negm=f32x16{};asm volatile("":"+v"(negm));
  #define CMASK(P0,P1,t) do{ if(MASKED){ const int jb_=(t)-(NT-4); if(jb_>=vis){ _Pragma("unroll") for(int r_=0;r_<16;++r_){P0[r_]=-INFINITY;P1[r_]=-INFINITY;} } } }while(0)
  bool resc=false;
  #define START(P0,P1) do{ const float rm=rowmax(P0,P1); resc=false; \
    { const float dl=rm; mhat=fadd_s(mhat,dl); \
      _Pragma("unroll") for(int r=0;r<16;++r){P0[r]=fsub_s(P0[r],dl);P1[r]=fsub_s(P1[r],dl);} \
      _Pragma("unroll") for(int r=0;r<16;++r)negm[r]=-mhat; asm volatile("":"+v"(negm)); } \
    _Pragma("unroll") for(int r=0;r<16;++r)P0[r]=__builtin_amdgcn_exp2f(P0[r]); }while(0)
  #define RESC() do{ if(resc){ asm volatile("s_waitcnt lgkmcnt(0)":::"memory"); \
      _Pragma("unroll") for(int d_=0;d_<4;++d_) _Pragma("unroll") for(int r=0;r<16;++r)o[d_][r]*=wsf[crow(r,hi)]; } }while(0)
  f32x16 pA0,pA1,pB0,pB1;
  int sl_prev=0,sl_cur=0,sl_next=SLOTB;
  #define ROT() do{sl_prev=sl_cur;sl_cur=sl_next;sl_next=(sl_next==(NSLOT-1)*SLOTB)?0:sl_next+SLOTB;}while(0)
  DMA_K(2,2*SLOTB);
  if constexpr(DUAL){WAIT_BAR(6);}else{WAIT_BAR(4);}
  { const f32x16 zc=f32x16{}; qkt(pA0,pA1,Kbase,qr,zc,r32,hi); } asm volatile("s_nop 15\n\ts_nop 7":"+v"(pA0),"+v"(pA1));
  if(MASKED){ _Pragma("unroll") for(int r_=8;r_<16;++r_)pA0[r_]=-INFINITY; _Pragma("unroll") for(int r_=0;r_<16;++r_)pA1[r_]=-INFINITY; }
  START(pA0,pA1);
  _Pragma("unroll") for(int r=0;r<16;++r)pA1[r]=__builtin_amdgcn_exp2f(pA1[r]);
  WAIT_BAR(0);
  DMA_K(3,0);DMA_V(1,SLOTB);
  ROT();
  kload8(kf,kp0+KSL*sl_cur);
  if constexpr(DUAL){WAIT_BAR(4);}else{WAIT_BAR(3);}
  s16x4 wlo[3],whi[3]; u32x4 pw0,pw1,pw2,pw3;
  #define PKW(P,B) cvtpk_s(P[B],P[B+1])
  #define PAF(k) __builtin_bit_cast(bf16x8,pw##k)
  #define VFW(s) (bf16x8){wlo[s][0],wlo[s][1],wlo[s][2],wlo[s][3],whi[s][0],whi[s][1],whi[s][2],whi[s][3]}
  #define PIN(x) asm volatile("":"+v"(x))
  #define MX3(a,b,c) __builtin_fmaxf(__builtin_fmaxf((a),(b)),(c))
  #define GAPA(MF,A0,A1,A2,A3,W0,W1,PW) do{ MF; sacc+=A0; sacc+=A1; sacc+=A2; sacc+=A3; PIN(sacc); W0; W1; PIN(PW); SBAR(); }while(0)
  #define EX(v) __builtin_amdgcn_exp2f(v)
  #define VRW(s,f) do{ wlo[s]=vtr(vp_+(((f)>>2)*4096+((f)&3)*1024)); whi[s]=vtr(vp_+(((f)>>2)*4096+((f)&3)*1024+512)); }while(0)
  #define KRD(G,j) do{ if(G){ kload2(kf,kp0+KSL*sl_next,j); SBAR(); } }while(0)
  #define FJ(j) ((((j)&3)<<2)|((j)>>2))
  #define VREQ(j) do{ VRW((j)%3,FJ(j)); SBAR(); }while(0)
  #define GAPB(RD,JN,KQ,QD,JU,X,B) do{ if(RD){ VREQ(JN); } o[QD]=__builtin_amdgcn_mfma_f32_32x32x16_bf16(PAF(KQ),VFW((JU)%3),o[QD],0,0,0); X[B]=EX(X[B]); X[B+1]=EX(X[B+1]); PIN(X); SBAR(); }while(0)
  #define STEP(C0,C1,P0,P1,t,GK,GV,GL) do{ SBAR(); \
    const lds_cptr vp_=vp0+2*sl_prev; \
    float sacc=(P0[0]+P0[1]); \
    GAPA(C0=__builtin_amdgcn_mfma_f32_32x32x16_bf16(kf[0],qr[0],negm,0,0,0), P0[2],P0[3],P0[4],P0[5],     pw0[0]=PKW(P0,0), pw0[1]=PKW(P0,2), pw0); \
    GAPA(C1=__builtin_amdgcn_mfma_f32_32x32x16_bf16(kf[1],qr[0],negm,0,0,0), P0[6],P0[7],P0[8],P0[9],     pw0[2]=PKW(P0,4), pw0[3]=PKW(P0,6), pw0); \
    GAPA(C0=__builtin_amdgcn_mfma_f32_32x32x16_bf16(kf[2],qr[1],C0,0,0,0),   P0[10],P0[11],P0[12],P0[13], pw1[0]=PKW(P0,8), pw1[1]=PKW(P0,10), pw1); \
    GAPA(C1=__builtin_amdgcn_mfma_f32_32x32x16_bf16(kf[3],qr[1],C1,0,0,0),   P0[14],P0[15],P1[0],P1[1],   pw1[2]=PKW(P0,12),pw1[3]=PKW(P0,14), pw1); \
    GAPA(C0=__builtin_amdgcn_mfma_f32_32x32x16_bf16(kf[4],qr[2],C0,0,0,0),   P1[2],P1[3],P1[4],P1[5],     pw2[0]=PKW(P1,0), pw2[1]=PKW(P1,2), pw2); \
    VREQ(0); \
    GAPA(C1=__builtin_amdgcn_mfma_f32_32x32x16_bf16(kf[5],qr[2],C1,0,0,0),   P1[6],P1[7],P1[8],P1[9],     pw2[2]=PKW(P1,4), pw2[3]=PKW(P1,6), pw2); \
    VREQ(1); \
    GAPA(C0=__builtin_amdgcn_mfma_f32_32x32x16_bf16(kf[6],qr[3],C0,0,0,0),   P1[10],P1[11],P1[12],P1[13], pw3[0]=PKW(P1,8), pw3[1]=PKW(P1,10), pw3); \
    GAPA(C1=__builtin_amdgcn_mfma_f32_32x32x16_bf16(kf[7],qr[3],C1,0,0,0),   P1[14],P1[15],0.f,0.f,       pw3[2]=PKW(P1,12),pw3[3]=PKW(P1,14), pw3); \
    l_reg+=sacc; \
    if(GK){DMA_K((t)+3,sl_cur);} if(GV){DMA_V((t)+1,sl_next);} \
    CMASK(C0,C1,t); \
    { float a=MX3(C0[0],C0[1],C1[0]),b=MX3(C0[2],C0[3],C1[1]); a=MX3(a,C1[2],C1[3]); \
      _Pragma("unroll") for(int r=4;r<16;r+=4){a=MX3(a,C0[r],C0[r+1]);b=MX3(b,C0[r+2],C0[r+3]);a=MX3(a,C1[r],C1[r+1]);b=MX3(b,C1[r+2],C1[r+3]);} \
      float rm=__builtin_fmaxf(a,b); { auto rr=__builtin_amdgcn_permlane32_swap(__float_as_uint(rm),__float_as_uint(rm),false,false); rm=__builtin_fmaxf(__uint_as_float(rr[0]),__uint_as_float(rr[1])); } \
      resc=false; \
      if(__builtin_expect(__any(rm>(float)THRL),0)){ const float dl=__builtin_fmaxf(rm,0.f); mhat+=dl; \
        _Pragma("unroll") for(int r=0;r<16;++r){C0[r]-=dl;C1[r]-=dl;} \
        _Pragma("unroll") for(int r=0;r<16;++r)negm[r]=-mhat; asm volatile("":"+v"(negm)); \
        const float f=__builtin_amdgcn_exp2f(-dl); l_reg*=f; if(hi==0)wsf[r32]=f; resc=true; } } \
    SBAR(); \
    GAPB(1,2, 0,0,0, C0,0); \
    GAPB(1,3, 0,1,1, C0,2); \
    GAPB(1,4, 0,2,2, C0,4); \
    GAPB(1,5, 0,3,3, C0,6); \
    KRD(GL,0); GAPB(1,6, 1,0,4, C0,8); \
    GAPB(1,7, 1,1,5, C0,10); \
    KRD(GL,1); GAPB(1,8, 1,2,6, C0,12); \
    GAPB(1,9, 1,3,7, C0,14); \
    KRD(GL,2); GAPB(1,10, 2,0,8, C1,0); \
    GAPB(1,11, 2,1,9, C1,2); \
    KRD(GL,3); GAPB(1,12, 2,2,10, C1,4); \
    GAPB(1,13, 2,3,11, C1,6); \
    GAPB(1,14, 3,0,12, C1,8); \
    GAPB(1,15, 3,1,13, C1,10); \
    GAPB(0,0, 3,2,14, C1,12); \
    GAPB(0,0, 3,3,15, C1,14); \
    }while(0)
  #define WBS() do{ if constexpr(DUAL){WAIT_BAR(4);}else{WAIT_BAR(3);} }while(0)
  if(!DUAL && wid>=4) __builtin_amdgcn_s_setprio(1);
  int t=1;
  #undef CMASK
  #define CMASK(P0,P1,t) do{}while(0)
  for(;t+5<NT;t+=2){
    STEP(pB0,pB1,pA0,pA1,t,true,true,true);     WBS(); RESC(); ROT();
    STEP(pA0,pA1,pB0,pB1,t+1,true,true,true);   WBS(); RESC(); ROT();
  }
  #undef CMASK
  #define CMASK(P0,P1,t) do{ if(MASKED){ const int jb_=(t)-(NT-4); if(jb_>=vis){ _Pragma("unroll") for(int r_=0;r_<16;++r_){P0[r_]=-INFINITY;P1[r_]=-INFINITY;} } } }while(0)
  #define ENDW(tt) do{ if((tt)+3<NT){WBS();} else if((tt)+2<NT){WAIT_BAR(2);} else {WAIT_BAR(0);} }while(0)
  for(;t+1<NT;t+=2){
    STEP(pB0,pB1,pA0,pA1,t,(t+3<NT),(t+1<NT),(t+1<NT));       ENDW(t);   RESC(); ROT();
    STEP(pA0,pA1,pB0,pB1,t+1,(t+4<NT),(t+2<NT),(t+2<NT));     ENDW(t+1); RESC(); ROT();
  }
  { float sacc=pA0[0]+pA0[1]; _Pragma("unroll") for(int r=2;r<16;++r)sacc+=pA0[r]; _Pragma("unroll") for(int r=0;r<16;++r)sacc+=pA1[r]; l_reg+=sacc;
    pw0=(u32x4){PKW(pA0,0),PKW(pA0,2),PKW(pA0,4),PKW(pA0,6)};pw1=(u32x4){PKW(pA0,8),PKW(pA0,10),PKW(pA0,12),PKW(pA0,14)};pw2=(u32x4){PKW(pA1,0),PKW(pA1,2),PKW(pA1,4),PKW(pA1,6)};pw3=(u32x4){PKW(pA1,8),PKW(pA1,10),PKW(pA1,12),PKW(pA1,14)};
    SBAR(); pv4(o,vb0+2*sl_prev,PAF(0),PAF(1),PAF(2),PAF(3)); }
  #undef PKW
  #undef PAF
  #undef VFW
  #undef PIN
  #undef MX3
  #undef GAPA
  #undef GAPB
  #undef EX
  #undef VRW
  #undef VREQ
  #undef FJ
  #undef KRD
  #undef STEP
  #undef ENDW
  #undef WBS
  __builtin_amdgcn_s_setprio(0);
  {auto rr=__builtin_amdgcn_permlane32_swap(__float_as_uint(l_reg),__float_as_uint(l_reg),false,false);l_reg=__uint_as_float(rr[0])+__uint_as_float(rr[1]);}
  if(hi==0)wsf[32+r32]=l_reg;asm volatile("s_waitcnt lgkmcnt(0)":::"memory");
  float rli[16];
  #pragma unroll
  for(int r=0;r<16;++r)rli[r]=__builtin_amdgcn_rcpf(wsf[32+crow(r,hi)]);
  bf16*Ow=Oin+cmap*128+(long)((DUAL?(wid&1):wid)*QBLK)*OPITCH;
  bf16*stg=(bf16*)(shm+LOST)+(DUAL?(wid&3):wid)*2048;
  if(do_store){
  u32x4 o2v[2][4];
  #pragma unroll
  for(int hf=0;hf<2;++hf){
    #pragma unroll
    for(int r=0;r<16;++r){const int orow=crow(r,hi);
      #pragma unroll
      for(int d0=0;d0<2;++d0)stg[orow*64+d0*32+r32]=__float2bfloat16(o[2*hf+d0][r]*rli[r]);}
    asm volatile("s_waitcnt lgkmcnt(0)":::"memory");
    #pragma unroll
    for(int i=0;i<4;++i){const int row=i*8+(lane>>3),ch=lane&7; const u32x4 v=*(const u32x4*)(stg+row*64+ch*8);
      if constexpr(FIN){ o2v[hf][i]=v; } else { ATTN_STORE16(Ow+(long)row*OPITCH+hf*64+ch*8,v); } }
    asm volatile("s_waitcnt lgkmcnt(0)":::"memory");
  }
  if constexpr(FIN){
    asm volatile("s_waitcnt vmcnt(0)":::"memory");
    ArgsP ka=KARG(); unsigned char*wsb=ka->ws;
    const bf16*fO1=(const bf16*)(wsb+WS_OP)+(size_t)fin.qrow*2048+(size_t)(fin.h*2)*128; const bf16*fZA=(const bf16*)(wsb+WS_ZA)+(size_t)fin.qrow*1024+fin.h*128;
    const float*fsw=ka->in[I_SUBLN]+fin.l*128; bf16*fOX=(bf16*)(wsb+WS_OX)+(size_t)fin.qrow*2048+1024+fin.h*128;
    const float flam=((const float*)(wsb+WS_MISC))[fin.l], foml=((const float*)(wsb+WS_MISC))[8+fin.l];
    const int ch=lane&7;
    #pragma unroll
    for(int i=0;i<4;++i){ const long grow=(long)(wid*QBLK+i*8+(lane>>3));
      float d[2][8]; float ss=0.f;
      #pragma unroll
      for(int hf=0;hf<2;++hf){ const u32x4 a=*(const u32x4*)(fO1+grow*OPITCH+hf*64+ch*8); const u32x4 b=o2v[hf][i];
        const unsigned aw[4]={a.x,a.y,a.z,a.w}, bw[4]={b.x,b.y,b.z,b.w};
        #pragma unroll
        for(int e=0;e<4;++e){ d[hf][2*e]=__uint_as_float(aw[e]<<16)-flam*__uint_as_float(bw[e]<<16); d[hf][2*e+1]=__uint_as_float(aw[e]&0xffff0000u)-flam*__uint_as_float(bw[e]&0xffff0000u); }
        #pragma unroll
        for(int e=0;e<8;++e)ss+=d[hf][e]*d[hf][e]; }
      ss+=__shfl_xor(ss,1); ss+=__shfl_xor(ss,2); ss+=__shfl_xor(ss,4);
      const float scale=rsqrtf(ss*(1.0f/128.0f)+1e-6f)*foml;
      #pragma unroll
      for(int hf=0;hf<2;++hf){ const u32x4 z=*(const u32x4*)(fZA+grow*DM+hf*64+ch*8); const float*swp=fsw+hf*64+ch*8;
        const unsigned zw[4]={z.x,z.y,z.z,z.w}; unsigned ow[4];
        #pragma unroll
        for(int e=0;e<4;++e){ const float v0=d[hf][2*e]*scale*swp[2*e]*__uint_as_float(zw[e]<<16), v1=d[hf][2*e+1]*scale*swp[2*e+1]*__uint_as_float(zw[e]&0xffff0000u); ow[e]=cvtpk_s(v0,v1); }
        ATTN_STORE16(fOX+grow*OPITCH+hf*64+ch*8,((u32x4){ow[0],ow[1],ow[2],ow[3]})); }
    }
  }
  }
  if constexpr(DUAL){ asm volatile("s_waitcnt vmcnt(0)":::"memory"); }
  asm volatile("s_waitcnt lgkmcnt(0)\n\ts_barrier":::"memory");
  #undef DMA_K
  #undef DMA_V
  #undef CMASK
  #undef START
  #undef RESC
  #undef ROT
}
#undef SBAR
#undef WAIT_BAR
}

#define GAS __attribute__((address_space(1)))
#define LAS __attribute__((address_space(3)))
typedef unsigned short bf16;
typedef unsigned v4u __attribute__((ext_vector_type(4)));
typedef float f32x4 __attribute__((ext_vector_type(4)));
typedef short bf16x8 __attribute__((ext_vector_type(8)));
typedef GAS unsigned gu32;
typedef GAS unsigned long long gu64;
#define RLX_AGENT __ATOMIC_RELAXED, __HIP_MEMORY_SCOPE_AGENT
#define LDS_WAIT() asm volatile("s_waitcnt lgkmcnt(0)" ::: "memory")
#define VM_WAIT() asm volatile("s_waitcnt vmcnt(0)" ::: "memory")
__device__ __forceinline__ unsigned long long rt() { return __builtin_amdgcn_s_memrealtime(); }
__device__ __forceinline__ unsigned f2bf(float f) { unsigned u = __builtin_bit_cast(unsigned, f); return (u + 0x7fffu + ((u >> 16) & 1u)) >> 16; }
__device__ __forceinline__ unsigned pk2(float lo, float hi) { return f2bf(lo) | (f2bf(hi) << 16); }

#define XB_TMO      128
#define XB_XCNT(j)  (256  + 64 * (j))
#define XB_XSUB(j)  (1280 + 64 * (j))
#define XB_XGEN(j)  (2304 + 64 * (j))
#define XB_TOP      3328
#define XB_TOPGEN   3392
#define XCD_BAR_WORDS 3456
#define XB_SPIN_CAP (1u << 18)

__device__ __forceinline__ unsigned xb_ld(unsigned* p)              { return __hip_atomic_load(p, __ATOMIC_RELAXED, __HIP_MEMORY_SCOPE_AGENT); }
__device__ __forceinline__ unsigned xb_add(unsigned* p, unsigned v) { return __hip_atomic_fetch_add(p, v, __ATOMIC_RELAXED, __HIP_MEMORY_SCOPE_AGENT); }
__device__ __forceinline__ unsigned xb_xcc_id() { return (unsigned)__builtin_amdgcn_s_getreg((3 << 11) | 20) & 0xFu; }
#define XB_SPIN(cond, bar) do { unsigned _sp = 0; while (cond) { __builtin_amdgcn_s_sleep(1); \
    if ((++_sp & 255u) == 0u) { if (xb_ld(&(bar)[XB_TMO])) break; if (_sp > XB_SPIN_CAP) { atomicAdd(&(bar)[XB_TMO], 1u); break; } } } } while (0)

struct XcdBarrier {
    unsigned* bar; unsigned x;
    volatile LAS unsigned* st;
};

__device__ __forceinline__ XcdBarrier xcd_barrier_post(unsigned* bar, volatile LAS unsigned* st) {
    XcdBarrier b; b.bar = bar; b.x = xb_xcc_id(); b.st = st;
    if (threadIdx.x == 0) (void)xb_add(&bar[XB_XCNT(b.x)], 1u);
    return b;
}
__device__ __forceinline__ void xcd_barrier_complete(unsigned* bar, unsigned x, unsigned& nloc, unsigned& nx) {
    const unsigned G = gridDim.x * gridDim.y * gridDim.z;
    unsigned sum, cnt, mine, sp = 0u;
    for (;;) {
        sum = 0u; cnt = 0u; mine = 0u;
#pragma unroll
        for (unsigned j = 0; j < 16; ++j) { const unsigned c = xb_ld(&bar[XB_XCNT(j)]); sum += c; cnt += (c > 0u) ? 1u : 0u; mine = (j == x) ? c : mine; }
        if (sum == G) break;
        __builtin_amdgcn_s_sleep(1);
        if ((++sp & 255u) == 0u) { if (xb_ld(&bar[XB_TMO])) break; if (sp > XB_SPIN_CAP) { atomicAdd(&bar[XB_TMO], 1u); break; } }
    }
    nloc = mine > 0u ? mine : 1u; nx = cnt > 0u ? cnt : 1u;
}

__device__ __forceinline__ void xcd_barrier(const XcdBarrier& b) {
    asm volatile("s_waitcnt vmcnt(0)" ::: "memory");
    __syncthreads();
    if (threadIdx.x == 0) {
        unsigned* bar = b.bar;
        __builtin_amdgcn_s_waitcnt(0);
        unsigned nloc = b.st[0], nx = b.st[1];
        if (nloc == 0u) { xcd_barrier_complete(bar, b.x, nloc, nx); b.st[0] = nloc; b.st[1] = nx; }
        const unsigned old = xb_add(&bar[XB_XSUB(b.x)], 1u);
        const unsigned gen = old / nloc;
        if (old + 1u == (gen + 1u) * nloc) {
            __builtin_amdgcn_fence(__ATOMIC_RELEASE, "agent");
            asm volatile("s_waitcnt vmcnt(0)" ::: "memory");
            const unsigned og = xb_add(&bar[XB_TOP], 1u);
            const unsigned tg = og / nx;
            if (og + 1u == (tg + 1u) * nx) xb_add(&bar[XB_TOPGEN], 1u);
            else XB_SPIN(xb_ld(&bar[XB_TOPGEN]) == tg, bar);
            __builtin_amdgcn_fence(__ATOMIC_ACQUIRE, "agent");
            xb_add(&bar[XB_XGEN(b.x)], 1u);
            asm volatile("s_waitcnt vmcnt(0)" ::: "memory");
        } else {
            XB_SPIN(xb_ld(&bar[XB_XGEN(b.x)]) == gen, bar);
            __builtin_amdgcn_fence(__ATOMIC_ACQUIRE, "agent");
            asm volatile("s_waitcnt vmcnt(0)" ::: "memory");
        }
    }
    __syncthreads();
}

constexpr int NWAVES = 8;
constexpr int RING_OFF = 0, RING_BYTES = 131072;
constexpr int LDSCTL_OFF = RING_BYTES, MISC_OFF = LDSCTL_OFF + 320;
constexpr int LDS_BYTES = 147456;
static_assert(MISC_OFF + 128 <= LDS_BYTES, "LDS map");
constexpr int N_PHASES = 2 + 4 * DEPTH;

__device__ __forceinline__ float wave_sum(float v) {
#pragma unroll
    for (int o = 1; o < 64; o <<= 1) v += __shfl_xor(v, o);
    return v;
}
__device__ __forceinline__ v4u pack8f(const f32x4 a, const f32x4 b) { v4u w; w.x = pk2(a[0], a[1]); w.y = pk2(a[2], a[3]); w.z = pk2(b[0], b[1]); w.w = pk2(b[2], b[3]); return w; }
__device__ __forceinline__ float bflo(unsigned w) { return __uint_as_float(w << 16); }
__device__ __forceinline__ float bfhi(unsigned w) { return __uint_as_float(w & 0xffff0000u); }

__host__ __device__ __forceinline__ int colmap_in(int np) {
    if (np >= 2048 && np < 4096) { const int g = np >> 6, j = np & 63, a = j >> 5, fq = (j >> 3) & 3, n = (j >> 2) & 1, e = j & 3; return (g << 6) + 32 * n + 16 * a + 4 * fq + e; }
    if (np >= 6144) { const int w = np - 6144, j8 = w >> 8, half = (w >> 7) & 1, cc = w & 127; return 6144 + half * 1024 + 128 * j8 + cc; }
    return np;
}
template <bool MAPPED>
__device__ __forceinline__ void p0_item(const float* W, int N, const float* kscale, bf16* WT, int ldk, int koff, LAS float* scr, int kb, int nb, int lane) {
    const int k0 = 64 * kb, n0 = 32 * nb; const int np = n0 + (lane & 31); const int src = MAPPED ? colmap_in(np) : np;
#pragma unroll
    for (int i = 0; i < 32; ++i) { const int kk = 2 * i + (lane >> 5); float v = W[(size_t)(k0 + kk) * N + src]; if (kscale) v *= kscale[k0 + kk]; scr[kk * 33 + (lane & 31)] = v; }
    LDS_WAIT(); asm volatile("" ::: "memory");
    const int c = lane & 7;
#pragma unroll
    for (int j = 0; j < 4; ++j) { const int n = (lane >> 3) + 8 * j; const LAS float* s = scr + (8 * c) * 33 + n;
        v4u o; o.x = pk2(s[0 * 33], s[1 * 33]); o.y = pk2(s[2 * 33], s[3 * 33]); o.z = pk2(s[4 * 33], s[5 * 33]); o.w = pk2(s[6 * 33], s[7 * 33]);
        *(GAS v4u*)(WT + (size_t)(n0 + n) * ldk + koff + k0 + 8 * c) = o; }
    LDS_WAIT(); asm volatile("" ::: "memory");
}

__device__ __forceinline__ void cache_convert(ArgsP args, int lc, int c_lo, int n_ch, int tid0, int nth) {
    unsigned char* ws = args->ws;
    bf16* KS = (bf16*)(ws + WS_KS) + (size_t)lc * NDB * KSROWS * D; bf16* VS = (bf16*)(ws + WS_VS) + (size_t)lc * NDB * KSROWS * D;
    const float* ck = args->in[I_CK] + (size_t)lc * NDB * PAST * D; const float* cv = args->in[I_CV] + (size_t)lc * NDB * PAST * D;
    for (int c0 = c_lo + tid0; c0 < c_lo + n_ch; c0 += 4 * nth) {
        f32x4 klo[4], khi[4], vlo[4], vhi[4];
#pragma unroll
        for (int u = 0; u < 4; ++u) { const int c = c0 + u * nth; if (c < c_lo + n_ch) { const int row = c >> 7, chn = c & 127;
            const int gq = chn >> 3, q8 = chn & 7, d0 = 16 * (q8 >> 2) + 4 * (q8 & 3); const float* s = ck + (size_t)row * D + 64 * gq + d0; const float* sv = cv + (size_t)row * D + 8 * chn;
            klo[u] = __builtin_nontemporal_load((const GAS f32x4*)s); khi[u] = __builtin_nontemporal_load((const GAS f32x4*)(s + 32)); vlo[u] = __builtin_nontemporal_load((const GAS f32x4*)sv); vhi[u] = __builtin_nontemporal_load((const GAS f32x4*)(sv + 4)); } }
#pragma unroll
        for (int u = 0; u < 4; ++u) { const int c = c0 + u * nth; if (c < c_lo + n_ch) { const int row = c >> 7, chn = c & 127; const size_t drow = ((size_t)(row >> 11) * KSROWS + (row & 2047)) * D;
            *(GAS v4u*)(KS + drow + 8 * chn) = pack8f(klo[u], khi[u]); *(GAS v4u*)(VS + drow + 8 * chn) = pack8f(vlo[u], vhi[u]); } }
    }
}

__device__ __forceinline__ void cache_convert_head(ArgsP args, int lc, int db, int h, int tid0, int nth) {
    unsigned char* ws = args->ws;
    bf16* KS = (bf16*)(ws + WS_KS) + (size_t)(lc * NDB + db) * KSROWS * D; bf16* VS = (bf16*)(ws + WS_VS) + (size_t)(lc * NDB + db) * KSROWS * D;
    const float* ck = args->in[I_CK] + (size_t)(lc * NDB + db) * PAST * D; const float* cv = args->in[I_CV] + (size_t)(lc * NDB + db) * PAST * D;
    constexpr int NCHK = PAST * 16;
    for (int c0 = tid0; c0 < NCHK; c0 += 4 * nth) {
        f32x4 klo[4], khi[4], vlo[4], vhi[4];
#pragma unroll
        for (int u = 0; u < 4; ++u) { const int c = c0 + u * nth; if (c < NCHK) { const int row = c >> 4, chn = h * 16 + (c & 15);
            const int gq = chn >> 3, q8 = chn & 7, d0 = 16 * (q8 >> 2) + 4 * (q8 & 3); const float* s = ck + (size_t)row * D + 64 * gq + d0; const float* sv = cv + (size_t)row * D + 8 * chn;
            klo[u] = __builtin_nontemporal_load((const GAS f32x4*)s); khi[u] = __builtin_nontemporal_load((const GAS f32x4*)(s + 32)); vlo[u] = __builtin_nontemporal_load((const GAS f32x4*)sv); vhi[u] = __builtin_nontemporal_load((const GAS f32x4*)(sv + 4)); } }
#pragma unroll
        for (int u = 0; u < 4; ++u) { const int c = c0 + u * nth; if (c < NCHK) { const int row = c >> 4, chn = h * 16 + (c & 15); const size_t drow = (size_t)row * D;
            *(GAS v4u*)(KS + drow + 8 * chn) = pack8f(klo[u], khi[u]); *(GAS v4u*)(VS + drow + 8 * chn) = pack8f(vlo[u], vhi[u]); } }
    }
}

__device__ __forceinline__ void p0_prologue(ArgsP args, LAS unsigned char* lds, int lane, int wave, int vcu, int G) {
    unsigned char* ws = args->ws;
    LAS float* scr = (LAS float*)(lds + RING_OFF + wave * 16384);
    const int gw = vcu * NWAVES + wave, NGW = G * NWAVES;
    constexpr int IT_L = 2048 + 256 + 256 + 256 + 64;
    typedef float f32x2_t __attribute__((ext_vector_type(2)));
    struct WItem { const float* src; const float* ksc; bf16* dst; int N, ldk; };
    auto decode = [&](int it) -> WItem {
        const int l = it / IT_L; int r = it % IT_L; unsigned char* wl = ws + WS_W + (size_t)l * W_LAYER;
        const float* W; const float* kscale = nullptr; bf16* WT; int N, ldk, koff = 0, kb, nb; bool mapped = false;
        if (r < 2048) { W = args->in[I_WIN] + (size_t)l * D * INC; N = INC; kscale = args->in[I_NW] + l * D; WT = (bf16*)(wl + W_IN); ldk = D; kb = r >> 7; nb = r & 127; mapped = true; }
        else if (r < 2048 + 256) { r -= 2048; W = args->in[I_WPR] + (size_t)l * D * D; N = D; WT = (bf16*)(wl + W_PROJ); ldk = 2 * D; kb = r >> 4; nb = r & 15; }
        else if (r < 2048 + 512) { r -= 2048 + 256; W = args->in[I_WPA] + (size_t)l * D * D; N = D; WT = (bf16*)(wl + W_PROJ); ldk = 2 * D; koff = D; kb = r >> 4; nb = r & 15; }
        else if (r < 2048 + 768) { r -= 2048 + 512; W = args->in[I_WOUT] + (size_t)l * D * D; N = D; WT = (bf16*)(wl + W_OUT); ldk = D; kb = r >> 4; nb = r & 15; }
        else { r -= 2048 + 768; const int gate = r >> 5, blk = (r >> 2) & 7; kb = (r >> 1) & 1; nb = r & 1;
            W = args->in[gate ? I_WIG : I_WRG] + (size_t)(l * 8 + blk) * 16384; N = 128; WT = (bf16*)(wl + W_G) + (size_t)(blk * 2 + gate) * 16384; ldk = 128; }
        const int k0 = 64 * kb, n0 = 64 * nb, np = n0 + 2 * (lane & 31), srcc = mapped ? colmap_in(np) : np;
        WItem w; w.src = W + (size_t)k0 * N + srcc; w.ksc = kscale ? kscale + k0 + 8 * (lane & 7) : nullptr; w.dst = WT + (size_t)n0 * ldk + koff + k0; w.N = N; w.ldk = ldk; return w; };
    auto wload = [&](const WItem& w, f32x2_t (&v)[32]) {
#pragma unroll
        for (int i = 0; i < 32; ++i) v[i] = *(const GAS f32x2_t*)(w.src + (size_t)(2 * i + (lane >> 5)) * w.N); };
    auto wstore = [&](const WItem& w, const f32x2_t (&v)[32]) {
        f32x4 ka = (f32x4){1.f, 1.f, 1.f, 1.f}, kb2 = ka;
        if (w.ksc) { ka = *(const GAS f32x4*)w.ksc; kb2 = *(const GAS f32x4*)(w.ksc + 4); }
#pragma unroll
        for (int par = 0; par < 2; ++par) {
#pragma unroll
            for (int i = 0; i < 32; ++i) scr[(2 * i + (lane >> 5)) * 33 + (lane & 31)] = v[i][par];
            LDS_WAIT(); asm volatile("" ::: "memory");
            const int c = lane & 7;
#pragma unroll
            for (int j = 0; j < 4; ++j) { const int n = (lane >> 3) + 8 * j; const LAS float* sp = scr + (8 * c) * 33 + n;
                v4u o; o.x = pk2(sp[0 * 33] * ka[0], sp[1 * 33] * ka[1]); o.y = pk2(sp[2 * 33] * ka[2], sp[3 * 33] * ka[3]); o.z = pk2(sp[4 * 33] * kb2[0], sp[5 * 33] * kb2[1]); o.w = pk2(sp[6 * 33] * kb2[2], sp[7 * 33] * kb2[3]);
                *(GAS v4u*)(w.dst + (size_t)(2 * n + par) * w.ldk + 8 * c) = o; }
            LDS_WAIT(); asm volatile("" ::: "memory"); } };
    for (int it = gw; it < DEPTH * IT_L; it += 2 * NGW) {
        const bool hb = it + NGW < DEPTH * IT_L;
        const WItem wa = decode(it), wb = decode(hb ? it + NGW : it);
        f32x2_t va[32], vb[32];
        wload(wa, va); wload(wb, vb);
        wstore(wa, va); if (hb) wstore(wb, vb);
    }
    { bf16* HB = (bf16*)(ws + WS_HB); float* SSQ = (float*)(ws + WS_SSQ);
      for (int row0 = gw; row0 < M; row0 += 4 * NGW) {
        f32x4 v[4][4]; float sv[4]; bool ok[4];
#pragma unroll
        for (int u = 0; u < 4; ++u) { const int row = row0 + u * NGW; ok[u] = row < M;
            const float* src = !ok[u] ? nullptr : row < ROW_S ? args->in[I_XP] + (size_t)row * D : row < ROW_M ? args->in[I_XS] + (size_t)(row - ROW_S) * D : (row - ROW_M) < NMETA ? args->in[I_META] + (size_t)(row - ROW_M) * D : nullptr;
#pragma unroll
            for (int j = 0; j < 4; ++j) v[u][j] = src ? ((const GAS f32x4*)src)[lane + 64 * j] : (f32x4){0.f, 0.f, 0.f, 0.f}; }
#pragma unroll
        for (int u = 0; u < 4; ++u) { float s = 0.f;
#pragma unroll
            for (int j = 0; j < 4; ++j) s += (v[u][j].x * v[u][j].x + v[u][j].y * v[u][j].y) + (v[u][j].z * v[u][j].z + v[u][j].w * v[u][j].w);
            sv[u] = wave_sum(s); }
#pragma unroll
        for (int u = 0; u < 4; ++u) if (ok[u]) { const int row = row0 + u * NGW;
#pragma unroll
            for (int j = 0; j < 4; ++j) ((GAS unsigned long long*)(HB + (size_t)row * D))[lane + 64 * j] = (unsigned long long)pk2(v[u][j].x, v[u][j].y) | ((unsigned long long)pk2(v[u][j].z, v[u][j].w) << 32);
            if (lane < 16) SSQ[(size_t)row * 16 + lane] = lane == 0 ? sv[u] : 0.f; }
      } }
    const int gtid = gw * 64 + lane, NTH = NGW * 64;
    { float* TC = (float*)(ws + WS_TCOS); float* TS = (float*)(ws + WS_TSIN);
      for (int idx = gtid; idx < TP * 32; idx += NTH) {
        const int pos = idx >> 5, i = idx & 31;
        double th = 1.0; for (int k = 0; k < i; ++k) th *= 0.74989420933245582730;
        const double t2 = th * th; double cb = 1.0, sb = th, tc = 1.0, tsn = th;
#pragma unroll 1
        for (int k = 1; k <= 11; ++k) { tc *= -t2 / (double)((2 * k - 1) * (2 * k)); tsn *= -t2 / (double)((2 * k) * (2 * k + 1)); cb += tc; sb += tsn; }
        double cr = 1.0, sr = 0.0;
#pragma unroll 1
        for (int bit = 0; bit < 13; ++bit) { if ((pos >> bit) & 1) { const double c2 = cr * cb - sr * sb, s2 = sr * cb + cr * sb; cr = c2; sr = s2; } const double c3 = cb * cb - sb * sb, s3 = 2.0 * cb * sb; cb = c3; sb = s3; }
        TC[idx] = (float)cr; TS[idx] = (float)sr;
      } }
    if (gw < DEPTH) { const int l = gw; const float s1 = wave_sum(args->in[I_LQ1][l * 64 + lane] * args->in[I_LK1][l * 64 + lane]), s2 = wave_sum(args->in[I_LQ2][l * 64 + lane] * args->in[I_LK2][l * 64 + lane]);
        if (lane == 0) { const float li = 0.8f - 0.6f * expf(-0.3f * (float)l); ((float*)(ws + WS_MISC))[l] = expf(s1) - expf(s2) + li; ((float*)(ws + WS_MISC))[8 + l] = 1.0f - li; } }
    { bf16* KP = (bf16*)(ws + WS_KP); bf16* VP = (bf16*)(ws + WS_VP);
      for (int c = gtid; c < NB * 48 * 128; c += NTH) { const int b = c / (48 * 128), rr = (c / 128) % 48, chn = c & 127; const size_t off = ((size_t)b * KPROWS + 16 + rr) * D + 8 * chn;
        *(GAS v4u*)(KP + off) = (v4u){0u, 0u, 0u, 0u}; *(GAS v4u*)(VP + off) = (v4u){0u, 0u, 0u, 0u}; } }
}

constexpr int RNN_XS = 0, RNN_XC = 36864, RNN_XA = 71680;
constexpr int CW_CNTA = 12288, CW_CNTB = 14336;
constexpr int CW_FLAG = 16384;
constexpr size_t MISC_CARRY = 131072;
#define RNN_BAR() do { asm volatile("s_waitcnt lgkmcnt(0)" ::: "memory"); __builtin_amdgcn_s_barrier(); asm volatile("" ::: "memory"); } while (0)
__device__ __forceinline__ void rnn_prefetch(ArgsP args, const bf16* XR, int l, int pmode, int seq, int n, size_t row0, int tid, v4u (&pf)[3]) {
#pragma unroll
    for (int k = 0; k < 3; ++k) { const int id = tid + k * NWAVES * 64, i = id >> 4, c8 = id & 15;
        if (id < 67 * 16) {
            if (i >= 3 || pmode == 0) pf[k] = *(const GAS v4u*)(XR + (row0 + i - 3) * D + 128 * n + 8 * c8);
            else if (pmode == 1) pf[k] = *(const GAS v4u*)(XR + ((size_t)ROW_M + 13 + i) * D + 128 * n + 8 * c8);
            else if (pmode == 2) { const float* sc = args->in[I_SC] + ((size_t)(l * NDB + seq) * 3 + i) * D + 128 * n + 8 * c8; pf[k] = pack8f(*(const GAS f32x4*)sc, *(const GAS f32x4*)(sc + 4)); }
            else pf[k] = (v4u){0u, 0u, 0u, 0u};
        } }
}
__device__ __forceinline__ void rnn_unit(ArgsP args, int l, int kind, int seq, int n, int g, LAS unsigned char* lds, int tid, int lane, int wid) {
    unsigned char* ws = args->ws;
    LAS float* XS = (LAS float*)(lds + RNN_XS); LAS float* XC = (LAS float*)(lds + RNN_XC); LAS bf16* XA = (LAS bf16*)(lds + RNN_XA);
    const bf16* XR = (const bf16*)(ws + WS_XR); const bf16* ZR = (const bf16*)(ws + WS_ZR); bf16* OX = (bf16*)(ws + WS_OX);
    const int q = lane >> 4, cl = lane & 15, cc = 16 * wid + cl, ch = 128 * n + cc;
    const float brg = args->in[I_BRG][l * D + ch], big = args->in[I_BIG][l * D + ch];
    float sp; { const float x = -args->in[I_LAM][l * D + ch]; sp = fmaxf(x, 0.f) + log1pf(__expf(-fabsf(x))); }
    const int c2 = tid & 127, rg = tid >> 7, chc = 128 * n + c2;
    const float cw0 = args->in[I_CW][(l * 4 + 0) * D + chc], cw1 = args->in[I_CW][(l * 4 + 1) * D + chc], cw2 = args->in[I_CW][(l * 4 + 2) * D + chc], cw3 = args->in[I_CW][(l * 4 + 3) * D + chc], cb = args->in[I_CB][l * D + chc];
    const bf16* wg = (const bf16*)(ws + WS_W + (size_t)l * W_LAYER + W_G) + (size_t)(n * 2) * 16384;
    bf16x8 Br[4], Bi[4];
#pragma unroll
    for (int ks = 0; ks < 4; ++ks) { Br[ks] = *(const bf16x8*)(wg + (size_t)cc * 128 + 32 * ks + 8 * q); Bi[ks] = *(const bf16x8*)(wg + 16384 + (size_t)cc * 128 + 32 * ks + 8 * q); }
    const int ntiles = kind == 0 ? 16 : 1;
    const int jstart = (kind == 0 && g == 0) ? -1 : 0;
    const size_t rowbase = kind == 0 ? (size_t)seq * SEQ + (size_t)g * 1024 : kind == 1 ? (size_t)ROW_S + (size_t)seq * DSQ : (size_t)ROW_M;
    float* carry = (float*)(ws + WS_MISC + MISC_CARRY) + (size_t)((((l * NB + seq) * 8 + n) * 4) + g) * 128;
    gu32* flag = (gu32*)(ws + WS_CTL) + CW_FLAG + 64 * ((((l * NB + seq) * 8 + n) * 4) + g);
    float hrun = 0.f;
    if (kind == 1) hrun = args->in[I_SR][(size_t)(l * NDB + seq) * D + ch];
    v4u pf[3] = {{0u, 0u, 0u, 0u}, {0u, 0u, 0u, 0u}, {0u, 0u, 0u, 0u}}, pf2[3] = {{0u, 0u, 0u, 0u}, {0u, 0u, 0u, 0u}, {0u, 0u, 0u, 0u}};
    rnn_prefetch(args, XR, l, jstart < 0 ? 3 : (kind == 0 ? 0 : kind == 1 ? 2 : 3), seq, n, jstart < 0 ? (size_t)ROW_M : rowbase, tid, pf);
    if (jstart + 1 < ntiles) rnn_prefetch(args, XR, l, jstart < 0 ? 1 : 0, seq, n, rowbase + 64 * (jstart + 1), tid, pf2);
    v4u zfn[2] = {{0u, 0u, 0u, 0u}, {0u, 0u, 0u, 0u}};
    if (jstart == 0) {
#pragma unroll
        for (int k = 0; k < 2; ++k) { const int id = tid + k * NWAVES * 64, r = id >> 4, c8 = id & 15; zfn[k] = *(const GAS v4u*)(ZR + (rowbase + r) * D + 128 * n + 8 * c8); } }
    if (kind == 0 && g > 0) {
        if (tid == 0) { unsigned spn = 0u; while (__hip_atomic_load(flag - 64, RLX_AGENT) == 0u) { __builtin_amdgcn_s_sleep(2); if (++spn > (1u << 22)) { __hip_atomic_store((gu32*)(ws + WS_CTL) + CW_TMO, 0xC0DEu, RLX_AGENT); break; } }
            __builtin_amdgcn_fence(__ATOMIC_ACQUIRE, "agent"); asm volatile("s_waitcnt vmcnt(0)" ::: "memory"); }
        __syncthreads();
        hrun = __hip_atomic_load(carry - 128 + cc, RLX_AGENT);
    }
    for (int j = jstart; j < ntiles; ++j) {
        const bool pre = j < 0;
        const size_t row0 = pre ? (size_t)ROW_M : rowbase + 64 * j;
        const int nvalid = (pre || kind == 2) ? NMETA : 64;
#pragma unroll
        for (int k = 0; k < 3; ++k) { const int id = tid + k * NWAVES * 64, i = id >> 4, c8 = id & 15;
            if (id < 67 * 16) { const v4u w = pf[k];
                *(LAS f32x4*)(XS + i * 132 + 8 * c8) = (f32x4){bflo(w.x), bfhi(w.x), bflo(w.y), bfhi(w.y)}; *(LAS f32x4*)(XS + i * 132 + 8 * c8 + 4) = (f32x4){bflo(w.z), bfhi(w.z), bflo(w.w), bfhi(w.w)}; } }
#pragma unroll
        for (int k = 0; k < 3; ++k) pf[k] = pf2[k];
        if (j + 2 < ntiles) rnn_prefetch(args, XR, l, 0, seq, n, rowbase + 64 * (j + 2), tid, pf2);
        v4u zf[2] = {zfn[0], zfn[1]};
        if (j + 1 < ntiles) {
#pragma unroll
            for (int k = 0; k < 2; ++k) { const int id = tid + k * NWAVES * 64, r = id >> 4, c8 = id & 15; zfn[k] = *(const GAS v4u*)(ZR + (rowbase + 64 * (j + 1) + r) * D + 128 * n + 8 * c8); } }
        RNN_BAR();
        { const int rb = 16 * rg; float x0 = XS[(rb + 0) * 132 + c2], x1 = XS[(rb + 1) * 132 + c2], x2 = XS[(rb + 2) * 132 + c2];
#pragma unroll
          for (int r = 0; r < 16; ++r) { const float x3 = XS[(rb + r + 3) * 132 + c2]; const float xc = (((cb + x0 * cw0) + x1 * cw1) + x2 * cw2) + x3 * cw3;
              XC[(rb + r) * 132 + c2] = xc; XA[(rb + r) * 136 + c2] = (bf16)f2bf(xc); x0 = x1; x1 = x2; x2 = x3; } }
        RNN_BAR();
#pragma unroll
        for (int mt = 0; mt < 4; ++mt) {
            f32x4 ar = {0.f, 0.f, 0.f, 0.f}, ai = {0.f, 0.f, 0.f, 0.f};
#pragma unroll
            for (int ks = 0; ks < 4; ++ks) { const bf16x8 A = *(const LAS bf16x8*)(XA + (16 * mt + cl) * 136 + 32 * ks + 8 * q);
                ar = __builtin_amdgcn_mfma_f32_16x16x32_bf16(A, Br[ks], ar, 0, 0, 0); ai = __builtin_amdgcn_mfma_f32_16x16x32_bf16(A, Bi[ks], ai, 0, 0, 0); }
            float a[4], b[4];
#pragma unroll
            for (int i = 0; i < 4; ++i) { const int r = 16 * mt + 4 * q + i; const float xc = XC[r * 132 + cc];
                const float rr = __builtin_amdgcn_rcpf(1.0f + __expf(-(ar[i] + brg))), ii = __builtin_amdgcn_rcpf(1.0f + __expf(-(ai[i] + big)));
                const float av = __expf(-8.0f * rr * sp); a[i] = av; b[i] = __builtin_amdgcn_sqrtf(fmaxf((1.0f - av) * (1.0f + av), 0.f)) * ii * xc;
                if (r >= nvalid) { a[i] = 1.f; b[i] = 0.f; } }
            const float A4 = (a[0] * a[1]) * (a[2] * a[3]), B4 = ((b[0] * a[1] + b[1]) * a[2] + b[2]) * a[3] + b[3];
            float Ai = A4, Bi2 = B4;
            { const float ua = __shfl_up(Ai, 16), ub = __shfl_up(Bi2, 16); if (q >= 1) { Bi2 = Ai * ub + Bi2; Ai = ua * Ai; } }
            { const float ua = __shfl_up(Ai, 32), ub = __shfl_up(Bi2, 32); if (q >= 2) { Bi2 = Ai * ub + Bi2; Ai = ua * Ai; } }
            float Ae = __shfl_up(Ai, 16), Be = __shfl_up(Bi2, 16); if (q == 0) { Ae = 1.f; Be = 0.f; }
            const float At = __shfl(Ai, 48 + cl), Bt = __shfl(Bi2, 48 + cl);
            float h = Ae * hrun + Be;
#pragma unroll
            for (int i = 0; i < 4; ++i) { h = a[i] * h + b[i]; XC[(16 * mt + 4 * q + i) * 132 + cc] = h; }
            hrun = At * hrun + Bt;
        }
        RNN_BAR();
        if (!pre) {
#pragma unroll
            for (int k = 0; k < 2; ++k) { const int id = tid + k * NWAVES * 64, r = id >> 4, c8 = id & 15;
                const f32x4 h0 = *(const LAS f32x4*)(XC + r * 132 + 8 * c8), h1 = *(const LAS f32x4*)(XC + r * 132 + 8 * c8 + 4);
                const v4u z = zf[k];
                const f32x4 o0 = h0 * (f32x4){bflo(z.x), bfhi(z.x), bflo(z.y), bfhi(z.y)}, o1 = h1 * (f32x4){bflo(z.z), bfhi(z.z), bflo(z.w), bfhi(z.w)};
                *(GAS v4u*)(OX + (row0 + r) * 2 * D + 128 * n + 8 * c8) = pack8f(o0, o1); }
        }
    }
    const bool publish = (kind == 0 && g < 3);
    if (q == 0) {
        if (kind == 0 && g == 3) args->out[O_RP + (size_t)(l * NB + seq) * D + ch] = hrun;
        if (kind == 1) args->out[O_RS + (size_t)(l * NDB + seq) * D + ch] = hrun;
        if (publish) __hip_atomic_store(carry + cc, hrun, RLX_AGENT);
    }
    if (publish) asm volatile("s_waitcnt vmcnt(0)" ::: "memory");
    RNN_BAR();
    if (publish && tid == 0) __hip_atomic_store(flag, 1u, RLX_AGENT);
}
__device__ __forceinline__ void attn_finish(ArgsP args, int l, size_t row0, int h, int nw, int lane, int wid) {
    if (wid >= nw) return;
    unsigned char* ws = args->ws;
    asm volatile("s_waitcnt vmcnt(0)" ::: "memory");
    const float lam = ((const float*)(ws + WS_MISC))[l], oml = ((const float*)(ws + WS_MISC))[8 + l];
    int ln = lane; asm volatile("" : "+v"(ln));
    const int r = ln >> 1, half = ln & 1; const size_t row = row0 + 32 * wid + r;
    const bf16* p1 = (const bf16*)(ws + WS_OP) + row * 2048 + (size_t)(h * 2) * 128 + half * 64; const bf16* p2 = p1 + 128;
    float d[64]; float ss = 0.f;
#pragma unroll
    for (int k = 0; k < 8; ++k) { const v4u a = *(const GAS v4u*)(p1 + 8 * k), b = *(const GAS v4u*)(p2 + 8 * k);
        d[8 * k + 0] = bflo(a.x) - lam * bflo(b.x); d[8 * k + 1] = bfhi(a.x) - lam * bfhi(b.x); d[8 * k + 2] = bflo(a.y) - lam * bflo(b.y); d[8 * k + 3] = bfhi(a.y) - lam * bfhi(b.y);
        d[8 * k + 4] = bflo(a.z) - lam * bflo(b.z); d[8 * k + 5] = bfhi(a.z) - lam * bfhi(b.z); d[8 * k + 6] = bflo(a.w) - lam * bflo(b.w); d[8 * k + 7] = bfhi(a.w) - lam * bfhi(b.w);
#pragma unroll
        for (int e = 0; e < 8; ++e) ss += d[8 * k + e] * d[8 * k + e]; }
    ss += __shfl_xor(ss, 1);
    const float scale = rsqrtf(ss * (1.0f / 128.0f) + EPS) * oml;
    const bf16* za = (const bf16*)(ws + WS_ZA) + row * D + h * 128 + half * 64; const float* sw = args->in[I_SUBLN] + l * 128 + half * 64;
    bf16* od = (bf16*)(ws + WS_OX) + row * 2 * D + D + h * 128 + half * 64;
#pragma unroll
    for (int k = 0; k < 8; ++k) { const v4u z = *(const GAS v4u*)(za + 8 * k); const f32x4 w0 = *(const GAS f32x4*)(sw + 8 * k), w1 = *(const GAS f32x4*)(sw + 8 * k + 4);
        f32x4 o0, o1;
        o0[0] = d[8 * k + 0] * scale * w0[0] * bflo(z.x); o0[1] = d[8 * k + 1] * scale * w0[1] * bfhi(z.x); o0[2] = d[8 * k + 2] * scale * w0[2] * bflo(z.y); o0[3] = d[8 * k + 3] * scale * w0[3] * bfhi(z.y);
        o1[0] = d[8 * k + 4] * scale * w1[0] * bflo(z.z); o1[1] = d[8 * k + 5] * scale * w1[1] * bfhi(z.z); o1[2] = d[8 * k + 6] * scale * w1[2] * bflo(z.w); o1[3] = d[8 * k + 7] * scale * w1[3] * bfhi(z.w);
        *(GAS v4u*)(od + 8 * k) = pack8f(o0, o1); }
}
__device__ __forceinline__ void attn_super(ArgsP args, int l, int kind, int a, int h, int qb, char* shm, int lane, int wid) {
    typedef attn_body::bf16 abf;
    unsigned char* ws = args->ws;
    const abf* Q = (const abf*)(ws + WS_Q); abf* OP = (abf*)(ws + WS_OP);
    size_t qrow; const abf* Kb; const abf* Vb; int NT, vis, qwaves;
    if (kind == 0)      { qrow = (size_t)a * SEQ + (size_t)qb * 256; Kb = (const abf*)(ws + WS_KP) + (size_t)a * KPROWS * D; Vb = (const abf*)(ws + WS_VP) + (size_t)a * KPROWS * D; NT = 4 * qb + 5; vis = (wid >> 1) + 1; qwaves = 8; }
    else if (kind == 1) { qrow = (size_t)ROW_S + (size_t)a * DSQ; Kb = (const abf*)(ws + WS_KS) + (size_t)(l * NDB + a) * KSROWS * D; Vb = (const abf*)(ws + WS_VS) + (size_t)(l * NDB + a) * KSROWS * D; NT = 33; vis = 4; qwaves = 2; }
    else                { qrow = (size_t)ROW_M; Kb = (const abf*)(ws + WS_KP); Vb = (const abf*)(ws + WS_VP); NT = 5; vis = 0; qwaves = 8; }
    const attn128::Fin nofin{0, 0, 0u};
    if (kind == 1) {
        attn128::attn_unit128<8, false, true, false>(Q + qrow * D + (h * 2) * 64, Kb + (h * 2) * 64, Vb + h * 128, OP + qrow * 2048 + (h * 2) * 128, NT, vis, qwaves, shm, nofin);
        attn_finish(args, l, qrow, h, qwaves, lane, wid);
    } else {
        attn128::attn_unit128<8, true, false, false>(Q + qrow * D + (h * 2) * 64, Kb + (h * 2) * 64, Vb + h * 128, OP + qrow * 2048 + (h * 2) * 128, NT, vis, qwaves, shm, nofin);
        const attn128::Fin fin{l, h, (unsigned)qrow};
        attn128::attn_unit128<8, true, false, true>(Q + qrow * D + (h * 2 + 1) * 64, Kb + (h * 2 + 1) * 64, Vb + h * 128, OP + qrow * 2048 + (h * 2 + 1) * 128, NT, vis, qwaves, shm, fin);
    }
}

__global__ void __launch_bounds__(NWAVES * 64, 2) hawk_fwd(Args args) {
    extern __shared__ __attribute__((aligned(16))) unsigned char lds_raw[];
    LAS unsigned char* lds = (LAS unsigned char*)lds_raw;
    volatile LAS unsigned* MISC = (volatile LAS unsigned*)(lds + MISC_OFF);
    const int tid = threadIdx.x;
    const int G = gridDim.x; const int bx = blockIdx.x; const int vcu = (G % 8 == 0) ? (bx % 8) * (G / 8) + bx / 8 : bx;
    for (int u = tid; u < (LDS_BYTES - LDSCTL_OFF) / 4; u += NWAVES * 64) ((LAS unsigned*)(lds + LDSCTL_OFF))[u] = 0u;
    __syncthreads();
#if MK_PER_PHASE
#define GRID_BAR() do { if (tid == 0) __hip_atomic_store((gu32*)(KARG()->ws + WS_CTL) + CW_TMO, 0xBADBA0u, RLX_AGENT); } while (0)
#else
    (void)xcd_barrier_post((unsigned*)((gu32*)(KARG()->ws + WS_CTL) + CW_BAR), MISC + 8);
#define GRID_BAR() do { XcdBarrier bar_; bar_.bar = (unsigned*)((gu32*)(KARG()->ws + WS_CTL) + CW_BAR); bar_.x = xb_xcc_id(); bar_.st = MISC + 8; xcd_barrier(bar_); } while (0)
#endif
    const int lo = KARG()->ph_lo, hi = KARG()->ph_hi;
#if MK_PROBE
#define TACC() ((unsigned long long*)(KARG()->ws + WS_MISC + 32768))
    if (blockIdx.x == 0 && tid == 0) { unsigned long long* ta = TACC(); for (int k = 0; k < 16; ++k) ta[k] = 0ull; ta[16] = __builtin_amdgcn_s_memrealtime(); }
#define TMARK(k) do { if (blockIdx.x == 0 && tid == 0) { unsigned long long* ta = TACC(); const unsigned long long now = __builtin_amdgcn_s_memrealtime(); ta[k] += now - ta[16]; ta[16] = now; } } while (0)
#else
#define TMARK(k) do {} while (0)
#endif
#define IN(k) (lo <= (k) && (k) < hi)
#ifndef PHMASK
#define PHMASK 0xff
#endif
#define PH(b) ((PHMASK >> (b)) & 1)
#define BOTH(k) (IN(k) && IN((k) + 1))
    typedef pg8::bf16_t pb;
    for (int rep_ = 0; rep_ < MK_REP_P0; ++rep_)
    if (PH(0) && IN(0)) { int tid_l = tid; asm volatile("" : "+v"(tid_l)); p0_prologue(KARG(), lds, tid_l & 63, __builtin_amdgcn_readfirstlane(tid_l >> 6), vcu, G); if (BOTH(0) || rep_ + 1 < MK_REP_P0) GRID_BAR(); TMARK(0); }

    for (int l = 0; l < DEPTH; ++l) {
        const int pbase = 1 + 4 * l;
        for (int rep_ = 0; rep_ < MK_REP_P1; ++rep_)
        if (PH(1) && IN(pbase)) {
            ArgsP args = KARG(); unsigned char* ws = args->ws; unsigned char* wl = ws + WS_W + (size_t)l * W_LAYER;
            pg8::Gemm g{(const pb*)(ws + WS_HB), (const pb*)(wl + W_IN), D, D, 0};
#if MK_KPROBE
            pg8::TwoPartOrder S; S.init(M, INC, G, bx);
#else
            pg8::StaticOrder S; S.init(M, INC, G, bx);
#endif
            pg8::EpiIn E{l, ws, args->out};
#if MK_STAGGER
            if ((blockIdx.x >> 3) & 1) { __builtin_amdgcn_s_sleep(127); __builtin_amdgcn_s_sleep(127); __builtin_amdgcn_s_sleep(127); __builtin_amdgcn_s_sleep(127); }
#endif
            #if MK_KPROBE
            pg8::gemm_phase<pg8::EpiIn, pg8::TwoPartOrder, true, true>(lds + RING_OFF, g, S, E);
#else
            pg8::gemm_phase<pg8::EpiIn, pg8::StaticOrder, MK_ALIGN_P1, true>(lds + RING_OFF, g, S, E);
#endif
            TMARK(7); if (BOTH(pbase) || rep_ + 1 < MK_REP_P1) GRID_BAR(); TMARK(1);
        }
        for (int rep_ = 0; rep_ < MK_REP_P3; ++rep_)
        if ((PH(3) || PH(4)) && IN(pbase + 1)) {
            const int xcd0 = (int)(xb_xcc_id() & 7u);
            for (int probe = 0; probe < 8; ++probe) {
              const int qx = (xcd0 + probe) & 7;
              if (probe == 1) {
                  int tid_c = tid; asm volatile("" : "+v"(tid_c));
                  if (tid_c < 64) { unsigned hv = 216u; if (tid_c < 8) hv = __hip_atomic_load((gu32*)(KARG()->ws + WS_CTL) + CW_QUEUE + 64 * ((l + 4 * rep_) * 8 + ((xcd0 + tid_c) & 7)), RLX_AGENT);
                      const unsigned long long lm = __ballot(hv < 216u); if (tid_c == 0) MISC[1] = (unsigned)lm; }
                  __syncthreads();
              }
              if (probe >= 1 && !((MISC[1] >> probe) & 1u)) continue;
              for (;;) {
                ArgsP args = KARG();
                int tid_l = tid; asm volatile("" : "+v"(tid_l)); const int lane_l = tid_l & 63, wave_l = __builtin_amdgcn_readfirstlane(tid_l >> 6);
                if (tid_l == 0) MISC[0] = __hip_atomic_fetch_add((gu32*)(args->ws + WS_CTL) + CW_QUEUE + 64 * ((l + 4 * rep_) * 8 + qx), 1u, RLX_AGENT);
                __syncthreads();
                const int idx = (int)MISC[0];
                __syncthreads();
                if (idx >= 216) break;
                int sig = -1;
                if (idx < 8) rnn_unit(args, l, 0, qx, idx, 0, lds + RING_OFF, tid_l, lane_l, wave_l);
                else if (idx < 24) { const int db = 2 * qx + ((idx - 8) >> 3);
                    cache_convert_head(args, l, db, (idx - 8) & 7, tid_l, NWAVES * 64); asm volatile("s_waitcnt vmcnt(0)" ::: "memory"); __syncthreads();
                    attn_super(args, l, 1, db, (idx - 8) & 7, 0, (char*)lds_raw + RING_OFF, lane_l, wave_l); sig = db >> 2; }
                else if (idx == 24) { attn_super(args, l, 2, 0, qx, 0, (char*)lds_raw + RING_OFF, lane_l, wave_l); sig = 4; }
                else if (idx >= 32 && idx < 56) rnn_unit(args, l, 0, qx, (idx - 32) & 7, 1 + ((idx - 32) >> 3), lds + RING_OFF, tid_l, lane_l, wave_l);
                else if (idx >= 56 && idx < 72) { const int db = 2 * qx + ((idx - 56) >> 3); rnn_unit(args, l, 1, db, (idx - 56) & 7, 0, lds + RING_OFF, tid_l, lane_l, wave_l); sig = db >> 2; }
                else if (idx == 72) { rnn_unit(args, l, 2, 0, qx, 0, lds + RING_OFF, tid_l, lane_l, wave_l); sig = 4; }
                else if (idx >= 73 && idx < 89) { }
                else if ((idx >= 105 && idx < 108) || (idx >= 130 && idx < 133)) {
                    const bool isC = idx >= 130; const int k = isC ? idx - 130 : idx - 105;
                    if (k < 2 || qx < 4) {
                        const int panel = k < 2 ? (qx >> 1) : 4, pn = k < 2 ? 2 * (qx & 1) + k : qx, pm = 128 + panel;
                        gu32* cw = (gu32*)(args->ws + WS_CTL) + (isC ? CW_CNTB : CW_CNTA) + 64 * (l * 8 + panel);
                        const unsigned want = isC ? 4u : (panel < 4 ? 64u : 16u);
                        if (tid_l == 0) { unsigned spn = 0u; while (__hip_atomic_load(cw, RLX_AGENT) < want) { __builtin_amdgcn_s_sleep(4); if (++spn > (1u << 22)) { __hip_atomic_store((gu32*)(args->ws + WS_CTL) + CW_TMO, 0xC0DFu, RLX_AGENT); break; } }
                            __builtin_amdgcn_fence(__ATOMIC_ACQUIRE, "agent"); asm volatile("s_waitcnt vmcnt(0)" ::: "memory"); }
                        __syncthreads();
                        unsigned char* ws = args->ws; unsigned char* wl = ws + WS_W + (size_t)l * W_LAYER;
                        if (!isC) { pg8::Gemm g{(const pb*)(ws + WS_OX), (const pb*)(wl + W_PROJ), 2 * D, D, D}; pg8::OneUnit S{pm, pn, 2}; pg8::EpiProj E{ws};
                            pg8::gemm_phase<pg8::EpiProj, pg8::OneUnit, true, true>(lds + RING_OFF, g, S, E);
                            asm volatile("s_waitcnt vmcnt(0)" ::: "memory"); __syncthreads();
                            if (tid_l == 0) { __builtin_amdgcn_fence(__ATOMIC_RELEASE, "agent"); asm volatile("s_waitcnt vmcnt(0)" ::: "memory");     __hip_atomic_fetch_add((gu32*)(ws + WS_CTL) + CW_CNTB + 64 * (l * 8 + panel), 1u, RLX_AGENT); } }
                        else { pg8::Gemm g{(const pb*)(ws + WS_MB), (const pb*)(wl + W_OUT), D, D, 0}; pg8::OneUnit S{pm, pn, 1}; pg8::EpiOut E{ws};
                            pg8::gemm_phase<pg8::EpiOut, pg8::OneUnit, true, true>(lds + RING_OFF, g, S, E); }
                    }
                }
                else { const int i = idx < 32 ? idx - 25 : idx < 105 ? idx - 89 + 7 : idx < 130 ? idx - 108 + 23 : idx - 133 + 45, r = i & 31;
                    (void)r; attn_super(args, l, 0, qx, i & 7, 15 - (i >> 3), (char*)lds_raw + RING_OFF, lane_l, wave_l); }
                if (sig >= 0) { asm volatile("s_waitcnt vmcnt(0)" ::: "memory"); __syncthreads();
                    if (tid_l == 0) { __builtin_amdgcn_fence(__ATOMIC_RELEASE, "agent"); asm volatile("s_waitcnt vmcnt(0)" ::: "memory");     __hip_atomic_fetch_add((gu32*)(args->ws + WS_CTL) + CW_CNTA + 64 * (l * 8 + sig), 1u, RLX_AGENT); } }
              }
            }
            TMARK(8); if (BOTH(pbase + 1) || rep_ + 1 < MK_REP_P3) GRID_BAR(); TMARK(3);
        }
        for (int rep_ = 0; rep_ < MK_REP_P4; ++rep_)
        if (PH(5) && IN(pbase + 2)) {
            ArgsP args = KARG(); unsigned char* ws = args->ws; unsigned char* wl = ws + WS_W + (size_t)l * W_LAYER;
            pg8::Gemm g{(const pb*)(ws + WS_OX), (const pb*)(wl + W_PROJ), 2 * D, D, D}; pg8::TwoPartOrder S; S.init(MP, D, G, bx);
            pg8::EpiProj E{ws};
            pg8::gemm_phase<pg8::EpiProj, pg8::TwoPartOrder, true, true>(lds + RING_OFF, g, S, E);
            TMARK(9); if (BOTH(pbase + 2) || rep_ + 1 < MK_REP_P4) GRID_BAR(); TMARK(4);
        }
#define P5_BODY() do { ArgsP args = KARG(); unsigned char* ws = args->ws; unsigned char* wl = ws + WS_W + (size_t)l * W_LAYER; \
            pg8::Gemm g{(const pb*)(ws + WS_MB), (const pb*)(wl + W_OUT), D, D, 0}; pg8::StaticOrder S; S.init(MP, D, G, bx); \
            pg8::EpiOut E{ws}; \
            pg8::gemm_phase<pg8::EpiOut, pg8::StaticOrder, true, true>(lds + RING_OFF, g, S, E); } while (0)
        if (PH(6) && IN(pbase + 3)) {
#if MK_REP_P5 == 2
            P5_BODY(); GRID_BAR();
#endif
            P5_BODY();
            if (BOTH(pbase + 3)) GRID_BAR(); TMARK(5);
        }
    }
    if (PH(7) && IN(N_PHASES - 1)) {
        ArgsP args = KARG(); unsigned char* ws = args->ws;
        int tid_l = tid; asm volatile("" : "+v"(tid_l)); const int lane = tid_l & 63, wave = __builtin_amdgcn_readfirstlane(tid_l >> 6);
        const bf16* HB = (const bf16*)(ws + WS_HB); const float* fw = args->in[I_FNW];
        const int gw = vcu * NWAVES + wave, NGW = G * NWAVES;
        f32x4 w4[4];
#pragma unroll
        for (int j = 0; j < 4; ++j) w4[j] = ((const GAS f32x4*)fw)[lane + 64 * j];
        for (int row = gw; row < ROW_M; row += NGW) {
            f32x4 v[4]; float s = 0.f;
#pragma unroll
            for (int j = 0; j < 4; ++j) { const unsigned long long w = ((const GAS unsigned long long*)(HB + (size_t)row * D))[lane + 64 * j]; const unsigned lo = (unsigned)w, hi = (unsigned)(w >> 32);
                v[j] = (f32x4){bflo(lo), bfhi(lo), bflo(hi), bfhi(hi)}; s += (v[j].x * v[j].x + v[j].y * v[j].y) + (v[j].z * v[j].z + v[j].w * v[j].w); }
            const float rs = rsqrtf(wave_sum(s) * (1.0f / 1024.0f) + EPS);
            float* o = args->out + (row < ROW_S ? O_YP + (size_t)row * D : O_YS + (size_t)(row - ROW_S) * D);
#pragma unroll
            for (int j = 0; j < 4; ++j) ((GAS f32x4*)o)[lane + 64 * j] = v[j] * rs * w4[j];
        }
    }
#if MK_PROBE
    GRID_BAR(); TMARK(6);
    if (blockIdx.x == 0) {
        __syncthreads();
        const size_t offs[10] = {O_YP, O_YS, O_KP, O_VP, O_CP, O_RP, O_KS, O_VS, O_CS, O_RS};
#pragma unroll
        for (int k = 0; k < 10; ++k) { unsigned long long t = TACC()[k]; if (k == 1) t += TACC()[7]; if (k == 3) t += TACC()[8]; if (k == 4) t += TACC()[9];
            unsigned n = (unsigned)(t / 100ull); if (n > 30000u) n = 30000u;
            unsigned* o = (unsigned*)(KARG()->out + offs[k]); for (unsigned i = tid; i < n; i += NWAVES * 64) o[i] = 0xAAAAAAAAu; }
    }
#endif
#undef IN
#undef BOTH
}

extern "C" void kernel_launch(void* const* d_in, const int* in_sizes, int n_in, void* d_out, int out_size, void* d_ws, size_t ws_size, hipStream_t stream) {
    static int grid = 0;
    if (grid == 0) {
        if (n_in != 25 || (size_t)out_size != O_END || ws_size < WS_END) { fprintf(stderr, "kernel_launch: unexpected shapes (n_in %d, out %d, ws %zu); nothing launched\n", n_in, out_size, ws_size); grid = -1; return; }
        int dev = 0, cus = 0, per_cu = 0;
        if (hipGetDevice(&dev) != hipSuccess || hipDeviceGetAttribute(&cus, hipDeviceAttributeMultiprocessorCount, dev) != hipSuccess) { grid = -1; return; }
        if (hipFuncSetAttribute((const void*)hawk_fwd, hipFuncAttributeMaxDynamicSharedMemorySize, LDS_BYTES) != hipSuccess) { fprintf(stderr, "kernel_launch: hipFuncSetAttribute failed\n"); grid = -1; return; }
        if (hipOccupancyMaxActiveBlocksPerMultiprocessor(&per_cu, (const void*)hawk_fwd, NWAVES * 64, LDS_BYTES) != hipSuccess || per_cu < 1) { fprintf(stderr, "kernel_launch: occupancy query reports %d workgroups per CU\n", per_cu); }
        (void)hipGetLastError();
        grid = cus;
    }
    if (grid < 0) return;
    if (hipMemsetAsync((char*)d_ws + WS_CTL, 0, CTL_ZERO_BYTES, stream) != hipSuccess) return;
    Args a{};
    for (int i = 0; i < 25; ++i) a.in[i] = (const float*)d_in[i];
    a.out = (float*)d_out; a.ws = (unsigned char*)d_ws;
#if MK_PER_PHASE
    for (int p = 0; p < N_PHASES; ++p) { a.ph_lo = p; a.ph_hi = p + 1; a.li = p; hipLaunchKernelGGL(hawk_fwd, dim3(grid), dim3(NWAVES * 64), LDS_BYTES, stream, a); }
#else
    a.ph_lo = 0; a.ph_hi = N_PHASES; a.li = 0;
    hipLaunchKernelGGL(hawk_fwd, dim3(grid), dim3(NWAVES * 64), LDS_BYTES, stream, a);
#endif
    const hipError_t le = hipPeekAtLastError();
    if (le != hipSuccess) fprintf(stderr, "kernel_launch: launch failed: %s\n", hipGetErrorName(le));
}
```

```cpp
#include <hip/hip_runtime.h>
#include <hip/hip_bf16.h>
#include <cstdio>
#include <cstdint>
#include <cmath>

#ifndef MK_PROBE
#define MK_PROBE 0
#endif
#ifndef MK_REP_P0
#define MK_REP_P0 1
#endif
#ifndef MK_REP_P1
#define MK_REP_P1 1
#endif
#ifndef MK_REP_P2
#define MK_REP_P2 1
#endif
#ifndef MK_REP_P3
#define MK_REP_P3 1
#endif
#ifndef MK_REP_P4
#define MK_REP_P4 1
#endif
#ifndef MK_REP_P5
#define MK_REP_P5 1
#endif
#ifndef MK_ALIGN_P1
#define MK_ALIGN_P1 true
#endif
#ifndef MK_EPI2
#define MK_EPI2 0
#endif
#ifndef MK_KPROBE
#define MK_KPROBE 0
#endif
#ifndef MK_STAGGER
#define MK_STAGGER 0
#endif
#ifndef MK_PER_PHASE
#define MK_PER_PHASE 0
#endif

constexpr int D = 1024, NB = 8, SEQ = 4096, DEPTH = 4, NDB = 16, DSQ = 64, PAST = 2048, NMETA = 16, NH = 8, INC = 8192;
constexpr int MP = NB * SEQ;
constexpr int MSM = NDB * DSQ;
constexpr int ROW_S = MP, ROW_M = MP + MSM;
constexpr int M = ROW_M + 256;
constexpr int TP = NMETA + SEQ;
constexpr int KPROWS = 64 + SEQ;
constexpr int KSROWS = PAST + DSQ;
constexpr float EPS = 1e-6f;
constexpr float QSCALE = 0.125f * 1.4426950408889634f;

constexpr size_t O_YP = 0, O_YS = 33554432, O_KP = 34603008, O_VP = 169345024, O_CP = 304087040, O_RP = 304185344,
                 O_KS = 304218112, O_VS = 308412416, O_CS = 312606720, O_RS = 312803328, O_END = 312868864;

constexpr size_t MiB = 1u << 20;
constexpr size_t WS_CTL = 0, CTL_ZERO_BYTES = 1 * MiB;
constexpr size_t WS_TCOS = 1 * MiB, WS_TSIN = 2 * MiB;
constexpr size_t WS_MISC = 3 * MiB;
constexpr size_t WS_W = 4 * MiB, W_LAYER = 24 * MiB, W_IN = 0, W_PROJ = 16 * MiB, W_OUT = 20 * MiB, W_G = 22 * MiB;
constexpr size_t WS_HRES = 100 * MiB;
constexpr size_t WS_HB = 233 * MiB;
constexpr size_t WS_SSQ = 300 * MiB;
constexpr size_t WS_XR = 303 * MiB, WS_ZR = 370 * MiB, WS_Q = 437 * MiB, WS_ZA = 504 * MiB, WS_RHO = 571 * MiB, WS_SGA = 638 * MiB;
constexpr size_t WS_OX = 705 * MiB;
constexpr size_t WS_MB = 838 * MiB;
constexpr size_t WS_OP = 905 * MiB;
constexpr size_t WS_KP = 1038 * MiB, WS_VP = 1103 * MiB;
constexpr size_t WS_KS = 1168 * MiB, WS_VS = 1432 * MiB;
constexpr size_t WS_HRES2 = 1696 * MiB;
constexpr size_t WS_END = 1830 * MiB;
static_assert(WS_HRES + (size_t)M * D * 4 <= WS_HB && WS_HB + (size_t)M * D * 2 <= WS_SSQ && WS_SSQ + (size_t)M * 64 <= WS_XR, "ws map 1");
static_assert(WS_XR + (size_t)M * D * 2 <= WS_ZR && WS_SGA + (size_t)M * D * 2 <= WS_OX && WS_OX + (size_t)M * 4096 <= WS_MB && WS_MB + (size_t)M * 2048 <= WS_OP, "ws map 2");
static_assert(WS_OP + (size_t)M * 4096 <= WS_KP && WS_KP + (size_t)NB * KPROWS * 2048 <= WS_VP && WS_VP + (size_t)NB * KPROWS * 2048 <= WS_KS, "ws map 3");
static_assert(WS_KS + (size_t)DEPTH * NDB * KSROWS * 2048 <= WS_VS && WS_VS + (size_t)DEPTH * NDB * KSROWS * 2048 <= WS_END, "ws map 4");
constexpr int CW_TMO = 0, CW_CODE = 1;
constexpr int CW_QUEUE = 64;
constexpr int CW_BAR = 8192;

struct Args { const float* in[25]; float* out; unsigned char* ws; int ph_lo, ph_hi, li, pad; };
#define CAS __attribute__((address_space(4)))
typedef const CAS struct Args* ArgsP;
#define KARG() ({ ArgsP p_ = (ArgsP)__builtin_amdgcn_kernarg_segment_ptr(); asm volatile("" : "+s"(p_)); p_; })
enum { I_XP = 0, I_XS, I_CK, I_CV, I_SC, I_SR, I_META, I_NW, I_WIN, I_CW, I_CB, I_WRG, I_BRG, I_WIG, I_BIG, I_LAM, I_LQ1, I_LK1, I_LQ2, I_LK2, I_SUBLN, I_WPR, I_WPA, I_WOUT, I_FNW };


namespace pg8 {
#define PG8_LAS __attribute__((address_space(3)))
typedef unsigned short bf16_t;
typedef short bf16x8 __attribute__((ext_vector_type(8)));
typedef float f32x4 __attribute__((ext_vector_type(4)));
typedef unsigned u32x4 __attribute__((ext_vector_type(4)));
typedef unsigned u32x2 __attribute__((ext_vector_type(2)));
constexpr int BM = 256, BK = 64, HALF = 128, HTB = HALF * BK * 2  , STAGE_BYTES = 8 * HTB, NXCD = 8, WGM = 4;

__host__ __device__ __forceinline__ int lds_byte(int r, int c) { const int st = (r >> 4) * 2 + (c >> 5), rr = r & 15, cc = c & 31, ob = rr * 64 + cc * 2; return st * 1024 + (ob ^ (((ob >> 9) & 1) << 5)); }
__host__ __device__ __forceinline__ void stage_rc(int b, int& R, int& C) { const int st = b / 1024, sb = b % 1024, swz = sb ^ (((sb >> 9) & 1) << 5); R = (st >> 1) * 16 + swz / 64; C = (st & 1) * 32 + (swz % 64) / 2; }
__host__ __device__ __forceinline__ int perm32(int rho) { const int n = rho >> 4, i = rho & 15; return 8 * (i >> 2) + 4 * n + (i & 3); }

struct Unit { int pm, pn, kh; };
struct Gemm { const bf16_t* A; const bf16_t* Bt; int ld, kt, ks; };

struct StaticOrder {
    int nM, nN, nwg, G, c;
    __host__ __device__ void init(int M_, int N_, int G_, int c_) { nM = M_ / BM; nN = N_ / BM; nwg = nM * nN; G = G_; c = c_; }
    __host__ __device__ bool next(int i, Unit& u) const {
        const long L = (long)i * G + c; if (L >= nwg) return false;
        int wgid = (int)L; { const int q = nwg / NXCD, r = nwg % NXCD, xcd = wgid % NXCD, off = wgid / NXCD; wgid = (xcd < r ? xcd * (q + 1) : r * (q + 1) + (xcd - r) * q) + off; }
        const int nig = WGM * nN, gid = wgid / nig, fm = gid * WGM, gsz = (nM - fm) < WGM ? (nM - fm) : WGM;
        u.pm = fm + ((wgid % nig) % gsz); u.pn = (wgid % nig) / gsz;
        u.kh = 0; return true;
    }
    __device__ __forceinline__ void a_ready(const Unit&) const {}
    __device__ __forceinline__ void done(const Unit&) const {}
};
struct OneUnit {
    int pm, pn, nk;
    __host__ __device__ bool next(int i, Unit& u) const { if (i >= nk) return false; u.pm = pm; u.pn = pn; u.kh = i; return true; }
    __device__ __forceinline__ void a_ready(const Unit&) const {}
    __device__ __forceinline__ void done(const Unit&) const {}
};
struct TwoPartOrder {
    StaticOrder S;
    __host__ __device__ void init(int M_, int N_, int G_, int c_) { S.init(M_, N_, G_, c_); }
    __host__ __device__ bool next(int i, Unit& u) const { if (!S.next(i >> 1, u)) return false; u.kh = i & 1; return true; }
    __device__ __forceinline__ void a_ready(const Unit&) const {}
    __device__ __forceinline__ void done(const Unit&) const {}
};
__device__ __forceinline__ unsigned cvt_pk_bf16(float lo, float hi) { unsigned r; asm volatile("v_cvt_pk_bf16_f32 %0, %1, %2" : "=v"(r) : "v"(lo), "v"(hi)); return r; }
__device__ __forceinline__ float bf_lo(unsigned w) { return __uint_as_float(w << 16); }
__device__ __forceinline__ float bf_hi(unsigned w) { return __uint_as_float(w & 0xffff0000u); }
__device__ __forceinline__ float sigm(float x) { return __builtin_amdgcn_rcpf(1.0f + __expf(-x)); }
__device__ __forceinline__ u32x4 pack8(const f32x4 a, const f32x4 b) { u32x4 w; w.x = cvt_pk_bf16(a[0], a[1]); w.y = cvt_pk_bf16(a[2], a[3]); w.z = cvt_pk_bf16(b[0], b[1]); w.w = cvt_pk_bf16(b[2], b[3]); return w; }

struct EpiIn {
    static constexpr bool PERM = true, AFTER_DRAIN = false, TWO_PART = (MK_KPROBE != 0);
    int l; unsigned char* ws; float* out;
    __device__ __forceinline__ void mid(f32x4 (&)[2][2][4][2], const Unit&, int, int, int, int) const {}
    __device__ __forceinline__ void operator()(const f32x4 (&acc)[2][2][4][2], const Unit& u, int wr, int wc, int fr_in, int fq_in) const {
        int fr = fr_in, fq = fq_in; asm volatile("" : "+v"(fr), "+v"(fq));
        const float* ssq = (const float*)(ws + WS_SSQ); const float* tcos = (const float*)(ws + WS_TCOS); const float* tsin = (const float*)(ws + WS_TSIN);
        bf16_t* XR = (bf16_t*)(ws + WS_XR); bf16_t* ZR = (bf16_t*)(ws + WS_ZR); bf16_t* Q = (bf16_t*)(ws + WS_Q); bf16_t* ZA = (bf16_t*)(ws + WS_ZA); bf16_t* RHO = (bf16_t*)(ws + WS_RHO); bf16_t* SGA = (bf16_t*)(ws + WS_SGA);
        bf16_t* KP = (bf16_t*)(ws + WS_KP); bf16_t* VP = (bf16_t*)(ws + WS_VP); bf16_t* KS = (bf16_t*)(ws + WS_KS) + (size_t)l * NDB * KSROWS * D; bf16_t* VS = (bf16_t*)(ws + WS_VS) + (size_t)l * NDB * KSROWS * D;
        const int part = u.pn >> 2, pm = u.pm;
        const int ct = (u.pn & 3) * 256 + wc * 32 + 8 * fq;
        const int a = wc & 1;
        float rsv[2][4];
        { f32x4 sq[2][4];
#pragma unroll
          for (int ai = 0; ai < 2; ++ai)
#pragma unroll
            for (int m = 0; m < 4; ++m) sq[ai][m] = *(const f32x4*)(ssq + ((size_t)pm * BM + ai * HALF + wr * 64 + m * 16 + fr) * 16 + 4 * fq);
#pragma unroll
          for (int ai = 0; ai < 2; ++ai)
#pragma unroll
            for (int m = 0; m < 4; ++m) { float t = (sq[ai][m][0] + sq[ai][m][1]) + (sq[ai][m][2] + sq[ai][m][3]); t += __shfl_xor(t, 16); t += __shfl_xor(t, 32); rsv[ai][m] = rsqrtf(t * (1.0f / 1024.0f) + EPS) * (MK_KPROBE ? 0.5f : 1.0f); } }
        asm volatile("" ::: "memory");
#pragma unroll
        for (int ai = 0; ai < 2; ++ai) {
#pragma unroll
            for (int m = 0; m < 4; ++m) {
                const int r = ai * HALF + wr * 64 + m * 16 + fr; const size_t grow = (size_t)pm * BM + r;
                const float rs = rsv[ai][m];
                int pos, nrep = 1; size_t krow, frow; bool valid = true;
                if (pm < 128) { const int b = pm >> 4, t = (pm & 15) * 256 + r; pos = NMETA + t; krow = (size_t)b * KPROWS + 64 + t; frow = (size_t)(l * NB + b) * TP + NMETA + t; }
                else if (pm < 132) { const int idx = (pm - 128) * 256 + r, db = idx >> 6, s = idx & 63; pos = NMETA + PAST + s; krow = (size_t)db * KSROWS + PAST + s; frow = (size_t)(l * NDB + db) * DSQ + s; }
                else { pos = r & 15; krow = (size_t)(r & 15); frow = (size_t)(l * NB) * TP + (r & 15); nrep = NB; valid = r < NMETA; }
                const bool smp = (pm >= 128 && pm < 132);
                if (part == 0) {
                    bf16_t* rowp = XR + grow * D + ct;
#pragma unroll
                    for (int bj = 0; bj < 2; ++bj) { const f32x4 v0 = acc[ai][bj][m][0] * rs, v1 = acc[ai][bj][m][1] * rs; *(u32x4*)(rowp + bj * HALF) = pack8(v0, v1); }
                    if (m == 3 && fr >= 13) {
                        float* dst = nullptr;
                        if (pm < 128) { if ((pm & 15) == 15 && ai == 1 && wr == 1) dst = out + O_CP + ((size_t)(l * NB + (pm >> 4)) * 3 + (fr - 13)) * D; }
                        else if (pm < 132) { const int db = ((pm - 128) * 256 + r) >> 6; dst = out + O_CS + ((size_t)(l * NDB + db) * 3 + (fr - 13)) * D; }
                        if (dst) {
#pragma unroll
                            for (int bj = 0; bj < 2; ++bj) { *(f32x4*)(dst + ct + bj * HALF) = acc[ai][bj][m][0] * rs; *(f32x4*)(dst + ct + bj * HALF + 4) = acc[ai][bj][m][1] * rs; }
                        }
                    }
                } else if (part == 1 || part == 5) {
                    bf16_t* rowp = (part == 1 ? ZR : ZA) + grow * D + ct;
#pragma unroll
                    for (int bj = 0; bj < 2; ++bj) { f32x4 v0 = acc[ai][bj][m][0] * rs, v1 = acc[ai][bj][m][1] * rs;
#pragma unroll
                        for (int e = 0; e < 4; ++e) { v0[e] = v0[e] * sigm(v0[e]); v1[e] = v1[e] * sigm(v1[e]); }
                        *(u32x4*)(rowp + bj * HALF) = pack8(v0, v1); }
                } else if (part == 2 || part == 3) {
                    const size_t ci = (size_t)pos * 32 + 16 * a + 4 * fq; const f32x4 c4 = *(const f32x4*)(tcos + ci), s4 = *(const f32x4*)(tsin + ci);
#pragma unroll
                    for (int bj = 0; bj < 2; ++bj) { const f32x4 x1 = acc[ai][bj][m][0] * rs, x2 = acc[ai][bj][m][1] * rs; const f32x4 o1 = x1 * c4 - x2 * s4, o2 = x2 * c4 + x1 * s4;
                        if (part == 2) { *(u32x4*)(Q + grow * D + ct + bj * HALF) = pack8(o1 * QSCALE, o2 * QSCALE); }
                        else if (valid) {
                            const int oc = 64 * (4 * (u.pn & 3) + 2 * bj + (wc >> 1)) + 16 * a + 4 * fq;
                            const u32x4 w = pack8(o1, o2);
                            bf16_t* kd = (smp ? KS : KP) + krow * D + ct + bj * HALF; float* fd = out + (smp ? O_KS : O_KP) + frow * D + oc;
                            for (int rep = 0; rep < nrep; ++rep) { *(u32x4*)(kd + (size_t)rep * KPROWS * D) = w; *(f32x4*)(fd + (size_t)rep * TP * D) = o1; *(f32x4*)(fd + (size_t)rep * TP * D + 32) = o2; }
                        } }
                } else if (part == 4) {
                    if (valid) {
#pragma unroll
                        for (int bj = 0; bj < 2; ++bj) { const f32x4 v0 = acc[ai][bj][m][0] * rs, v1 = acc[ai][bj][m][1] * rs; const u32x4 w = pack8(v0, v1);
                            bf16_t* vd = (smp ? VS : VP) + krow * D + ct + bj * HALF; float* fd = out + (smp ? O_VS : O_VP) + frow * D + ct + bj * HALF;
                            for (int rep = 0; rep < nrep; ++rep) { *(u32x4*)(vd + (size_t)rep * KPROWS * D) = w; *(f32x4*)(fd + (size_t)rep * TP * D) = v0; *(f32x4*)(fd + (size_t)rep * TP * D + 4) = v1; } }
                    }
                } else {
                    const int gc = 128 * (u.pn - 24) + wc * 32 + 8 * fq;
                    f32x4 rho[2], sga[2];
#pragma unroll
                    for (int n = 0; n < 2; ++n) { const f32x4 gr = acc[ai][0][m][n] * rs, ga = acc[ai][1][m][n] * rs;
#pragma unroll
                        for (int e = 0; e < 4; ++e) { const float er = __expf(-fminf(fmaxf(gr[e], -30.f), 30.f)), ea = __expf(-fminf(fmaxf(ga[e], -30.f), 30.f));
                            rho[n][e] = (1.0f + ea) * __builtin_amdgcn_rcpf(1.0f + er); sga[n][e] = __builtin_amdgcn_rcpf(1.0f + ea); } }
                    *(u32x4*)(RHO + grow * D + gc) = pack8(rho[0], rho[1]); *(u32x4*)(SGA + grow * D + gc) = pack8(sga[0], sga[1]);
                }
                asm volatile("" ::: "memory");
            }
        }
    }
};

struct EpiProj {
    static constexpr bool PERM = true, AFTER_DRAIN = false, TWO_PART = true;
    unsigned char* ws;
    __device__ __forceinline__ void mid(f32x4 (&acc)[2][2][4][2], const Unit& u, int wr, int wc, int fr_in, int fq_in) const {
        int fr = fr_in, fq = fq_in; asm volatile("" : "+v"(fr), "+v"(fq));
        const bf16_t* RHO = (const bf16_t*)(ws + WS_RHO);
        const int c0 = u.pn * BM + wc * 32 + 8 * fq;
        u32x4 wv[2][4][2];
#pragma unroll
        for (int ai = 0; ai < 2; ++ai)
#pragma unroll
            for (int m = 0; m < 4; ++m)
#pragma unroll
                for (int bj = 0; bj < 2; ++bj) wv[ai][m][bj] = *(const u32x4*)(RHO + ((size_t)u.pm * BM + ai * HALF + wr * 64 + m * 16 + fr) * D + c0 + bj * HALF);
#pragma unroll
        for (int ai = 0; ai < 2; ++ai)
#pragma unroll
            for (int m = 0; m < 4; ++m)
#pragma unroll
                for (int bj = 0; bj < 2; ++bj) { const u32x4 w = wv[ai][m][bj];
                    acc[ai][bj][m][0] *= (f32x4){bf_lo(w.x), bf_hi(w.x), bf_lo(w.y), bf_hi(w.y)}; acc[ai][bj][m][1] *= (f32x4){bf_lo(w.z), bf_hi(w.z), bf_lo(w.w), bf_hi(w.w)}; }
    }
    __device__ __forceinline__ void operator()(const f32x4 (&acc)[2][2][4][2], const Unit& u, int wr, int wc, int fr_in, int fq_in) const {
        int fr = fr_in, fq = fq_in; asm volatile("" : "+v"(fr), "+v"(fq));
        const bf16_t* SGA = (const bf16_t*)(ws + WS_SGA); bf16_t* MB = (bf16_t*)(ws + WS_MB);
        const int c0 = u.pn * BM + wc * 32 + 8 * fq;
        u32x4 wv[2][4][2];
#pragma unroll
        for (int ai = 0; ai < 2; ++ai)
#pragma unroll
            for (int m = 0; m < 4; ++m)
#pragma unroll
                for (int bj = 0; bj < 2; ++bj) wv[ai][m][bj] = *(const u32x4*)(SGA + ((size_t)u.pm * BM + ai * HALF + wr * 64 + m * 16 + fr) * D + c0 + bj * HALF);
        asm volatile("" ::: "memory");
#pragma unroll
        for (int ai = 0; ai < 2; ++ai)
#pragma unroll
            for (int m = 0; m < 4; ++m) { const size_t grow = (size_t)u.pm * BM + ai * HALF + wr * 64 + m * 16 + fr;
#pragma unroll
                for (int bj = 0; bj < 2; ++bj) { const u32x4 w = wv[ai][m][bj];
                    const f32x4 v0 = acc[ai][bj][m][0] * (f32x4){bf_lo(w.x), bf_hi(w.x), bf_lo(w.y), bf_hi(w.y)}, v1 = acc[ai][bj][m][1] * (f32x4){bf_lo(w.z), bf_hi(w.z), bf_lo(w.w), bf_hi(w.w)};
                    *(u32x4*)(MB + grow * D + c0 + bj * HALF) = pack8(v0, v1); }
                if (m & 1) asm volatile("" ::: "memory"); }
    }
};

struct EpiOut {
    static constexpr bool PERM = true, AFTER_DRAIN = false, TWO_PART = false;
    unsigned char* ws;
    __device__ __forceinline__ void mid(f32x4 (&)[2][2][4][2], const Unit&, int, int, int, int) const {}
    __device__ __forceinline__ void operator()(const f32x4 (&acc)[2][2][4][2], const Unit& u, int wr, int wc, int fr_in, int fq_in) const {
        int fr = fr_in, fq = fq_in; asm volatile("" : "+v"(fr), "+v"(fq));
        bf16_t* HB = (bf16_t*)(ws + WS_HB); float* ssq = (float*)(ws + WS_SSQ);
        const int c0 = u.pn * BM + wc * 32 + 8 * fq;
        u32x4 hin[2][4][2];
#pragma unroll
        for (int ai = 0; ai < 2; ++ai)
#pragma unroll
            for (int m = 0; m < 4; ++m)
#pragma unroll
                for (int bj = 0; bj < 2; ++bj) hin[ai][m][bj] = *(const u32x4*)(HB + ((size_t)u.pm * BM + ai * HALF + wr * 64 + m * 16 + fr) * D + c0 + bj * HALF);
        asm volatile("" ::: "memory");
#pragma unroll
        for (int ai = 0; ai < 2; ++ai)
#pragma unroll
            for (int m = 0; m < 4; ++m) { const size_t grow = (size_t)u.pm * BM + ai * HALF + wr * 64 + m * 16 + fr; float ss = 0.f;
#pragma unroll
                for (int bj = 0; bj < 2; ++bj) { const u32x4 w = hin[ai][m][bj];
                    const f32x4 v0 = (f32x4){bf_lo(w.x), bf_hi(w.x), bf_lo(w.y), bf_hi(w.y)} + acc[ai][bj][m][0], v1 = (f32x4){bf_lo(w.z), bf_hi(w.z), bf_lo(w.w), bf_hi(w.w)} + acc[ai][bj][m][1];
                    *(u32x4*)(HB + grow * D + c0 + bj * HALF) = pack8(v0, v1);
                    ss += ((v0[0] * v0[0] + v0[1] * v0[1]) + (v0[2] * v0[2] + v0[3] * v0[3])) + ((v1[0] * v1[0] + v1[1] * v1[1]) + (v1[2] * v1[2] + v1[3] * v1[3])); }
                ss += __shfl_xor(ss, 16); ss += __shfl_xor(ss, 32);
                if (fq == 0) ssq[grow * 16 + u.pn * 4 + wc] = ss;
            }
    }
};
template <class Epi, class Sched, bool ALIGN_EPI = false, bool SP2 = false>
__device__ __forceinline__ void gemm_phase(PG8_LAS unsigned char* lds, const Gemm g, const Sched& S, const Epi& E) {
    int tid_o = threadIdx.x; asm volatile("" : "+v"(tid_o));
    const int tid = tid_o, wid = __builtin_amdgcn_readfirstlane(tid >> 6), lane = tid & 63, wr = wid >> 2, wc = wid & 3, fr = lane & 15, fq = lane >> 4;
    const int K = g.ld, nt = g.kt / BK; const size_t khb = (size_t)g.ks * 2;
    unsigned voffA[2], voffB[2];
#pragma unroll
    for (int i = 0; i < 2; ++i) { int R, C; stage_rc(tid * 16 + i * 8192, R, C); const int Rb = Epi::PERM ? ((R & ~31) + perm32(R & 31)) : R;
        voffA[i] = (unsigned)(R * K + C) * 2u; voffB[i] = (unsigned)(Rb * K + C) * 2u; }
    const size_t kstep = (size_t)(BK * 2);
    const size_t hstep = (size_t)HALF * K * 2;
    const size_t tstep = 2 * hstep;
    const unsigned ldsw = (unsigned)wid * 1024u;
    const int aoff = lds_byte(wr * 64 + fr, fq * 8), boff = lds_byte(wc * 32 + fr, fq * 8);
#define PG8_SA(b, h) (((b) * 2 + (h)) * HTB)
#define PG8_SB(b, h) ((4 + (b) * 2 + (h)) * HTB)
#define PG8_STAGE(bufoff, gbase, voff) do { _Pragma("unroll") for (int _i = 0; _i < 2; ++_i) \
        __builtin_amdgcn_global_load_lds((const unsigned*)((const char*)(gbase) + (voff)[_i]), (PG8_LAS unsigned*)(lds + (bufoff) + ldsw + _i * 8192), 16, 0, 0); } while (0)
#define PG8_LDA(dst, b, h) do { _Pragma("unroll") for (int m = 0; m < 4; ++m) _Pragma("unroll") for (int k = 0; k < 2; ++k) dst[m][k] = *(const PG8_LAS bf16x8*)(lds + PG8_SA(b, h) + aoff + m * 2048 + k * 1024); } while (0)
#define PG8_LDB(dst, b, h) do { _Pragma("unroll") for (int n = 0; n < 2; ++n) _Pragma("unroll") for (int k = 0; k < 2; ++k) dst[n][k] = *(const PG8_LAS bf16x8*)(lds + PG8_SB(b, h) + boff + n * 2048 + k * 1024); } while (0)
#define PG8_MMA(ai, bj, At, Bt) do { __builtin_amdgcn_s_setprio(1); _Pragma("unroll") for (int m = 0; m < 4; ++m) _Pragma("unroll") for (int n = 0; n < 2; ++n) _Pragma("unroll") for (int k = 0; k < 2; ++k) \
        acc[ai][bj][m][n] = __builtin_amdgcn_mfma_f32_16x16x32_bf16(Bt[n][k], At[m][k], acc[ai][bj][m][n], 0, 0, 0); __builtin_amdgcn_s_setprio(0); } while (0)
#define PG8_WAIT_V(n) asm volatile("s_waitcnt vmcnt(" #n ")" ::: "memory")
#define PG8_WAIT_L(n) asm volatile("s_waitcnt lgkmcnt(" #n ")" ::: "memory")
#define PG8_BAR __builtin_amdgcn_s_barrier()
#define PG8_SCHED __builtin_amdgcn_sched_barrier(0)
    Unit cur, nxt; int ui = 0;
    if (!S.next(0, cur)) return;
    f32x4 acc[2][2][4][2];
#pragma unroll
    for (int a = 0; a < 2; ++a)
#pragma unroll
        for (int b = 0; b < 2; ++b)
#pragma unroll
            for (int m = 0; m < 4; ++m)
#pragma unroll
                for (int n = 0; n < 2; ++n) acc[a][b][m][n] = (f32x4){0.f, 0.f, 0.f, 0.f};
    bf16x8 At[4][2], B0[2][2], B1[2][2];
    const char* cA = (const char*)g.A + (size_t)cur.pm * tstep + (size_t)cur.kh * khb; const char* cB = (const char*)g.Bt + (size_t)cur.pn * tstep + (size_t)cur.kh * khb;
    S.a_ready(cur);
    if constexpr (SP2) {
        PG8_STAGE(PG8_SB(0, 0), cB, voffB); PG8_STAGE(PG8_SB(0, 1), cB + hstep, voffB); PG8_STAGE(PG8_SA(0, 0), cA, voffA); PG8_STAGE(PG8_SA(0, 1), cA + hstep, voffA);
        if (wr == 1) PG8_BAR;
        PG8_WAIT_V(2); PG8_BAR;
        PG8_STAGE(PG8_SB(1, 0), cB + kstep, voffB); PG8_STAGE(PG8_SA(1, 0), cA + kstep, voffA); PG8_STAGE(PG8_SB(1, 1), cB + hstep + kstep, voffB);
        PG8_WAIT_V(6); PG8_BAR;
    } else {
        PG8_STAGE(PG8_SB(0, 0), cB, voffB); PG8_STAGE(PG8_SA(0, 0), cA, voffA); PG8_STAGE(PG8_SB(0, 1), cB + hstep, voffB); PG8_STAGE(PG8_SA(0, 1), cA + hstep, voffA);
        if (wr == 1) PG8_BAR;
        PG8_WAIT_V(4); PG8_BAR;
        PG8_STAGE(PG8_SB(1, 0), cB + kstep, voffB); PG8_STAGE(PG8_SA(1, 0), cA + kstep, voffA); PG8_STAGE(PG8_SB(1, 1), cB + hstep + kstep, voffB);
        PG8_WAIT_V(6); PG8_BAR;
    }
    for (;;) {
        const bool has_next = S.next(ui + 1, nxt);
        const char* nA = has_next ? (const char*)g.A + (size_t)nxt.pm * tstep + (size_t)nxt.kh * khb : cA; const char* nB = has_next ? (const char*)g.Bt + (size_t)nxt.pn * tstep + (size_t)nxt.kh * khb : cB;
        for (int t = 0; t < nt; t += 2) {
            const bool last = (t == nt - 2);
            const char* a1 = cA + (size_t)(t + 1) * kstep;
            const char* a2 = last ? nA : cA + (size_t)(t + 2) * kstep; const char* b2 = last ? nB : cB + (size_t)(t + 2) * kstep;
            const char* a3 = a2 + kstep; const char* b3 = b2 + kstep;
            if (last && has_next) S.a_ready(nxt);
            if constexpr (SP2) {
            PG8_LDB(B0, 0, 0); PG8_LDB(B1, 0, 1); PG8_SCHED; PG8_LDA(At, 0, 0); PG8_STAGE(PG8_SA(1, 1), a1 + hstep, voffA);
            PG8_WAIT_V(8); PG8_WAIT_L(0); PG8_BAR; PG8_MMA(0, 0, At, B0); PG8_MMA(0, 1, At, B1); PG8_BAR; PG8_SCHED;
            PG8_LDA(At, 0, 1); PG8_STAGE(PG8_SB(0, 0), b2, voffB); PG8_STAGE(PG8_SB(0, 1), b2 + hstep, voffB); PG8_STAGE(PG8_SA(0, 0), a2, voffA);
            PG8_WAIT_V(8); PG8_WAIT_L(0); PG8_BAR; PG8_MMA(1, 0, At, B0); PG8_MMA(1, 1, At, B1); PG8_BAR; PG8_SCHED;
            PG8_LDB(B0, 1, 0); PG8_LDB(B1, 1, 1); PG8_SCHED; PG8_LDA(At, 1, 0); PG8_STAGE(PG8_SA(0, 1), a2 + hstep, voffA);
            PG8_WAIT_V(8); PG8_WAIT_L(0); PG8_BAR; PG8_MMA(0, 0, At, B0); PG8_MMA(0, 1, At, B1); PG8_BAR; PG8_SCHED;
            PG8_LDA(At, 1, 1); PG8_STAGE(PG8_SB(1, 0), b3, voffB); PG8_STAGE(PG8_SB(1, 1), b3 + hstep, voffB); PG8_STAGE(PG8_SA(1, 0), a3, voffA);
            PG8_WAIT_V(8); PG8_WAIT_L(0); PG8_BAR; PG8_MMA(1, 0, At, B0); PG8_MMA(1, 1, At, B1); PG8_BAR; PG8_SCHED;
            } else {
            PG8_LDB(B0, 0, 0); PG8_SCHED; PG8_LDA(At, 0, 0); PG8_STAGE(PG8_SA(1, 1), a1 + hstep, voffA);
            PG8_WAIT_L(8); PG8_BAR; PG8_WAIT_L(0); PG8_MMA(0, 0, At, B0); PG8_BAR; PG8_SCHED;
            PG8_LDB(B1, 0, 1); PG8_STAGE(PG8_SB(0, 0), b2, voffB);
            PG8_BAR; PG8_WAIT_L(0); PG8_MMA(0, 1, At, B1); PG8_BAR;
            PG8_LDA(At, 0, 1); PG8_STAGE(PG8_SA(0, 0), a2, voffA);
            PG8_BAR; PG8_WAIT_L(0); PG8_MMA(1, 0, At, B0); PG8_BAR; PG8_SCHED;
            PG8_STAGE(PG8_SB(0, 1), b2 + hstep, voffB);
            PG8_WAIT_V(6); PG8_BAR; PG8_MMA(1, 1, At, B1); PG8_BAR;
            PG8_LDB(B0, 1, 0); PG8_SCHED; PG8_LDA(At, 1, 0); PG8_STAGE(PG8_SA(0, 1), a2 + hstep, voffA);
            PG8_WAIT_L(8); PG8_BAR; PG8_WAIT_L(0); PG8_MMA(0, 0, At, B0); PG8_BAR; PG8_SCHED;
            PG8_LDB(B1, 1, 1); PG8_STAGE(PG8_SB(1, 0), b3, voffB);
            PG8_BAR; PG8_WAIT_L(0); PG8_MMA(0, 1, At, B1); PG8_BAR;
            PG8_LDA(At, 1, 1); PG8_STAGE(PG8_SA(1, 0), a3, voffA);
            PG8_BAR; PG8_WAIT_L(0); PG8_MMA(1, 0, At, B0); PG8_BAR; PG8_SCHED;
            PG8_STAGE(PG8_SB(1, 1), b3 + hstep, voffB);
            PG8_WAIT_V(6); PG8_BAR; PG8_MMA(1, 1, At, B1); PG8_BAR;
            }
        }
        if constexpr (ALIGN_EPI) { if (wr == 0) PG8_BAR; }
        bool keep = false;
        if constexpr (Epi::TWO_PART) { if (cur.kh == 0) { E.mid(acc, cur, wr, wc, fr, fq); keep = true; } else { E(acc, cur, wr, wc, fr, fq); } } else { E(acc, cur, wr, wc, fr, fq); }
        S.done(cur);
        if (!has_next) break;
        if (!keep) {
#pragma unroll
        for (int a = 0; a < 2; ++a)
#pragma unroll
            for (int b = 0; b < 2; ++b)
#pragma unroll
                for (int m = 0; m < 4; ++m)
#pragma unroll
                    for (int n = 0; n < 2; ++n) acc[a][b][m][n] = (f32x4){0.f, 0.f, 0.f, 0.f};
        }
        cur = nxt; cA = nA; cB = nB; ++ui;
        if constexpr (ALIGN_EPI) { if (wr == 1) PG8_BAR; }
    }
    PG8_WAIT_V(0);
    if constexpr (!ALIGN_EPI) { if (wr == 0) PG8_BAR; }
    PG8_BAR;
#undef PG8_SA
#undef PG8_SB
#undef PG8_STAGE
#undef PG8_LDA
#undef PG8_LDB
#undef PG8_MMA
#undef PG8_WAIT_V
#undef PG8_WAIT_L
#undef PG8_BAR
#undef PG8_SCHED
}
}

#include <hip/hip_bf16.h>
#include <cmath>
namespace attn_body {
using bf16=__hip_bfloat16;
using bf16x8=__attribute__((ext_vector_type(8)))short;
using s16x4=__attribute__((ext_vector_type(4)))short;
using f32x16=__attribute__((ext_vector_type(16)))float;
using u32x4=__attribute__((ext_vector_type(4)))unsigned;
constexpr int D=64,DM=1024,OPITCH=2048;
constexpr int NW=8,QBLK=32,QB=QBLK*NW,KVBLK=64;
constexpr int ATTN_PITCH=DM, ATTN_UNIT_ROWS=QB;
__device__ __forceinline__ int crow(int r,int hi){return (r&3)+8*(r>>2)+4*hi;}
#define SBAR() __builtin_amdgcn_sched_barrier(0)
__device__ __forceinline__ void cmask(f32x16&p0,f32x16&p1,int jb,int qrel,int hi){
  const float NEG=-INFINITY; int kb=64*jb+4*hi;
  #pragma unroll
  for(int r=0;r<16;++r){int kv=kb+(r&3)+8*(r>>2); if(kv>qrel)p0[r]=NEG; if(kv+32>qrel)p1[r]=NEG;}
}

constexpr int NSLOT=3, SLOTB=8192;
constexpr int LDS_K=0, LDS_V=NSLOT*SLOTB, LDS_WS=2*NSLOT*SLOTB, LDS_OST=LDS_WS+NW*64*4, LDS_BYTES=LDS_OST+NW*4096;
constexpr float C2=0.125f*1.4426950408889634f;
__device__ __forceinline__ void glds16(const void*gsrc,unsigned lds_dst){unsigned keep;
  asm volatile("s_mov_b32 %0, m0\n\ts_mov_b32 m0, %2\n\ts_nop 0\n\tglobal_load_lds_dwordx4 %1, off\n\ts_mov_b32 m0, %0":"=&s"(keep):"v"(gsrc),"s"(lds_dst):"memory");}
__device__ __forceinline__ float max3f(float a,float b,float c){float r;asm("v_max3_f32 %0, %1, %2, %3":"=v"(r):"v"(a),"v"(b),"v"(c));return r;}
__device__ __forceinline__ float max2f(float a,float b){float r;asm("v_max_f32_e32 %0, %1, %2":"=v"(r):"v"(a),"v"(b));return r;}
__device__ __forceinline__ float fadd_s(float a,float b){float r;asm("v_add_f32_e32 %0, %1, %2":"=v"(r):"v"(a),"v"(b));return r;}
__device__ __forceinline__ float fsub_s(float a,float b){float r;asm("v_sub_f32_e32 %0, %1, %2":"=v"(r):"v"(a),"v"(b));return r;}
typedef float f32x2_t __attribute__((ext_vector_type(2))); typedef __bf16 bf16x2_t __attribute__((ext_vector_type(2)));
__device__ __forceinline__ unsigned cvtpk_s(float lo,float hi){f32x2_t v={lo,hi};bf16x2_t b=__builtin_convertvector(v,bf16x2_t);return __builtin_bit_cast(unsigned,b);}
#define WAIT_BAR(N) asm volatile("s_waitcnt vmcnt(" #N ") lgkmcnt(0)\n\ts_barrier":::"memory")

__device__ __forceinline__ void qkt(f32x16&p0,f32x16&p1,const char*Kslot,const bf16x8*qr,const f32x16&negm,int r32,int hi){
  const char*kb=Kslot+hi*1024+r32*16;
  #pragma unroll
  for(int d0=0;d0<4;++d0){
    const bf16x8 b0=*reinterpret_cast<const bf16x8*>(kb+d0*2048);
    const bf16x8 b1=*reinterpret_cast<const bf16x8*>(kb+d0*2048+512);
    if(d0==0){p0=__builtin_amdgcn_mfma_f32_32x32x16_bf16(b0,qr[0],negm,0,0,0);p1=__builtin_amdgcn_mfma_f32_32x32x16_bf16(b1,qr[0],negm,0,0,0);}
    else{p0=__builtin_amdgcn_mfma_f32_32x32x16_bf16(b0,qr[d0],p0,0,0,0);p1=__builtin_amdgcn_mfma_f32_32x32x16_bf16(b1,qr[d0],p1,0,0,0);}}
}
typedef __attribute__((address_space(3))) const char* lds_cptr;
typedef short v4i16_t __attribute__((ext_vector_type(4)));
__device__ __forceinline__ void kload8(bf16x8*kf,lds_cptr kp){
  kf[0]=*(const __attribute__((address_space(3))) bf16x8*)(kp);      kf[1]=*(const __attribute__((address_space(3))) bf16x8*)(kp+512);
  kf[2]=*(const __attribute__((address_space(3))) bf16x8*)(kp+2048); kf[3]=*(const __attribute__((address_space(3))) bf16x8*)(kp+2560);
  kf[4]=*(const __attribute__((address_space(3))) bf16x8*)(kp+4096); kf[5]=*(const __attribute__((address_space(3))) bf16x8*)(kp+4608);
  kf[6]=*(const __attribute__((address_space(3))) bf16x8*)(kp+6144); kf[7]=*(const __attribute__((address_space(3))) bf16x8*)(kp+6656);
}
__device__ __forceinline__ void kload2(bf16x8*kf,lds_cptr kp,int j){ kf[2*j]=*(const __attribute__((address_space(3))) bf16x8*)(kp+j*2048); kf[2*j+1]=*(const __attribute__((address_space(3))) bf16x8*)(kp+j*2048+512); }
__device__ __forceinline__ s16x4 vtr(lds_cptr p){ return __builtin_bit_cast(s16x4,__builtin_amdgcn_ds_read_tr16_b64_v4i16((__attribute__((address_space(3))) v4i16_t*)p)); }
__device__ __forceinline__ float rowmax(const f32x16&p0,const f32x16&p1){
  float a=max3f(p0[0],p0[1],p1[0]),b=max3f(p0[2],p0[3],p1[1]);a=max3f(a,p1[2],p1[3]);
  #pragma unroll
  for(int r=4;r<16;r+=4){a=max3f(a,p0[r],p0[r+1]);b=max3f(b,p0[r+2],p0[r+3]);a=max3f(a,p1[r],p1[r+1]);b=max3f(b,p1[r+2],p1[r+3]);}
  const float m=max2f(a,b);
  auto rr=__builtin_amdgcn_permlane32_swap(__float_as_uint(m),__float_as_uint(m),false,false);
  return max2f(__uint_as_float(rr[0]),__uint_as_float(rr[1]));
}
__device__ __forceinline__ void pv(f32x16*o,int vb,bf16x8 pa0,bf16x8 pa1,bf16x8 pa2,bf16x8 pa3){
  #pragma unroll
  for(int d0=0;d0<2;++d0){s16x4 lo[4],hi[4];
    #pragma unroll
    for(int ks=0;ks<4;++ks){
      asm volatile("ds_read_b64_tr_b16 %0,%1 offset:%c2":"=&v"(lo[ks]):"v"(vb),"i"(d0*4096+ks*1024):"memory");
      asm volatile("ds_read_b64_tr_b16 %0,%1 offset:%c2":"=&v"(hi[ks]):"v"(vb),"i"(d0*4096+ks*1024+512):"memory");}
    asm volatile("s_waitcnt lgkmcnt(0)":::"memory");SBAR();
    #define PK(k) (bf16x8){lo[k][0],lo[k][1],lo[k][2],lo[k][3],hi[k][0],hi[k][1],hi[k][2],hi[k][3]}
    o[d0]=__builtin_amdgcn_mfma_f32_32x32x16_bf16(pa0,PK(0),o[d0],0,0,0);
    o[d0]=__builtin_amdgcn_mfma_f32_32x32x16_bf16(pa1,PK(1),o[d0],0,0,0);
    o[d0]=__builtin_amdgcn_mfma_f32_32x32x16_bf16(pa2,PK(2),o[d0],0,0,0);
    o[d0]=__builtin_amdgcn_mfma_f32_32x32x16_bf16(pa3,PK(3),o[d0],0,0,0);
    #undef PK
  }
}

#ifndef ATTN_STORE16
#define ATTN_STORE16(p,v) (*(u32x4*)(p)=(v))
#endif
template<int THRL,bool MASKED> __device__ __forceinline__ void attn_unit(const bf16*Qin,const bf16*__restrict__ Kh,const bf16*__restrict__ Vh,bf16*Oin,const int NT,const int vis,const int qwaves,char*shm){
  int tid_o=threadIdx.x; asm volatile("":"+v"(tid_o));
  const int tid=tid_o,lane=tid&63,r32=lane&31,hi=lane>>5; const int wid=__builtin_amdgcn_readfirstlane(tid>>6);
  const bf16*Qw=Qin+(long)((wid&(qwaves-1))*QBLK)*DM;
  const unsigned lds0=(unsigned)(uintptr_t)shm;
  float*wsf=(float*)(shm+LDS_WS)+wid*64;
  const bf16*ksrc=Kh+(long)lane*DM+wid*8;
  const bf16*vsrc=Vh+(long)(16*(wid&3)+(lane>>2))*DM+(wid>>2)*32+(lane&3)*8;
  const unsigned kdst=lds0+LDS_K+wid*1024, vdst=lds0+LDS_V+wid*1024;
  #define DMA_K(t,slot) glds16(ksrc+(long)(t)*KVBLK*DM,(unsigned)__builtin_amdgcn_readfirstlane(kdst+(slot)))
  #define DMA_V(t,slot) glds16(vsrc+(long)(t)*KVBLK*DM,(unsigned)__builtin_amdgcn_readfirstlane(vdst+(slot)))
  const int vb0=(int)(lds0+LDS_V)+((lane>>4)&1)*32+(lane&3)*8+(4*hi+((lane&15)>>2))*64;
  const char*Kbase=shm+LDS_K; bf16x8 kf[8];
  const lds_cptr shm3=(lds_cptr)shm; const lds_cptr kp0=shm3+LDS_K+hi*1024+r32*16; const lds_cptr vp0=shm3+LDS_V+((lane>>4)&1)*32+(lane&3)*8+(4*hi+((lane&15)>>2))*64;
  DMA_K(0,0);DMA_V(0,0);DMA_K(1,SLOTB);
  bf16x8 qr[4];
  #pragma unroll
  for(int d0=0;d0<4;++d0)qr[d0]=*reinterpret_cast<const bf16x8*>(&Qw[(long)r32*DM+d0*16+hi*8]);
  float mhat=0.f,l_reg=0.f;f32x16 o[2];o[0]=f32x16{};o[1]=f32x16{};f32x16 negm=f32x16{};asm volatile("":"+v"(negm));
  #define CMASK(P0,P1,t) do{ if(MASKED){ const int jb_=(t)-(NT-4); if(jb_>=vis){ _Pragma("unroll") for(int r_=0;r_<16;++r_){P0[r_]=-INFINITY;P1[r_]=-INFINITY;} } } }while(0)
  bool resc=false;
  #define START(P0,P1) do{ const float rm=rowmax(P0,P1); resc=false; \
    { const float dl=rm; mhat=fadd_s(mhat,dl); \
      _Pragma("unroll") for(int r=0;r<16;++r){P0[r]=fsub_s(P0[r],dl);P1[r]=fsub_s(P1[r],dl);} \
      _Pragma("unroll") for(int r=0;r<16;++r)negm[r]=-mhat; asm volatile("":"+v"(negm)); } \
    _Pragma("unroll") for(int r=0;r<16;++r)P0[r]=__builtin_amdgcn_exp2f(P0[r]); }while(0)
  #define RESC() do{ if(resc){ asm volatile("s_waitcnt lgkmcnt(0)":::"memory"); \
      _Pragma("unroll") for(int d_=0;d_<2;++d_) _Pragma("unroll") for(int r=0;r<16;++r)o[d_][r]*=wsf[crow(r,hi)]; } }while(0)
  f32x16 pA0,pA1,pB0,pB1;
  int sl_prev=0,sl_cur=0,sl_next=SLOTB;
  #define ROT() do{sl_prev=sl_cur;sl_cur=sl_next;sl_next=(sl_next==(NSLOT-1)*SLOTB)?0:sl_next+SLOTB;}while(0)
  DMA_K(2,2*SLOTB);
  WAIT_BAR(3);
  qkt(pA0,pA1,Kbase,qr,negm,r32,hi);asm volatile("s_nop 15\n\ts_nop 7":"+v"(pA0),"+v"(pA1));
  if(MASKED){ _Pragma("unroll") for(int r_=8;r_<16;++r_)pA0[r_]=-INFINITY; _Pragma("unroll") for(int r_=0;r_<16;++r_)pA1[r_]=-INFINITY; }
  START(pA0,pA1);
  _Pragma("unroll") for(int r=0;r<16;++r)pA1[r]=__builtin_amdgcn_exp2f(pA1[r]);
  WAIT_BAR(0);
  DMA_K(3,0);DMA_V(1,SLOTB);
  ROT();
  kload8(kf,kp0+sl_cur);
  WAIT_BAR(2);
  s16x4 vlo[8],vhi[8]; u32x4 pw0,pw1,pw2,pw3;
  #define PKW(P,B) cvtpk_s(P[B],P[B+1])
  #define PAF(k) __builtin_bit_cast(bf16x8,pw##k)
  #define VFR(i) (bf16x8){vlo[i][0],vlo[i][1],vlo[i][2],vlo[i][3],vhi[i][0],vhi[i][1],vhi[i][2],vhi[i][3]}
  #define PIN(x) asm volatile("":"+v"(x))
  #define MX3(a,b,c) __builtin_fmaxf(__builtin_fmaxf((a),(b)),(c))
  #define GAPA(MF,A0,A1,A2,A3,W0,W1,PW) do{ MF; sacc+=A0; sacc+=A1; sacc+=A2; sacc+=A3; PIN(sacc); W0; W1; PIN(PW); SBAR(); }while(0)
  #define EX(v) __builtin_amdgcn_exp2f(v)
  #define GAPB(MF,X,B) do{ MF; X[B]=EX(X[B]); X[B+1]=EX(X[B+1]); X[B+2]=EX(X[B+2]); X[B+3]=EX(X[B+3]); PIN(X); SBAR(); }while(0)
  #define VRD(i) do{ vlo[i]=vtr(vp_+(((i)>>2)*4096+((i)&3)*1024)); vhi[i]=vtr(vp_+(((i)>>2)*4096+((i)&3)*1024+512)); }while(0)
  #define KRD(G,j) do{ if(G){ kload2(kf,kp0+sl_next,j); SBAR(); } }while(0)
  #define STEP(C0,C1,P0,P1,t,GK,GV,GL) do{ SBAR(); \
    const lds_cptr vp_=vp0+sl_prev; \
    VRD(0); SBAR(); float sacc=(P0[0]+P0[1]); \
    GAPA(C0=__builtin_amdgcn_mfma_f32_32x32x16_bf16(kf[0],qr[0],negm,0,0,0), P0[2],P0[3],P0[4],P0[5],     pw0[0]=PKW(P0,0), pw0[1]=PKW(P0,2), pw0); \
    VRD(4); SBAR(); GAPA(C1=__builtin_amdgcn_mfma_f32_32x32x16_bf16(kf[1],qr[0],negm,0,0,0), P0[6],P0[7],P0[8],P0[9],     pw0[2]=PKW(P0,4), pw0[3]=PKW(P0,6), pw0); \
    VRD(1); SBAR(); GAPA(C0=__builtin_amdgcn_mfma_f32_32x32x16_bf16(kf[2],qr[1],C0,0,0,0),   P0[10],P0[11],P0[12],P0[13], pw1[0]=PKW(P0,8), pw1[1]=PKW(P0,10), pw1); \
    VRD(5); SBAR(); GAPA(C1=__builtin_amdgcn_mfma_f32_32x32x16_bf16(kf[3],qr[1],C1,0,0,0),   P0[14],P0[15],P1[0],P1[1],   pw1[2]=PKW(P0,12),pw1[3]=PKW(P0,14), pw1); \
    VRD(2); SBAR(); GAPA(C0=__builtin_amdgcn_mfma_f32_32x32x16_bf16(kf[4],qr[2],C0,0,0,0),   P1[2],P1[3],P1[4],P1[5],     pw2[0]=PKW(P1,0), pw2[1]=PKW(P1,2), pw2); \
    VRD(6); SBAR(); GAPA(C1=__builtin_amdgcn_mfma_f32_32x32x16_bf16(kf[5],qr[2],C1,0,0,0),   P1[6],P1[7],P1[8],P1[9],     pw2[2]=PKW(P1,4), pw2[3]=PKW(P1,6), pw2); \
    VRD(3); SBAR(); GAPA(C0=__builtin_amdgcn_mfma_f32_32x32x16_bf16(kf[6],qr[3],C0,0,0,0),   P1[10],P1[11],P1[12],P1[13], pw3[0]=PKW(P1,8), pw3[1]=PKW(P1,10), pw3); \
    VRD(7); SBAR(); GAPA(C1=__builtin_amdgcn_mfma_f32_32x32x16_bf16(kf[7],qr[3],C1,0,0,0),   P1[14],P1[15],0.f,0.f,       pw3[2]=PKW(P1,12),pw3[3]=PKW(P1,14), pw3); \
    l_reg+=sacc; \
    if(GK){DMA_K((t)+3,sl_cur);} if(GV){DMA_V((t)+1,sl_next);} \
    CMASK(C0,C1,t); \
    { float a=MX3(C0[0],C0[1],C1[0]),b=MX3(C0[2],C0[3],C1[1]); a=MX3(a,C1[2],C1[3]); \
      _Pragma("unroll") for(int r=4;r<16;r+=4){a=MX3(a,C0[r],C0[r+1]);b=MX3(b,C0[r+2],C0[r+3]);a=MX3(a,C1[r],C1[r+1]);b=MX3(b,C1[r+2],C1[r+3]);} \
      float rm=__builtin_fmaxf(a,b); { auto rr=__builtin_amdgcn_permlane32_swap(__float_as_uint(rm),__float_as_uint(rm),false,false); rm=__builtin_fmaxf(__uint_as_float(rr[0]),__uint_as_float(rr[1])); } \
      resc=false; \
      if(__builtin_expect(__any(rm>(float)THRL),0)){ const float dl=__builtin_fmaxf(rm,0.f); mhat+=dl; \
        _Pragma("unroll") for(int r=0;r<16;++r){C0[r]-=dl;C1[r]-=dl;} \
        _Pragma("unroll") for(int r=0;r<16;++r)negm[r]=-mhat; asm volatile("":"+v"(negm)); \
        const float f=__builtin_amdgcn_exp2f(-dl); l_reg*=f; if(hi==0)wsf[r32]=f; resc=true; } } \
    SBAR(); \
    GAPB(o[0]=__builtin_amdgcn_mfma_f32_32x32x16_bf16(PAF(0),VFR(0),o[0],0,0,0), C0,0); \
    GAPB(o[1]=__builtin_amdgcn_mfma_f32_32x32x16_bf16(PAF(0),VFR(4),o[1],0,0,0), C0,4); \
    KRD(GL,0); GAPB(o[0]=__builtin_amdgcn_mfma_f32_32x32x16_bf16(PAF(1),VFR(1),o[0],0,0,0), C0,8); \
    KRD(GL,1); GAPB(o[1]=__builtin_amdgcn_mfma_f32_32x32x16_bf16(PAF(1),VFR(5),o[1],0,0,0), C0,12); \
    KRD(GL,2); GAPB(o[0]=__builtin_amdgcn_mfma_f32_32x32x16_bf16(PAF(2),VFR(2),o[0],0,0,0), C1,0); \
    KRD(GL,3); GAPB(o[1]=__builtin_amdgcn_mfma_f32_32x32x16_bf16(PAF(2),VFR(6),o[1],0,0,0), C1,4); \
    GAPB(o[0]=__builtin_amdgcn_mfma_f32_32x32x16_bf16(PAF(3),VFR(3),o[0],0,0,0), C1,8); \
    GAPB(o[1]=__builtin_amdgcn_mfma_f32_32x32x16_bf16(PAF(3),VFR(7),o[1],0,0,0), C1,12); \
    }while(0)
  int t=1;
  #undef CMASK
  #define CMASK(P0,P1,t) do{}while(0)
  for(;t+5<NT;t+=2){
    STEP(pB0,pB1,pA0,pA1,t,true,true,true);     WAIT_BAR(2); RESC(); ROT();
    STEP(pA0,pA1,pB0,pB1,t+1,true,true,true);   WAIT_BAR(2); RESC(); ROT();
  }
  #undef CMASK
  #define CMASK(P0,P1,t) do{ if(MASKED){ const int jb_=(t)-(NT-4); if(jb_>=vis){ _Pragma("unroll") for(int r_=0;r_<16;++r_){P0[r_]=-INFINITY;P1[r_]=-INFINITY;} } } }while(0)
  #define ENDW(tt) do{ if((tt)+3<NT){WAIT_BAR(2);} else if((tt)+2<NT){WAIT_BAR(1);} else {WAIT_BAR(0);} }while(0)
  for(;t+1<NT;t+=2){
    STEP(pB0,pB1,pA0,pA1,t,(t+3<NT),(t+1<NT),(t+1<NT));       ENDW(t);   RESC(); ROT();
    STEP(pA0,pA1,pB0,pB1,t+1,(t+4<NT),(t+2<NT),(t+2<NT));     ENDW(t+1); RESC(); ROT();
  }
  { float sacc=pA0[0]+pA0[1]; _Pragma("unroll") for(int r=2;r<16;++r)sacc+=pA0[r]; _Pragma("unroll") for(int r=0;r<16;++r)sacc+=pA1[r]; l_reg+=sacc;
    pw0=(u32x4){PKW(pA0,0),PKW(pA0,2),PKW(pA0,4),PKW(pA0,6)};pw1=(u32x4){PKW(pA0,8),PKW(pA0,10),PKW(pA0,12),PKW(pA0,14)};pw2=(u32x4){PKW(pA1,0),PKW(pA1,2),PKW(pA1,4),PKW(pA1,6)};pw3=(u32x4){PKW(pA1,8),PKW(pA1,10),PKW(pA1,12),PKW(pA1,14)};
    SBAR(); pv(o,vb0+sl_prev,PAF(0),PAF(1),PAF(2),PAF(3)); }
  #undef PKW
  #undef PAF
  #undef VFR
  #undef PIN
  #undef MX3
  #undef GAPA
  #undef GAPB
  #undef EX
  #undef VRD
  #undef KRD
  #undef STEP
  #undef ENDW
  {auto rr=__builtin_amdgcn_permlane32_swap(__float_as_uint(l_reg),__float_as_uint(l_reg),false,false);l_reg=__uint_as_float(rr[0])+__uint_as_float(rr[1]);}
  if(hi==0)wsf[32+r32]=l_reg;asm volatile("s_waitcnt lgkmcnt(0)":::"memory");
  float rli[16];
  #pragma unroll
  for(int r=0;r<16;++r)rli[r]=__builtin_amdgcn_rcpf(wsf[32+crow(r,hi)]);
  bf16*Ow=Oin+(long)(wid*QBLK)*OPITCH;
  { bf16*stg=(bf16*)(shm+LDS_OST)+wid*2048;
    #pragma unroll
    for(int r=0;r<16;++r){const int orow=crow(r,hi);
      #pragma unroll
      for(int d0=0;d0<2;++d0)stg[orow*64+d0*32+r32]=__float2bfloat16(o[d0][r]*rli[r]);}
    asm volatile("s_waitcnt lgkmcnt(0)":::"memory");
    #pragma unroll
    for(int i=0;i<4;++i){const int row=i*8+(lane>>3),ch=lane&7; const u32x4 v=*(const u32x4*)(stg+row*64+ch*8); if(wid<qwaves)ATTN_STORE16(Ow+(long)row*OPITCH+ch*8,v);} }
  asm volatile("s_waitcnt lgkmcnt(0)\n\ts_barrier":::"memory");
  #undef DMA_K
  #undef DMA_V
  #undef CMASK
  #undef START
  #undef RESC
  #undef ROT
}
constexpr int ATTN_LDS_BYTES=LDS_BYTES;
#undef SBAR
#undef WAIT_BAR
}

namespace attn128 {
using namespace attn_body;
#define SBAR() __builtin_amdgcn_sched_barrier(0)
#define WAIT_BAR(N) asm volatile("s_waitcnt vmcnt(" #N ") lgkmcnt(0)\n\ts_barrier":::"memory")
constexpr int VSLOTB=16384;
constexpr int L_K=0, L_V=NSLOT*SLOTB, L_WS=L_V+NSLOT*VSLOTB, L_OST=L_WS+NW*64*4, L_BYTES=L_OST+NW*4096;
__device__ __forceinline__ void pv4(f32x16*o,int vb,bf16x8 pa0,bf16x8 pa1,bf16x8 pa2,bf16x8 pa3){
  #pragma unroll
  for(int d0=0;d0<4;++d0){s16x4 lo[4],hi[4];
    #pragma unroll
    for(int ks=0;ks<4;++ks){
      asm volatile("ds_read_b64_tr_b16 %0,%1 offset:%c2":"=&v"(lo[ks]):"v"(vb),"i"(d0*4096+ks*1024):"memory");
      asm volatile("ds_read_b64_tr_b16 %0,%1 offset:%c2":"=&v"(hi[ks]):"v"(vb),"i"(d0*4096+ks*1024+512):"memory");}
    asm volatile("s_waitcnt lgkmcnt(0)":::"memory");SBAR();
    #define PK(k) (bf16x8){lo[k][0],lo[k][1],lo[k][2],lo[k][3],hi[k][0],hi[k][1],hi[k][2],hi[k][3]}
    o[d0]=__builtin_amdgcn_mfma_f32_32x32x16_bf16(pa0,PK(0),o[d0],0,0,0);
    o[d0]=__builtin_amdgcn_mfma_f32_32x32x16_bf16(pa1,PK(1),o[d0],0,0,0);
    o[d0]=__builtin_amdgcn_mfma_f32_32x32x16_bf16(pa2,PK(2),o[d0],0,0,0);
    o[d0]=__builtin_amdgcn_mfma_f32_32x32x16_bf16(pa3,PK(3),o[d0],0,0,0);
    #undef PK
  }
}
struct Fin { int l, h; unsigned qrow; };
template<int THRL,bool MASKED,bool DUAL,bool FIN> __device__ __forceinline__ void attn_unit128(const bf16*Qin,const bf16*__restrict__ Kh,const bf16*__restrict__ Vh,bf16*Oin,const int NT,const int vis,const int qwaves,char*shm,const Fin fin){
  int tid_o=threadIdx.x; asm volatile("":"+v"(tid_o));
  const int tid=tid_o,lane=tid&63,r32=lane&31,hi=lane>>5; const int wid=__builtin_amdgcn_readfirstlane(tid>>6);
  constexpr int KSL=DUAL?2:1;
  constexpr int LK=0, LV=NSLOT*SLOTB*KSL, LWS=LV+NSLOT*VSLOTB, LOST=LWS+NW*64*4;
  const int cmap=DUAL?((wid>>1)&1):0, qgrp=DUAL?(wid&1):(wid&(qwaves-1)); const bool do_store=DUAL?(wid<4):(wid<qwaves);
  const bf16*Qw=Qin+cmap*64+(long)(qgrp*QBLK)*DM;
  const unsigned lds0=(unsigned)(uintptr_t)shm;
  float*wsf=(float*)(shm+LWS)+wid*64;
  const bf16*ksrc=Kh+(long)lane*DM+wid*8;
  const bf16*vsrc=Vh+(long)(16*(wid&3)+(lane>>2))*DM+(wid>>2)*32+(lane&3)*8;
  const unsigned kdst=lds0+LK+wid*1024, vdst=lds0+LV+wid*1024;
  #define DMA_K(t,slot) do{ glds16(ksrc+(long)(t)*KVBLK*DM,(unsigned)__builtin_amdgcn_readfirstlane(kdst+KSL*(slot))); if(DUAL) glds16(ksrc+(long)(t)*KVBLK*DM+64,(unsigned)__builtin_amdgcn_readfirstlane(kdst+KSL*(slot)+8192)); }while(0)
  #define DMA_V(t,slot) do{ glds16(vsrc+(long)(t)*KVBLK*DM,(unsigned)__builtin_amdgcn_readfirstlane(vdst+2*(slot))); glds16(vsrc+(long)(t)*KVBLK*DM+64,(unsigned)__builtin_amdgcn_readfirstlane(vdst+2*(slot)+8192)); }while(0)
  const int vb0=(int)(lds0+LV)+((lane>>4)&1)*32+(lane&3)*8+(4*hi+((lane&15)>>2))*64;
  const char*Kbase=shm+LK+cmap*8192; bf16x8 kf[8];
  const lds_cptr shm3=(lds_cptr)shm; const lds_cptr kp0=shm3+LK+cmap*8192+hi*1024+r32*16; const lds_cptr vp0=shm3+LV+((lane>>4)&1)*32+(lane&3)*8+(4*hi+((lane&15)>>2))*64;
  DMA_K(0,0);DMA_V(0,0);DMA_K(1,SLOTB);
  bf16x8 qr[4];
  #pragma unroll
  for(int d0=0;d0<4;++d0)qr[d0]=*reinterpret_cast<const bf16x8*>(&Qw[(long)r32*DM+d0*16+hi*8]);
  float mhat=0.f,l_reg=0.f;f32x16 o[4];o[0]=f32x16{};o[1]=f32x16{};o[2]=f32x16{};o[3]=f32x16{};f32x16 negm=f32x16{};asm volatile("":"+v"(negm));
  #define CMASK(P0,P1,t) do{ if(MASKED){ const int jb_=(t)-(NT-4); if(jb_>=vis){ _Pragma("unroll") for(int r_=0;r_<16;++r_){P0[r_]=-INFINITY;P1[r_]=-INFINITY;} } } }while(0)
  bool resc=false;
  #define START(P0,P1) do{ const float rm=rowmax(P0,P1); resc=false; \
    { const float dl=rm; mhat=fadd_s(mhat,dl); \
      _Pragma("unroll") for(int r=0;r<16;++r){P0[r]=fsub_s(P0[r],dl);P1[r]=fsub_s(P1[r],dl);} \
      _Pragma("unroll") for(int r=0;r<16;++r)negm[r]=-mhat; asm volatile("":"+v"(negm)); } \
    _Pragma("unroll") for(int r=0;r<16;++r)P0[r]=__builtin_amdgcn_exp2f(P0[r]); }while(0)
  #define RESC() do{ if(resc){ asm volatile("s_waitcnt lgkmcnt(0)":::"memory"); \
      _Pragma("unroll") for(int d_=0;d_<4;++d_) _Pragma("unroll") for(int r=0;r<16;++r)o[d_][r]*=wsf[crow(r,hi)]; } }while(0)
  f32x16 pA0,pA1,pB0,pB1;
  int sl_prev=0,sl_cur=0,sl_next=SLOTB;
  #define ROT() do{sl_prev=sl_cur;sl_cur=sl_next;sl_next=(sl_next==(NSLOT-1)*SLOTB)?0:sl_next+SLOTB;}while(0)
  DMA_K(2,2*SLOTB);
  if constexpr(DUAL){WAIT_BAR(6);}else{WAIT_BAR(4);}
  { const f32x16 zc=f32x16{}; qkt(pA0,pA1,Kbase,qr,zc,r32,hi); } asm volatile("s_nop 15\n\ts_nop 7":"+v"(pA0),"+v"(pA1));
  if(MASKED){ _Pragma("unroll") for(int r_=8;r_<16;++r_)pA0[r_]=-INFINITY; _Pragma("unroll") for(int r_=0;r_<16;++r_)pA1[r_]=-INFINITY; }
  START(pA0,pA1);
  _Pragma("unroll") for(int r=0;r<16;++r)pA1[r]=__builtin_amdgcn_exp2f(pA1[r]);
  WAIT_BAR(0);
  DMA_K(3,0);DMA_V(1,SLOTB);
  ROT();
  kload8(kf,kp0+KSL*sl_cur);
  if constexpr(DUAL){WAIT_BAR(4);}else{WAIT_BAR(3);}
  s16x4 wlo[3],whi[3]; u32x4 pw0,pw1,pw2,pw3;
  #define PKW(P,B) cvtpk_s(P[B],P[B+1])
  #define PAF(k) __builtin_bit_cast(bf16x8,pw##k)
  #define VFW(s) (bf16x8){wlo[s][0],wlo[s][1],wlo[s][2],wlo[s][3],whi[s][0],whi[s][1],whi[s][2],whi[s][3]}
  #define PIN(x) asm volatile("":"+v"(x))
  #define MX3(a,b,c) __builtin_fmaxf(__builtin_fmaxf((a),(b)),(c))
  #define GAPA(MF,A0,A1,A2,A3,W0,W1,PW) do{ MF; sacc+=A0; sacc+=A1; sacc+=A2; sacc+=A3; PIN(sacc); W0; W1; PIN(PW); SBAR(); }while(0)
  #define EX(v) __builtin_amdgcn_exp2f(v)
  #define VRW(s,f) do{ wlo[s]=vtr(vp_+(((f)>>2)*4096+((f)&3)*1024)); whi[s]=vtr(vp_+(((f)>>2)*4096+((f)&3)*1024+512)); }while(0)
  #define KRD(G,j) do{ if(G){ kload2(kf,kp0+KSL*sl_next,j); SBAR(); } }while(0)
  #define FJ(j) ((((j)&3)<<2)|((j)>>2))
  #define VREQ(j) do{ VRW((j)%3,FJ(j)); SBAR(); }while(0)
  #define GAPB(RD,JN,KQ,QD,JU,X,B) do{ if(RD){ VREQ(JN); } o[QD]=__builtin_amdgcn_mfma_f32_32x32x16_bf16(PAF(KQ),VFW((JU)%3),o[QD],0,0,0); X[B]=EX(X[B]); X[B+1]=EX(X[B+1]); PIN(X); SBAR(); }while(0)
  #define STEP(C0,C1,P0,P1,t,GK,GV,GL) do{ SBAR(); \
    const lds_cptr vp_=vp0+2*sl_prev; \
    float sacc=(P0[0]+P0[1]); \
    GAPA(C0=__builtin_amdgcn_mfma_f32_32x32x16_bf16(kf[0],qr[0],negm,0,0,0), P0[2],P0[3],P0[4],P0[5],     pw0[0]=PKW(P0,0), pw0[1]=PKW(P0,2), pw0); \
    GAPA(C1=__builtin_amdgcn_mfma_f32_32x32x16_bf16(kf[1],qr[0],negm,0,0,0), P0[6],P0[7],P0[8],P0[9],     pw0[2]=PKW(P0,4), pw0[3]=PKW(P0,6), pw0); \
    GAPA(C0=__builtin_amdgcn_mfma_f32_32x32x16_bf16(kf[2],qr[1],C0,0,0,0),   P0[10],P0[11],P0[12],P0[13], pw1[0]=PKW(P0,8), pw1[1]=PKW(P0,10), pw1); \
    GAPA(C1=__builtin_amdgcn_mfma_f32_32x32x16_bf16(kf[3],qr[1],C1,0,0,0),   P0[14],P0[15],P1[0],P1[1],   pw1[2]=PKW(P0,12),pw1[3]=PKW(P0,14), pw1); \
    GAPA(C0=__builtin_amdgcn_mfma_f32_32x32x16_bf16(kf[4],qr[2],C0,0,0,0),   P1[2],P1[3],P1[4],P1[5],     pw2[0]=PKW(P1,0), pw2[1]=PKW(P1,2), pw2); \
    VREQ(0); \
    GAPA(C1=__builtin_amdgcn_mfma_f32_32x32x16_bf16(kf[5],qr[2],C1,0,0,0),   P1[6],P1[7],P1[8],P1[9],     pw2[2]=PKW(P1,4), pw2[3]=PKW(P1,6), pw2); \
    VREQ(1); \
    GAPA(C0=__builtin_amdgcn_mfma_f32_32x32x16_bf16(kf[6],qr[3],C0,0,0,0),   P1[10],P1[11],P1[12],P1[13], pw3[0]=PKW(P1,8), pw3[1]=PKW(P1,10), pw3); \
    GAPA(C1=__builtin_amdgcn_mfma_f32_32x32x16_bf16(kf[7],qr[3],C1,0,0,0),   P1[14],P1[15],0.f,0.f,       pw3[2]=PKW(P1,12),pw3[3]=PKW(P1,14), pw3); \
    l_reg+=sacc; \
    if(GK){DMA_K((t)+3,sl_cur);} if(GV){DMA_V((t)+1,sl_next);} \
    CMASK(C0,C1,t); \
    { float a=MX3(C0[0],C0[1],C1[0]),b=MX3(C0[2],C0[3],C1[1]); a=MX3(a,C1[2],C1[3]); \
      _Pragma("unroll") for(int r=4;r<16;r+=4){a=MX3(a,C0[r],C0[r+1]);b=MX3(b,C0[r+2],C0[r+3]);a=MX3(a,C1[r],C1[r+1]);b=MX3(b,C1[r+2],C1[r+3]);} \
      float rm=__builtin_fmaxf(a,b); { auto rr=__builtin_amdgcn_permlane32_swap(__float_as_uint(rm),__float_as_uint(rm),false,false); rm=__builtin_fmaxf(__uint_as_float(rr[0]),__uint_as_float(rr[1])); } \
      resc=false; \
      if(__builtin_expect(__any(rm>(float)THRL),0)){ const float dl=__builtin_fmaxf(rm,0.f); mhat+=dl; \
        _Pragma("unroll") for(int r=0;r<16;++r){C0[r]-=dl;C1[r]-=dl;} \
        _Pragma("unroll") for(int r=0;r<16;++r)negm[r]=-mhat; asm volatile("":"+v"(negm)); \
        const float f=__builtin_amdgcn_exp2f(-dl); l_reg*=f; if(hi==0)wsf[r32]=f; resc=true; } } \
    SBAR(); \
    GAPB(1,2, 0,0,0, C0,0); \
    GAPB(1,3, 0,1,1, C0,2); \
    GAPB(1,4, 0,2,2, C0,4); \
    GAPB(1,5, 0,3,3, C0,6); \
    KRD(GL,0); GAPB(1,6, 1,0,4, C0,8); \
    GAPB(1,7, 1,1,5, C0,10); \
    KRD(GL,1); GAPB(1,8, 1,2,6, C0,12); \
    GAPB(1,9, 1,3,7, C0,14); \
    KRD(GL,2); GAPB(1,10, 2,0,8, C1,0); \
    GAPB(1,11, 2,1,9, C1,2); \
    KRD(GL,3); GAPB(1,12, 2,2,10, C1,4); \
    GAPB(1,13, 2,3,11, C1,6); \
    GAPB(1,14, 3,0,12, C1,8); \
    GAPB(1,15, 3,1,13, C1,10); \
    GAPB(0,0, 3,2,14, C1,12); \
    GAPB(0,0, 3,3,15, C1,14); \
    }while(0)
  #define WBS() do{ if constexpr(DUAL){WAIT_BAR(4);}else{WAIT_BAR(3);} }while(0)
  if(!DUAL && wid>=4) __builtin_amdgcn_s_setprio(1);
  int t=1;
  #undef CMASK
  #define CMASK(P0,P1,t) do{}while(0)
  for(;t+5<NT;t+=2){
    STEP(pB0,pB1,pA0,pA1,t,true,true,true);     WBS(); RESC(); ROT();
    STEP(pA0,pA1,pB0,pB1,t+1,true,true,true);   WBS(); RESC(); ROT();
  }
  #undef CMASK
  #define CMASK(P0,P1,t) do{ if(MASKED){ const int jb_=(t)-(NT-4); if(jb_>=vis){ _Pragma("unroll") for(int r_=0;r_<16;++r_){P0[r_]=-INFINITY;P1[r_]=-INFINITY;} } } }while(0)
  #define ENDW(tt) do{ if((tt)+3<NT){WBS();} else if((tt)+2<NT){WAIT_BAR(2);} else {WAIT_BAR(0);} }while(0)
  for(;t+1<NT;t+=2){
    STEP(pB0,pB1,pA0,pA1,t,(t+3<NT),(t+1<NT),(t+1<NT));       ENDW(t);   RESC(); ROT();
    STEP(pA0,pA1,pB0,pB1,t+1,(t+4<NT),(t+2<NT),(t+2<NT));     ENDW(t+1); RESC(); ROT();
  }
  { float sacc=pA0[0]+pA0[1]; _Pragma("unroll") for(int r=2;r<16;++r)sacc+=pA0[r]; _Pragma("unroll") for(int r=0;r<16;++r)sacc+=pA1[r]; l_reg+=sacc;
    pw0=(u32x4){PKW(pA0,0),PKW(pA0,2),PKW(pA0,4),PKW(pA0,6)};pw1=(u32x4){PKW(pA0,8),PKW(pA0,10),PKW(pA0,12),PKW(pA0,14)};pw2=(u32x4){PKW(pA1,0),PKW(pA1,2),PKW(pA1,4),PKW(pA1,6)};pw3=(u32x4){PKW(pA1,8),PKW(pA1,10),PKW(pA1,12),PKW(pA1,14)};
    SBAR(); pv4(o,vb0+2*sl_prev,PAF(0),PAF(1),PAF(2),PAF(3)); }
  #undef PKW
  #undef PAF
  #undef VFW
  #undef PIN
  #undef MX3
  #undef GAPA
  #undef GAPB
  #undef EX
  #undef VRW
  #undef VREQ
  #undef FJ
  #undef KRD
  #undef STEP
  #undef ENDW
  #undef WBS
  __builtin_amdgcn_s_setprio(0);
  {auto rr=__builtin_amdgcn_permlane32_swap(__float_as_uint(l_reg),__float_as_uint(l_reg),false,false);l_reg=__uint_as_float(rr[0])+__uint_as_float(rr[1]);}
  if(hi==0)wsf[32+r32]=l_reg;asm volatile("s_waitcnt lgkmcnt(0)":::"memory");
  float rli[16];
  #pragma unroll
  for(int r=0;r<16;++r)rli[r]=__builtin_amdgcn_rcpf(wsf[32+crow(r,hi)]);
  bf16*Ow=Oin+cmap*128+(long)((DUAL?(wid&1):wid)*QBLK)*OPITCH;
  bf16*stg=(bf16*)(shm+LOST)+(DUAL?(wid&3):wid)*2048;
  if(do_store){
  u32x4 o2v[2][4];
  #pragma unroll
  for(int hf=0;hf<2;++hf){
    #pragma unroll
    for(int r=0;r<16;++r){const int orow=crow(r,hi);
      #pragma unroll
      for(int d0=0;d0<2;++d0)stg[orow*64+d0*32+r32]=__float2bfloat16(o[2*hf+d0][r]*rli[r]);}
    asm volatile("s_waitcnt lgkmcnt(0)":::"memory");
    #pragma unroll
    for(int i=0;i<4;++i){const int row=i*8+(lane>>3),ch=lane&7; const u32x4 v=*(const u32x4*)(stg+row*64+ch*8);
      if constexpr(FIN){ o2v[hf][i]=v; } else { ATTN_STORE16(Ow+(long)row*OPITCH+hf*64+ch*8,v); } }
    asm volatile("s_waitcnt lgkmcnt(0)":::"memory");
  }
  if constexpr(FIN){
    asm volatile("s_waitcnt vmcnt(0)":::"memory");
    ArgsP ka=KARG(); unsigned char*wsb=ka->ws;
    const bf16*fO1=(const bf16*)(wsb+WS_OP)+(size_t)fin.qrow*2048+(size_t)(fin.h*2)*128; const bf16*fZA=(const bf16*)(wsb+WS_ZA)+(size_t)fin.qrow*1024+fin.h*128;
    const float*fsw=ka->in[I_SUBLN]+fin.l*128; bf16*fOX=(bf16*)(wsb+WS_OX)+(size_t)fin.qrow*2048+1024+fin.h*128;
    const float flam=((const float*)(wsb+WS_MISC))[fin.l], foml=((const float*)(wsb+WS_MISC))[8+fin.l];
    const int ch=lane&7;
    #pragma unroll
    for(int i=0;i<4;++i){ const long grow=(long)(wid*QBLK+i*8+(lane>>3));
      float d[2][8]; float ss=0.f;
      #pragma unroll
      for(int hf=0;hf<2;++hf){ const u32x4 a=*(const u32x4*)(fO1+grow*OPITCH+hf*64+ch*8); const u32x4 b=o2v[hf][i];
        const unsigned aw[4]={a.x,a.y,a.z,a.w}, bw[4]={b.x,b.y,b.z,b.w};
        #pragma unroll
        for(int e=0;e<4;++e){ d[hf][2*e]=__uint_as_float(aw[e]<<16)-flam*__uint_as_float(bw[e]<<16); d[hf][2*e+1]=__uint_as_float(aw[e]&0xffff0000u)-flam*__uint_as_float(bw[e]&0xffff0000u); }
        #pragma unroll
        for(int e=0;e<8;++e)ss+=d[hf][e]*d[hf][e]; }
      ss+=__shfl_xor(ss,1); ss+=__shfl_xor(ss,2); ss+=__shfl_xor(ss,4);
      const float scale=rsqrtf(ss*(1.0f/128.0f)+1e-6f)*foml;
      #pragma unroll
      for(int hf=0;hf<2;++hf){ const u32x4 z=*(const u32x4*)(fZA+grow*DM+hf*64+ch*8); const float*swp=fsw+hf*64+ch*8;
        const unsigned zw[4]={z.x,z.y,z.z,z.w}; unsigned ow[4];
        #pragma unroll
        for(int e=0;e<4;++e){ const float v0=d[hf][2*e]*scale*swp[2*e]*__uint_as_float(zw[e]<<16), v1=d[hf][2*e+1]*scale*swp[2*e+1]*__uint_as_float(zw[e]&0xffff0000u); ow[e]=cvtpk_s(v0,v1); }
        ATTN_STORE16(fOX+grow*OPITCH+hf*64+ch*8,((u32x4){ow[0],ow[1],ow[2],ow[3]})); }
    }
  }
  }
  if constexpr(DUAL){ asm volatile("s_waitcnt vmcnt(0)":::"memory"); }
  asm volatile("s_waitcnt lgkmcnt(0)\n\ts_barrier":::"memory");
  #undef DMA_K
  #undef DMA_V
  #undef CMASK
  #undef START
  #undef RESC
  #undef ROT
}
#undef SBAR
#undef WAIT_BAR
}

#define GAS __attribute__((address_space(1)))
#define LAS __attribute__((address_space(3)))
typedef unsigned short bf16;
typedef unsigned v4u __attribute__((ext_vector_type(4)));
typedef float f32x4 __attribute__((ext_vector_type(4)));
typedef short bf16x8 __attribute__((ext_vector_type(8)));
typedef GAS unsigned gu32;
typedef GAS unsigned long long gu64;
#define RLX_AGENT __ATOMIC_RELAXED, __HIP_MEMORY_SCOPE_AGENT
#define LDS_WAIT() asm volatile("s_waitcnt lgkmcnt(0)" ::: "memory")
#define VM_WAIT() asm volatile("s_waitcnt vmcnt(0)" ::: "memory")
__device__ __forceinline__ unsigned long long rt() { return __builtin_amdgcn_s_memrealtime(); }
__device__ __forceinline__ unsigned f2bf(float f) { unsigned u = __builtin_bit_cast(unsigned, f); return (u + 0x7fffu + ((u >> 16) & 1u)) >> 16; }
__device__ __forceinline__ unsigned pk2(float lo, float hi) { return f2bf(lo) | (f2bf(hi) << 16); }

#define XB_TMO      128
#define XB_XCNT(j)  (256  + 64 * (j))
#define XB_XSUB(j)  (1280 + 64 * (j))
#define XB_XGEN(j)  (2304 + 64 * (j))
#define XB_TOP      3328
#define XB_TOPGEN   3392
#define XCD_BAR_WORDS 3456
#define XB_SPIN_CAP (1u << 18)

__device__ __forceinline__ unsigned xb_ld(unsigned* p)              { return __hip_atomic_load(p, __ATOMIC_RELAXED, __HIP_MEMORY_SCOPE_AGENT); }
__device__ __forceinline__ unsigned xb_add(unsigned* p, unsigned v) { return __hip_atomic_fetch_add(p, v, __ATOMIC_RELAXED, __HIP_MEMORY_SCOPE_AGENT); }
__device__ __forceinline__ unsigned xb_xcc_id() { return (unsigned)__builtin_amdgcn_s_getreg((3 << 11) | 20) & 0xFu; }
#define XB_SPIN(cond, bar) do { unsigned _sp = 0; while (cond) { __builtin_amdgcn_s_sleep(1); \
    if ((++_sp & 255u) == 0u) { if (xb_ld(&(bar)[XB_TMO])) break; if (_sp > XB_SPIN_CAP) { atomicAdd(&(bar)[XB_TMO], 1u); break; } } } } while (0)

struct XcdBarrier {
    unsigned* bar; unsigned x;
    volatile LAS unsigned* st;
};

__device__ __forceinline__ XcdBarrier xcd_barrier_post(unsigned* bar, volatile LAS unsigned* st) {
    XcdBarrier b; b.bar = bar; b.x = xb_xcc_id(); b.st = st;
    if (threadIdx.x == 0) (void)xb_add(&bar[XB_XCNT(b.x)], 1u);
    return b;
}
__device__ __forceinline__ void xcd_barrier_complete(unsigned* bar, unsigned x, unsigned& nloc, unsigned& nx) {
    const unsigned G = gridDim.x * gridDim.y * gridDim.z;
    unsigned sum, cnt, mine, sp = 0u;
    for (;;) {
        sum = 0u; cnt = 0u; mine = 0u;
#pragma unroll
        for (unsigned j = 0; j < 16; ++j) { const unsigned c = xb_ld(&bar[XB_XCNT(j)]); sum += c; cnt += (c > 0u) ? 1u : 0u; mine = (j == x) ? c : mine; }
        if (sum == G) break;
        __builtin_amdgcn_s_sleep(1);
        if ((++sp & 255u) == 0u) { if (xb_ld(&bar[XB_TMO])) break; if (sp > XB_SPIN_CAP) { atomicAdd(&bar[XB_TMO], 1u); break; } }
    }
    nloc = mine > 0u ? mine : 1u; nx = cnt > 0u ? cnt : 1u;
}

__device__ __forceinline__ void xcd_barrier(const XcdBarrier& b) {
    asm volatile("s_waitcnt vmcnt(0)" ::: "memory");
    __syncthreads();
    if (threadIdx.x == 0) {
        unsigned* bar = b.bar;
        __builtin_amdgcn_s_waitcnt(0);
        unsigned nloc = b.st[0], nx = b.st[1];
        if (nloc == 0u) { xcd_barrier_complete(bar, b.x, nloc, nx); b.st[0] = nloc; b.st[1] = nx; }
        const unsigned old = xb_add(&bar[XB_XSUB(b.x)], 1u);
        const unsigned gen = old / nloc;
        if (old + 1u == (gen + 1u) * nloc) {
            __builtin_amdgcn_fence(__ATOMIC_RELEASE, "agent");
            asm volatile("s_waitcnt vmcnt(0)" ::: "memory");
            const unsigned og = xb_add(&bar[XB_TOP], 1u);
            const unsigned tg = og / nx;
            if (og + 1u == (tg + 1u) * nx) xb_add(&bar[XB_TOPGEN], 1u);
            else XB_SPIN(xb_ld(&bar[XB_TOPGEN]) == tg, bar);
            __builtin_amdgcn_fence(__ATOMIC_ACQUIRE, "agent");
            xb_add(&bar[XB_XGEN(b.x)], 1u);
            asm volatile("s_waitcnt vmcnt(0)" ::: "memory");
        } else {
            XB_SPIN(xb_ld(&bar[XB_XGEN(b.x)]) == gen, bar);
            __builtin_amdgcn_fence(__ATOMIC_ACQUIRE, "agent");
            asm volatile("s_waitcnt vmcnt(0)" ::: "memory");
        }
    }
    __syncthreads();
}

constexpr int NWAVES = 8;
constexpr int RING_OFF = 0, RING_BYTES = 131072;
constexpr int LDSCTL_OFF = RING_BYTES, MISC_OFF = LDSCTL_OFF + 320;
constexpr int LDS_BYTES = 147456;
static_assert(MISC_OFF + 128 <= LDS_BYTES, "LDS map");
constexpr int N_PHASES = 2 + 4 * DEPTH;

__device__ __forceinline__ float wave_sum(float v) {
#pragma unroll
    for (int o = 1; o < 64; o <<= 1) v += __shfl_xor(v, o);
    return v;
}
__device__ __forceinline__ v4u pack8f(const f32x4 a, const f32x4 b) { v4u w; w.x = pk2(a[0], a[1]); w.y = pk2(a[2], a[3]); w.z = pk2(b[0], b[1]); w.w = pk2(b[2], b[3]); return w; }
__device__ __forceinline__ float bflo(unsigned w) { return __uint_as_float(w << 16); }
__device__ __forceinline__ float bfhi(unsigned w) { return __uint_as_float(w & 0xffff0000u); }

__host__ __device__ __forceinline__ int colmap_in(int np) {
    if (np >= 2048 && np < 4096) { const int g = np >> 6, j = np & 63, a = j >> 5, fq = (j >> 3) & 3, n = (j >> 2) & 1, e = j & 3; return (g << 6) + 32 * n + 16 * a + 4 * fq + e; }
    if (np >= 6144) { const int w = np - 6144, j8 = w >> 8, half = (w >> 7) & 1, cc = w & 127; return 6144 + half * 1024 + 128 * j8 + cc; }
    return np;
}
template <bool MAPPED>
__device__ __forceinline__ void p0_item(const float* W, int N, const float* kscale, bf16* WT, int ldk, int koff, LAS float* scr, int kb, int nb, int lane) {
    const int k0 = 64 * kb, n0 = 32 * nb; const int np = n0 + (lane & 31); const int src = MAPPED ? colmap_in(np) : np;
#pragma unroll
    for (int i = 0; i < 32; ++i) { const int kk = 2 * i + (lane >> 5); float v = W[(size_t)(k0 + kk) * N + src]; if (kscale) v *= kscale[k0 + kk]; scr[kk * 33 + (lane & 31)] = v; }
    LDS_WAIT(); asm volatile("" ::: "memory");
    const int c = lane & 7;
#pragma unroll
    for (int j = 0; j < 4; ++j) { const int n = (lane >> 3) + 8 * j; const LAS float* s = scr + (8 * c) * 33 + n;
        v4u o; o.x = pk2(s[0 * 33], s[1 * 33]); o.y = pk2(s[2 * 33], s[3 * 33]); o.z = pk2(s[4 * 33], s[5 * 33]); o.w = pk2(s[6 * 33], s[7 * 33]);
        *(GAS v4u*)(WT + (size_t)(n0 + n) * ldk + koff + k0 + 8 * c) = o; }
    LDS_WAIT(); asm volatile("" ::: "memory");
}

__device__ __forceinline__ void cache_convert(ArgsP args, int lc, int c_lo, int n_ch, int tid0, int nth) {
    unsigned char* ws = args->ws;
    bf16* KS = (bf16*)(ws + WS_KS) + (size_t)lc * NDB * KSROWS * D; bf16* VS = (bf16*)(ws + WS_VS) + (size_t)lc * NDB * KSROWS * D;
    const float* ck = args->in[I_CK] + (size_t)lc * NDB * PAST * D; const float* cv = args->in[I_CV] + (size_t)lc * NDB * PAST * D;
    for (int c0 = c_lo + tid0; c0 < c_lo + n_ch; c0 += 4 * nth) {
        f32x4 klo[4], khi[4], vlo[4], vhi[4];
#pragma unroll
        for (int u = 0; u < 4; ++u) { const int c = c0 + u * nth; if (c < c_lo + n_ch) { const int row = c >> 7, chn = c & 127;
            const int gq = chn >> 3, q8 = chn & 7, d0 = 16 * (q8 >> 2) + 4 * (q8 & 3); const float* s = ck + (size_t)row * D + 64 * gq + d0; const float* sv = cv + (size_t)row * D + 8 * chn;
            klo[u] = __builtin_nontemporal_load((const GAS f32x4*)s); khi[u] = __builtin_nontemporal_load((const GAS f32x4*)(s + 32)); vlo[u] = __builtin_nontemporal_load((const GAS f32x4*)sv); vhi[u] = __builtin_nontemporal_load((const GAS f32x4*)(sv + 4)); } }
#pragma unroll
        for (int u = 0; u < 4; ++u) { const int c = c0 + u * nth; if (c < c_lo + n_ch) { const int row = c >> 7, chn = c & 127; const size_t drow = ((size_t)(row >> 11) * KSROWS + (row & 2047)) * D;
            *(GAS v4u*)(KS + drow + 8 * chn) = pack8f(klo[u], khi[u]); *(GAS v4u*)(VS + drow + 8 * chn) = pack8f(vlo[u], vhi[u]); } }
    }
}

__device__ __forceinline__ void cache_convert_head(ArgsP args, int lc, int db, int h, int tid0, int nth) {
    unsigned char* ws = args->ws;
    bf16* KS = (bf16*)(ws + WS_KS) + (size_t)(lc * NDB + db) * KSROWS * D; bf16* VS = (bf16*)(ws + WS_VS) + (size_t)(lc * NDB + db) * KSROWS * D;
    const float* ck = args->in[I_CK] + (size_t)(lc * NDB + db) * PAST * D; const float* cv = args->in[I_CV] + (size_t)(lc * NDB + db) * PAST * D;
    constexpr int NCHK = PAST * 16;
    for (int c0 = tid0; c0 < NCHK; c0 += 4 * nth) {
        f32x4 klo[4], khi[4], vlo[4], vhi[4];
#pragma unroll
        for (int u = 0; u < 4; ++u) { const int c = c0 + u * nth; if (c < NCHK) { const int row = c >> 4, chn = h * 16 + (c & 15);
            const int gq = chn >> 3, q8 = chn & 7, d0 = 16 * (q8 >> 2) + 4 * (q8 & 3); const float* s = ck + (size_t)row * D + 64 * gq + d0; const float* sv = cv + (size_t)row * D + 8 * chn;
            klo[u] = __builtin_nontemporal_load((const GAS f32x4*)s); khi[u] = __builtin_nontemporal_load((const GAS f32x4*)(s + 32)); vlo[u] = __builtin_nontemporal_load((const GAS f32x4*)sv); vhi[u] = __builtin_nontemporal_load((const GAS f32x4*)(sv + 4)); } }
#pragma unroll
        for (int u = 0; u < 4; ++u) { const int c = c0 + u * nth; if (c < NCHK) { const int row = c >> 4, chn = h * 16 + (c & 15); const size_t drow = (size_t)row * D;
            *(GAS v4u*)(KS + drow + 8 * chn) = pack8f(klo[u], khi[u]); *(GAS v4u*)(VS + drow + 8 * chn) = pack8f(vlo[u], vhi[u]); } }
    }
}

__device__ __forceinline__ void p0_prologue(ArgsP args, LAS unsigned char* lds, int lane, int wave, int vcu, int G) {
    unsigned char* ws = args->ws;
    LAS float* scr = (LAS float*)(lds + RING_OFF + wave * 16384);
    const int gw = vcu * NWAVES + wave, NGW = G * NWAVES;
    constexpr int IT_L = 2048 + 256 + 256 + 256 + 64;
    typedef float f32x2_t __attribute__((ext_vector_type(2)));
    struct WItem { const float* src; const float* ksc; bf16* dst; int N, ldk; };
    auto decode = [&](int it) -> WItem {
        const int l = it / IT_L; int r = it % IT_L; unsigned char* wl = ws + WS_W + (size_t)l * W_LAYER;
        const float* W; const float* kscale = nullptr; bf16* WT; int N, ldk, koff = 0, kb, nb; bool mapped = false;
        if (r < 2048) { W = args->in[I_WIN] + (size_t)l * D * INC; N = INC; kscale = args->in[I_NW] + l * D; WT = (bf16*)(wl + W_IN); ldk = D; kb = r >> 7; nb = r & 127; mapped = true; }
        else if (r < 2048 + 256) { r -= 2048; W = args->in[I_WPR] + (size_t)l * D * D; N = D; WT = (bf16*)(wl + W_PROJ); ldk = 2 * D; kb = r >> 4; nb = r & 15; }
        else if (r < 2048 + 512) { r -= 2048 + 256; W = args->in[I_WPA] + (size_t)l * D * D; N = D; WT = (bf16*)(wl + W_PROJ); ldk = 2 * D; koff = D; kb = r >> 4; nb = r & 15; }
        else if (r < 2048 + 768) { r -= 2048 + 512; W = args->in[I_WOUT] + (size_t)l * D * D; N = D; WT = (bf16*)(wl + W_OUT); ldk = D; kb = r >> 4; nb = r & 15; }
        else { r -= 2048 + 768; const int gate = r >> 5, blk = (r >> 2) & 7; kb = (r >> 1) & 1; nb = r & 1;
            W = args->in[gate ? I_WIG : I_WRG] + (size_t)(l * 8 + blk) * 16384; N = 128; WT = (bf16*)(wl + W_G) + (size_t)(blk * 2 + gate) * 16384; ldk = 128; }
        const int k0 = 64 * kb, n0 = 64 * nb, np = n0 + 2 * (lane & 31), srcc = mapped ? colmap_in(np) : np;
        WItem w; w.src = W + (size_t)k0 * N + srcc; w.ksc = kscale ? kscale + k0 + 8 * (lane & 7) : nullptr; w.dst = WT + (size_t)n0 * ldk + koff + k0; w.N = N; w.ldk = ldk; return w; };
    auto wload = [&](const WItem& w, f32x2_t (&v)[32]) {
#pragma unroll
        for (int i = 0; i < 32; ++i) v[i] = *(const GAS f32x2_t*)(w.src + (size_t)(2 * i + (lane >> 5)) * w.N); };
    auto wstore = [&](const WItem& w, const f32x2_t (&v)[32]) {
        f32x4 ka = (f32x4){1.f, 1.f, 1.f, 1.f}, kb2 = ka;
        if (w.ksc) { ka = *(const GAS f32x4*)w.ksc; kb2 = *(const GAS f32x4*)(w.ksc + 4); }
#pragma unroll
        for (int par = 0; par < 2; ++par) {
#pragma unroll
            for (int i = 0; i < 32; ++i) scr[(2 * i + (lane >> 5)) * 33 + (lane & 31)] = v[i][par];
            LDS_WAIT(); asm volatile("" ::: "memory");
            const int c = lane & 7;
#pragma unroll
            for (int j = 0; j < 4; ++j) { const int n = (lane >> 3) + 8 * j; const LAS float* sp = scr + (8 * c) * 33 + n;
                v4u o; o.x = pk2(sp[0 * 33] * ka[0], sp[1 * 33] * ka[1]); o.y = pk2(sp[2 * 33] * ka[2], sp[3 * 33] * ka[3]); o.z = pk2(sp[4 * 33] * kb2[0], sp[5 * 33] * kb2[1]); o.w = pk2(sp[6 * 33] * kb2[2], sp[7 * 33] * kb2[3]);
                *(GAS v4u*)(w.dst + (size_t)(2 * n + par) * w.ldk + 8 * c) = o; }
            LDS_WAIT(); asm volatile("" ::: "memory"); } };
    for (int it = gw; it < DEPTH * IT_L; it += 2 * NGW) {
        const bool hb = it + NGW < DEPTH * IT_L;
        const WItem wa = decode(it), wb = decode(hb ? it + NGW : it);
        f32x2_t va[32], vb[32];
        wload(wa, va); wload(wb, vb);
        wstore(wa, va); if (hb) wstore(wb, vb);
    }
    { bf16* HB = (bf16*)(ws + WS_HB); float* SSQ = (float*)(ws + WS_SSQ);
      for (int row0 = gw; row0 < M; row0 += 4 * NGW) {
        f32x4 v[4][4]; float sv[4]; bool ok[4];
#pragma unroll
        for (int u = 0; u < 4; ++u) { const int row = row0 + u * NGW; ok[u] = row < M;
            const float* src = !ok[u] ? nullptr : row < ROW_S ? args->in[I_XP] + (size_t)row * D : row < ROW_M ? args->in[I_XS] + (size_t)(row - ROW_S) * D : (row - ROW_M) < NMETA ? args->in[I_META] + (size_t)(row - ROW_M) * D : nullptr;
#pragma unroll
            for (int j = 0; j < 4; ++j) v[u][j] = src ? ((const GAS f32x4*)src)[lane + 64 * j] : (f32x4){0.f, 0.f, 0.f, 0.f}; }
#pragma unroll
        for (int u = 0; u < 4; ++u) { float s = 0.f;
#pragma unroll
            for (int j = 0; j < 4; ++j) s += (v[u][j].x * v[u][j].x + v[u][j].y * v[u][j].y) + (v[u][j].z * v[u][j].z + v[u][j].w * v[u][j].w);
            sv[u] = wave_sum(s); }
#pragma unroll
        for (int u = 0; u < 4; ++u) if (ok[u]) { const int row = row0 + u * NGW;
#pragma unroll
            for (int j = 0; j < 4; ++j) ((GAS unsigned long long*)(HB + (size_t)row * D))[lane + 64 * j] = (unsigned long long)pk2(v[u][j].x, v[u][j].y) | ((unsigned long long)pk2(v[u][j].z, v[u][j].w) << 32);
            if (lane < 16) SSQ[(size_t)row * 16 + lane] = lane == 0 ? sv[u] : 0.f; }
      } }
    const int gtid = gw * 64 + lane, NTH = NGW * 64;
    { float* TC = (float*)(ws + WS_TCOS); float* TS = (float*)(ws + WS_TSIN);
      for (int idx = gtid; idx < TP * 32; idx += NTH) {
        const int pos = idx >> 5, i = idx & 31;
        double th = 1.0; for (int k = 0; k < i; ++k) th *= 0.74989420933245582730;
        const double t2 = th * th; double cb = 1.0, sb = th, tc = 1.0, tsn = th;
#pragma unroll 1
        for (int k = 1; k <= 11; ++k) { tc *= -t2 / (double)((2 * k - 1) * (2 * k)); tsn *= -t2 / (double)((2 * k) * (2 * k + 1)); cb += tc; sb += tsn; }
        double cr = 1.0, sr = 0.0;
#pragma unroll 1
        for (int bit = 0; bit < 13; ++bit) { if ((pos >> bit) & 1) { const double c2 = cr * cb - sr * sb, s2 = sr * cb + cr * sb; cr = c2; sr = s2; } const double c3 = cb * cb - sb * sb, s3 = 2.0 * cb * sb; cb = c3; sb = s3; }
        TC[idx] = (float)cr; TS[idx] = (float)sr;
      } }
    if (gw < DEPTH) { const int l = gw; const float s1 = wave_sum(args->in[I_LQ1][l * 64 + lane] * args->in[I_LK1][l * 64 + lane]), s2 = wave_sum(args->in[I_LQ2][l * 64 + lane] * args->in[I_LK2][l * 64 + lane]);
        if (lane == 0) { const float li = 0.8f - 0.6f * expf(-0.3f * (float)l); ((float*)(ws + WS_MISC))[l] = expf(s1) - expf(s2) + li; ((float*)(ws + WS_MISC))[8 + l] = 1.0f - li; } }
    { bf16* KP = (bf16*)(ws + WS_KP); bf16* VP = (bf16*)(ws + WS_VP);
      for (int c = gtid; c < NB * 48 * 128; c += NTH) { const int b = c / (48 * 128), rr = (c / 128) % 48, chn = c & 127; const size_t off = ((size_t)b * KPROWS + 16 + rr) * D + 8 * chn;
        *(GAS v4u*)(KP + off) = (v4u){0u, 0u, 0u, 0u}; *(GAS v4u*)(VP + off) = (v4u){0u, 0u, 0u, 0u}; } }
}

constexpr int RNN_XS = 0, RNN_XC = 36864, RNN_XA = 71680;
constexpr int CW_CNTA = 12288, CW_CNTB = 14336;
constexpr int CW_FLAG = 16384;
constexpr size_t MISC_CARRY = 131072;
#define RNN_BAR() do { asm volatile("s_waitcnt lgkmcnt(0)" ::: "memory"); __builtin_amdgcn_s_barrier(); asm volatile("" ::: "memory"); } while (0)
__device__ __forceinline__ void rnn_prefetch(ArgsP args, const bf16* XR, int l, int pmode, int seq, int n, size_t row0, int tid, v4u (&pf)[3]) {
#pragma unroll
    for (int k = 0; k < 3; ++k) { const int id = tid + k * NWAVES * 64, i = id >> 4, c8 = id & 15;
        if (id < 67 * 16) {
            if (i >= 3 || pmode == 0) pf[k] = *(const GAS v4u*)(XR + (row0 + i - 3) * D + 128 * n + 8 * c8);
            else if (pmode == 1) pf[k] = *(const GAS v4u*)(XR + ((size_t)ROW_M + 13 + i) * D + 128 * n + 8 * c8);
            else if (pmode == 2) { const float* sc = args->in[I_SC] + ((size_t)(l * NDB + seq) * 3 + i) * D + 128 * n + 8 * c8; pf[k] = pack8f(*(const GAS f32x4*)sc, *(const GAS f32x4*)(sc + 4)); }
            else pf[k] = (v4u){0u, 0u, 0u, 0u};
        } }
}
__device__ __forceinline__ void rnn_prefetch0(const bf16* XR, int n, size_t row0, int tid, v4u (&pf)[3]) {
#pragma unroll
    for (int k = 0; k < 3; ++k) { const int id = tid + k * NWAVES * 64, i = id >> 4, c8 = id & 15;
        const size_t row = (id < 67 * 16) ? row0 + i - 3 : row0;
        pf[k] = *(const GAS v4u*)(XR + row * D + 128 * n + 8 * c8); }
}
__device__ __forceinline__ void rnn_unit(ArgsP args, int l, int kind, int seq, int n, int g, LAS unsigned char* lds, int tid, int lane, int wid) {
    unsigned char* ws = args->ws;
    LAS float* XS = (LAS float*)(lds + RNN_XS); LAS float* XC = (LAS float*)(lds + RNN_XC); LAS bf16* XA = (LAS bf16*)(lds + RNN_XA);
    const bf16* XR = (const bf16*)(ws + WS_XR); const bf16* ZR = (const bf16*)(ws + WS_ZR); bf16* OX = (bf16*)(ws + WS_OX);
    const int q = lane >> 4, cl = lane & 15, cc = 16 * wid + cl, ch = 128 * n + cc;
    const float brg = args->in[I_BRG][l * D + ch], big = args->in[I_BIG][l * D + ch];
    float sp; { const float x = -args->in[I_LAM][l * D + ch]; sp = fmaxf(x, 0.f) + log1pf(__expf(-fabsf(x))); }
    const int c2 = tid & 127, rg = tid >> 7, chc = 128 * n + c2;
    const float cw0 = args->in[I_CW][(l * 4 + 0) * D + chc], cw1 = args->in[I_CW][(l * 4 + 1) * D + chc], cw2 = args->in[I_CW][(l * 4 + 2) * D + chc], cw3 = args->in[I_CW][(l * 4 + 3) * D + chc], cb = args->in[I_CB][l * D + chc];
    const bf16* wg = (const bf16*)(ws + WS_W + (size_t)l * W_LAYER + W_G) + (size_t)(n * 2) * 16384;
    bf16x8 Br[4], Bi[4];
#pragma unroll
    for (int ks = 0; ks < 4; ++ks) { Br[ks] = *(const bf16x8*)(wg + (size_t)cc * 128 + 32 * ks + 8 * q); Bi[ks] = *(const bf16x8*)(wg + 16384 + (size_t)cc * 128 + 32 * ks + 8 * q); }
    const int ntiles = kind == 0 ? 16 : 1;
    const int jstart = (kind == 0 && g == 0) ? -1 : 0;
    const size_t rowbase = kind == 0 ? (size_t)seq * SEQ + (size_t)g * 1024 : kind == 1 ? (size_t)ROW_S + (size_t)seq * DSQ : (size_t)ROW_M;
    float* carry = (float*)(ws + WS_MISC + MISC_CARRY) + (size_t)((((l * NB + seq) * 8 + n) * 4) + g) * 128;
    gu32* flag = (gu32*)(ws + WS_CTL) + CW_FLAG + 64 * ((((l * NB + seq) * 8 + n) * 4) + g);
    float hrun = 0.f;
    if (kind == 1) hrun = args->in[I_SR][(size_t)(l * NDB + seq) * D + ch];
    v4u pf[3] = {{0u, 0u, 0u, 0u}, {0u, 0u, 0u, 0u}, {0u, 0u, 0u, 0u}};
    rnn_prefetch(args, XR, l, jstart < 0 ? 3 : (kind == 0 ? 0 : kind == 1 ? 2 : 3), seq, n, jstart < 0 ? (size_t)ROW_M : rowbase, tid, pf);
    if (kind == 0 && g > 0) {
        if (tid == 0) { unsigned spn = 0u; while (__hip_atomic_load(flag - 64, RLX_AGENT) == 0u) { __builtin_amdgcn_s_sleep(2); if (++spn > (1u << 22)) { __hip_atomic_store((gu32*)(ws + WS_CTL) + CW_TMO, 0xC0DEu, RLX_AGENT); break; } }
            __builtin_amdgcn_fence(__ATOMIC_ACQUIRE, "agent"); asm volatile("s_waitcnt vmcnt(0)" ::: "memory"); }
        __syncthreads();
        hrun = __hip_atomic_load(carry - 128 + cc, RLX_AGENT);
    }
    for (int j = jstart; j < ntiles; ++j) {
        const bool pre = j < 0;
        const size_t row0 = pre ? (size_t)ROW_M : rowbase + 64 * j;
        const int nvalid = (pre || kind == 2) ? NMETA : 64;
#pragma unroll
        for (int k = 0; k < 3; ++k) { const int id = tid + k * NWAVES * 64, i = id >> 4, c8 = id & 15;
            if (id < 67 * 16) { const v4u w = pf[k];
                *(LAS f32x4*)(XS + i * 132 + 8 * c8) = (f32x4){bflo(w.x), bfhi(w.x), bflo(w.y), bfhi(w.y)}; *(LAS f32x4*)(XS + i * 132 + 8 * c8 + 4) = (f32x4){bflo(w.z), bfhi(w.z), bflo(w.w), bfhi(w.w)}; } }
        if (j + 1 < ntiles) { if (pre) rnn_prefetch(args, XR, l, 1, seq, n, rowbase + 64 * (j + 1), tid, pf); else rnn_prefetch0(XR, n, rowbase + 64 * (j + 1), tid, pf); }
        v4u zf[2] = {{0u, 0u, 0u, 0u}, {0u, 0u, 0u, 0u}};
        if (!pre) {
#pragma unroll
            for (int k = 0; k < 2; ++k) { const int id = tid + k * NWAVES * 64, r = id >> 4, c8 = id & 15; zf[k] = *(const GAS v4u*)(ZR + (row0 + r) * D + 128 * n + 8 * c8); } }
        RNN_BAR();
        { const int rb = 16 * rg; float x0 = XS[(rb + 0) * 132 + c2], x1 = XS[(rb + 1) * 132 + c2], x2 = XS[(rb + 2) * 132 + c2];
#pragma unroll
          for (int r = 0; r < 16; ++r) { const float x3 = XS[(rb + r + 3) * 132 + c2]; const float xc = (((cb + x0 * cw0) + x1 * cw1) + x2 * cw2) + x3 * cw3;
              XC[(rb + r) * 132 + c2] = xc; XA[(rb + r) * 136 + c2] = (bf16)f2bf(xc); x0 = x1; x1 = x2; x2 = x3; } }
        RNN_BAR();
#pragma unroll
        for (int mt = 0; mt < 4; ++mt) {
            f32x4 ar = {0.f, 0.f, 0.f, 0.f}, ai = {0.f, 0.f, 0.f, 0.f};
#pragma unroll
            for (int ks = 0; ks < 4; ++ks) { const bf16x8 A = *(const LAS bf16x8*)(XA + (16 * mt + cl) * 136 + 32 * ks + 8 * q);
                ar = __builtin_amdgcn_mfma_f32_16x16x32_bf16(A, Br[ks], ar, 0, 0, 0); ai = __builtin_amdgcn_mfma_f32_16x16x32_bf16(A, Bi[ks], ai, 0, 0, 0); }
            float a[4], b[4];
#pragma unroll
            for (int i = 0; i < 4; ++i) { const int r = 16 * mt + 4 * q + i; const float xc = XC[r * 132 + cc];
                const float rr = __builtin_amdgcn_rcpf(1.0f + __expf(-(ar[i] + brg))), ii = __builtin_amdgcn_rcpf(1.0f + __expf(-(ai[i] + big)));
                const float av = __expf(-8.0f * rr * sp); a[i] = av; b[i] = __builtin_amdgcn_sqrtf(fmaxf((1.0f - av) * (1.0f + av), 0.f)) * ii * xc;
                if (r >= nvalid) { a[i] = 1.f; b[i] = 0.f; } }
            const float A4 = (a[0] * a[1]) * (a[2] * a[3]), B4 = ((b[0] * a[1] + b[1]) * a[2] + b[2]) * a[3] + b[3];
            float Ai = A4, Bi2 = B4;
            { const float ua = __shfl_up(Ai, 16), ub = __shfl_up(Bi2, 16); if (q >= 1) { Bi2 = Ai * ub + Bi2; Ai = ua * Ai; } }
            { const float ua = __shfl_up(Ai, 32), ub = __shfl_up(Bi2, 32); if (q >= 2) { Bi2 = Ai * ub + Bi2; Ai = ua * Ai; } }
            float Ae = __shfl_up(Ai, 16), Be = __shfl_up(Bi2, 16); if (q == 0) { Ae = 1.f; Be = 0.f; }
            const float At = __shfl(Ai, 48 + cl), Bt = __shfl(Bi2, 48 + cl);
            float h = Ae * hrun + Be;
#pragma unroll
            for (int i = 0; i < 4; ++i) { h = a[i] * h + b[i]; XC[(16 * mt + 4 * q + i) * 132 + cc] = h; }
            hrun = At * hrun + Bt;
        }
        RNN_BAR();
        if (!pre) {
#pragma unroll
            for (int k = 0; k < 2; ++k) { const int id = tid + k * NWAVES * 64, r = id >> 4, c8 = id & 15;
                const f32x4 h0 = *(const LAS f32x4*)(XC + r * 132 + 8 * c8), h1 = *(const LAS f32x4*)(XC + r * 132 + 8 * c8 + 4);
                const v4u z = zf[k];
                const f32x4 o0 = h0 * (f32x4){bflo(z.x), bfhi(z.x), bflo(z.y), bfhi(z.y)}, o1 = h1 * (f32x4){bflo(z.z), bfhi(z.z), bflo(z.w), bfhi(z.w)};
                *(GAS v4u*)(OX + (row0 + r) * 2 * D + 128 * n + 8 * c8) = pack8f(o0, o1); }
        }
    }
    const bool publish = (kind == 0 && g < 3);
    if (q == 0) {
        if (kind == 0 && g == 3) args->out[O_RP + (size_t)(l * NB + seq) * D + ch] = hrun;
        if (kind == 1) args->out[O_RS + (size_t)(l * NDB + seq) * D + ch] = hrun;
        if (publish) __hip_atomic_store(carry + cc, hrun, RLX_AGENT);
    }
    if (publish) asm volatile("s_waitcnt vmcnt(0)" ::: "memory");
    RNN_BAR();
    if (publish && tid == 0) __hip_atomic_store(flag, 1u, RLX_AGENT);
}
__device__ __forceinline__ void attn_finish(ArgsP args, int l, size_t row0, int h, int nw, int lane, int wid) {
    if (wid >= nw) return;
    unsigned char* ws = args->ws;
    asm volatile("s_waitcnt vmcnt(0)" ::: "memory");
    const float lam = ((const float*)(ws + WS_MISC))[l], oml = ((const float*)(ws + WS_MISC))[8 + l];
    int ln = lane; asm volatile("" : "+v"(ln));
    const int r = ln >> 1, half = ln & 1; const size_t row = row0 + 32 * wid + r;
    const bf16* p1 = (const bf16*)(ws + WS_OP) + row * 2048 + (size_t)(h * 2) * 128 + half * 64; const bf16* p2 = p1 + 128;
    float d[64]; float ss = 0.f;
#pragma unroll
    for (int k = 0; k < 8; ++k) { const v4u a = *(const GAS v4u*)(p1 + 8 * k), b = *(const GAS v4u*)(p2 + 8 * k);
        d[8 * k + 0] = bflo(a.x) - lam * bflo(b.x); d[8 * k + 1] = bfhi(a.x) - lam * bfhi(b.x); d[8 * k + 2] = bflo(a.y) - lam * bflo(b.y); d[8 * k + 3] = bfhi(a.y) - lam * bfhi(b.y);
        d[8 * k + 4] = bflo(a.z) - lam * bflo(b.z); d[8 * k + 5] = bfhi(a.z) - lam * bfhi(b.z); d[8 * k + 6] = bflo(a.w) - lam * bflo(b.w); d[8 * k + 7] = bfhi(a.w) - lam * bfhi(b.w);
#pragma unroll
        for (int e = 0; e < 8; ++e) ss += d[8 * k + e] * d[8 * k + e]; }
    ss += __shfl_xor(ss, 1);
    const float scale = rsqrtf(ss * (1.0f / 128.0f) + EPS) * oml;
    const bf16* za = (const bf16*)(ws + WS_ZA) + row * D + h * 128 + half * 64; const float* sw = args->in[I_SUBLN] + l * 128 + half * 64;
    bf16* od = (bf16*)(ws + WS_OX) + row * 2 * D + D + h * 128 + half * 64;
#pragma unroll
    for (int k = 0; k < 8; ++k) { const v4u z = *(const GAS v4u*)(za + 8 * k); const f32x4 w0 = *(const GAS f32x4*)(sw + 8 * k), w1 = *(const GAS f32x4*)(sw + 8 * k + 4);
        f32x4 o0, o1;
        o0[0] = d[8 * k + 0] * scale * w0[0] * bflo(z.x); o0[1] = d[8 * k + 1] * scale * w0[1] * bfhi(z.x); o0[2] = d[8 * k + 2] * scale * w0[2] * bflo(z.y); o0[3] = d[8 * k + 3] * scale * w0[3] * bfhi(z.y);
        o1[0] = d[8 * k + 4] * scale * w1[0] * bflo(z.z); o1[1] = d[8 * k + 5] * scale * w1[1] * bfhi(z.z); o1[2] = d[8 * k + 6] * scale * w1[2] * bflo(z.w); o1[3] = d[8 * k + 7] * scale * w1[3] * bfhi(z.w);
        *(GAS v4u*)(od + 8 * k) = pack8f(o0, o1); }
}
__device__ __forceinline__ void attn_super(ArgsP args, int l, int kind, int a, int h, int qb, char* shm, int lane, int wid) {
    typedef attn_body::bf16 abf;
    unsigned char* ws = args->ws;
    const abf* Q = (const abf*)(ws + WS_Q); abf* OP = (abf*)(ws + WS_OP);
    size_t qrow; const abf* Kb; const abf* Vb; int NT, vis, qwaves;
    if (kind == 0)      { qrow = (size_t)a * SEQ + (size_t)qb * 256; Kb = (const abf*)(ws + WS_KP) + (size_t)a * KPROWS * D; Vb = (const abf*)(ws + WS_VP) + (size_t)a * KPROWS * D; NT = 4 * qb + 5; vis = (wid >> 1) + 1; qwaves = 8; }
    else if (kind == 1) { qrow = (size_t)ROW_S + (size_t)a * DSQ; Kb = (const abf*)(ws + WS_KS) + (size_t)(l * NDB + a) * KSROWS * D; Vb = (const abf*)(ws + WS_VS) + (size_t)(l * NDB + a) * KSROWS * D; NT = 33; vis = 4; qwaves = 2; }
    else                { qrow = (size_t)ROW_M; Kb = (const abf*)(ws + WS_KP); Vb = (const abf*)(ws + WS_VP); NT = 5; vis = 0; qwaves = 8; }
    const attn128::Fin nofin{0, 0, 0u};
    if (kind == 1) {
        attn128::attn_unit128<8, false, true, false>(Q + qrow * D + (h * 2) * 64, Kb + (h * 2) * 64, Vb + h * 128, OP + qrow * 2048 + (h * 2) * 128, NT, vis, qwaves, shm, nofin);
        attn_finish(args, l, qrow, h, qwaves, lane, wid);
    } else {
        attn128::attn_unit128<8, true, false, false>(Q + qrow * D + (h * 2) * 64, Kb + (h * 2) * 64, Vb + h * 128, OP + qrow * 2048 + (h * 2) * 128, NT, vis, qwaves, shm, nofin);
        const attn128::Fin fin{l, h, (unsigned)qrow};
        attn128::attn_unit128<8, true, false, true>(Q + qrow * D + (h * 2 + 1) * 64, Kb + (h * 2 + 1) * 64, Vb + h * 128, OP + qrow * 2048 + (h * 2 + 1) * 128, NT, vis, qwaves, shm, fin);
    }
}

__global__ void __launch_bounds__(NWAVES * 64, 2) hawk_fwd(Args args) {
    extern __shared__ __attribute__((aligned(16))) unsigned char lds_raw[];
    LAS unsigned char* lds = (LAS unsigned char*)lds_raw;
    volatile LAS unsigned* MISC = (volatile LAS unsigned*)(lds + MISC_OFF);
    const int tid = threadIdx.x;
    const int G = gridDim.x; const int bx = blockIdx.x; const int vcu = (G % 8 == 0) ? (bx % 8) * (G / 8) + bx / 8 : bx;
    for (int u = tid; u < (LDS_BYTES - LDSCTL_OFF) / 4; u += NWAVES * 64) ((LAS unsigned*)(lds + LDSCTL_OFF))[u] = 0u;
    __syncthreads();
#if MK_PER_PHASE
#define GRID_BAR() do { if (tid == 0) __hip_atomic_store((gu32*)(KARG()->ws + WS_CTL) + CW_TMO, 0xBADBA0u, RLX_AGENT); } while (0)
#else
    (void)xcd_barrier_post((unsigned*)((gu32*)(KARG()->ws + WS_CTL) + CW_BAR), MISC + 8);
#define GRID_BAR() do { XcdBarrier bar_; bar_.bar = (unsigned*)((gu32*)(KARG()->ws + WS_CTL) + CW_BAR); bar_.x = xb_xcc_id(); bar_.st = MISC + 8; xcd_barrier(bar_); } while (0)
#endif
    const int lo = KARG()->ph_lo, hi = KARG()->ph_hi;
#if MK_PROBE
#define TACC() ((unsigned long long*)(KARG()->ws + WS_MISC + 32768))
    if (blockIdx.x == 0 && tid == 0) { unsigned long long* ta = TACC(); for (int k = 0; k < 16; ++k) ta[k] = 0ull; ta[16] = __builtin_amdgcn_s_memrealtime(); }
#define TMARK(k) do { if (blockIdx.x == 0 && tid == 0) { unsigned long long* ta = TACC(); const unsigned long long now = __builtin_amdgcn_s_memrealtime(); ta[k] += now - ta[16]; ta[16] = now; } } while (0)
#else
#define TMARK(k) do {} while (0)
#endif
#define IN(k) (lo <= (k) && (k) < hi)
#ifndef PHMASK
#define PHMASK 0xff
#endif
#define PH(b) ((PHMASK >> (b)) & 1)
#define BOTH(k) (IN(k) && IN((k) + 1))
    typedef pg8::bf16_t pb;
    for (int rep_ = 0; rep_ < MK_REP_P0; ++rep_)
    if (PH(0) && IN(0)) { int tid_l = tid; asm volatile("" : "+v"(tid_l)); p0_prologue(KARG(), lds, tid_l & 63, __builtin_amdgcn_readfirstlane(tid_l >> 6), vcu, G); if (BOTH(0) || rep_ + 1 < MK_REP_P0) GRID_BAR(); TMARK(0); }

    for (int l = 0; l < DEPTH; ++l) {
        const int pbase = 1 + 4 * l;
        for (int rep_ = 0; rep_ < MK_REP_P1; ++rep_)
        if (PH(1) && IN(pbase)) {
            ArgsP args = KARG(); unsigned char* ws = args->ws; unsigned char* wl = ws + WS_W + (size_t)l * W_LAYER;
            pg8::Gemm g{(const pb*)(ws + WS_HB), (const pb*)(wl + W_IN), D, D, 0};
#if MK_KPROBE
            pg8::TwoPartOrder S; S.init(M, INC, G, bx);
#else
            pg8::StaticOrder S; S.init(M, INC, G, bx);
#endif
            pg8::EpiIn E{l, ws, args->out};
#if MK_STAGGER
            if ((blockIdx.x >> 3) & 1) { __builtin_amdgcn_s_sleep(127); __builtin_amdgcn_s_sleep(127); __builtin_amdgcn_s_sleep(127); __builtin_amdgcn_s_sleep(127); }
#endif
            #if MK_KPROBE
            pg8::gemm_phase<pg8::EpiIn, pg8::TwoPartOrder, true, true>(lds + RING_OFF, g, S, E);
#else
            pg8::gemm_phase<pg8::EpiIn, pg8::StaticOrder, MK_ALIGN_P1, true>(lds + RING_OFF, g, S, E);
#endif
            TMARK(7); if (BOTH(pbase) || rep_ + 1 < MK_REP_P1) GRID_BAR(); TMARK(1);
        }
        for (int rep_ = 0; rep_ < MK_REP_P3; ++rep_)
        if ((PH(3) || PH(4)) && IN(pbase + 1)) {
            const int xcd0 = (int)(xb_xcc_id() & 7u);
            for (int probe = 0; probe < 8; ++probe) {
              const int qx = (xcd0 + probe) & 7;
              if (probe == 1) {
                  int tid_c = tid; asm volatile("" : "+v"(tid_c));
                  if (tid_c < 64) { unsigned hv = 216u; if (tid_c < 8) hv = __hip_atomic_load((gu32*)(KARG()->ws + WS_CTL) + CW_QUEUE + 64 * ((l + 4 * rep_) * 8 + ((xcd0 + tid_c) & 7)), RLX_AGENT);
                      const unsigned long long lm = __ballot(hv < 216u); if (tid_c == 0) MISC[1] = (unsigned)lm; }
                  __syncthreads();
              }
              if (probe >= 1 && !((MISC[1] >> probe) & 1u)) continue;
              for (;;) {
                ArgsP args = KARG();
                int tid_l = tid; asm volatile("" : "+v"(tid_l)); const int lane_l = tid_l & 63, wave_l = __builtin_amdgcn_readfirstlane(tid_l >> 6);
                if (tid_l == 0) MISC[0] = __hip_atomic_fetch_add((gu32*)(args->ws + WS_CTL) + CW_QUEUE + 64 * ((l + 4 * rep_) * 8 + qx), 1u, RLX_AGENT);
                __syncthreads();
                const int idx = (int)MISC[0];
                __syncthreads();
                if (idx >= 216) break;
                int sig = -1;
                if (idx < 8) rnn_unit(args, l, 0, qx, idx, 0, lds + RING_OFF, tid_l, lane_l, wave_l);
                else if (idx < 24) { const int db = 2 * qx + ((idx - 8) >> 3);
                    cache_convert_head(args, l, db, (idx - 8) & 7, tid_l, NWAVES * 64); asm volatile("s_waitcnt vmcnt(0)" ::: "memory"); __syncthreads();
                    attn_super(args, l, 1, db, (idx - 8) & 7, 0, (char*)lds_raw + RING_OFF, lane_l, wave_l); sig = db >> 2; }
                else if (idx == 24) { attn_super(args, l, 2, 0, qx, 0, (char*)lds_raw + RING_OFF, lane_l, wave_l); sig = 4; }
                else if (idx >= 32 && idx < 56) rnn_unit(args, l, 0, qx, (idx - 32) & 7, 1 + ((idx - 32) >> 3), lds + RING_OFF, tid_l, lane_l, wave_l);
                else if (idx >= 56 && idx < 72) { const int db = 2 * qx + ((idx - 56) >> 3); rnn_unit(args, l, 1, db, (idx - 56) & 7, 0, lds + RING_OFF, tid_l, lane_l, wave_l); sig = db >> 2; }
                else if (idx == 72) { rnn_unit(args, l, 2, 0, qx, 0, lds + RING_OFF, tid_l, lane_l, wave_l); sig = 4; }
                else if (idx >= 73 && idx < 89) { }
                else if ((idx >= 105 && idx < 108) || (idx >= 130 && idx < 133)) {
                    const bool isC = idx >= 130; const int k = isC ? idx - 130 : idx - 105;
                    if (k < 2 || qx < 4) {
                        const int panel = k < 2 ? (qx >> 1) : 4, pn = k < 2 ? 2 * (qx & 1) + k : qx, pm = 128 + panel;
                        gu32* cw = (gu32*)(args->ws + WS_CTL) + (isC ? CW_CNTB : CW_CNTA) + 64 * (l * 8 + panel);
                        const unsigned want = isC ? 4u : (panel < 4 ? 64u : 16u);
                        if (tid_l == 0) { unsigned spn = 0u; while (__hip_atomic_load(cw, RLX_AGENT) < want) { __builtin_amdgcn_s_sleep(4); if (++spn > (1u << 22)) { __hip_atomic_store((gu32*)(args->ws + WS_CTL) + CW_TMO, 0xC0DFu, RLX_AGENT); break; } }
                            __builtin_amdgcn_fence(__ATOMIC_ACQUIRE, "agent"); asm volatile("s_waitcnt vmcnt(0)" ::: "memory"); }
                        __syncthreads();
                        unsigned char* ws = args->ws; unsigned char* wl = ws + WS_W + (size_t)l * W_LAYER;
                        if (!isC) { pg8::Gemm g{(const pb*)(ws + WS_OX), (const pb*)(wl + W_PROJ), 2 * D, D, D}; pg8::OneUnit S{pm, pn, 2}; pg8::EpiProj E{ws};
                            pg8::gemm_phase<pg8::EpiProj, pg8::OneUnit, true, true>(lds + RING_OFF, g, S, E);
                            asm volatile("s_waitcnt vmcnt(0)" ::: "memory"); __syncthreads();
                            if (tid_l == 0) { __builtin_amdgcn_fence(__ATOMIC_RELEASE, "agent"); asm volatile("s_waitcnt vmcnt(0)" ::: "memory");     __hip_atomic_fetch_add((gu32*)(ws + WS_CTL) + CW_CNTB + 64 * (l * 8 + panel), 1u, RLX_AGENT); } }
                        else { pg8::Gemm g{(const pb*)(ws + WS_MB), (const pb*)(wl + W_OUT), D, D, 0}; pg8::OneUnit S{pm, pn, 1}; pg8::EpiOut E{ws};
                            pg8::gemm_phase<pg8::EpiOut, pg8::OneUnit, true, true>(lds + RING_OFF, g, S, E); }
                    }
                }
                else { const int i = idx < 32 ? idx - 25 : idx < 105 ? idx - 89 + 7 : idx < 130 ? idx - 108 + 23 : idx - 133 + 45, r = i & 31;
                    (void)r; attn_super(args, l, 0, qx, i & 7, 15 - (i >> 3), (char*)lds_raw + RING_OFF, lane_l, wave_l); }
                if (sig >= 0) { asm volatile("s_waitcnt vmcnt(0)" ::: "memory"); __syncthreads();
                    if (tid_l == 0) { __builtin_amdgcn_fence(__ATOMIC_RELEASE, "agent"); asm volatile("s_waitcnt vmcnt(0)" ::: "memory");     __hip_atomic_fetch_add((gu32*)(args->ws + WS_CTL) + CW_CNTA + 64 * (l * 8 + sig), 1u, RLX_AGENT); } }
              }
            }
            TMARK(8); if (BOTH(pbase + 1) || rep_ + 1 < MK_REP_P3) GRID_BAR(); TMARK(3);
        }
        for (int rep_ = 0; rep_ < MK_REP_P4; ++rep_)
        if (PH(5) && IN(pbase + 2)) {
            ArgsP args = KARG(); unsigned char* ws = args->ws; unsigned char* wl = ws + WS_W + (size_t)l * W_LAYER;
            pg8::Gemm g{(const pb*)(ws + WS_OX), (const pb*)(wl + W_PROJ), 2 * D, D, D}; pg8::TwoPartOrder S; S.init(MP, D, G, bx);
            pg8::EpiProj E{ws};
            pg8::gemm_phase<pg8::EpiProj, pg8::TwoPartOrder, true, true>(lds + RING_OFF, g, S, E);
            TMARK(9); if (BOTH(pbase + 2) || rep_ + 1 < MK_REP_P4) GRID_BAR(); TMARK(4);
        }
#define P5_BODY() do { ArgsP args = KARG(); unsigned char* ws = args->ws; unsigned char* wl = ws + WS_W + (size_t)l * W_LAYER; \
            pg8::Gemm g{(const pb*)(ws + WS_MB), (const pb*)(wl + W_OUT), D, D, 0}; pg8::StaticOrder S; S.init(MP, D, G, bx); \
            pg8::EpiOut E{ws}; \
            pg8::gemm_phase<pg8::EpiOut, pg8::StaticOrder, true, true>(lds + RING_OFF, g, S, E); } while (0)
        if (PH(6) && IN(pbase + 3)) {
#if MK_REP_P5 == 2
            P5_BODY(); GRID_BAR();
#endif
            P5_BODY();
            if (BOTH(pbase + 3)) GRID_BAR(); TMARK(5);
        }
    }
    if (PH(7) && IN(N_PHASES - 1)) {
        ArgsP args = KARG(); unsigned char* ws = args->ws;
        int tid_l = tid; asm volatile("" : "+v"(tid_l)); const int lane = tid_l & 63, wave = __builtin_amdgcn_readfirstlane(tid_l >> 6);
        const bf16* HB = (const bf16*)(ws + WS_HB); const float* fw = args->in[I_FNW];
        const int gw = vcu * NWAVES + wave, NGW = G * NWAVES;
        f32x4 w4[4];
#pragma unroll
        for (int j = 0; j < 4; ++j) w4[j] = ((const GAS f32x4*)fw)[lane + 64 * j];
        for (int row = gw; row < ROW_M; row += NGW) {
            f32x4 v[4]; float s = 0.f;
#pragma unroll
            for (int j = 0; j < 4; ++j) { const unsigned long long w = ((const GAS unsigned long long*)(HB + (size_t)row * D))[lane + 64 * j]; const unsigned lo = (unsigned)w, hi = (unsigned)(w >> 32);
                v[j] = (f32x4){bflo(lo), bfhi(lo), bflo(hi), bfhi(hi)}; s += (v[j].x * v[j].x + v[j].y * v[j].y) + (v[j].z * v[j].z + v[j].w * v[j].w); }
            const float rs = rsqrtf(wave_sum(s) * (1.0f / 1024.0f) + EPS);
            float* o = args->out + (row < ROW_S ? O_YP + (size_t)row * D : O_YS + (size_t)(row - ROW_S) * D);
#pragma unroll
            for (int j = 0; j < 4; ++j) ((GAS f32x4*)o)[lane + 64 * j] = v[j] * rs * w4[j];
        }
    }
#if MK_PROBE
    GRID_BAR(); TMARK(6);
    if (blockIdx.x == 0) {
        __syncthreads();
        const size_t offs[10] = {O_YP, O_YS, O_KP, O_VP, O_CP, O_RP, O_KS, O_VS, O_CS, O_RS};
#pragma unroll
        for (int k = 0; k < 10; ++k) { unsigned long long t = TACC()[k]; if (k == 1) t += TACC()[7]; if (k == 3) t += TACC()[8]; if (k == 4) t += TACC()[9];
            unsigned n = (unsigned)(t / 100ull); if (n > 30000u) n = 30000u;
            unsigned* o = (unsigned*)(KARG()->out + offs[k]); for (unsigned i = tid; i < n; i += NWAVES * 64) o[i] = 0xAAAAAAAAu; }
    }
#endif
#undef IN
#undef BOTH
}

extern "C" void kernel_launch(void* const* d_in, const int* in_sizes, int n_in, void* d_out, int out_size, void* d_ws, size_t ws_size, hipStream_t stream) {
    static int grid = 0;
    if (grid == 0) {
        if (n_in != 25 || (size_t)out_size != O_END || ws_size < WS_END) { fprintf(stderr, "kernel_launch: unexpected shapes (n_in %d, out %d, ws %zu); nothing launched\n", n_in, out_size, ws_size); grid = -1; return; }
        int dev = 0, cus = 0, per_cu = 0;
        if (hipGetDevice(&dev) != hipSuccess || hipDeviceGetAttribute(&cus, hipDeviceAttributeMultiprocessorCount, dev) != hipSuccess) { grid = -1; return; }
        if (hipFuncSetAttribute((const void*)hawk_fwd, hipFuncAttributeMaxDynamicSharedMemorySize, LDS_BYTES) != hipSuccess) { fprintf(stderr, "kernel_launch: hipFuncSetAttribute failed\n"); grid = -1; return; }
        if (hipOccupancyMaxActiveBlocksPerMultiprocessor(&per_cu, (const void*)hawk_fwd, NWAVES * 64, LDS_BYTES) != hipSuccess || per_cu < 1) { fprintf(stderr, "kernel_launch: occupancy query reports %d workgroups per CU\n", per_cu); }
        (void)hipGetLastError();
        grid = cus;
    }
    if (grid < 0) return;
    if (hipMemsetAsync((char*)d_ws + WS_CTL, 0, CTL_ZERO_BYTES, stream) != hipSuccess) return;
    Args a{};
    for (int i = 0; i < 25; ++i) a.in[i] = (const float*)d_in[i];
    a.out = (float*)d_out; a.ws = (unsigned char*)d_ws;
#if MK_PER_PHASE
    for (int p = 0; p < N_PHASES; ++p) { a.ph_lo = p; a.ph_hi = p + 1; a.li = p; hipLaunchKernelGGL(hawk_fwd, dim3(grid), dim3(NWAVES * 64), LDS_BYTES, stream, a); }
#else
    a.ph_lo = 0; a.ph_hi = N_PHASES; a.li = 0;
    hipLaunchKernelGGL(hawk_fwd, dim3(grid), dim3(NWAVES * 64), LDS_BYTES, stream, a);
#endif
    const hipError_t le = hipPeekAtLastError();
    if (le != hipSuccess) fprintf(stderr, "kernel_launch: launch failed: %s\n", hipGetErrorName(le));
}
```
